# Optimizing an MI355X kernel written in HIP

```python
import jax
import jax.numpy as jnp
from jax import lax
import numpy as np

D_MODEL = 1024
BATCH = 8
SEQ = 4096
DEPTH = 4

CHUNK = 64
N_EVEN = (DEPTH + 1) // 2
N_ODD = DEPTH // 2
DEEPNORM_ALPHA = (2 * DEPTH) ** 0.25
DEEPNORM_BETA = (8 * DEPTH) ** -0.25
LN_EPS = 1e-5
RMS_EPS = 1e-6

A_BLOCK = 128
A_GROUPS = 4
A_WIDTH = D_MODEL // 2
A_GROUP_DIM = A_WIDTH // A_GROUPS

B_HEADS = 4
B_HEAD_DIM = D_MODEL // 8
B_WIDTH = B_HEADS * B_HEAD_DIM
CONV_K = 4

EVEN_SPLITS = (A_WIDTH, A_WIDTH, B_WIDTH, B_WIDTH, B_WIDTH, B_WIDTH, B_HEADS, B_HEADS)
EVEN_IN = sum(EVEN_SPLITS)
EVEN_MIX = A_WIDTH + B_WIDTH

C_HEADS = 8
C_NOPE = 128
C_ROPE = 64
C_V = D_MODEL // C_HEADS
Q_LORA = 3 * D_MODEL // 8
KV_LORA = D_MODEL // 4
ODD_IN = Q_LORA + KV_LORA + C_ROPE
ROPE_THETA = 10000.0
Q_BLOCK = 128

N_EXPERTS = 32
TOP_K = 4
D_FF = D_MODEL
SWIGLU_LIMIT = 7.0
SWIGLU_ALPHA = 1.702
EXPERT_BLOCK = 512

kernel_name = 'hybrid_gmlp_gdn_mla_moe_deepnorm'


def layer_norm(x, g, b):
    xf = x.astype(jnp.float32)
    mu = jnp.mean(xf, axis=-1, keepdims=True)
    var = jnp.mean(jnp.square(xf - mu), axis=-1, keepdims=True)
    return ((xf - mu) * lax.rsqrt(var + LN_EPS) * g + b).astype(x.dtype)


def rms_norm(x, g):
    xf = x.astype(jnp.float32)
    return (xf * lax.rsqrt(jnp.mean(xf * xf, axis=-1, keepdims=True) + RMS_EPS) * g).astype(x.dtype)


def l2_normalize(x):
    return x * lax.rsqrt(jnp.sum(x * x, axis=-1, keepdims=True) + RMS_EPS)


def split_columns(h, sizes):
    return jnp.split(h, np.cumsum(sizes)[:-1].tolist(), axis=-1)


def spatial_gating(u, v, ln_g, ln_b, w_s, b_s):
    bsz, seq, _ = u.shape
    n_blk = seq // A_BLOCK
    u = jax.nn.gelu(u, approximate=False)
    v = jax.nn.gelu(v, approximate=False).reshape(bsz, seq, A_GROUPS, A_GROUP_DIM)
    v = layer_norm(v, ln_g.reshape(A_GROUPS, A_GROUP_DIM), ln_b.reshape(A_GROUPS, A_GROUP_DIM))
    pos_chunk = jnp.arange(A_BLOCK) // CHUNK
    allowed = pos_chunk[None, :] <= pos_chunk[:, None]
    w = jnp.where(allowed[None], w_s, 0)
    v = v.reshape(bsz, n_blk, A_BLOCK, A_GROUPS, A_GROUP_DIM)
    mixed = jnp.einsum('gij,bnjgc->bnigc', w, v) + b_s.T[:, :, None]
    return u * mixed.reshape(bsz, seq, A_WIDTH)


def causal_depthwise_conv(x, w):
    xp = jnp.pad(x, ((0, 0), (CONV_K - 1, 0), (0, 0)))
    return lax.conv_general_dilated(xp, w[:, None, :].astype(x.dtype), window_strides=(1,), padding='VALID',
                                    dimension_numbers=('NWC', 'WIO', 'NWC'), feature_group_count=x.shape[-1])


def chunked_gated_delta_rule(q, k, v, g, beta):
    bsz, nh, seq, dk = q.shape
    dv = v.shape[-1]
    n_chunks = seq // CHUNK

    def to_chunks(t):
        return t.reshape(bsz, nh, n_chunks, CHUNK, *t.shape[3:])

    q, k, v, g, beta = (to_chunks(t) for t in (q, k, v, g, beta))
    g = jnp.cumsum(g, axis=-1)
    idx = jnp.arange(CHUNK)
    incl = idx[:, None] >= idx[None, :]
    strict = idx[:, None] > idx[None, :]
    decay = jnp.exp(jnp.where(incl, g[..., :, None] - g[..., None, :], -jnp.inf))
    k_beta = k * beta[..., None]
    lower = jnp.where(strict, jnp.einsum('bhncd,bhnmd->bhncm', k_beta, k) * decay, 0.0)
    eye = jnp.eye(CHUNK, dtype=jnp.float32)
    t_mat = lax.linalg.triangular_solve(eye + lower, jnp.broadcast_to(eye, lower.shape),
                                        left_side=True, lower=True, unit_diagonal=True)
    u = t_mat @ (v * beta[..., None])
    w = t_mat @ (k_beta * jnp.exp(g)[..., None])
    intra = jnp.where(incl, jnp.einsum('bhncd,bhnmd->bhncm', q, k) * decay, 0.0)
    q_dec = q * jnp.exp(g)[..., None]
    g_last = g[..., -1]
    k_dec = k * jnp.exp(g_last[..., None] - g)[..., None]

    def step(state, inp):
        u_c, w_c, intra_c, q_c, k_c, gl_c = inp
        v_new = u_c - w_c @ state
        out = q_c @ state + intra_c @ v_new
        state = state * jnp.exp(gl_c)[..., None, None] + jnp.swapaxes(k_c, -1, -2) @ v_new
        return state, out

    xs = tuple(jnp.moveaxis(t, 2, 0) for t in (u, w, intra, q_dec, k_dec, g_last))
    state0 = jnp.zeros((bsz, nh, dk, dv), jnp.float32)
    _, out = lax.scan(step, state0, xs)
    return jnp.moveaxis(out, 0, 2).reshape(bsz, nh, seq, dv)


def gated_deltanet(q, k, v, a, b, z, conv_w, a_log, dt_bias, norm_w):
    bsz, seq, _ = q.shape
    qkv = jax.nn.silu(causal_depthwise_conv(jnp.concatenate([q, k, v], axis=-1), conv_w))
    q, k, v = jnp.split(qkv, 3, axis=-1)

    def heads(t):
        return t.reshape(bsz, seq, B_HEADS, B_HEAD_DIM).transpose(0, 2, 1, 3).astype(jnp.float32)

    q = l2_normalize(heads(q)) * (B_HEAD_DIM ** -0.5)
    k = l2_normalize(heads(k))
    v = heads(v)
    beta = jax.nn.sigmoid(b.astype(jnp.float32)).transpose(0, 2, 1)
    g = (-jnp.exp(a_log.astype(jnp.float32)) * jax.nn.softplus(a.astype(jnp.float32) + dt_bias)).transpose(0, 2, 1)
    o = chunked_gated_delta_rule(q, k, v, g, beta).transpose(0, 2, 1, 3)
    gate = jax.nn.silu(z.reshape(bsz, seq, B_HEADS, B_HEAD_DIM).astype(jnp.float32))
    o = rms_norm(o, norm_w) * gate
    return o.reshape(bsz, seq, B_WIDTH).astype(z.dtype)


def even_mixer(x, w_in, sgu_ln_g, sgu_ln_b, sgu_w, sgu_b, conv_w, a_log, dt_bias, gdn_norm, w_out):
    a_u, a_v, b_q, b_k, b_v, b_z, b_a, b_b = split_columns(x @ w_in, EVEN_SPLITS)
    y_a = spatial_gating(a_u, a_v, sgu_ln_g, sgu_ln_b, sgu_w, sgu_b)
    y_b = gated_deltanet(b_q, b_k, b_v, b_a, b_b, b_z, conv_w, a_log, dt_bias, gdn_norm)
    return jnp.concatenate([y_a, y_b], axis=-1) @ w_out


def rope_tables(seq):
    inv_freq = ROPE_THETA ** (-jnp.arange(0, C_ROPE, 2, dtype=jnp.float32) / C_ROPE)
    ang = jnp.arange(seq, dtype=jnp.float32)[:, None] * inv_freq[None, :]
    return jnp.cos(ang), jnp.sin(ang)


def apply_rope(x, cos, sin):
    x1, x2 = jnp.split(x, 2, axis=-1)
    c = cos[None, :, None, :]
    s = sin[None, :, None, :]
    return jnp.concatenate([x1 * c - x2 * s, x1 * s + x2 * c], axis=-1).astype(x.dtype)


def chunk_causal_attention(q, k, v, scale):
    seq = q.shape[2]
    outs = []
    for blk in range(seq // Q_BLOCK):
        q0 = blk * Q_BLOCK
        k_end = q0 + Q_BLOCK
        s = jnp.einsum('bhqd,bhkd->bhqk', q[:, :, q0:k_end], k[:, :, :k_end]).astype(jnp.float32) * scale
        q_chunk = (q0 + jnp.arange(Q_BLOCK)) // CHUNK
        k_chunk = jnp.arange(k_end) // CHUNK
        s = jnp.where(k_chunk[None, :] <= q_chunk[:, None], s, -jnp.inf)
        p = jax.nn.softmax(s, axis=-1).astype(v.dtype)
        outs.append(jnp.einsum('bhqk,bhkd->bhqd', p, v[:, :, :k_end]))
    return jnp.concatenate(outs, axis=2)


def odd_mixer(x, w_in, q_norm, w_uq, kv_norm, w_ukv, w_out, cos, sin):
    bsz, seq, _ = x.shape
    c_q, c_kv, k_pe = split_columns(x @ w_in, (Q_LORA, KV_LORA, C_ROPE))
    q = (rms_norm(c_q, q_norm) @ w_uq).reshape(bsz, seq, C_HEADS, C_NOPE + C_ROPE)
    q = jnp.concatenate([q[..., :C_NOPE], apply_rope(q[..., C_NOPE:], cos, sin)], axis=-1)
    kv = (rms_norm(c_kv, kv_norm) @ w_ukv).reshape(bsz, seq, C_HEADS, C_NOPE + C_V)
    k_pe = apply_rope(k_pe[:, :, None, :], cos, sin)
    k = jnp.concatenate([kv[..., :C_NOPE], jnp.broadcast_to(k_pe, (bsz, seq, C_HEADS, C_ROPE))], axis=-1)
    v = kv[..., C_NOPE:]
    o = chunk_causal_attention(q.transpose(0, 2, 1, 3), k.transpose(0, 2, 1, 3), v.transpose(0, 2, 1, 3),
                               (C_NOPE + C_ROPE) ** -0.5)
    return o.transpose(0, 2, 1, 3).reshape(bsz, seq, C_HEADS * C_V) @ w_out


def clamped_swiglu(h):
    glu = jnp.minimum(h[..., ::2], SWIGLU_LIMIT)
    lin = jnp.clip(h[..., 1::2], -SWIGLU_LIMIT, SWIGLU_LIMIT)
    return glu * jax.nn.sigmoid(SWIGLU_ALPHA * glu) * (lin + 1.0)


def moe_ffn(x, w_router, b_router, w_gate_up, b_gate_up, w_down, b_down):
    bsz, seq, d = x.shape
    xt = x.reshape(-1, d)
    n_tok = xt.shape[0]
    n_assign = n_tok * TOP_K
    logits = (xt @ w_router + b_router).astype(jnp.float32)
    top_logit, top_e = lax.top_k(logits, TOP_K)
    gate = jax.nn.softmax(top_logit, axis=-1)
    e_flat = top_e.reshape(-1)
    order = jnp.argsort(e_flat)
    e_sorted = e_flat[order]
    tok_sorted = (order // TOP_K).astype(jnp.int32)
    gate_sorted = gate.reshape(-1)[order]
    counts = jnp.bincount(e_flat, length=N_EXPERTS)
    padded = (counts + EXPERT_BLOCK - 1) // EXPERT_BLOCK * EXPERT_BLOCK
    start = jnp.cumsum(counts) - counts
    pad_end = jnp.cumsum(padded)
    pad_start = pad_end - padded
    dest = pad_start[e_sorted] + jnp.arange(n_assign) - start[e_sorted]
    n_blocks = -(-n_assign // EXPERT_BLOCK) + N_EXPERTS
    slots = n_blocks * EXPERT_BLOCK
    tok_buf = jnp.full((slots,), n_tok, jnp.int32).at[dest].set(tok_sorted)
    gate_buf = jnp.zeros((slots,), jnp.float32).at[dest].set(gate_sorted)
    block_expert = jnp.minimum(jnp.searchsorted(pad_end, jnp.arange(n_blocks) * EXPERT_BLOCK, side='right'),
                               N_EXPERTS - 1)
    x_pad = jnp.concatenate([xt, jnp.zeros((1, d), xt.dtype)], axis=0)

    def run_block(args):
        tok, gt, e = args
        h = x_pad[tok] @ w_gate_up[e] + b_gate_up[e]
        y = clamped_swiglu(h) @ w_down[e] + b_down[e]
        return y * gt[:, None].astype(y.dtype)

    y = lax.map(run_block, (tok_buf.reshape(n_blocks, EXPERT_BLOCK), gate_buf.reshape(n_blocks, EXPERT_BLOCK),
                            block_expert))
    out = jax.ops.segment_sum(y.reshape(slots, d), tok_buf, num_segments=n_tok + 1)[:n_tok]
    return out.reshape(bsz, seq, d)


def setup_inputs(seed: int = 0) -> dict:
    key = jax.random.key(seed)
    ks = jax.random.split(key, 32)

    def nrm(k, shape, scale):
        return jax.random.normal(k, shape, jnp.float32) * scale

    def gain(k, shape):
        return 1.0 + nrm(k, shape, 0.02)

    dt = jnp.exp(jax.random.uniform(ks[8], (N_EVEN, B_HEADS), jnp.float32, np.log(1e-3), np.log(1e-1)))
    return {
        'x': nrm(ks[0], (BATCH, SEQ, D_MODEL), 1.0),
        'even_w_in': nrm(ks[1], (N_EVEN, D_MODEL, EVEN_IN), D_MODEL ** -0.5),
        'even_sgu_ln_g': gain(ks[2], (N_EVEN, A_WIDTH)),
        'even_sgu_ln_b': nrm(ks[3], (N_EVEN, A_WIDTH), 0.02),
        'even_sgu_w': nrm(ks[4], (N_EVEN, A_GROUPS, A_BLOCK, A_BLOCK), A_BLOCK ** -0.5),
        'even_sgu_b': gain(ks[5], (N_EVEN, A_GROUPS, A_BLOCK)),
        'even_conv_w': nrm(ks[6], (N_EVEN, CONV_K, 3 * B_WIDTH), CONV_K ** -0.5),
        'even_a_log': jnp.log(jax.random.uniform(ks[7], (N_EVEN, B_HEADS), jnp.float32, 1.0, 16.0)),
        'even_dt_bias': dt + jnp.log(-jnp.expm1(-dt)),
        'even_gdn_norm': gain(ks[9], (N_EVEN, B_HEAD_DIM)),
        'even_w_out': nrm(ks[10], (N_EVEN, EVEN_MIX, D_MODEL), EVEN_MIX ** -0.5 * DEEPNORM_BETA),
        'odd_w_in': nrm(ks[11], (N_ODD, D_MODEL, ODD_IN), D_MODEL ** -0.5),
        'odd_q_norm': gain(ks[12], (N_ODD, Q_LORA)),
        'odd_w_uq': nrm(ks[13], (N_ODD, Q_LORA, C_HEADS * (C_NOPE + C_ROPE)), Q_LORA ** -0.5),
        'odd_kv_norm': gain(ks[14], (N_ODD, KV_LORA)),
        'odd_w_ukv': nrm(ks[15], (N_ODD, KV_LORA, C_HEADS * (C_NOPE + C_V)), KV_LORA ** -0.5),
        'odd_w_out': nrm(ks[16], (N_ODD, C_HEADS * C_V, D_MODEL), (C_HEADS * C_V) ** -0.5 * DEEPNORM_BETA),
        'ln_mix_g': gain(ks[17], (DEPTH, D_MODEL)),
        'ln_mix_b': nrm(ks[18], (DEPTH, D_MODEL), 0.02),
        'ln_ffn_g': gain(ks[19], (DEPTH, D_MODEL)),
        'ln_ffn_b': nrm(ks[20], (DEPTH, D_MODEL), 0.02),
        'moe_w_router': nrm(ks[21], (DEPTH, D_MODEL, N_EXPERTS), D_MODEL ** -0.5),
        'moe_b_router': nrm(ks[22], (DEPTH, N_EXPERTS), 0.01),
        'moe_w_gate_up': nrm(ks[23], (DEPTH, N_EXPERTS, D_MODEL, 2 * D_FF), D_MODEL ** -0.5),
        'moe_b_gate_up': nrm(ks[24], (DEPTH, N_EXPERTS, 2 * D_FF), 0.02),
        'moe_w_down': nrm(ks[25], (DEPTH, N_EXPERTS, D_FF, D_MODEL), D_FF ** -0.5 * DEEPNORM_BETA),
        'moe_b_down': nrm(ks[26], (DEPTH, N_EXPERTS, D_MODEL), 0.02),
    }


def reference(x, even_w_in, even_sgu_ln_g, even_sgu_ln_b, even_sgu_w, even_sgu_b, even_conv_w, even_a_log,
              even_dt_bias, even_gdn_norm, even_w_out, odd_w_in, odd_q_norm, odd_w_uq, odd_kv_norm, odd_w_ukv,
              odd_w_out, ln_mix_g, ln_mix_b, ln_ffn_g, ln_ffn_b, moe_w_router, moe_b_router, moe_w_gate_up,
              moe_b_gate_up, moe_w_down, moe_b_down):
    cos, sin = rope_tables(x.shape[1])
    for layer in range(DEPTH):
        i = layer // 2
        if layer % 2 == 0:
            mix = even_mixer(x, even_w_in[i], even_sgu_ln_g[i], even_sgu_ln_b[i], even_sgu_w[i], even_sgu_b[i],
                             even_conv_w[i], even_a_log[i], even_dt_bias[i], even_gdn_norm[i], even_w_out[i])
        else:
            mix = odd_mixer(x, odd_w_in[i], odd_q_norm[i], odd_w_uq[i], odd_kv_norm[i], odd_w_ukv[i],
                            odd_w_out[i], cos, sin)
        x = layer_norm(DEEPNORM_ALPHA * x + mix, ln_mix_g[layer], ln_mix_b[layer])
        ffn = moe_ffn(x, moe_w_router[layer], moe_b_router[layer], moe_w_gate_up[layer], moe_b_gate_up[layer],
                      moe_w_down[layer], moe_b_down[layer])
        x = layer_norm(DEEPNORM_ALPHA * x + ffn, ln_ffn_g[layer], ln_ffn_b[layer])
    return x
```

```cpp
#define MK_PER_PHASE 0
#include <hip/hip_runtime.h>
#include <cstdio>
#include <cstdint>

#define GAS __attribute__((address_space(1)))
#define LAS __attribute__((address_space(3)))
typedef unsigned short bf16;
typedef short bf16x8 __attribute__((ext_vector_type(8)));
typedef short s16x4 __attribute__((ext_vector_type(4)));
typedef float f32x2 __attribute__((ext_vector_type(2)));
typedef float f32x4 __attribute__((ext_vector_type(4)));
typedef float f32x16 __attribute__((ext_vector_type(16)));
typedef unsigned u32x2 __attribute__((ext_vector_type(2)));
typedef unsigned u32x4 __attribute__((ext_vector_type(4)));
typedef GAS unsigned gu32;

typedef __bf16 bf16v2_t __attribute__((ext_vector_type(2)));
__device__ __forceinline__ unsigned cvt_pk_bf16(float lo, float hi) { const bf16v2_t v = __builtin_convertvector((f32x2){lo, hi}, bf16v2_t); return __builtin_bit_cast(unsigned, v); }
__device__ __forceinline__ float bf_lo(unsigned w) { return __uint_as_float(w << 16); }
__device__ __forceinline__ float bf_hi(unsigned w) { return __uint_as_float(w & 0xffff0000u); }
__device__ __forceinline__ float bf2f(bf16 b) { return __uint_as_float(((unsigned)b) << 16); }
__device__ __forceinline__ bf16 f2bf(float f) { return (bf16)(cvt_pk_bf16(f, 0.f) & 0xffffu); }
__device__ __forceinline__ float wave_sum(float v) {
#pragma unroll
    for (int o = 1; o < 64; o <<= 1) v += __shfl_xor(v, o);
    return v;
}

namespace pg8 {
constexpr int BM = 256, BK = 64, HALF = 128, HTB = HALF * BK * 2, STAGE_BYTES = 8 * HTB, NXCD = 8, WGM = 8;
__host__ __device__ __forceinline__ int lds_byte(int r, int c) { const int st = (r >> 4) * 2 + (c >> 5), rr = r & 15, cc = c & 31, ob = rr * 64 + cc * 2; return st * 1024 + (ob ^ (((ob >> 9) & 1) << 5)); }
__host__ __device__ __forceinline__ void stage_rc(int b, int& R, int& C) { const int st = b / 1024, sb = b % 1024, swz = sb ^ (((sb >> 9) & 1) << 5); R = (st >> 1) * 16 + swz / 64; C = (st & 1) * 32 + (swz % 64) / 2; }
__host__ __device__ __forceinline__ int perm32(int rho) { const int n = rho >> 4, i = rho & 15; return 8 * (i >> 2) + 4 * n + (i & 3); }

struct Unit { int pm, pn, e, li; };

struct StaticOrder {
    int nM, nN, nwg, G, c;
    __device__ void init(int M, int N, int G_, int c_) { nM = M / BM; nN = N / BM; nwg = nM * nN; G = G_; c = c_; }
    __device__ bool next(int i, Unit& u) const {
        const long L = (long)i * G + c; if (L >= nwg) return false;
        int wgid = (int)L; { const int q = nwg / NXCD, r = nwg % NXCD, xcd = wgid % NXCD, off = wgid / NXCD; wgid = (xcd < r ? xcd * (q + 1) : r * (q + 1) + (xcd - r) * q) + off; }
        const int nig = WGM * nN, gid = wgid / nig, fm = gid * WGM, gsz = (nM - fm) < WGM ? (nM - fm) : WGM;
        u.pm = fm + ((wgid % nig) % gsz); u.pn = (wgid % nig) / gsz; u.e = 0; u.li = 0; return true;
    }
};
struct PlainSched {
    static constexpr bool GATHER = false;
    StaticOrder o; const char* Bt; int K; int lda;
    __device__ __forceinline__ size_t arow0(const Unit& u) const { return (size_t)u.pm * BM * lda * 2; }
    __device__ __forceinline__ bool next(int i, Unit& u) const { return o.next(i, u); }
    __device__ __forceinline__ const char* bbase(const Unit& u) const { return Bt + (size_t)u.pn * BM * K * 2; }
};

__device__ __forceinline__ f32x2 gelu_pk(f32x2 v) {
    const f32x2 av = __builtin_elementwise_abs(v), d = av * 0.2316418882f + 1.0f;
    f32x2 t; t.x = __builtin_amdgcn_rcpf(d.x); t.y = __builtin_amdgcn_rcpf(d.y);
    f32x2 q = t * 0.5307027145f + (-0.7265760135f); q = q * t + 0.7107068705f; q = q * t + (-0.142248368f); q = q * t + 0.127414796f; q = q * t;
    const f32x2 s = (v * v) * (-0.72134752044f);
    f32x2 e; e.x = __builtin_amdgcn_exp2f(s.x); e.y = __builtin_amdgcn_exp2f(s.y);
    const f32x2 m = v * (q * e), r = v - m;
    f32x2 o; o.x = v.x < 0.f ? m.x : r.x; o.y = v.y < 0.f ? m.y : r.y; return o;
}

template <class Epi, class Sched, bool ALIGN_EPI>
__device__ __forceinline__ void gemm_phase(LAS unsigned char* lds, const char* Abase, int K, const Sched& S, const Epi& E) {
    int tid_ = threadIdx.x; asm volatile("" : "+v"(tid_));
    const int tid = tid_, wid = __builtin_amdgcn_readfirstlane(tid >> 6), lane = tid & 63, wr = wid >> 2, wc = wid & 3, fr = lane & 15, fq = lane >> 4;
    int nt = K / BK; asm volatile("" : "+s"(nt));
    int Rr[2], Cc[2]; unsigned voffB[2], voffA[2];
#pragma unroll
    for (int i = 0; i < 2; ++i) { stage_rc(tid * 16 + i * 8192, Rr[i], Cc[i]); const int Rb = Epi::PERM ? ((Rr[i] & ~31) + perm32(Rr[i] & 31)) : Rr[i]; voffB[i] = (unsigned)(Rb * K + Cc[i]) * 2u;
        voffA[i] = 0u; if constexpr (!Sched::GATHER) voffA[i] = (unsigned)(Rr[i] * S.lda + Cc[i]) * 2u; }
    const size_t hstepA = (size_t)HALF * S.lda * 2;
    const size_t kstep = (size_t)(BK * 2);
    const size_t hstepB = (size_t)HALF * K * 2;
    const unsigned ldsw = (unsigned)wid * 1024u;
    const int aoff = lds_byte(wr * 64 + fr, fq * 8), boff = lds_byte(wc * 32 + fr, fq * 8);
#define PG8_SA(b, h) (((b) * 2 + (h)) * HTB)
#define PG8_SB(b, h) ((4 + (b) * 2 + (h)) * HTB)
#define PG8_STAGEB(bufoff, gbase) do { _Pragma("unroll") for (int _i = 0; _i < 2; ++_i) \
        __builtin_amdgcn_global_load_lds((const unsigned*)((const char*)(gbase) + voffB[_i]), (LAS unsigned*)(lds + (bufoff) + ldsw + _i * 8192), 16, 0, 0); } while (0)
#define PG8_STAGEA(bufoff, h, koff) do { _Pragma("unroll") for (int _i = 0; _i < 2; ++_i) { \
        if constexpr (Sched::GATHER) __builtin_amdgcn_global_load_lds((const unsigned*)(Abase + (size_t)va[h][_i] + (koff)), (LAS unsigned*)(lds + (bufoff) + ldsw + _i * 8192), 16, 0, 0); \
        else __builtin_amdgcn_global_load_lds((const unsigned*)(cA + (h) * hstepA + (koff) + voffA[_i]), (LAS unsigned*)(lds + (bufoff) + ldsw + _i * 8192), 16, 0, 0); } } while (0)
#define PG8_LDA(dst, b, h) do { _Pragma("unroll") for (int m = 0; m < 4; ++m) _Pragma("unroll") for (int k = 0; k < 2; ++k) dst[m][k] = *(const LAS bf16x8*)(lds + PG8_SA(b, h) + aoff + m * 2048 + k * 1024); } while (0)
#define PG8_LDB(dst, b, h) do { _Pragma("unroll") for (int n = 0; n < 2; ++n) _Pragma("unroll") for (int k = 0; k < 2; ++k) dst[n][k] = *(const LAS bf16x8*)(lds + PG8_SB(b, h) + boff + n * 2048 + k * 1024); } while (0)
#define PG8_MMA(ai, bj, At, Bt) do { __builtin_amdgcn_s_setprio(1); _Pragma("unroll") for (int m = 0; m < 4; ++m) _Pragma("unroll") for (int n = 0; n < 2; ++n) _Pragma("unroll") for (int k = 0; k < 2; ++k) \
        acc[ai][bj][m][n] = __builtin_amdgcn_mfma_f32_16x16x32_bf16(Bt[n][k], At[m][k], acc[ai][bj][m][n], 0, 0, 0); __builtin_amdgcn_s_setprio(0); } while (0)
#define PG8_WAIT_V(n) asm volatile("s_waitcnt vmcnt(" #n ")" ::: "memory")
#define PG8_WAIT_L(n) asm volatile("s_waitcnt lgkmcnt(" #n ")" ::: "memory")
#define PG8_BAR __builtin_amdgcn_s_barrier()
#define PG8_SCHED __builtin_amdgcn_sched_barrier(0)
    Unit cur, nxt; int ui = 0;
    if (!S.next(0, cur)) return;
    f32x4 acc[2][2][4][2];
#pragma unroll
    for (int a = 0; a < 2; ++a)
#pragma unroll
        for (int b = 0; b < 2; ++b)
#pragma unroll
            for (int m = 0; m < 4; ++m)
#pragma unroll
                for (int n = 0; n < 2; ++n) acc[a][b][m][n] = (f32x4){0.f, 0.f, 0.f, 0.f};
    bf16x8 At[4][2], B0[2][2], B1[2][2];
    unsigned va[2][2], vn[2][2]; const char* cA = Abase; const char* nA = Abase;
    if constexpr (Sched::GATHER) {
#pragma unroll
        for (int h = 0; h < 2; ++h)
#pragma unroll
            for (int i = 0; i < 2; ++i) va[h][i] = S.aoff(cur, h * HALF + Rr[i]) + (unsigned)Cc[i] * 2u;
    } else { cA = Abase + S.arow0(cur); }
    const char* cB = S.bbase(cur);
    PG8_STAGEB(PG8_SB(0, 0), cB); PG8_STAGEB(PG8_SB(0, 1), cB + hstepB); PG8_STAGEA(PG8_SA(0, 0), 0, 0); PG8_STAGEA(PG8_SA(0, 1), 1, 0);
    if (wr == 1) PG8_BAR;
    PG8_WAIT_V(2); PG8_BAR;
    PG8_STAGEB(PG8_SB(1, 0), cB + kstep); PG8_STAGEA(PG8_SA(1, 0), 0, kstep); PG8_STAGEB(PG8_SB(1, 1), cB + hstepB + kstep);
    PG8_WAIT_V(6); PG8_BAR;
    for (;;) {
        const bool has_next = S.next(ui + 1, nxt);
        const char* nB = has_next ? S.bbase(nxt) : cB;
        if constexpr (Sched::GATHER) {
            if (has_next) {
#pragma unroll
                for (int h = 0; h < 2; ++h)
#pragma unroll
                    for (int i = 0; i < 2; ++i) vn[h][i] = S.aoff(nxt, h * HALF + Rr[i]) + (unsigned)Cc[i] * 2u;
            } else {
#pragma unroll
                for (int h = 0; h < 2; ++h)
#pragma unroll
                    for (int i = 0; i < 2; ++i) vn[h][i] = va[h][i];
            }
        } else { nA = has_next ? Abase + S.arow0(nxt) : cA; }
        for (int t = 0; t < nt; t += 2) {
            const bool last = (t == nt - 2);
            const size_t k1 = (size_t)(t + 1) * kstep;
            PG8_LDB(B0, 0, 0); PG8_LDB(B1, 0, 1); PG8_SCHED; PG8_LDA(At, 0, 0); PG8_STAGEA(PG8_SA(1, 1), 1, k1);
            PG8_WAIT_V(8); PG8_WAIT_L(0); PG8_BAR; PG8_MMA(0, 0, At, B0); PG8_MMA(0, 1, At, B1); PG8_BAR; PG8_SCHED;
            if (last) {
                if constexpr (Sched::GATHER) {
#pragma unroll
                    for (int h = 0; h < 2; ++h)
#pragma unroll
                        for (int i = 0; i < 2; ++i) va[h][i] = vn[h][i];
                } else { cA = nA; }
            }
            const char* bX = last ? nB : cB;
            const size_t k2 = last ? (size_t)0 : (size_t)(t + 2) * kstep, k3 = k2 + kstep;
            PG8_LDA(At, 0, 1); PG8_STAGEB(PG8_SB(0, 0), bX + k2); PG8_STAGEB(PG8_SB(0, 1), bX + hstepB + k2); PG8_STAGEA(PG8_SA(0, 0), 0, k2);
            PG8_WAIT_V(8); PG8_WAIT_L(0); PG8_BAR; PG8_MMA(1, 0, At, B0); PG8_MMA(1, 1, At, B1); PG8_BAR; PG8_SCHED;
            PG8_LDB(B0, 1, 0); PG8_LDB(B1, 1, 1); PG8_SCHED; PG8_LDA(At, 1, 0); PG8_STAGEA(PG8_SA(0, 1), 1, k2);
            PG8_WAIT_V(8); PG8_WAIT_L(0); PG8_BAR; PG8_MMA(0, 0, At, B0); PG8_MMA(0, 1, At, B1); PG8_BAR; PG8_SCHED;
            PG8_LDA(At, 1, 1); PG8_STAGEB(PG8_SB(1, 0), bX + k3); PG8_STAGEB(PG8_SB(1, 1), bX + hstepB + k3); PG8_STAGEA(PG8_SA(1, 0), 0, k3);
            PG8_WAIT_V(8); PG8_WAIT_L(0); PG8_BAR; PG8_MMA(1, 0, At, B0); PG8_MMA(1, 1, At, B1); PG8_BAR; PG8_SCHED;
        }
        if constexpr (ALIGN_EPI) { if (wr == 0) PG8_BAR; }
        E(acc, cur, wr, wc, fr, fq);
        if (!has_next) break;
#pragma unroll
        for (int a = 0; a < 2; ++a)
#pragma unroll
            for (int b = 0; b < 2; ++b)
#pragma unroll
                for (int m = 0; m < 4; ++m)
#pragma unroll
                    for (int n = 0; n < 2; ++n) acc[a][b][m][n] = (f32x4){0.f, 0.f, 0.f, 0.f};
        cur = nxt; cB = nB; ++ui;
        if constexpr (ALIGN_EPI) { if (wr == 1) PG8_BAR; }
    }
    PG8_WAIT_V(0);
    if constexpr (!ALIGN_EPI) { if (wr == 0) PG8_BAR; }
    PG8_BAR;
#undef PG8_SA
#undef PG8_SB
#undef PG8_STAGEA
#undef PG8_STAGEB
#undef PG8_LDA
#undef PG8_LDB
#undef PG8_MMA
#undef PG8_WAIT_V
#undef PG8_WAIT_L
#undef PG8_BAR
#undef PG8_SCHED
}
}

constexpr int NWAVES = 8;
constexpr int BATCH = 8, SEQ = 4096, DM = 1024, DEPTH = 4;
constexpr int T = BATCH * SEQ;
constexpr int EVEN_IN = 3080, EVEN_N = 3072;
constexpr int ODD_IN = 704, ODD_N = 768, QL = 384, KVL = 256;
constexpr int NEXP = 32, TOPK = 4, DFF = 1024;
constexpr int NSLOT = T * TOPK;
constexpr int LCAP = T;
constexpr float LN_EPS = 1e-5f, RMS_EPS = 1e-6f;
constexpr float DN_ALPHA = 1.681792830507429f;
constexpr float ATT_SCALE = 0.07216878364870323f;

constexpr size_t MiB = 1u << 20;
constexpr size_t WS_CTL = 0, CTL_ZERO_BYTES = 1 * MiB;
constexpr size_t WS_WGU = 16 * MiB, WS_WDN = 528 * MiB, WS_WEIN = 784 * MiB, WS_WEOUT = 796 * MiB, WS_WOIN = 800 * MiB, WS_WUQ = 804 * MiB, WS_WUKV = 808 * MiB, WS_WOOUT = 810 * MiB;
constexpr size_t WS_ROPE = 814 * MiB, WS_AB = 815 * MiB, WS_RS = 816 * MiB, WS_GATE = 817 * MiB, WS_LIST = 818 * MiB, WS_GAM = 822 * MiB;
constexpr size_t WS_XF = 832 * MiB, WS_XB = 960 * MiB, WS_Y = 1024 * MiB, WS_ARENA = 1152 * MiB, WS_MIX = 1440 * MiB;
constexpr size_t WS_GM = 1504 * MiB, WS_GB = 1568 * MiB, WS_GC = 1632 * MiB, WS_GD = 1664 * MiB, WS_GS = 1696 * MiB, WS_HID = 1760 * MiB, WS_YE = 2016 * MiB, WS_END = 2272 * MiB;
constexpr size_t AR_C1 = 0, AR_Q = 48 * MiB, AR_KV = 144 * MiB, AR_KPE = 272 * MiB;
constexpr int CW_TMO = 0, CW_CODE = 1, CW_BAR = 4096, CW_CNT = 16384;

constexpr int LDS_BYTES = 163840;
constexpr int LDS_CTL_OFF = 163840 - 512;
constexpr int LDS_SPARE = 131072;

#define RLX_AGENT __ATOMIC_RELAXED, __HIP_MEMORY_SCOPE_AGENT
#define LDS_WAIT() asm volatile("s_waitcnt lgkmcnt(0)" ::: "memory")
#define VM_WAIT() asm volatile("s_waitcnt vmcnt(0)" ::: "memory")

#define XB_TMO      128
#define XB_XCNT(j)  (256  + 64 * (j))
#define XB_XSUB(j)  (1280 + 64 * (j))
#define XB_XGEN(j)  (2304 + 64 * (j))
#define XB_TOP      3328
#define XB_TOPGEN   3392
#define XCD_BAR_WORDS 3456
#define XB_SPIN_CAP (1u << 18)
__device__ __forceinline__ unsigned xb_ld(unsigned* p)              { return __hip_atomic_load(p, __ATOMIC_RELAXED, __HIP_MEMORY_SCOPE_AGENT); }
__device__ __forceinline__ unsigned xb_add(unsigned* p, unsigned v) { return __hip_atomic_fetch_add(p, v, __ATOMIC_RELAXED, __HIP_MEMORY_SCOPE_AGENT); }
__device__ __forceinline__ unsigned xb_xcc_id() { return (unsigned)__builtin_amdgcn_s_getreg((3 << 11) | 20) & 0xFu; }
#define XB_SPIN(cond, bar) do { unsigned _sp = 0; while (cond) { __builtin_amdgcn_s_sleep(1); \
    if ((++_sp & 255u) == 0u) { if (xb_ld(&(bar)[XB_TMO])) break; if (_sp > XB_SPIN_CAP) { atomicAdd(&(bar)[XB_TMO], 1u); break; } } } } while (0)
struct XcdBarrier { unsigned* bar; unsigned x; volatile LAS unsigned* st; };
__device__ __forceinline__ XcdBarrier xcd_barrier_post(unsigned* bar, volatile LAS unsigned* st) {
    XcdBarrier b; b.bar = bar; b.x = xb_xcc_id(); b.st = st;
    if (threadIdx.x == 0) (void)xb_add(&bar[XB_XCNT(b.x)], 1u);
    return b;
}
__device__ __forceinline__ void xcd_barrier_complete(unsigned* bar, unsigned x, unsigned& nloc, unsigned& nx) {
    const unsigned G = gridDim.x * gridDim.y * gridDim.z;
    unsigned sum, cnt, mine, sp = 0u;
    for (;;) {
        sum = 0u; cnt = 0u; mine = 0u;
#pragma unroll
        for (unsigned j = 0; j < 16; ++j) { const unsigned c = xb_ld(&bar[XB_XCNT(j)]); sum += c; cnt += (c > 0u) ? 1u : 0u; mine = (j == x) ? c : mine; }
        if (sum == G) break;
        __builtin_amdgcn_s_sleep(1);
        if ((++sp & 255u) == 0u) { if (xb_ld(&bar[XB_TMO])) break; if (sp > XB_SPIN_CAP) { atomicAdd(&bar[XB_TMO], 1u); break; } }
    }
    nloc = mine > 0u ? mine : 1u; nx = cnt > 0u ? cnt : 1u;
}
__device__ __forceinline__ void xcd_barrier(const XcdBarrier& b) {
    asm volatile("s_waitcnt vmcnt(0)" ::: "memory");
    __syncthreads();
    if (threadIdx.x == 0) {
        unsigned* bar = b.bar;
        __builtin_amdgcn_s_waitcnt(0);
        unsigned nloc = b.st[0], nx = b.st[1];
        if (nloc == 0u) { xcd_barrier_complete(bar, b.x, nloc, nx); b.st[0] = nloc; b.st[1] = nx; }
        const unsigned old = xb_add(&bar[XB_XSUB(b.x)], 1u);
        const unsigned gen = old / nloc;
        if (old + 1u == (gen + 1u) * nloc) {
            __builtin_amdgcn_fence(__ATOMIC_RELEASE, "agent");
            asm volatile("s_waitcnt vmcnt(0)" ::: "memory");
            const unsigned og = xb_add(&bar[XB_TOP], 1u);
            const unsigned tg = og / nx;
            if (og + 1u == (tg + 1u) * nx) xb_add(&bar[XB_TOPGEN], 1u);
            else XB_SPIN(xb_ld(&bar[XB_TOPGEN]) == tg, bar);
            __builtin_amdgcn_fence(__ATOMIC_ACQUIRE, "agent");
            xb_add(&bar[XB_XGEN(b.x)], 1u);
            asm volatile("s_waitcnt vmcnt(0)" ::: "memory");
        } else {
            XB_SPIN(xb_ld(&bar[XB_XGEN(b.x)]) == gen, bar);
            __builtin_amdgcn_fence(__ATOMIC_ACQUIRE, "agent");
            asm volatile("s_waitcnt vmcnt(0)" ::: "memory");
        }
    }
    __syncthreads();
}

struct Ctx {
    LAS unsigned char* lds;
    int tid, lane, wave, G, bid;
    const __attribute__((address_space(4))) char* ka;
    __device__ __forceinline__ const float* inp(int i) const { return ((const float* const __attribute__((address_space(4)))*)ka)[i]; }
    float* out;
    unsigned char* ws;
    unsigned* ctl;
};

__device__ __forceinline__ Ctx phase_ctx(const Ctx& C0) { Ctx C; C.lds = C0.lds; { int g_ = C0.G, b_ = C0.bid; asm volatile("" : "+s"(g_), "+s"(b_)); C.G = g_; C.bid = b_; } int t = threadIdx.x; asm volatile("" : "+v"(t)); C.tid = t; C.lane = t & 63; C.wave = __builtin_amdgcn_readfirstlane(t >> 6);
    const __attribute__((address_space(4))) char* ka = C0.ka; asm volatile("" : "+s"(ka)); C.ka = ka;
    C.out = *(float* const __attribute__((address_space(4)))*)(ka + 216); C.ws = *(unsigned char* const __attribute__((address_space(4)))*)(ka + 224); C.ctl = (unsigned*)C.ws; return C; }

__device__ __forceinline__ int uq_rowmap(int n) { const int h = n / 192, o = n - h * 192; if (o < 128) return n; const int j = o - 128; return h * 192 + 128 + (j < 32 ? 2 * j : 2 * (j - 32) + 1); }
__device__ __forceinline__ void conv_item(const float* W, int ldn, int c0, int nvalid, int K, bf16* WT, const float* kscale, int mode, LAS float* scr, int kb, int nb, int lane) {
    const int k0 = 64 * kb, n0 = 64 * nb;
    const int lc = (lane & 15) * 4, lr = lane >> 4;
#pragma unroll
    for (int i = 0; i < 16; ++i) {
        const int kk = lr + 4 * i;
        f32x4 v = (f32x4){0.f, 0.f, 0.f, 0.f};
        if (n0 + lc < nvalid) v = *(const f32x4*)(W + (size_t)(k0 + kk) * ldn + c0 + n0 + lc);
        if (kscale) { const float s = kscale[k0 + kk]; v = v * s; }
        scr[kk * 65 + lc + 0] = v.x; scr[kk * 65 + lc + 1] = v.y; scr[kk * 65 + lc + 2] = v.z; scr[kk * 65 + lc + 3] = v.w;
    }
    LDS_WAIT(); asm volatile("" ::: "memory");
    const int c = lane & 7;
#pragma unroll
    for (int j = 0; j < 8; ++j) {
        const int n = (lane >> 3) + 8 * j; const LAS float* s = scr + (8 * c) * 65 + n;
        u32x4 o; o.x = cvt_pk_bf16(s[0 * 65], s[1 * 65]); o.y = cvt_pk_bf16(s[2 * 65], s[3 * 65]); o.z = cvt_pk_bf16(s[4 * 65], s[5 * 65]); o.w = cvt_pk_bf16(s[6 * 65], s[7 * 65]);
        const int dn = mode == 1 ? uq_rowmap(n0 + n) : (n0 + n);
        *(u32x4*)(WT + (size_t)dn * K + k0 + 8 * c) = o;
    }
    LDS_WAIT(); asm volatile("" ::: "memory");
}

__device__ __forceinline__ void row_load_f32(const float* p, int lane, f32x4 (&v)[4]) {
#pragma unroll
    for (int j = 0; j < 4; ++j) v[j] = *(const f32x4*)(p + 4 * lane + 256 * j);
}
__device__ __forceinline__ void row_store_f32(float* p, int lane, const f32x4 (&v)[4]) {
#pragma unroll
    for (int j = 0; j < 4; ++j) *(f32x4*)(p + 4 * lane + 256 * j) = v[j];
}
__device__ __forceinline__ void row_store_bf16(bf16* p, int lane, const f32x4 (&v)[4]) {
#pragma unroll
    for (int j = 0; j < 4; ++j) { u32x2 w; w.x = cvt_pk_bf16(v[j].x, v[j].y); w.y = cvt_pk_bf16(v[j].z, v[j].w); *(u32x2*)(p + 4 * lane + 256 * j) = w; }
}
__device__ __forceinline__ void row_layernorm(f32x4 (&v)[4], const f32x4 (&g)[4], const f32x4 (&b)[4]) {
    float s = 0.f;
#pragma unroll
    for (int j = 0; j < 4; ++j) s += (v[j].x + v[j].y) + (v[j].z + v[j].w);
    const float mean = wave_sum(s) * (1.f / DM); float s2 = 0.f;
#pragma unroll
    for (int j = 0; j < 4; ++j) { v[j] = v[j] - mean; s2 += (v[j].x * v[j].x + v[j].y * v[j].y) + (v[j].z * v[j].z + v[j].w * v[j].w); }
    const float rstd = 1.f / sqrtf(wave_sum(s2) * (1.f / DM) + LN_EPS);
#pragma unroll
    for (int j = 0; j < 4; ++j) v[j] = v[j] * rstd * g[j] + b[j];
}
__device__ __forceinline__ void row_ab(const f32x4 (&v)[4], const LAS float* w8, int lane, float (&ab)[8]) {
#pragma unroll
    for (int e = 0; e < 8; ++e) { float s = 0.f;
#pragma unroll
        for (int j = 0; j < 4; ++j) { const f32x4 w = *(const LAS f32x4*)(w8 + e * 1024 + 4 * lane + 256 * j); s += (v[j].x * w.x + v[j].y * w.y) + (v[j].z * w.z + v[j].w * w.w); }
        ab[e] = wave_sum(s); }
}
__device__ __forceinline__ void load_w8(const Ctx& C, int ei, LAS float* w8) {
    const float* W = C.inp(1) + (size_t)ei * DM * EVEN_IN;
    for (int idx = C.tid; idx < 8 * 1024; idx += NWAVES * 64) { const int k = idx >> 3, e = idx & 7; w8[e * 1024 + k] = W[(size_t)k * EVEN_IN + EVEN_N + e]; }
}

__device__ __forceinline__ void phase_prologue(const Ctx& C0) {
    const Ctx C = phase_ctx(C0);
    const int gw = C.bid * NWAVES + C.wave, NGW = C.G * NWAVES, lane = C.lane;
    LAS float* scr = (LAS float*)(C.lds + C.wave * 16640);
    unsigned char* ws = C.ws;
    constexpr int I0 = 128 * 512, I1 = 128 * 256, I2 = 2 * 768, I3 = 2 * 256, I4 = 2 * 192, I5 = 2 * 144, I6 = 2 * 128, I7 = 2 * 256;
    constexpr int NITEMS = I0 + I1 + I2 + I3 + I4 + I5 + I6 + I7;
    for (int it = gw; it < NITEMS; it += NGW) {
        int r = it;
        if (r < I0) { const int mi = r / 512, q = r % 512; conv_item(C.inp(23) + (size_t)mi * 1024 * 2048, 2048, 0, 2048, 1024, (bf16*)(ws + WS_WGU) + (size_t)mi * 2048 * 1024, nullptr, 0, scr, q / 32, q % 32, lane); continue; } r -= I0;
        if (r < I1) { const int mi = r / 256, q = r % 256; conv_item(C.inp(25) + (size_t)mi * 1024 * 1024, 1024, 0, 1024, 1024, (bf16*)(ws + WS_WDN) + (size_t)mi * 1024 * 1024, nullptr, 0, scr, q / 16, q % 16, lane); continue; } r -= I1;
        if (r < I2) { const int mi = r / 768, q = r % 768; conv_item(C.inp(1) + (size_t)mi * 1024 * EVEN_IN, EVEN_IN, 0, EVEN_N, 1024, (bf16*)(ws + WS_WEIN) + (size_t)mi * EVEN_N * 1024, nullptr, 0, scr, q / 48, q % 48, lane); continue; } r -= I2;
        if (r < I3) { const int mi = r / 256, q = r % 256; conv_item(C.inp(10) + (size_t)mi * 1024 * 1024, 1024, 0, 1024, 1024, (bf16*)(ws + WS_WEOUT) + (size_t)mi * 1024 * 1024, nullptr, 0, scr, q / 16, q % 16, lane); continue; } r -= I3;
        if (r < I4) { const int mi = r / 192, q = r % 192; conv_item(C.inp(11) + (size_t)mi * 1024 * ODD_IN, ODD_IN, 0, ODD_IN, 1024, (bf16*)(ws + WS_WOIN) + (size_t)mi * ODD_N * 1024, nullptr, 0, scr, q / 12, q % 12, lane); continue; } r -= I4;
        if (r < I5) { const int mi = r / 144, q = r % 144; conv_item(C.inp(13) + (size_t)mi * QL * 1536, 1536, 0, 1536, QL, (bf16*)(ws + WS_WUQ) + (size_t)mi * 1536 * QL, C.inp(12) + mi * QL, 1, scr, q / 24, q % 24, lane); continue; } r -= I5;
        if (r < I6) { const int mi = r / 128, q = r % 128; conv_item(C.inp(15) + (size_t)mi * KVL * 2048, 2048, 0, 2048, KVL, (bf16*)(ws + WS_WUKV) + (size_t)mi * 2048 * KVL, C.inp(14) + mi * KVL, 0, scr, q / 32, q % 32, lane); continue; } r -= I6;
        { const int mi = r / 256, q = r % 256; conv_item(C.inp(16) + (size_t)mi * 1024 * 1024, 1024, 0, 1024, 1024, (bf16*)(ws + WS_WOOUT) + (size_t)mi * 1024 * 1024, nullptr, 0, scr, q / 16, q % 16, lane); }
    }
    { f32x2* rope = (f32x2*)(ws + WS_ROPE);
      for (int idx = C.bid * NWAVES * 64 + C.tid; idx < SEQ * 32; idx += C.G * NWAVES * 64) { const int pos = idx >> 5, j = idx & 31;
          const float inv = powf(10000.0f, -(float)(2 * j) / 64.0f); const float ang = (float)pos * inv; rope[idx] = (f32x2){cosf(ang), sinf(ang)}; } }
    __syncthreads();
    LAS float* w8 = (LAS float*)(C.lds);
    load_w8(C, 0, w8);
    __syncthreads();
    const float* x = C.inp(0); bf16* XB = (bf16*)(ws + WS_XB); float* AB = (float*)(ws + WS_AB);
    for (int m = gw; m < T; m += NGW) { f32x4 v[4]; row_load_f32(x + (size_t)m * DM, lane, v); row_store_bf16(XB + (size_t)m * DM, lane, v);
        float ab[8]; row_ab(v, w8, lane, ab); if (lane < 8) { float s = ab[0];
#pragma unroll
            for (int e = 1; e < 8; ++e) s = (lane == e) ? ab[e] : s;
            AB[(size_t)m * 8 + lane] = s; } }
}

using pg8::Unit;
struct EpiBf16 {
    static constexpr bool PERM = true;
    bf16* O; int ldc; int gelu_cols;
    __device__ __forceinline__ void operator()(const f32x4 (&acc)[2][2][4][2], const Unit& u, int wr, int wc, int fr, int fq) const {
        const int row0 = u.pm * 256 + wr * 64 + fr, col0 = u.pn * 256 + wc * 32 + 8 * fq;
        const bool g = (u.pn * 256) < gelu_cols;
#pragma unroll
        for (int ai = 0; ai < 2; ++ai)
#pragma unroll
            for (int m = 0; m < 4; ++m) { bf16* rowp = O + (size_t)(row0 + ai * 128 + m * 16) * ldc + col0;
#pragma unroll
                for (int bj = 0; bj < 2; ++bj) { f32x4 v0 = acc[ai][bj][m][0], v1 = acc[ai][bj][m][1];
                    if (g) { f32x2 a = pg8::gelu_pk((f32x2){v0[0], v0[1]}), b = pg8::gelu_pk((f32x2){v0[2], v0[3]}), c = pg8::gelu_pk((f32x2){v1[0], v1[1]}), d = pg8::gelu_pk((f32x2){v1[2], v1[3]});
                        v0 = (f32x4){a.x, a.y, b.x, b.y}; v1 = (f32x4){c.x, c.y, d.x, d.y}; }
                    u32x4 w; w.x = cvt_pk_bf16(v0[0], v0[1]); w.y = cvt_pk_bf16(v0[2], v0[3]); w.z = cvt_pk_bf16(v1[0], v1[1]); w.w = cvt_pk_bf16(v1[2], v1[3]);
                    *(u32x4*)(rowp + bj * 128) = w; } }
    }
};
struct EpiRes {
    static constexpr bool PERM = false;
    const float* X; float* Y;
    __device__ __forceinline__ void operator()(const f32x4 (&acc)[2][2][4][2], const Unit& u, int wr, int wc, int fr, int fq) const {
        const int row0 = u.pm * 256 + wr * 64 + fr, col0 = u.pn * 256 + wc * 32 + 4 * fq;
#pragma unroll
        for (int ai = 0; ai < 2; ++ai)
#pragma unroll
            for (int m = 0; m < 4; ++m) { const size_t off = (size_t)(row0 + ai * 128 + m * 16) * DM + col0;
                f32x4 xs[2][2];
#pragma unroll
                for (int bj = 0; bj < 2; ++bj)
#pragma unroll
                    for (int n = 0; n < 2; ++n) xs[bj][n] = *(const f32x4*)(X + off + bj * 128 + n * 16);
#pragma unroll
                for (int bj = 0; bj < 2; ++bj)
#pragma unroll
                    for (int n = 0; n < 2; ++n) *(f32x4*)(Y + off + bj * 128 + n * 16) = xs[bj][n] * DN_ALPHA + acc[ai][bj][m][n];
                asm volatile("" ::: "memory"); }
    }
};
struct EpiQ {
    static constexpr bool PERM = true;
    bf16* O; const float* rs; const f32x4* rope;
    __device__ __forceinline__ void operator()(const f32x4 (&acc)[2][2][4][2], const Unit& u, int wr, int wc, int fr, int fq) const {
        const int row0 = u.pm * 256 + wr * 64 + fr, col0 = u.pn * 256 + wc * 32 + 8 * fq;
#pragma unroll
        for (int ai = 0; ai < 2; ++ai)
#pragma unroll
            for (int m = 0; m < 4; ++m) { const int row = row0 + ai * 128 + m * 16; const float s = rs[row]; const int pos = row & (SEQ - 1);
                bf16* rowp = O + (size_t)row * 1536 + col0;
#pragma unroll
                for (int bj = 0; bj < 2; ++bj) { f32x4 v0 = acc[ai][bj][m][0] * s, v1 = acc[ai][bj][m][1] * s;
                    const int c = col0 + bj * 128, o = c % 192;
                    if (o >= 128) { const int jp = (o - 128) >> 1;
                        const f32x4 r0 = rope[(pos * 32 + jp) >> 1], r1 = rope[(pos * 32 + jp + 2) >> 1];
                        v0 = (f32x4){v0[0] * r0[0] - v0[1] * r0[1], v0[0] * r0[1] + v0[1] * r0[0], v0[2] * r0[2] - v0[3] * r0[3], v0[2] * r0[3] + v0[3] * r0[2]};
                        v1 = (f32x4){v1[0] * r1[0] - v1[1] * r1[1], v1[0] * r1[1] + v1[1] * r1[0], v1[2] * r1[2] - v1[3] * r1[3], v1[2] * r1[3] + v1[3] * r1[2]}; }
                    u32x4 w; w.x = cvt_pk_bf16(v0[0], v0[1]); w.y = cvt_pk_bf16(v0[2], v0[3]); w.z = cvt_pk_bf16(v1[0], v1[1]); w.w = cvt_pk_bf16(v1[2], v1[3]);
                    *(u32x4*)(rowp + bj * 128) = w; }
                asm volatile("" ::: "memory"); }
    }
};
struct EpiKV {
    static constexpr bool PERM = true;
    bf16* O; const float* rs;
    __device__ __forceinline__ void operator()(const f32x4 (&acc)[2][2][4][2], const Unit& u, int wr, int wc, int fr, int fq) const {
        const int row0 = u.pm * 256 + wr * 64 + fr, col0 = u.pn * 256 + wc * 32 + 8 * fq;
#pragma unroll
        for (int ai = 0; ai < 2; ++ai)
#pragma unroll
            for (int m = 0; m < 4; ++m) { const int row = row0 + ai * 128 + m * 16; const float s = rs[row]; bf16* rowp = O + (size_t)row * 2048 + col0;
#pragma unroll
                for (int bj = 0; bj < 2; ++bj) { const f32x4 v0 = acc[ai][bj][m][0] * s, v1 = acc[ai][bj][m][1] * s;
                    u32x4 w; w.x = cvt_pk_bf16(v0[0], v0[1]); w.y = cvt_pk_bf16(v0[2], v0[3]); w.z = cvt_pk_bf16(v1[0], v1[1]); w.w = cvt_pk_bf16(v1[2], v1[3]);
                    *(u32x4*)(rowp + bj * 128) = w; }
                asm volatile("" ::: "memory"); }
    }
};
struct EpiSwiglu {
    static constexpr bool PERM = true;
    bf16* HID; const float* bias; const LAS int* rmap;
    __device__ __forceinline__ void operator()(const f32x4 (&acc)[2][2][4][2], const Unit& u, int wr, int wc, int fr, int fq) const {
        const int col0 = u.pn * 256 + wc * 32 + 8 * fq; const float* bp = bias + (size_t)u.e * 2048 + col0;
        f32x4 bv[2][2];
#pragma unroll
        for (int bj = 0; bj < 2; ++bj)
#pragma unroll
            for (int n = 0; n < 2; ++n) bv[bj][n] = *(const f32x4*)(bp + bj * 128 + 4 * n);
#pragma unroll
        for (int ai = 0; ai < 2; ++ai)
#pragma unroll
            for (int m = 0; m < 4; ++m) { const int slot = rmap[u.li * 256 + ai * 128 + wr * 64 + m * 16 + fr];
                if (slot >= 0) { bf16* rowp = HID + (size_t)slot * DFF + (col0 >> 1);
#pragma unroll
                    for (int bj = 0; bj < 2; ++bj) { const f32x4 h0 = acc[ai][bj][m][0] + bv[bj][0], h1 = acc[ai][bj][m][1] + bv[bj][1];
                        float o[4];
#pragma unroll
                        for (int q = 0; q < 4; ++q) { const float glu = fminf(q < 2 ? h0[2 * q] : h1[2 * q - 4], 7.0f); float lin = q < 2 ? h0[2 * q + 1] : h1[2 * q - 3]; lin = fminf(fmaxf(lin, -7.0f), 7.0f);
                            const float sg = __builtin_amdgcn_rcpf(1.0f + __builtin_amdgcn_exp2f(-1.702f * 1.4426950408889634f * glu)); o[q] = glu * sg * (lin + 1.0f); }
                        u32x2 w; w.x = cvt_pk_bf16(o[0], o[1]); w.y = cvt_pk_bf16(o[2], o[3]);
                        *(u32x2*)(rowp + bj * 64) = w; } }
                asm volatile("" ::: "memory"); }
    }
};
struct EpiDown {
    static constexpr bool PERM = true;
    bf16* YE; const float* bias; const float* gate; const LAS int* rmap;
    __device__ __forceinline__ void operator()(const f32x4 (&acc)[2][2][4][2], const Unit& u, int wr, int wc, int fr, int fq) const {
        const int col0 = u.pn * 256 + wc * 32 + 8 * fq; const float* bp = bias + (size_t)u.e * DM + col0;
        f32x4 bv[2][2];
#pragma unroll
        for (int bj = 0; bj < 2; ++bj)
#pragma unroll
            for (int n = 0; n < 2; ++n) bv[bj][n] = *(const f32x4*)(bp + bj * 128 + 4 * n);
#pragma unroll
        for (int ai = 0; ai < 2; ++ai)
#pragma unroll
            for (int m = 0; m < 4; ++m) { const int slot = rmap[u.li * 256 + ai * 128 + wr * 64 + m * 16 + fr];
                if (slot >= 0) { const float gt = gate[slot]; bf16* rowp = YE + (size_t)slot * DM + col0;
#pragma unroll
                    for (int bj = 0; bj < 2; ++bj) { const f32x4 v0 = (acc[ai][bj][m][0] + bv[bj][0]) * gt, v1 = (acc[ai][bj][m][1] + bv[bj][1]) * gt;
                        u32x4 w; w.x = cvt_pk_bf16(v0[0], v0[1]); w.y = cvt_pk_bf16(v0[2], v0[3]); w.z = cvt_pk_bf16(v1[0], v1[1]); w.w = cvt_pk_bf16(v1[2], v1[3]);
                        *(u32x4*)(rowp + bj * 128) = w; } }
                asm volatile("" ::: "memory"); }
    }
};

template <class Epi>
__device__ __forceinline__ void run_plain_gemm(const Ctx& C, const bf16* A, int lda, int K, int N, const bf16* Bt, const Epi& E) {
    pg8::PlainSched S; S.o.init(T, N, C.G, C.bid); S.Bt = (const char*)Bt; S.K = K; S.lda = lda;
    pg8::gemm_phase<Epi, pg8::PlainSched, true>(C.lds, (const char*)A, K, S, E);
}

constexpr int MOE_RMAP_OFF = LDS_SPARE, MOE_MAX_UNITS = 20, MOE_PRE_OFF = LDS_SPARE + MOE_MAX_UNITS * 1024, MOE_CNT_OFF = MOE_PRE_OFF + 256;
struct MoeSched {
    static constexpr bool GATHER = true;
    const LAS int* pre; const LAS int* rmap; const char* Bt; size_t bstride; int K, NT, G, c, lda, shift;
    __device__ __forceinline__ bool next(int i, Unit& u) const {
        const int L = i * G + c, tot = pre[32] * NT; if (L >= tot || i >= MOE_MAX_UNITS) return false;
        int e = 0;
#pragma unroll 1
        for (; e < 31; ++e) if (L < pre[e + 1] * NT) break;
        const int rem = L - pre[e] * NT, nte = pre[e + 1] - pre[e];
        u.e = e; u.pn = rem / nte; u.pm = rem - u.pn * nte; u.li = i; return true;
    }
    __device__ __forceinline__ const char* bbase(const Unit& u) const { return Bt + (size_t)u.e * bstride + (size_t)u.pn * 256 * K * 2; }
    __device__ __forceinline__ unsigned aoff(const Unit& u, int r) const { const int slot = rmap[u.li * 256 + r]; const int s = slot < 0 ? 0 : (slot >> shift); return (unsigned)(s * lda) * 2u; }
};
template <class Epi>
__device__ __forceinline__ void run_moe_gemm(const Ctx& C0, int layer, const bf16* A, int lda, int shift, int K, int N, const bf16* Bt, size_t bstride_elems, Epi E) {
    const Ctx C = phase_ctx(C0);
    LAS int* pre = (LAS int*)(C.lds + MOE_PRE_OFF); LAS int* cnt = (LAS int*)(C.lds + MOE_CNT_OFF); LAS int* rmap = (LAS int*)(C.lds + MOE_RMAP_OFF);
    const int* list = (const int*)(C.ws + WS_LIST);
    if (C.tid < 32) cnt[C.tid] = (int)__hip_atomic_load(C.ctl + CW_CNT + (layer * 32 + C.tid) * 64, RLX_AGENT);
    __syncthreads();
    if (C.tid == 0) { int s = 0; for (int e = 0; e < 32; ++e) { pre[e] = s; s += (cnt[e] + 255) >> 8; } pre[32] = s; }
    __syncthreads();
    MoeSched S; S.pre = pre; S.rmap = rmap; S.Bt = (const char*)Bt; S.bstride = bstride_elems * 2; S.K = K; S.NT = N / 256; S.G = C.G; S.c = C.bid; S.lda = lda; S.shift = shift;
    { Unit u; for (int i = 0; S.next(i, u); ++i) { if (C.tid < 256) { const int idx = u.pm * 256 + C.tid; rmap[i * 256 + C.tid] = idx < cnt[u.e] ? list[(size_t)u.e * LCAP + idx] : -1; } } }
    __syncthreads();
    E.rmap = rmap;
    pg8::gemm_phase<Epi, MoeSched, true>(C.lds, (const char*)A, K, S, E);
}

__device__ __forceinline__ void phase_router(const Ctx& C0, int layer) {
    const Ctx C = phase_ctx(C0);
    LAS float* wrT = (LAS float*)C.lds;
    LAS int* lcnt = (LAS int*)(C.lds + 132096); LAS int* lbase = (LAS int*)(C.lds + 132224);
    LAS int* asg_e = (LAS int*)(C.lds + 132352); LAS int* asg_pos = (LAS int*)(C.lds + 134400); LAS float* asg_gate = (LAS float*)(C.lds + 136448);
    const float* Wr = C.inp(21) + (size_t)layer * DM * NEXP; const float* br = C.inp(22) + layer * NEXP;
    const int lane = C.lane, tid = C.tid;
    for (int idx = tid; idx < DM * NEXP; idx += NWAVES * 64) { const int k = idx >> 5, e = idx & 31; wrT[e * 1028 + k] = Wr[idx]; }
    f32x4 g[4], b[4]; row_load_f32(C.inp(17) + layer * DM, lane, g); row_load_f32(C.inp(18) + layer * DM, lane, b);
    const float* Y = (const float*)(C.ws + WS_Y); float* XF = (float*)(C.ws + WS_XF); bf16* XB = (bf16*)(C.ws + WS_XB);
    int* list = (int*)(C.ws + WS_LIST); float* GATE = (float*)(C.ws + WS_GATE);
    const float mybias = br[lane >> 1];
    for (int rb = C.bid; rb < T / 128; rb += C.G) {
        if (tid < 32) lcnt[tid] = 0;
        __syncthreads();
#pragma unroll 1
        for (int i = 0; i < 16; ++i) {
            const int rl = C.wave * 16 + i, row = rb * 128 + rl;
            f32x4 v[4]; row_load_f32(Y + (size_t)row * DM, lane, v);
            row_layernorm(v, g, b);
            row_store_f32(XF + (size_t)row * DM, lane, v); row_store_bf16(XB + (size_t)row * DM, lane, v);
            float p[32];
#pragma unroll
            for (int e = 0; e < 32; ++e) { float s = 0.f;
#pragma unroll
                for (int j = 0; j < 4; ++j) { const f32x4 w = *(const LAS f32x4*)(wrT + e * 1028 + 4 * lane + 256 * j); s += (v[j].x * w.x + v[j].y * w.y) + (v[j].z * w.z + v[j].w * w.w); }
                p[e] = s; }
#define BFLY(bit, n) { const bool hi_ = (lane & (bit)) != 0; _Pragma("unroll") for (int q = 0; q < (n); ++q) { const float send = hi_ ? p[q] : p[q + (n)]; const float keep = hi_ ? p[q + (n)] : p[q]; p[q] = keep + __shfl_xor(send, (bit)); } }
            BFLY(32, 16) BFLY(16, 8) BFLY(8, 4) BFLY(4, 2) BFLY(2, 1)
#undef BFLY
            float val = p[0] + __shfl_xor(p[0], 1) + mybias; const int me = lane >> 1;
            float tv[4]; int te[4];
#pragma unroll
            for (int k = 0; k < 4; ++k) { float bv = val; int be = me;
#pragma unroll
                for (int off = 1; off < 64; off <<= 1) { const float ov = __shfl_xor(bv, off); const int oe = __shfl_xor(be, off); const bool take = (ov > bv) || (ov == bv && oe < be); bv = take ? ov : bv; be = take ? oe : be; }
                tv[k] = bv; te[k] = be; if (me == be) val = -__builtin_inff(); }
            const float e1 = __expf(tv[1] - tv[0]), e2 = __expf(tv[2] - tv[0]), e3 = __expf(tv[3] - tv[0]); const float inv = 1.0f / (1.0f + e1 + e2 + e3);
            if (lane < 4) { const int my_e = lane == 0 ? te[0] : lane == 1 ? te[1] : lane == 2 ? te[2] : te[3]; const float my_g = (lane == 0 ? 1.0f : lane == 1 ? e1 : lane == 2 ? e2 : e3) * inv;
                const int lpos = __hip_atomic_fetch_add(lcnt + my_e, 1, __ATOMIC_RELAXED, __HIP_MEMORY_SCOPE_WORKGROUP);
                const int a = rl * 4 + lane; asg_e[a] = my_e; asg_pos[a] = lpos; asg_gate[a] = my_g; }
        }
        __syncthreads();
        if (tid < 32) lbase[tid] = (int)__hip_atomic_fetch_add(C.ctl + CW_CNT + (layer * 32 + tid) * 64, (unsigned)lcnt[tid], RLX_AGENT);
        __syncthreads();
        { const int a = tid, e = asg_e[a], slot = (rb * 128 + (a >> 2)) * 4 + (a & 3); list[(size_t)e * LCAP + lbase[e] + asg_pos[a]] = slot; GATE[slot] = asg_gate[a]; }
        __syncthreads();
    }
}

__device__ __forceinline__ void phase_combine(const Ctx& C0, int layer) {
    const Ctx C = phase_ctx(C0);
    const int gw = C.bid * NWAVES + C.wave, NGW = C.G * NWAVES, lane = C.lane;
    LAS float* w8 = (LAS float*)C.lds;
    if (layer == 1) { load_w8(C, 1, w8); __syncthreads(); }
    f32x4 g[4], b[4]; row_load_f32(C.inp(19) + layer * DM, lane, g); row_load_f32(C.inp(20) + layer * DM, lane, b);
    float* XF = (float*)(C.ws + WS_XF); bf16* XB = (bf16*)(C.ws + WS_XB); const bf16* YE = (const bf16*)(C.ws + WS_YE); float* AB = (float*)(C.ws + WS_AB);
    for (int m = gw; m < T; m += NGW) {
        f32x4 v[4]; row_load_f32(XF + (size_t)m * DM, lane, v);
#pragma unroll
        for (int j = 0; j < 4; ++j) v[j] = v[j] * DN_ALPHA;
#pragma unroll
        for (int k = 0; k < 4; ++k) { const bf16* yr = YE + (size_t)(m * 4 + k) * DM;
#pragma unroll
            for (int j = 0; j < 4; ++j) { const u32x2 w = *(const u32x2*)(yr + 4 * lane + 256 * j); v[j] = v[j] + (f32x4){bf_lo(w.x), bf_hi(w.x), bf_lo(w.y), bf_hi(w.y)}; } }
        row_layernorm(v, g, b);
        if (layer == DEPTH - 1) row_store_f32(C.out + (size_t)m * DM, lane, v);
        else { row_store_f32(XF + (size_t)m * DM, lane, v); row_store_bf16(XB + (size_t)m * DM, lane, v); }
        if (layer == 1) { float ab[8]; row_ab(v, w8, lane, ab); if (lane < 8) { float s = ab[0];
#pragma unroll
                for (int e = 1; e < 8; ++e) s = (lane == e) ? ab[e] : s;
                AB[(size_t)m * 8 + lane] = s; } }
    }
}

__device__ __forceinline__ void phase_o1b(const Ctx& C0) {
    const Ctx C = phase_ctx(C0);
    const int gw = C.bid * NWAVES + C.wave, NGW = C.G * NWAVES, lane = C.lane;
    const bf16* C1 = (const bf16*)(C.ws + WS_ARENA + AR_C1); bf16* KPE = (bf16*)(C.ws + WS_ARENA + AR_KPE);
    float* RSQ = (float*)(C.ws + WS_RS); float* RKV = RSQ + T; const f32x2* rope = (const f32x2*)(C.ws + WS_ROPE);
    for (int m = gw; m < T; m += NGW) {
        const bf16* rp = C1 + (size_t)m * ODD_N;
        const u32x4 a = *(const u32x4*)(rp + 8 * lane);
        float s = 0.f;
#pragma unroll
        for (int q = 0; q < 4; ++q) { const float lo = bf_lo(a[q]), hi = bf_hi(a[q]); s += lo * lo + hi * hi; }
        float sq = lane < 48 ? s : 0.f, skv = lane < 48 ? 0.f : s;
        if (lane < 16) { const u32x4 b = *(const u32x4*)(rp + 8 * (64 + lane)); float s2 = 0.f;
#pragma unroll
            for (int q = 0; q < 4; ++q) { const float lo = bf_lo(b[q]), hi = bf_hi(b[q]); s2 += lo * lo + hi * hi; }
            skv += s2; }
        sq = wave_sum(sq); skv = wave_sum(skv);
        if (lane == 0) { RSQ[m] = 1.0f / sqrtf(sq * (1.0f / QL) + RMS_EPS); RKV[m] = 1.0f / sqrtf(skv * (1.0f / KVL) + RMS_EPS); }
        if (lane < 32) { const float x1 = bf2f(rp[640 + lane]), x2 = bf2f(rp[672 + lane]); const f32x2 cs = rope[(m & (SEQ - 1)) * 32 + lane];
            *(unsigned*)(KPE + (size_t)m * 64 + 2 * lane) = cvt_pk_bf16(x1 * cs.x - x2 * cs.y, x1 * cs.y + x2 * cs.x); }
    }
}

namespace att {
constexpr int SHM_V = 16384, SHM_K = 16384, SHM_KR = 8192;
constexpr int OFF_V = 0, OFF_K = 2 * SHM_V, OFF_KR = OFF_K + 2 * SHM_K, OFF_WS = OFF_KR + 2 * SHM_KR, OFF_QR = OFF_WS + 2048;
constexpr float THR = 8.f, SCALE = ATT_SCALE;
#define KSWZ(row, colB) ((row) * 256 + ((colB) ^ (((row) & 7) << 4)))
#define KRSWZ(row, colB) ((row) * 128 + ((colB) ^ (((row) & 7) << 4)))
#define SBAR() __builtin_amdgcn_sched_barrier(0)
__device__ __forceinline__ int v_st(int k, int c) { const int kk = (k & ~0xC) | ((k & 4) << 1) | ((k & 8) >> 1); return ((kk >> 3) * 4 + (c >> 5)) * 512 + ((kk & 7) * 32 + (c & 31)) * 2; }
__device__ __forceinline__ int v_rd_base(int lane) { return ((lane & 3) << 3) | (((lane >> 2) & 3) << 6) | (((lane >> 4) & 1) << 5) | (((lane >> 5) & 1) << 8); }
constexpr int v_rd_off(int d0, int ks, int half) { return d0 * 512 + ks * 4096 + half * 2048; }
__device__ __forceinline__ int crow(int r, int hi) { return (r & 3) + 8 * (r >> 2) + 4 * hi; }
__device__ __forceinline__ void partialSM(f32x16& p0, f32x16& p1, float& m_reg, float& mn, float& alpha) {
    float pmax = p0[0];
#pragma unroll
    for (int r = 1; r < 16; ++r) pmax = fmaxf(pmax, p0[r]);
#pragma unroll
    for (int r = 0; r < 16; ++r) pmax = fmaxf(pmax, p1[r]);
    { auto rr = __builtin_amdgcn_permlane32_swap(__float_as_uint(pmax), __float_as_uint(pmax), false, false);
      pmax = fmaxf(__uint_as_float(rr[0]), __uint_as_float(rr[1])); }
    constexpr float C2 = 1.4426950408889634f * SCALE;
    if (__builtin_expect(__all((pmax - m_reg) * SCALE <= THR), 1)) { mn = m_reg; alpha = 1.f; }
    else { mn = fmaxf(m_reg, pmax); alpha = __builtin_amdgcn_exp2f((m_reg - mn) * C2); m_reg = mn; }
    const float mnL = -mn * C2;
#pragma unroll
    for (int r = 0; r < 16; ++r) p0[r] = fmaf(p0[r], C2, mnL);
#pragma unroll
    for (int r = 0; r < 16; ++r) p1[r] = fmaf(p1[r], C2, mnL);
#pragma unroll
    for (int r = 0; r < 16; ++r) p0[r] = __builtin_amdgcn_exp2f(p0[r]);
}
__device__ __forceinline__ void finishSM(f32x16& p0, f32x16& p1, float alpha, float& l_reg, bf16x8& pa0, bf16x8& pa1, bf16x8& pa2, bf16x8& pa3) {
#pragma unroll
    for (int r = 0; r < 16; ++r) p1[r] = __builtin_amdgcn_exp2f(p1[r]);
    float ps = 0;
#pragma unroll
    for (int r = 0; r < 16; ++r) ps += p0[r];
#pragma unroll
    for (int r = 0; r < 16; ++r) ps += p1[r];
    { auto rr = __builtin_amdgcn_permlane32_swap(__float_as_uint(ps), __float_as_uint(ps), false, false);
      ps = __uint_as_float(rr[0]) + __uint_as_float(rr[1]); }
    l_reg = l_reg * alpha + ps;
#define PK4(P, B_, OUT) do { unsigned a0 = cvt_pk_bf16(P[B_+0], P[B_+1]), a1 = cvt_pk_bf16(P[B_+2], P[B_+3]);                          \
        unsigned b0 = cvt_pk_bf16(P[B_+4], P[B_+5]), b1 = cvt_pk_bf16(P[B_+6], P[B_+7]);                                             \
        auto r0 = __builtin_amdgcn_permlane32_swap(a0, b0, false, false); auto r1 = __builtin_amdgcn_permlane32_swap(a1, b1, false, false); \
        u32x4 w = {r0[0], r1[0], r0[1], r1[1]}; OUT = *reinterpret_cast<bf16x8*>(&w); } while (0)
    PK4(p0, 0, pa0); PK4(p0, 8, pa1); PK4(p1, 0, pa2); PK4(p1, 8, pa3);
#undef PK4
}
template <int KB>
__device__ __forceinline__ void qkt(f32x16& p0, f32x16& p1, const LAS char* lds, int r32, int hi, const bf16x8* qr, const LAS char* qrl) {
    p0 = f32x16{}; p1 = f32x16{};
    const LAS char* kb[4]; const LAS char* kr[4];
#pragma unroll
    for (int dd = 0; dd < 4; ++dd) { kb[dd] = lds + OFF_K + KB * SHM_K + KSWZ(r32, (dd * 16 + hi * 8) * 2); kr[dd] = lds + OFF_KR + KB * SHM_KR + KRSWZ(r32, (dd * 16 + hi * 8) * 2); }
#pragma unroll
    for (int d0 = 0; d0 < 8; ++d0) { const LAS char* a = kb[d0 & 3] + (d0 >> 2) * 128;
        const bf16x8 b0 = *reinterpret_cast<const LAS bf16x8*>(a);
        const bf16x8 b1 = *reinterpret_cast<const LAS bf16x8*>(a + 32 * 256);
        p0 = __builtin_amdgcn_mfma_f32_32x32x16_bf16(b0, qr[d0], p0, 0, 0, 0);
        p1 = __builtin_amdgcn_mfma_f32_32x32x16_bf16(b1, qr[d0], p1, 0, 0, 0); }
#pragma unroll
    for (int d0 = 0; d0 < 4; ++d0) { const LAS char* a = kr[d0];
        const bf16x8 b0 = *reinterpret_cast<const LAS bf16x8*>(a);
        const bf16x8 b1 = *reinterpret_cast<const LAS bf16x8*>(a + 32 * 128);
        const bf16x8 qf = *reinterpret_cast<const LAS bf16x8*>(qrl + d0 * 1024);
        p0 = __builtin_amdgcn_mfma_f32_32x32x16_bf16(b0, qf, p0, 0, 0, 0);
        p1 = __builtin_amdgcn_mfma_f32_32x32x16_bf16(b1, qf, p1, 0, 0, 0); }
}
template <int VB>
__device__ __forceinline__ void pv_tile(f32x16* o, int vb0, bf16x8 pa0, bf16x8 pa1, bf16x8 pa2, bf16x8 pa3) {
#define TRRD(dst, off) asm volatile("ds_read_b64_tr_b16 %0, %1 offset:%2" : "=&v"(dst) : "v"(vb0), "i"(off) : "memory")
#define PV_D0(d0) do { s16x4 l0, l1, l2, l3, h0, h1, h2, h3; constexpr int b_ = OFF_V + VB * SHM_V + v_rd_off(d0, 0, 0); \
        TRRD(l0, b_); TRRD(h0, b_ + 2048); TRRD(l1, b_ + 4096); TRRD(h1, b_ + 6144); TRRD(l2, b_ + 8192); TRRD(h2, b_ + 10240); TRRD(l3, b_ + 12288); TRRD(h3, b_ + 14336); \
        asm volatile("s_waitcnt lgkmcnt(0)" ::: "memory"); SBAR();   \
        o[d0] = __builtin_amdgcn_mfma_f32_32x32x16_bf16(pa0, (bf16x8){l0[0], l0[1], l0[2], l0[3], h0[0], h0[1], h0[2], h0[3]}, o[d0], 0, 0, 0);   \
        o[d0] = __builtin_amdgcn_mfma_f32_32x32x16_bf16(pa1, (bf16x8){l1[0], l1[1], l1[2], l1[3], h1[0], h1[1], h1[2], h1[3]}, o[d0], 0, 0, 0);   \
        o[d0] = __builtin_amdgcn_mfma_f32_32x32x16_bf16(pa2, (bf16x8){l2[0], l2[1], l2[2], l2[3], h2[0], h2[1], h2[2], h2[3]}, o[d0], 0, 0, 0);   \
        o[d0] = __builtin_amdgcn_mfma_f32_32x32x16_bf16(pa3, (bf16x8){l3[0], l3[1], l3[2], l3[3], h3[0], h3[1], h3[2], h3[3]}, o[d0], 0, 0, 0); } while (0)
    PV_D0(0); PV_D0(1); PV_D0(2); PV_D0(3);
#undef PV_D0
#undef TRRD
}

__device__ __forceinline__ void attn_block(const Ctx& C, int b, int h, int qb) {
    LAS char* lds = (LAS char*)C.lds;
    const int tid = C.tid, wid = C.wave, lane = C.lane, r32 = lane & 31, hi = lane >> 5;
    const bf16* Qg = (const bf16*)(C.ws + WS_ARENA + AR_Q); const bf16* KVg = (const bf16*)(C.ws + WS_ARENA + AR_KV); const bf16* KPE = (const bf16*)(C.ws + WS_ARENA + AR_KPE);
    bf16* MIX = (bf16*)(C.ws + WS_MIX);
    const size_t tok0 = (size_t)b * SEQ; const int P0 = qb * 256;
    const int NT = 4 * (qb + 1), jmax = (P0 + wid * 32) >> 6;
    bf16x8 qr[8];
    LAS char* qrl = lds + OFF_QR + wid * 4096 + lane * 16;
    { const bf16* qp = Qg + (tok0 + P0 + wid * 32 + r32) * 1536 + h * 192 + hi * 8;
#pragma unroll
      for (int d0 = 0; d0 < 8; ++d0) qr[d0] = *(const bf16x8*)(qp + d0 * 16);
#pragma unroll
      for (int d0 = 0; d0 < 4; ++d0) *(LAS bf16x8*)(qrl + d0 * 1024) = *(const bf16x8*)(qp + (8 + d0) * 16); }
    const bf16* kvp = KVg + tok0 * 2048 + h * 256; const bf16* kpp = KPE + tok0 * 64;
#define A_LOAD(kb, bf) do { const bf16* p_ = kvp + (size_t)(kb) * 2048; int ln_ = lane; asm volatile("" : "+v"(ln_)); \
        _Pragma("unroll") for (int i_ = 0; i_ < 2; ++i_) { const int B_ = (wid * 2 + i_) * 1024 + ln_ * 16; \
            const int row_ = B_ >> 8, c_ = ((B_ & 255) >> 4) ^ (row_ & 7); \
            const int sub_ = B_ >> 9, kk_ = (sub_ >> 2) * 8 + ((B_ & 511) >> 6), k_ = (kk_ & ~0xC) | ((kk_ & 4) << 1) | ((kk_ & 8) >> 1), cc_ = (sub_ & 3) * 32 + ((B_ & 63) >> 1); \
            __builtin_amdgcn_global_load_lds((const unsigned*)(p_ + (unsigned)(row_ * 2048 + c_ * 8)), (LAS unsigned*)(lds + OFF_K + (bf) * SHM_K + (wid * 2 + i_) * 1024), 16, 0, 0); \
            __builtin_amdgcn_global_load_lds((const unsigned*)(p_ + (unsigned)(k_ * 2048 + 128 + cc_)), (LAS unsigned*)(lds + OFF_V + (bf) * SHM_V + (wid * 2 + i_) * 1024), 16, 0, 0); } \
        { const int B_ = wid * 1024 + ln_ * 16, row_ = B_ >> 7, c_ = ((B_ & 127) >> 4) ^ (row_ & 7); \
          __builtin_amdgcn_global_load_lds((const unsigned*)(kpp + (size_t)(kb) * 64 + (unsigned)(row_ * 64 + c_ * 8)), (LAS unsigned*)(lds + OFF_KR + (bf) * SHM_KR + wid * 1024), 16, 0, 0); } } while (0)
    LAS float* wsl = (LAS float*)(lds + OFF_WS) + wid * 64; LAS float* li_l = wsl; LAS float* al_l = wsl + 32;
    float m_reg = -1e30f, l_reg = 0.f; f32x16 o[4] = {};
    const int vb0 = (int)(uintptr_t)lds + v_rd_base(lane);
    A_LOAD(0, 0);
    asm volatile("s_waitcnt vmcnt(0)" ::: "memory");
    __syncthreads();
    f32x16 p0, p1; float mn, al; bf16x8 pa0, pa1, pa2, pa3;
#define A_STEP(KB) do { \
        if (t + 1 < NT) A_LOAD((t + 1) * 64, 1 - KB); \
        if (t <= jmax) { qkt<KB>(p0, p1, lds, r32, hi, qr, qrl); partialSM(p0, p1, m_reg, mn, al); \
            if (__any(al < 1.f)) { if (hi == 0) al_l[r32] = al; asm volatile("s_waitcnt lgkmcnt(0)" ::: "memory"); \
                _Pragma("unroll") for (int d_ = 0; d_ < 4; ++d_) _Pragma("unroll") for (int r = 0; r < 16; ++r) o[d_][r] *= al_l[crow(r, hi)]; } \
            finishSM(p0, p1, al, l_reg, pa0, pa1, pa2, pa3); SBAR(); pv_tile<KB>(o, vb0, pa0, pa1, pa2, pa3); } \
        asm volatile("s_waitcnt vmcnt(0)" ::: "memory"); \
        __syncthreads(); } while (0)
    for (int t = 0; t < NT; t += 2) { A_STEP(0); ++t; A_STEP(1); --t; }
#undef A_STEP
#undef A_LOAD
    if (hi == 0) li_l[r32] = l_reg;
    asm volatile("s_waitcnt lgkmcnt(0)" ::: "memory");
    float rli[16];
#pragma unroll
    for (int r = 0; r < 16; ++r) rli[r] = __builtin_amdgcn_rcpf(li_l[crow(r, hi)]);
    bf16* Ow = MIX + (tok0 + P0 + wid * 32) * DM + h * 128;
#pragma unroll
    for (int r = 0; r < 16; ++r) { const int orow = crow(r, hi);
#pragma unroll
        for (int d0 = 0; d0 < 4; ++d0) { const float v = o[d0][r] * rli[r]; const float vn = __shfl_xor(v, 1);
            if ((r32 & 1) == 0) *(unsigned*)(Ow + (size_t)orow * DM + d0 * 32 + r32) = cvt_pk_bf16(v, vn); } }
    __syncthreads();
}
#undef KSWZ
#undef KRSWZ
#undef SBAR
}

__device__ __forceinline__ void phase_attn(const Ctx& C0) {
    const Ctx C = phase_ctx(C0);
    const int x = C.bid & 7, k = C.bid >> 3, per = C.G >> 3;
    for (int u = k; u < 64; u += per) {
        const int bh = x * 8 + (u >> 3), p = u & 7;
        att::attn_block(C, bh >> 3, bh & 7, 15 - p);
        att::attn_block(C, bh >> 3, bh & 7, p);
    }
}

namespace sm {
__device__ __forceinline__ bf16x8 frag_n(const LAS char* base, int S, int x0, int k0, int lane) { return *(const LAS bf16x8*)(base + (x0 + (lane & 15)) * S + (k0 + 8 * (lane >> 4)) * 2); }
__device__ __forceinline__ bf16x8 frag_t(const LAS char* base, int S, int x0, int k0, int lane) {
    const int g = lane >> 4, q = (lane >> 2) & 3, p = lane & 3;
    const LAS char* a = base + (k0 + 8 * g + q) * S + (x0 + 4 * p) * 2;
    const s16x4 lo = __builtin_amdgcn_ds_read_tr16_b64_v4i16((LAS s16x4*)a);
    const s16x4 hi = __builtin_amdgcn_ds_read_tr16_b64_v4i16((LAS s16x4*)(a + 4 * S));
    return (bf16x8){lo[0], lo[1], lo[2], lo[3], hi[0], hi[1], hi[2], hi[3]};
}
__device__ __forceinline__ f32x4 mma(bf16x8 a, bf16x8 b, f32x4 c) { return __builtin_amdgcn_mfma_f32_16x16x32_bf16(a, b, c, 0, 0, 0); }
__device__ __forceinline__ u32x2 pack4(f32x4 v) { u32x2 w; w.x = cvt_pk_bf16(v[0], v[1]); w.y = cvt_pk_bf16(v[2], v[3]); return w; }
__device__ __forceinline__ f32x4 unpack4(u32x2 w) { return (f32x4){bf_lo(w.x), bf_hi(w.x), bf_lo(w.y), bf_hi(w.y)}; }
}

constexpr int H1LD = EVEN_N;

__device__ __forceinline__ void sgu_unit(const Ctx& C, int ei, int unit) {
    const int g4 = unit & 3, blk = (unit >> 2) & 31, b = unit >> 7;
    const int tid = C.tid, lane = C.lane, w = C.wave;
    const bf16* H1 = (const bf16*)(C.ws + WS_ARENA); bf16* MIX = (bf16*)(C.ws + WS_MIX);
    LAS char* Vn = (LAS char*)C.lds; LAS char* Wm = Vn + 34816;
    const size_t t0 = (size_t)b * SEQ + blk * 128;
    const float* lng = C.inp(2) + ei * 512 + g4 * 128; const float* lnb = C.inp(3) + ei * 512 + g4 * 128;
    const float* Wg = C.inp(4) + (size_t)(ei * 4 + g4) * 128 * 128; const float* bs = C.inp(5) + (ei * 4 + g4) * 128;
    { const int l16 = tid & 15; f32x4 ga = *(const f32x4*)(lng + 8 * l16), gb = *(const f32x4*)(lng + 8 * l16 + 4), ba = *(const f32x4*)(lnb + 8 * l16), bb = *(const f32x4*)(lnb + 8 * l16 + 4);
#pragma unroll
      for (int pp = 0; pp < 4; ++pp) { const int j = pp * 32 + (tid >> 4);
        const u32x4 raw = *(const u32x4*)(H1 + (t0 + j) * H1LD + 512 + g4 * 128 + 8 * l16);
        float x[8];
#pragma unroll
        for (int q = 0; q < 4; ++q) { x[2 * q] = bf_lo(raw[q]); x[2 * q + 1] = bf_hi(raw[q]); }
        float s = 0.f;
#pragma unroll
        for (int q = 0; q < 8; ++q) s += x[q];
        s += __shfl_xor(s, 1); s += __shfl_xor(s, 2); s += __shfl_xor(s, 4); s += __shfl_xor(s, 8);
        const float mean = s * (1.f / 128.f); float s2 = 0.f;
#pragma unroll
        for (int q = 0; q < 8; ++q) { x[q] -= mean; s2 += x[q] * x[q]; }
        s2 += __shfl_xor(s2, 1); s2 += __shfl_xor(s2, 2); s2 += __shfl_xor(s2, 4); s2 += __shfl_xor(s2, 8);
        const float rstd = 1.f / sqrtf(s2 * (1.f / 128.f) + LN_EPS);
        u32x4 o; o.x = cvt_pk_bf16(x[0] * rstd * ga[0] + ba[0], x[1] * rstd * ga[1] + ba[1]); o.y = cvt_pk_bf16(x[2] * rstd * ga[2] + ba[2], x[3] * rstd * ga[3] + ba[3]);
        o.z = cvt_pk_bf16(x[4] * rstd * gb[0] + bb[0], x[5] * rstd * gb[1] + bb[1]); o.w = cvt_pk_bf16(x[6] * rstd * gb[2] + bb[2], x[7] * rstd * gb[3] + bb[3]);
        *(LAS u32x4*)(Vn + j * 272 + l16 * 16) = o; } }
#pragma unroll
    for (int q = 0; q < 8; ++q) { const int f = (tid + 512 * q) * 4, i = f >> 7, j = f & 127; const f32x4 wv = *(const f32x4*)(Wg + f);
        *(LAS u32x2*)(Wm + i * 272 + j * 2) = sm::pack4(wv); }
    __syncthreads();
    const int i0 = 16 * w, nks = (w < 4) ? 2 : 4;
    bf16x8 f2[4];
#pragma unroll
    for (int ks = 0; ks < 4; ++ks) f2[ks] = sm::frag_n(Wm, 272, i0, 32 * ks, lane);
    const int i = i0 + (lane & 15), gq = lane >> 4; const float bsi = bs[i];
    const bf16* urow = H1 + (t0 + i) * H1LD + g4 * 128; bf16* orow = MIX + (t0 + i) * DM + g4 * 128;
#pragma unroll
    for (int ct = 0; ct < 8; ++ct) { f32x4 acc = (f32x4){0.f, 0.f, 0.f, 0.f};
#pragma unroll
        for (int ks = 0; ks < 4; ++ks) if (ks < nks) acc = sm::mma(sm::frag_t(Vn, 272, 16 * ct, 32 * ks, lane), f2[ks], acc);
        const int c = 16 * ct + 4 * gq; const f32x4 u = sm::unpack4(*(const u32x2*)(urow + c));
        *(u32x2*)(orow + c) = sm::pack4(u * (acc + bsi)); }
    __syncthreads();
}

namespace gdn {
constexpr int LF = 0, T1 = 17408, T2 = 26624, INM = 35840, VEC = 45056, QS = 46080, KS = 63488, VS = 80896, KDS = 98304, WT = 115712, UT = 133120;
__device__ __forceinline__ float silu(float x) { return x * __builtin_amdgcn_rcpf(1.0f + __expf(-x)); }
__device__ __forceinline__ void prep_unit(const Ctx& C, int ei, int unit) {
    const int n = unit & 63, h = (unit >> 6) & 3, b = unit >> 8;
    const int tid = C.tid, lane = C.lane, w = C.wave;
    LAS char* L = (LAS char*)C.lds;
    LAS float* gcs = (LAS float*)(L + VEC); LAS float* bet = gcs + 64; LAS float* egs = gcs + 128; LAS float* eks = gcs + 192;
    const bf16* H1 = (const bf16*)(C.ws + WS_ARENA);
    const size_t tok0 = (size_t)b * SEQ + n * 64;
    const int chunk = (b * 4 + h) * 64 + n;
    { const int i = tid >> 3, dc = (tid & 7) * 16, pos = n * 64 + i;
      const float* cw = C.inp(6) + (size_t)ei * 4 * 1536;
#pragma unroll 1
      for (int X = 0; X < 3; ++X) {
        float acc[16];
#pragma unroll
        for (int q = 0; q < 16; ++q) acc[q] = 0.f;
        const int chb = X * 512 + h * 128 + dc;
#pragma unroll
        for (int jj = 0; jj < 4; ++jj) { if (pos - 3 + jj >= 0) {
            const bf16* rp = H1 + (tok0 + i - 3 + jj) * H1LD + 1024 + chb;
            const u32x4 r0 = *(const u32x4*)rp, r1 = *(const u32x4*)(rp + 8);
            const float* wp = cw + jj * 1536 + chb; const f32x4 w0 = *(const f32x4*)wp, w1 = *(const f32x4*)(wp + 4), w2 = *(const f32x4*)(wp + 8), w3 = *(const f32x4*)(wp + 12);
            acc[0] += w0[0] * bf_lo(r0[0]); acc[1] += w0[1] * bf_hi(r0[0]); acc[2] += w0[2] * bf_lo(r0[1]); acc[3] += w0[3] * bf_hi(r0[1]);
            acc[4] += w1[0] * bf_lo(r0[2]); acc[5] += w1[1] * bf_hi(r0[2]); acc[6] += w1[2] * bf_lo(r0[3]); acc[7] += w1[3] * bf_hi(r0[3]);
            acc[8] += w2[0] * bf_lo(r1[0]); acc[9] += w2[1] * bf_hi(r1[0]); acc[10] += w2[2] * bf_lo(r1[1]); acc[11] += w2[3] * bf_hi(r1[1]);
            acc[12] += w3[0] * bf_lo(r1[2]); acc[13] += w3[1] * bf_hi(r1[2]); acc[14] += w3[2] * bf_lo(r1[3]); acc[15] += w3[3] * bf_hi(r1[3]); } }
        float ss = 0.f;
#pragma unroll
        for (int q = 0; q < 16; ++q) { acc[q] = silu(acc[q]); ss += acc[q] * acc[q]; }
        float sc = 1.f;
        if (X < 2) { ss += __shfl_xor(ss, 1); ss += __shfl_xor(ss, 2); ss += __shfl_xor(ss, 4); sc = 1.0f / sqrtf(ss + RMS_EPS); if (X == 0) sc *= 0.08838834764831845f; }
        u32x4 o0, o1;
        o0.x = cvt_pk_bf16(acc[0] * sc, acc[1] * sc); o0.y = cvt_pk_bf16(acc[2] * sc, acc[3] * sc); o0.z = cvt_pk_bf16(acc[4] * sc, acc[5] * sc); o0.w = cvt_pk_bf16(acc[6] * sc, acc[7] * sc);
        o1.x = cvt_pk_bf16(acc[8] * sc, acc[9] * sc); o1.y = cvt_pk_bf16(acc[10] * sc, acc[11] * sc); o1.z = cvt_pk_bf16(acc[12] * sc, acc[13] * sc); o1.w = cvt_pk_bf16(acc[14] * sc, acc[15] * sc);
        LAS char* dst = L + (X == 0 ? QS : X == 1 ? KS : VS) + i * 272 + dc * 2;
        *(LAS u32x4*)dst = o0; *(LAS u32x4*)(dst + 16) = o1; } }
    if (w == 0) { const float* AB = (const float*)(C.ws + WS_AB) + (tok0 + lane) * 8;
        const float a = AB[h], bb = AB[4 + h]; const float alog = C.inp(7)[ei * 4 + h], dtb = C.inp(8)[ei * 4 + h];
        const float xs = a + dtb; const float sp = xs > 20.f ? xs : log1pf(__expf(xs));
        float gv = -__expf(alog) * sp;
#pragma unroll
        for (int o = 1; o < 64; o <<= 1) { const float t_ = __shfl_up(gv, o); if (lane >= o) gv += t_; }
        const float gl = __shfl(gv, 63);
        gcs[lane] = gv; bet[lane] = 1.0f / (1.0f + __expf(-bb)); egs[lane] = __expf(gv); eks[lane] = __expf(gl - gv);
        if (lane == 0) ((float*)(C.ws + WS_GAM))[chunk] = __expf(gl); }
    __syncthreads();
    { const int i = tid >> 3, dc = (tid & 7) * 16; const float e = eks[i];
#pragma unroll
      for (int hh = 0; hh < 2; ++hh) { const u32x4 r = *(const LAS u32x4*)(L + KS + i * 272 + dc * 2 + 16 * hh); u32x4 o;
#pragma unroll
        for (int q = 0; q < 4; ++q) o[q] = cvt_pk_bf16(bf_lo(r[q]) * e, bf_hi(r[q]) * e);
        *(LAS u32x4*)(L + KDS + i * 272 + dc * 2 + 16 * hh) = o; } }
#pragma unroll
    for (int q = 0; q < 2; ++q) { const int tt = 2 * w + q, it = tt >> 2, jt = tt & 3;
        if (jt <= it) { f32x4 acc = (f32x4){0.f, 0.f, 0.f, 0.f};
#pragma unroll
            for (int ks = 0; ks < 4; ++ks) acc = sm::mma(sm::frag_n(L + KS, 272, 16 * jt, 32 * ks, lane), sm::frag_n(L + KS, 272, 16 * it, 32 * ks, lane), acc);
            const int i = 16 * it + (lane & 15), j0 = 16 * jt + 4 * (lane >> 4); const float gi = gcs[i], bi = bet[i]; f32x4 o;
#pragma unroll
            for (int r = 0; r < 4; ++r) o[r] = (i > j0 + r) ? bi * acc[r] * __expf(gi - gcs[j0 + r]) : 0.f;
            *(LAS f32x4*)(L + LF + (i * 68 + j0) * 4) = o; } }
    __syncthreads();
    if (w == 0) {
        float t[64];
#pragma unroll
        for (int i = 0; i < 64; ++i) t[i] = 0.f;
#pragma unroll
        for (int i = 0; i < 64; ++i) { float s0 = 0.f, s1 = 0.f, s2 = 0.f, s3 = 0.f;
#pragma unroll
            for (int m = 0; m < i; m += 4) { const f32x4 l = *(const LAS f32x4*)(L + LF + (i * 68 + m) * 4); s0 += l[0] * t[m]; s1 += l[1] * t[m + 1]; s2 += l[2] * t[m + 2]; s3 += l[3] * t[m + 3]; }
            t[i] = ((lane == i) ? 1.f : 0.f) - ((s0 + s1) + (s2 + s3)); }
        const float bj = bet[lane], bej = bj * egs[lane];
#pragma unroll
        for (int i = 0; i < 64; ++i) { *(LAS bf16*)(L + T1 + i * 144 + lane * 2) = f2bf(t[i] * bej); *(LAS bf16*)(L + T2 + i * 144 + lane * 2) = f2bf(t[i] * bj); }
    } else {
        for (int tt = w - 1; tt < 16; tt += 7) { const int it = tt >> 2, jt = tt & 3; f32x4 acc = (f32x4){0.f, 0.f, 0.f, 0.f};
            if (jt <= it) {
#pragma unroll
                for (int ks = 0; ks < 4; ++ks) acc = sm::mma(sm::frag_n(L + KS, 272, 16 * jt, 32 * ks, lane), sm::frag_n(L + QS, 272, 16 * it, 32 * ks, lane), acc); }
            const int i = 16 * it + (lane & 15), j0 = 16 * jt + 4 * (lane >> 4); const float gi = gcs[i]; f32x4 o;
#pragma unroll
            for (int r = 0; r < 4; ++r) o[r] = (i >= j0 + r) ? acc[r] * __expf(gi - gcs[j0 + r]) : 0.f;
            *(LAS u32x2*)(L + INM + i * 144 + j0 * 2) = sm::pack4(o); }
    }
    __syncthreads();
#pragma unroll 1
    for (int q = 0; q < 8; ++q) { const int tt = w * 8 + q, which = tt >> 5, xt = (tt & 31) >> 2, it = tt & 3; f32x4 acc = (f32x4){0.f, 0.f, 0.f, 0.f};
        const LAS char* src = L + (which ? VS : KS); const LAS char* tm = L + (which ? T2 : T1);
#pragma unroll
        for (int ks = 0; ks < 2; ++ks) acc = sm::mma(sm::frag_t(src, 272, 16 * xt, 32 * ks, lane), sm::frag_n(tm, 144, 16 * it, 32 * ks, lane), acc);
        *(LAS u32x2*)(L + (which ? UT : WT) + (16 * it + (lane & 15)) * 272 + (16 * xt + 4 * (lane >> 4)) * 2) = sm::pack4(acc); }
    __syncthreads();
    { bf16* Mg = (bf16*)(C.ws + WS_GM) + (size_t)chunk * 16384; bf16* Bg = (bf16*)(C.ws + WS_GB) + (size_t)chunk * 16384;
      bf16* Cg = (bf16*)(C.ws + WS_GC) + (size_t)chunk * 8192; bf16* Dg = (bf16*)(C.ws + WS_GD) + (size_t)chunk * 8192;
      const int x2 = lane & 15, x1 = 4 * (lane >> 4);
#pragma unroll 1
      for (int q = 0; q < 8; ++q) { const int tt = w * 8 + q, at = tt >> 3, bt = tt & 7;
        f32x4 am = (f32x4){0.f, 0.f, 0.f, 0.f}, ab = (f32x4){0.f, 0.f, 0.f, 0.f};
#pragma unroll
        for (int ks = 0; ks < 2; ++ks) { const bf16x8 fkd_b = sm::frag_t(L + KDS, 272, 16 * bt, 32 * ks, lane), fw = sm::frag_t(L + WT, 272, 16 * at, 32 * ks, lane);
            const bf16x8 fkd_a = sm::frag_t(L + KDS, 272, 16 * at, 32 * ks, lane), fu = sm::frag_t(L + UT, 272, 16 * bt, 32 * ks, lane);
            am = sm::mma(fw, fkd_b, am);
            ab = sm::mma(fkd_a, fu, ab); }
        *(u32x2*)(Mg + (16 * bt + x2) * 128 + 16 * at + x1) = sm::pack4(-am);
        *(u32x2*)(Bg + (16 * bt + x2) * 128 + 16 * at + x1) = sm::pack4(ab); }
#pragma unroll 1
      for (int q = 0; q < 4; ++q) { const int tt = w * 4 + q, at = tt >> 2, it = tt & 3;
        f32x4 ac = (f32x4){0.f, 0.f, 0.f, 0.f}, ad = (f32x4){0.f, 0.f, 0.f, 0.f};
#pragma unroll
        for (int ks = 0; ks < 2; ++ks) { const bf16x8 fin = sm::frag_n(L + INM, 144, 16 * it, 32 * ks, lane);
            ac = sm::mma(sm::frag_t(L + WT, 272, 16 * at, 32 * ks, lane), fin, ac);
            ad = sm::mma(sm::frag_t(L + UT, 272, 16 * at, 32 * ks, lane), fin, ad); }
        const int i = 16 * it + x2, d = 16 * at + x1; const f32x4 qv = sm::unpack4(*(const LAS u32x2*)(L + QS + i * 272 + d * 2));
        *(u32x2*)(Cg + i * 128 + d) = sm::pack4(qv * egs[i] - ac);
        *(u32x2*)(Dg + i * 128 + d) = sm::pack4(ad); } }
#ifdef DBG_DUMP
    { unsigned char* dst = C.ws + WS_HID + (size_t)chunk * 150528; for (int o = tid * 16; o < 150528; o += 512 * 16) *(u32x4*)(dst + o) = *(const LAS u32x4*)(L + o); }
#endif
    __syncthreads();
}

__device__ __forceinline__ void scan_unit(const Ctx& C, int unit) {
    const int cs = unit & 7, bh = unit >> 3;
    const int lane = C.lane, w = C.wave, x2 = lane & 15, g = lane >> 4;
    LAS char* ST = (LAS char*)C.lds;
    const bf16* Mg = (const bf16*)(C.ws + WS_GM) + (size_t)bh * 64 * 16384; const bf16* Bg = (const bf16*)(C.ws + WS_GB) + (size_t)bh * 64 * 16384;
    bf16* Sg = (bf16*)(C.ws + WS_GS) + (size_t)bh * 64 * 16384; const float* GAM = (const float*)(C.ws + WS_GAM) + bh * 64;
    const int c = cs * 16 + x2, d0 = 16 * w + 4 * g;
    { unsigned zz = 0u; asm volatile("" : "+v"(zz));
      if (C.tid < 272) *(LAS u32x4*)(ST + C.tid * 16) = (u32x4){zz, zz, zz, zz}; }
    __syncthreads();
    f32x4 acc = (f32x4){0.f, 0.f, 0.f, 0.f};
    const bf16* mrow = Mg + (16 * w + x2) * 128 + 8 * g; const bf16* brow = Bg + c * 128 + d0; bf16* srow = Sg + c * 128 + d0;
    bf16x8 fm[4]; u32x2 bv; float gam;
#pragma unroll
    for (int ks = 0; ks < 4; ++ks) fm[ks] = *(const bf16x8*)(mrow + 32 * ks);
    bv = *(const u32x2*)brow; gam = GAM[0];
#pragma unroll 1
    for (int n = 0; n < 64; ++n) {
        *(u32x2*)(srow + (size_t)n * 16384) = sm::pack4(acc);
        bf16x8 fmn[4]; u32x2 bvn = bv; float gamn = gam;
#pragma unroll
        for (int ks = 0; ks < 4; ++ks) fmn[ks] = fm[ks];
        if (n + 1 < 64) {
#pragma unroll
            for (int ks = 0; ks < 4; ++ks) fmn[ks] = *(const bf16x8*)(mrow + (size_t)(n + 1) * 16384 + 32 * ks);
            bvn = *(const u32x2*)(brow + (size_t)(n + 1) * 16384); gamn = GAM[n + 1]; }
        f32x4 a = acc * gam + sm::unpack4(bv);
        const LAS char* sb = ST + (n & 1) * 4352;
#pragma unroll
        for (int ks = 0; ks < 4; ++ks) a = sm::mma(fm[ks], sm::frag_n(sb, 272, 0, 32 * ks, lane), a);
        acc = a;
        *(LAS u32x2*)(ST + ((n + 1) & 1) * 4352 + x2 * 272 + d0 * 2) = sm::pack4(acc);
#pragma unroll
        for (int ks = 0; ks < 4; ++ks) fm[ks] = fmn[ks];
        bv = bvn; gam = gamn;
        __syncthreads();
    }
}

__device__ __forceinline__ void out_unit(const Ctx& C, int ei, int unit) {
    const int pr = unit & 31, h = (unit >> 5) & 3, b = unit >> 7;
    const int lane = C.lane, w = C.wave, x2 = lane & 15, g = lane >> 4;
    const int n = 2 * pr + (w >> 2), it = w & 3, chunk = (b * 4 + h) * 64 + n;
    const bf16* Sg = (const bf16*)(C.ws + WS_GS) + (size_t)chunk * 16384; const bf16* Cg = (const bf16*)(C.ws + WS_GC) + (size_t)chunk * 8192; const bf16* Dg = (const bf16*)(C.ws + WS_GD) + (size_t)chunk * 8192;
    const bf16* H1 = (const bf16*)(C.ws + WS_ARENA); bf16* MIX = (bf16*)(C.ws + WS_MIX);
    const int i = 16 * it + x2; const size_t tok = (size_t)b * SEQ + n * 64 + i;
    bf16x8 fc[4];
#pragma unroll
    for (int ks = 0; ks < 4; ++ks) fc[ks] = *(const bf16x8*)(Cg + i * 128 + 32 * ks + 8 * g);
    f32x4 o[8]; float ss = 0.f;
#pragma unroll
    for (int ct = 0; ct < 8; ++ct) { f32x4 a = sm::unpack4(*(const u32x2*)(Dg + i * 128 + 16 * ct + 4 * g));
#pragma unroll
        for (int ks = 0; ks < 4; ++ks) a = sm::mma(*(const bf16x8*)(Sg + (16 * ct + x2) * 128 + 32 * ks + 8 * g), fc[ks], a);
        o[ct] = a; ss += (a[0] * a[0] + a[1] * a[1]) + (a[2] * a[2] + a[3] * a[3]); }
    ss += __shfl_xor(ss, 16); ss += __shfl_xor(ss, 32);
    const float rstd = 1.0f / sqrtf(ss * (1.f / 128.f) + RMS_EPS);
    const float* nw = C.inp(9) + ei * 128; const bf16* zrow = H1 + tok * H1LD + 2560 + h * 128; bf16* orow = MIX + tok * DM + 512 + h * 128;
#pragma unroll
    for (int ct = 0; ct < 8; ++ct) { const int c = 16 * ct + 4 * g; const f32x4 z = sm::unpack4(*(const u32x2*)(zrow + c)); const f32x4 nv = *(const f32x4*)(nw + c); f32x4 y;
#pragma unroll
        for (int r = 0; r < 4; ++r) y[r] = o[ct][r] * rstd * nv[r] * silu(z[r]);
        *(u32x2*)(orow + c) = sm::pack4(y); }
}
}

__device__ __forceinline__ void phase_even_local(const Ctx& C0, int ei) {
    { const Ctx C = phase_ctx(C0); for (int u = C.bid; u < 1024; u += C.G) sgu_unit(C, ei, u); }
    { const Ctx C = phase_ctx(C0); for (int u = C.bid; u < 2048; u += C.G) gdn::prep_unit(C, ei, u); }
}
__device__ __forceinline__ void phase_scan(const Ctx& C0) { const Ctx C = phase_ctx(C0); for (int u = C.bid; u < 256; u += C.G) { gdn::scan_unit(C, u); __syncthreads(); } }
__device__ __forceinline__ void phase_gdn_out(const Ctx& C0, int ei) { const Ctx C = phase_ctx(C0); for (int u = C.bid; u < 1024; u += C.G) gdn::out_unit(C, ei, u); }

#ifndef MK_PER_PHASE
#define MK_PER_PHASE 0
#endif
constexpr int N_PHASES = 1 + DEPTH * 9;
#ifndef PH_EN
#define PH_EN 0x7fff
#endif
#define PEN(k) ((PH_EN >> (k)) & 1)
struct Args { const float* in[27]; float* out; unsigned char* ws; int ph_lo, ph_hi; };

__global__ void __launch_bounds__(NWAVES * 64, 2) mk_fwd(Args args) {
    extern __shared__ __attribute__((aligned(16))) unsigned char lds_raw[];
    Ctx C;
    C.lds = (LAS unsigned char*)lds_raw;
    C.tid = threadIdx.x; C.lane = C.tid & 63; C.wave = __builtin_amdgcn_readfirstlane(C.tid >> 6); C.G = gridDim.x; C.bid = blockIdx.x;
    C.ka = (const __attribute__((address_space(4))) char*)__builtin_amdgcn_kernarg_segment_ptr();
    C.out = nullptr; C.ws = nullptr; C.ctl = nullptr;
    for (int u = C.tid; u < 128; u += NWAVES * 64) ((LAS unsigned*)(C.lds + LDS_CTL_OFF))[u] = 0u;
    __syncthreads();
#if !MK_PER_PHASE
    { const Ctx P = phase_ctx(C); (void)xcd_barrier_post((unsigned*)P.ws + CW_BAR, (volatile LAS unsigned*)(C.lds + LDS_CTL_OFF) + 8); }
#define GRID_BAR() do { const Ctx P_ = phase_ctx(C); XcdBarrier b_; b_.bar = (unsigned*)P_.ws + CW_BAR; b_.x = xb_xcc_id(); b_.st = (volatile LAS unsigned*)(C.lds + LDS_CTL_OFF) + 8; xcd_barrier(b_); } while (0)
#else
#define GRID_BAR() do {} while (0)
#endif
    const int lo = args.ph_lo, hi = args.ph_hi;
#define IN(k) (lo <= (k) && (k) < hi)
#define SEAM(k) do { if (IN((k) + 1)) GRID_BAR(); } while (0)
    if (PEN(0) && IN(0)) { phase_prologue(C); SEAM(0); }
#pragma unroll 1
    for (int L = 0; L < DEPTH; ++L) {
        const int pb = 1 + L * 9, li = L >> 1;
        if ((L & 1) == 0) {
            if (PEN(1) && IN(pb + 0)) {
                const Ctx P = phase_ctx(C); unsigned char* ws = P.ws;
                EpiBf16 E{(bf16*)(ws + WS_ARENA), EVEN_N, 1024};
                run_plain_gemm(P, (const bf16*)(ws + WS_XB), DM, DM, EVEN_N, (const bf16*)(ws + WS_WEIN) + (size_t)li * EVEN_N * DM, E);
                SEAM(pb + 0); }
            if (PEN(2) && IN(pb + 1)) { phase_even_local(C, li); SEAM(pb + 1); }
            if (PEN(3) && IN(pb + 2)) { phase_scan(C); SEAM(pb + 2); }
            if (PEN(4) && IN(pb + 3)) { phase_gdn_out(C, li); SEAM(pb + 3); }
            if (PEN(5) && IN(pb + 4)) {
                const Ctx P = phase_ctx(C); unsigned char* ws = P.ws;
                const float* xres = (L == 0) ? P.inp(0) : (const float*)(ws + WS_XF);
                EpiRes E{xres, (float*)(ws + WS_Y)};
                run_plain_gemm(P, (const bf16*)(ws + WS_MIX), DM, DM, DM, (const bf16*)(ws + WS_WEOUT) + (size_t)li * DM * DM, E);
                SEAM(pb + 4); }
        } else {
            if (PEN(6) && IN(pb + 0)) {
                const Ctx P = phase_ctx(C); unsigned char* ws = P.ws;
                EpiBf16 E{(bf16*)(ws + WS_ARENA + AR_C1), ODD_N, 0};
                run_plain_gemm(P, (const bf16*)(ws + WS_XB), DM, DM, ODD_N, (const bf16*)(ws + WS_WOIN) + (size_t)li * ODD_N * DM, E);
                SEAM(pb + 0); }
            if (PEN(7) && IN(pb + 1)) { phase_o1b(C); SEAM(pb + 1); }
            if (PEN(8) && IN(pb + 2)) {
                { const Ctx P = phase_ctx(C); unsigned char* ws = P.ws;
                  EpiQ E{(bf16*)(ws + WS_ARENA + AR_Q), (const float*)(ws + WS_RS), (const f32x4*)(ws + WS_ROPE)};
                  run_plain_gemm(P, (const bf16*)(ws + WS_ARENA + AR_C1), ODD_N, QL, 1536, (const bf16*)(ws + WS_WUQ) + (size_t)li * 1536 * QL, E); }
                { const Ctx P = phase_ctx(C); unsigned char* ws = P.ws;
                  EpiKV E{(bf16*)(ws + WS_ARENA + AR_KV), (const float*)(ws + WS_RS) + T};
                  run_plain_gemm(P, (const bf16*)(ws + WS_ARENA + AR_C1) + QL, ODD_N, KVL, 2048, (const bf16*)(ws + WS_WUKV) + (size_t)li * 2048 * KVL, E); }
                SEAM(pb + 2); }
            if (PEN(9) && IN(pb + 3)) { phase_attn(C); SEAM(pb + 3); }
            if (PEN(10) && IN(pb + 4)) {
                const Ctx P = phase_ctx(C); unsigned char* ws = P.ws;
                EpiRes E{(const float*)(ws + WS_XF), (float*)(ws + WS_Y)};
                run_plain_gemm(P, (const bf16*)(ws + WS_MIX), DM, DM, DM, (const bf16*)(ws + WS_WOOUT) + (size_t)li * DM * DM, E);
                SEAM(pb + 4); }
        }
        if (PEN(11) && IN(pb + 5)) { phase_router(C, L); SEAM(pb + 5); }
        if (PEN(12) && IN(pb + 6)) {
            const Ctx P = phase_ctx(C); unsigned char* ws = P.ws;
            EpiSwiglu E{(bf16*)(ws + WS_HID), P.inp(24) + (size_t)L * NEXP * 2048, nullptr};
            run_moe_gemm(P, L, (const bf16*)(ws + WS_XB), DM, 2, DM, 2048, (const bf16*)(ws + WS_WGU) + (size_t)L * NEXP * 2048 * DM, (size_t)2048 * DM, E);
            SEAM(pb + 6); }
        if (PEN(13) && IN(pb + 7)) {
            const Ctx P = phase_ctx(C); unsigned char* ws = P.ws;
            EpiDown E{(bf16*)(ws + WS_YE), P.inp(26) + (size_t)L * NEXP * DM, (const float*)(ws + WS_GATE), nullptr};
            run_moe_gemm(P, L, (const bf16*)(ws + WS_HID), DFF, 0, DFF, DM, (const bf16*)(ws + WS_WDN) + (size_t)L * NEXP * DM * DFF, (size_t)DM * DFF, E);
            SEAM(pb + 7); }
        if (PEN(14) && IN(pb + 8)) { phase_combine(C, L); SEAM(pb + 8); }
    }
#undef IN
#undef SEAM
}

extern "C" void kernel_launch(void* const* d_in, const int* in_sizes, int n_in, void* d_out, int out_size, void* d_ws, size_t ws_size, hipStream_t stream) {
    static int grid = 0;
    if (grid == 0) {
        if (n_in != 27 || in_sizes[0] != T * DM || out_size != T * DM || ws_size < WS_END) { fprintf(stderr, "kernel_launch: unexpected shapes (n_in %d, in0 %d, out %d, ws %zu)\n", n_in, n_in > 0 ? in_sizes[0] : -1, out_size, ws_size); grid = -1; return; }
        int dev = 0, cus = 0, per_cu = 0;
        if (hipGetDevice(&dev) != hipSuccess || hipDeviceGetAttribute(&cus, hipDeviceAttributeMultiprocessorCount, dev) != hipSuccess) { grid = -1; return; }
        if (hipFuncSetAttribute((const void*)mk_fwd, hipFuncAttributeMaxDynamicSharedMemorySize, LDS_BYTES) != hipSuccess) { fprintf(stderr, "kernel_launch: hipFuncSetAttribute failed\n"); grid = -1; return; }
        if (hipOccupancyMaxActiveBlocksPerMultiprocessor(&per_cu, (const void*)mk_fwd, NWAVES * 64, LDS_BYTES) != hipSuccess || per_cu < 1) fprintf(stderr, "kernel_launch: occupancy query reports %d\n", per_cu);
        (void)hipGetLastError();
        grid = cus;
        if (grid != 256) fprintf(stderr, "kernel_launch: %d CUs (built for 256)\n", grid);
    }
    if (grid < 0) return;
    if (hipMemsetAsync((char*)d_ws + WS_CTL, 0, CTL_ZERO_BYTES, stream) != hipSuccess) return;
    Args a{};
    for (int i = 0; i < 27; ++i) a.in[i] = (const float*)d_in[i];
    a.out = (float*)d_out; a.ws = (unsigned char*)d_ws;
#if MK_PER_PHASE
    for (int p = 0; p < N_PHASES; ++p) { a.ph_lo = p; a.ph_hi = p + 1; hipLaunchKernelGGL(mk_fwd, dim3(grid), dim3(NWAVES * 64), LDS_BYTES, stream, a); }
#else
    a.ph_lo = 0; a.ph_hi = N_PHASES;
    hipLaunchKernelGGL(mk_fwd, dim3(grid), dim3(NWAVES * 64), LDS_BYTES, stream, a);
#endif
    const hipError_t le = hipPeekAtLastError();
    if (le != hipSuccess) fprintf(stderr, "kernel_launch: launch failed: %s\n", hipGetErrorName(le));
}
```

```cpp
#define MK_PER_PHASE 0
#include <hip/hip_runtime.h>
#include <cstdio>
#include <cstdint>

#define GAS __attribute__((address_space(1)))
#define LAS __attribute__((address_space(3)))
typedef unsigned short bf16;
typedef short bf16x8 __attribute__((ext_vector_type(8)));
typedef short s16x4 __attribute__((ext_vector_type(4)));
typedef float f32x2 __attribute__((ext_vector_type(2)));
typedef float f32x4 __attribute__((ext_vector_type(4)));
typedef float f32x16 __attribute__((ext_vector_type(16)));
typedef unsigned u32x2 __attribute__((ext_vector_type(2)));
typedef unsigned u32x4 __attribute__((ext_vector_type(4)));
typedef GAS unsigned gu32;

typedef __bf16 bf16v2_t __attribute__((ext_vector_type(2)));
__device__ __forceinline__ unsigned cvt_pk_bf16(float lo, float hi) { const bf16v2_t v = __builtin_convertvector((f32x2){lo, hi}, bf16v2_t); return __builtin_bit_cast(unsigned, v); }
__device__ __forceinline__ float bf_lo(unsigned w) { return __uint_as_float(w << 16); }
__device__ __forceinline__ float bf_hi(unsigned w) { return __uint_as_float(w & 0xffff0000u); }
__device__ __forceinline__ float bf2f(bf16 b) { return __uint_as_float(((unsigned)b) << 16); }
__device__ __forceinline__ bf16 f2bf(float f) { return (bf16)(cvt_pk_bf16(f, 0.f) & 0xffffu); }
__device__ __forceinline__ float wave_sum(float v) {
#pragma unroll
    for (int o = 1; o < 64; o <<= 1) v += __shfl_xor(v, o);
    return v;
}

namespace pg8 {
constexpr int BM = 256, BK = 64, HALF = 128, HTB = HALF * BK * 2, STAGE_BYTES = 8 * HTB, NXCD = 8, WGM = 8;
__host__ __device__ __forceinline__ int lds_byte(int r, int c) { const int st = (r >> 4) * 2 + (c >> 5), rr = r & 15, cc = c & 31, ob = rr * 64 + cc * 2; return st * 1024 + (ob ^ (((ob >> 9) & 1) << 5)); }
__host__ __device__ __forceinline__ void stage_rc(int b, int& R, int& C) { const int st = b / 1024, sb = b % 1024, swz = sb ^ (((sb >> 9) & 1) << 5); R = (st >> 1) * 16 + swz / 64; C = (st & 1) * 32 + (swz % 64) / 2; }
__host__ __device__ __forceinline__ int perm32(int rho) { const int n = rho >> 4, i = rho & 15; return 8 * (i >> 2) + 4 * n + (i & 3); }

struct Unit { int pm, pn, e, li; };

struct StaticOrder {
    int nM, nN, nwg, G, c;
    __device__ void init(int M, int N, int G_, int c_) { nM = M / BM; nN = N / BM; nwg = nM * nN; G = G_; c = c_; }
    __device__ bool next(int i, Unit& u) const {
        const long L = (long)i * G + c; if (L >= nwg) return false;
        int wgid = (int)L; { const int q = nwg / NXCD, r = nwg % NXCD, xcd = wgid % NXCD, off = wgid / NXCD; wgid = (xcd < r ? xcd * (q + 1) : r * (q + 1) + (xcd - r) * q) + off; }
        const int nig = WGM * nN, gid = wgid / nig, fm = gid * WGM, gsz = (nM - fm) < WGM ? (nM - fm) : WGM;
        u.pm = fm + ((wgid % nig) % gsz); u.pn = (wgid % nig) / gsz; u.e = 0; u.li = 0; return true;
    }
};
struct PlainSched {
    static constexpr bool GATHER = false;
    StaticOrder o; const char* Bt; int K; int lda;
    __device__ __forceinline__ size_t arow0(const Unit& u) const { return (size_t)u.pm * BM * lda * 2; }
    __device__ __forceinline__ bool next(int i, Unit& u) const { return o.next(i, u); }
    __device__ __forceinline__ const char* bbase(const Unit& u) const { return Bt + (size_t)u.pn * BM * K * 2; }
};

__device__ __forceinline__ f32x2 gelu_pk(f32x2 v) {
    const f32x2 av = __builtin_elementwise_abs(v), d = av * 0.2316418882f + 1.0f;
    f32x2 t; t.x = __builtin_amdgcn_rcpf(d.x); t.y = __builtin_amdgcn_rcpf(d.y);
    f32x2 q = t * 0.5307027145f + (-0.7265760135f); q = q * t + 0.7107068705f; q = q * t + (-0.142248368f); q = q * t + 0.127414796f; q = q * t;
    const f32x2 s = (v * v) * (-0.72134752044f);
    f32x2 e; e.x = __builtin_amdgcn_exp2f(s.x); e.y = __builtin_amdgcn_exp2f(s.y);
    const f32x2 m = v * (q * e), r = v - m;
    f32x2 o; o.x = v.x < 0.f ? m.x : r.x; o.y = v.y < 0.f ? m.y : r.y; return o;
}

template <class Epi, class Sched, bool ALIGN_EPI>
__device__ __forceinline__ void gemm_phase(LAS unsigned char* lds, const char* Abase, int K, const Sched& S, const Epi& E) {
    int tid_ = threadIdx.x; asm volatile("" : "+v"(tid_));
    const int tid = tid_, wid = __builtin_amdgcn_readfirstlane(tid >> 6), lane = tid & 63, wr = wid >> 2, wc = wid & 3, fr = lane & 15, fq = lane >> 4;
    int nt = K / BK; asm volatile("" : "+s"(nt));
    int Rr[2], Cc[2]; unsigned voffB[2], voffA[2];
#pragma unroll
    for (int i = 0; i < 2; ++i) { stage_rc(tid * 16 + i * 8192, Rr[i], Cc[i]); const int Rb = Epi::PERM ? ((Rr[i] & ~31) + perm32(Rr[i] & 31)) : Rr[i]; voffB[i] = (unsigned)(Rb * K + Cc[i]) * 2u;
        voffA[i] = 0u; if constexpr (!Sched::GATHER) voffA[i] = (unsigned)(Rr[i] * S.lda + Cc[i]) * 2u; }
    const size_t hstepA = (size_t)HALF * S.lda * 2;
    const size_t kstep = (size_t)(BK * 2);
    const size_t hstepB = (size_t)HALF * K * 2;
    const unsigned ldsw = (unsigned)wid * 1024u;
    const int aoff = lds_byte(wr * 64 + fr, fq * 8), boff = lds_byte(wc * 32 + fr, fq * 8);
#define PG8_SA(b, h) (((b) * 2 + (h)) * HTB)
#define PG8_SB(b, h) ((4 + (b) * 2 + (h)) * HTB)
#define PG8_STAGEB(bufoff, gbase) do { _Pragma("unroll") for (int _i = 0; _i < 2; ++_i) \
        __builtin_amdgcn_global_load_lds((const unsigned*)((const char*)(gbase) + voffB[_i]), (LAS unsigned*)(lds + (bufoff) + ldsw + _i * 8192), 16, 0, 0); } while (0)
#define PG8_STAGEA(bufoff, h, koff) do { _Pragma("unroll") for (int _i = 0; _i < 2; ++_i) { \
        if constexpr (Sched::GATHER) __builtin_amdgcn_global_load_lds((const unsigned*)(Abase + (size_t)va[h][_i] + (koff)), (LAS unsigned*)(lds + (bufoff) + ldsw + _i * 8192), 16, 0, 0); \
        else __builtin_amdgcn_global_load_lds((const unsigned*)(cA + (h) * hstepA + (koff) + voffA[_i]), (LAS unsigned*)(lds + (bufoff) + ldsw + _i * 8192), 16, 0, 0); } } while (0)
#define PG8_LDA(dst, b, h) do { _Pragma("unroll") for (int m = 0; m < 4; ++m) _Pragma("unroll") for (int k = 0; k < 2; ++k) dst[m][k] = *(const LAS bf16x8*)(lds + PG8_SA(b, h) + aoff + m * 2048 + k * 1024); } while (0)
#define PG8_LDB(dst, b, h) do { _Pragma("unroll") for (int n = 0; n < 2; ++n) _Pragma("unroll") for (int k = 0; k < 2; ++k) dst[n][k] = *(const LAS bf16x8*)(lds + PG8_SB(b, h) + boff + n * 2048 + k * 1024); } while (0)
#define PG8_MMA(ai, bj, At, Bt) do { __builtin_amdgcn_s_setprio(1); _Pragma("unroll") for (int m = 0; m < 4; ++m) _Pragma("unroll") for (int n = 0; n < 2; ++n) _Pragma("unroll") for (int k = 0; k < 2; ++k) \
        acc[ai][bj][m][n] = __builtin_amdgcn_mfma_f32_16x16x32_bf16(Bt[n][k], At[m][k], acc[ai][bj][m][n], 0, 0, 0); __builtin_amdgcn_s_setprio(0); } while (0)
#define PG8_WAIT_V(n) asm volatile("s_waitcnt vmcnt(" #n ")" ::: "memory")
#define PG8_WAIT_L(n) asm volatile("s_waitcnt lgkmcnt(" #n ")" ::: "memory")
#define PG8_BAR __builtin_amdgcn_s_barrier()
#define PG8_SCHED __builtin_amdgcn_sched_barrier(0)
    Unit cur, nxt; int ui = 0;
    if (!S.next(0, cur)) return;
    f32x4 acc[2][2][4][2];
#pragma unroll
    for (int a = 0; a < 2; ++a)
#pragma unroll
        for (int b = 0; b < 2; ++b)
#pragma unroll
            for (int m = 0; m < 4; ++m)
#pragma unroll
                for (int n = 0; n < 2; ++n) acc[a][b][m][n] = (f32x4){0.f, 0.f, 0.f, 0.f};
    bf16x8 At[4][2], B0[2][2], B1[2][2];
    unsigned va[2][2], vn[2][2]; const char* cA = Abase; const char* nA = Abase;
    if constexpr (Sched::GATHER) {
#pragma unroll
        for (int h = 0; h < 2; ++h)
#pragma unroll
            for (int i = 0; i < 2; ++i) va[h][i] = S.aoff(cur, h * HALF + Rr[i]) + (unsigned)Cc[i] * 2u;
    } else { cA = Abase + S.arow0(cur); }
    const char* cB = S.bbase(cur);
    PG8_STAGEB(PG8_SB(0, 0), cB); PG8_STAGEB(PG8_SB(0, 1), cB + hstepB); PG8_STAGEA(PG8_SA(0, 0), 0, 0); PG8_STAGEA(PG8_SA(0, 1), 1, 0);
    if (wr == 1) PG8_BAR;
    PG8_WAIT_V(2); PG8_BAR;
    PG8_STAGEB(PG8_SB(1, 0), cB + kstep); PG8_STAGEA(PG8_SA(1, 0), 0, kstep); PG8_STAGEB(PG8_SB(1, 1), cB + hstepB + kstep);
    PG8_WAIT_V(6); PG8_BAR;
    for (;;) {
        const bool has_next = S.next(ui + 1, nxt);
        const char* nB = has_next ? S.bbase(nxt) : cB;
        if constexpr (Sched::GATHER) {
            if (has_next) {
#pragma unroll
                for (int h = 0; h < 2; ++h)
#pragma unroll
                    for (int i = 0; i < 2; ++i) vn[h][i] = S.aoff(nxt, h * HALF + Rr[i]) + (unsigned)Cc[i] * 2u;
            } else {
#pragma unroll
                for (int h = 0; h < 2; ++h)
#pragma unroll
                    for (int i = 0; i < 2; ++i) vn[h][i] = va[h][i];
            }
        } else { nA = has_next ? Abase + S.arow0(nxt) : cA; }
        for (int t = 0; t < nt; t += 2) {
            const bool last = (t == nt - 2);
            const size_t k1 = (size_t)(t + 1) * kstep;
            PG8_LDB(B0, 0, 0); PG8_LDB(B1, 0, 1); PG8_SCHED; PG8_LDA(At, 0, 0); PG8_STAGEA(PG8_SA(1, 1), 1, k1);
            PG8_WAIT_V(8); PG8_WAIT_L(0); PG8_BAR; PG8_MMA(0, 0, At, B0); PG8_MMA(0, 1, At, B1); PG8_BAR; PG8_SCHED;
            if (last) {
                if constexpr (Sched::GATHER) {
#pragma unroll
                    for (int h = 0; h < 2; ++h)
#pragma unroll
                        for (int i = 0; i < 2; ++i) va[h][i] = vn[h][i];
                } else { cA = nA; }
            }
            const char* bX = last ? nB : cB;
            const size_t k2 = last ? (size_t)0 : (size_t)(t + 2) * kstep, k3 = k2 + kstep;
            PG8_LDA(At, 0, 1); PG8_STAGEB(PG8_SB(0, 0), bX + k2); PG8_STAGEB(PG8_SB(0, 1), bX + hstepB + k2); PG8_STAGEA(PG8_SA(0, 0), 0, k2);
            PG8_WAIT_V(8); PG8_WAIT_L(0); PG8_BAR; PG8_MMA(1, 0, At, B0); PG8_MMA(1, 1, At, B1); PG8_BAR; PG8_SCHED;
            PG8_LDB(B0, 1, 0); PG8_LDB(B1, 1, 1); PG8_SCHED; PG8_LDA(At, 1, 0); PG8_STAGEA(PG8_SA(0, 1), 1, k2);
            PG8_WAIT_V(8); PG8_WAIT_L(0); PG8_BAR; PG8_MMA(0, 0, At, B0); PG8_MMA(0, 1, At, B1); PG8_BAR; PG8_SCHED;
            PG8_LDA(At, 1, 1); PG8_STAGEB(PG8_SB(1, 0), bX + k3); PG8_STAGEB(PG8_SB(1, 1), bX + hstepB + k3); PG8_STAGEA(PG8_SA(1, 0), 0, k3);
            PG8_WAIT_V(8); PG8_WAIT_L(0); PG8_BAR; PG8_MMA(1, 0, At, B0); PG8_MMA(1, 1, At, B1); PG8_BAR; PG8_SCHED;
        }
        if constexpr (ALIGN_EPI) { if (wr == 0) PG8_BAR; }
        E(acc, cur, wr, wc, fr, fq);
        if (!has_next) break;
#pragma unroll
        for (int a = 0; a < 2; ++a)
#pragma unroll
            for (int b = 0; b < 2; ++b)
#pragma unroll
                for (int m = 0; m < 4; ++m)
#pragma unroll
                    for (int n = 0; n < 2; ++n) acc[a][b][m][n] = (f32x4){0.f, 0.f, 0.f, 0.f};
        cur = nxt; cB = nB; ++ui;
        if constexpr (ALIGN_EPI) { if (wr == 1) PG8_BAR; }
    }
    PG8_WAIT_V(0);
    if constexpr (!ALIGN_EPI) { if (wr == 0) PG8_BAR; }
    PG8_BAR;
#undef PG8_SA
#undef PG8_SB
#undef PG8_STAGEA
#undef PG8_STAGEB
#undef PG8_LDA
#undef PG8_LDB
#undef PG8_MMA
#undef PG8_WAIT_V
#undef PG8_WAIT_L
#undef PG8_BAR
#undef PG8_SCHED
}
}

constexpr int NWAVES = 8;
constexpr int BATCH = 8, SEQ = 4096, DM = 1024, DEPTH = 4;
constexpr int T = BATCH * SEQ;
constexpr int EVEN_IN = 3080, EVEN_N = 3072;
constexpr int ODD_IN = 704, ODD_N = 768, QL = 384, KVL = 256;
constexpr int NEXP = 32, TOPK = 4, DFF = 1024;
constexpr int NSLOT = T * TOPK;
constexpr int LCAP = T;
constexpr float LN_EPS = 1e-5f, RMS_EPS = 1e-6f;
constexpr float DN_ALPHA = 1.681792830507429f;
constexpr float ATT_SCALE = 0.07216878364870323f;

constexpr size_t MiB = 1u << 20;
constexpr size_t WS_CTL = 0, CTL_ZERO_BYTES = 1 * MiB;
constexpr size_t WS_WGU = 16 * MiB, WS_WDN = 528 * MiB, WS_WEIN = 784 * MiB, WS_WEOUT = 796 * MiB, WS_WOIN = 800 * MiB, WS_WUQ = 804 * MiB, WS_WUKV = 808 * MiB, WS_WOOUT = 810 * MiB;
constexpr size_t WS_ROPE = 814 * MiB, WS_AB = 815 * MiB, WS_RS = 816 * MiB, WS_GATE = 817 * MiB, WS_LIST = 818 * MiB, WS_GAM = 822 * MiB;
constexpr size_t WS_XF = 832 * MiB, WS_XB = 960 * MiB, WS_Y = 1024 * MiB, WS_ARENA = 1152 * MiB, WS_MIX = 1440 * MiB;
constexpr size_t WS_GM = 1504 * MiB, WS_GB = 1568 * MiB, WS_GC = 1632 * MiB, WS_GD = 1664 * MiB, WS_GS = 1696 * MiB, WS_HID = 1760 * MiB, WS_YE = 2016 * MiB, WS_END = 2272 * MiB;
constexpr size_t AR_C1 = 0, AR_Q = 48 * MiB, AR_KV = 144 * MiB, AR_KPE = 272 * MiB;
constexpr int CW_TMO = 0, CW_CODE = 1, CW_BAR = 4096, CW_CNT = 16384;

constexpr int LDS_BYTES = 163840;
constexpr int LDS_CTL_OFF = 163840 - 512;
constexpr int LDS_SPARE = 131072;

#define RLX_AGENT __ATOMIC_RELAXED, __HIP_MEMORY_SCOPE_AGENT
#define LDS_WAIT() asm volatile("s_waitcnt lgkmcnt(0)" ::: "memory")
#define VM_WAIT() asm volatile("s_waitcnt vmcnt(0)" ::: "memory")

#define XB_TMO      128
#define XB_XCNT(j)  (256  + 64 * (j))
#define XB_XSUB(j)  (1280 + 64 * (j))
#define XB_XGEN(j)  (2304 + 64 * (j))
#define XB_TOP      3328
#define XB_TOPGEN   3392
#define XCD_BAR_WORDS 3456
#define XB_SPIN_CAP (1u << 18)
__device__ __forceinline__ unsigned xb_ld(unsigned* p)              { return __hip_atomic_load(p, __ATOMIC_RELAXED, __HIP_MEMORY_SCOPE_AGENT); }
__device__ __forceinline__ unsigned xb_add(unsigned* p, unsigned v) { return __hip_atomic_fetch_add(p, v, __ATOMIC_RELAXED, __HIP_MEMORY_SCOPE_AGENT); }
__device__ __forceinline__ unsigned xb_xcc_id() { return (unsigned)__builtin_amdgcn_s_getreg((3 << 11) | 20) & 0xFu; }
#define XB_SPIN(cond, bar) do { unsigned _sp = 0; while (cond) { __builtin_amdgcn_s_sleep(1); \
    if ((++_sp & 255u) == 0u) { if (xb_ld(&(bar)[XB_TMO])) break; if (_sp > XB_SPIN_CAP) { atomicAdd(&(bar)[XB_TMO], 1u); break; } } } } while (0)
struct XcdBarrier { unsigned* bar; unsigned x; volatile LAS unsigned* st; };
__device__ __forceinline__ XcdBarrier xcd_barrier_post(unsigned* bar, volatile LAS unsigned* st) {
    XcdBarrier b; b.bar = bar; b.x = xb_xcc_id(); b.st = st;
    if (threadIdx.x == 0) (void)xb_add(&bar[XB_XCNT(b.x)], 1u);
    return b;
}
__device__ __forceinline__ void xcd_barrier_complete(unsigned* bar, unsigned x, unsigned& nloc, unsigned& nx) {
    const unsigned G = gridDim.x * gridDim.y * gridDim.z;
    unsigned sum, cnt, mine, sp = 0u;
    for (;;) {
        sum = 0u; cnt = 0u; mine = 0u;
#pragma unroll
        for (unsigned j = 0; j < 16; ++j) { const unsigned c = xb_ld(&bar[XB_XCNT(j)]); sum += c; cnt += (c > 0u) ? 1u : 0u; mine = (j == x) ? c : mine; }
        if (sum == G) break;
        __builtin_amdgcn_s_sleep(1);
        if ((++sp & 255u) == 0u) { if (xb_ld(&bar[XB_TMO])) break; if (sp > XB_SPIN_CAP) { atomicAdd(&bar[XB_TMO], 1u); break; } }
    }
    nloc = mine > 0u ? mine : 1u; nx = cnt > 0u ? cnt : 1u;
}
__device__ __forceinline__ void xcd_barrier(const XcdBarrier& b) {
    asm volatile("s_waitcnt vmcnt(0)" ::: "memory");
    __syncthreads();
    if (threadIdx.x == 0) {
        unsigned* bar = b.bar;
        __builtin_amdgcn_s_waitcnt(0);
        unsigned nloc = b.st[0], nx = b.st[1];
        if (nloc == 0u) { xcd_barrier_complete(bar, b.x, nloc, nx); b.st[0] = nloc; b.st[1] = nx; }
        const unsigned old = xb_add(&bar[XB_XSUB(b.x)], 1u);
        const unsigned gen = old / nloc;
        if (old + 1u == (gen + 1u) * nloc) {
            __builtin_amdgcn_fence(__ATOMIC_RELEASE, "agent");
            asm volatile("s_waitcnt vmcnt(0)" ::: "memory");
            const unsigned og = xb_add(&bar[XB_TOP], 1u);
            const unsigned tg = og / nx;
            if (og + 1u == (tg + 1u) * nx) xb_add(&bar[XB_TOPGEN], 1u);
            else XB_SPIN(xb_ld(&bar[XB_TOPGEN]) == tg, bar);
            __builtin_amdgcn_fence(__ATOMIC_ACQUIRE, "agent");
            xb_add(&bar[XB_XGEN(b.x)], 1u);
            asm volatile("s_waitcnt vmcnt(0)" ::: "memory");
        } else {
            XB_SPIN(xb_ld(&bar[XB_XGEN(b.x)]) == gen, bar);
            __builtin_amdgcn_fence(__ATOMIC_ACQUIRE, "agent");
            asm volatile("s_waitcnt vmcnt(0)" ::: "memory");
        }
    }
    __syncthreads();
}

struct Ctx {
    LAS unsigned char* lds;
    int tid, lane, wave, G, bid;
    const __attribute__((address_space(4))) char* ka;
    __device__ __forceinline__ const float* inp(int i) const { return ((const float* const __attribute__((address_space(4)))*)ka)[i]; }
    float* out;
    unsigned char* ws;
    unsigned* ctl;
};

__device__ __forceinline__ Ctx phase_ctx(const Ctx& C0) { Ctx C; C.lds = C0.lds; { int g_ = C0.G, b_ = C0.bid; asm volatile("" : "+s"(g_), "+s"(b_)); C.G = g_; C.bid = b_; } int t = threadIdx.x; asm volatile("" : "+v"(t)); C.tid = t; C.lane = t & 63; C.wave = __builtin_amdgcn_readfirstlane(t >> 6);
    const __attribute__((address_space(4))) char* ka = C0.ka; asm volatile("" : "+s"(ka)); C.ka = ka;
    C.out = *(float* const __attribute__((address_space(4)))*)(ka + 216); C.ws = *(unsigned char* const __attribute__((address_space(4)))*)(ka + 224); C.ctl = (unsigned*)C.ws; return C; }

__device__ __forceinline__ int uq_rowmap(int n) { const int h = n / 192, o = n - h * 192; if (o < 128) return n; const int j = o - 128; return h * 192 + 128 + (j < 32 ? 2 * j : 2 * (j - 32) + 1); }
__device__ __forceinline__ void conv_item(const float* W, int ldn, int c0, int nvalid, int K, bf16* WT, const float* kscale, int mode, LAS float* scr, int kb, int nb, int lane) {
    const int k0 = 64 * kb, n0 = 64 * nb;
    const int lc = (lane & 15) * 4, lr = lane >> 4;
#pragma unroll
    for (int i = 0; i < 16; ++i) {
        const int kk = lr + 4 * i;
        f32x4 v = (f32x4){0.f, 0.f, 0.f, 0.f};
        if (n0 + lc < nvalid) v = *(const f32x4*)(W + (size_t)(k0 + kk) * ldn + c0 + n0 + lc);
        if (kscale) { const float s = kscale[k0 + kk]; v = v * s; }
        scr[kk * 65 + lc + 0] = v.x; scr[kk * 65 + lc + 1] = v.y; scr[kk * 65 + lc + 2] = v.z; scr[kk * 65 + lc + 3] = v.w;
    }
    LDS_WAIT(); asm volatile("" ::: "memory");
    const int c = lane & 7;
#pragma unroll
    for (int j = 0; j < 8; ++j) {
        const int n = (lane >> 3) + 8 * j; const LAS float* s = scr + (8 * c) * 65 + n;
        u32x4 o; o.x = cvt_pk_bf16(s[0 * 65], s[1 * 65]); o.y = cvt_pk_bf16(s[2 * 65], s[3 * 65]); o.z = cvt_pk_bf16(s[4 * 65], s[5 * 65]); o.w = cvt_pk_bf16(s[6 * 65], s[7 * 65]);
        const int dn = mode == 1 ? uq_rowmap(n0 + n) : (n0 + n);
        *(u32x4*)(WT + (size_t)dn * K + k0 + 8 * c) = o;
    }
    LDS_WAIT(); asm volatile("" ::: "memory");
}

__device__ __forceinline__ void row_load_f32(const float* p, int lane, f32x4 (&v)[4]) {
#pragma unroll
    for (int j = 0; j < 4; ++j) v[j] = *(const f32x4*)(p + 4 * lane + 256 * j);
}
__device__ __forceinline__ void row_load_bf16(const bf16* p, int lane, f32x4 (&v)[4]) {
#pragma unroll
    for (int j = 0; j < 4; ++j) { const u32x2 w = *(const u32x2*)(p + 4 * lane + 256 * j); v[j] = (f32x4){bf_lo(w.x), bf_hi(w.x), bf_lo(w.y), bf_hi(w.y)}; }
}
__device__ __forceinline__ void row_store_f32(float* p, int lane, const f32x4 (&v)[4]) {
#pragma unroll
    for (int j = 0; j < 4; ++j) *(f32x4*)(p + 4 * lane + 256 * j) = v[j];
}
__device__ __forceinline__ void row_store_bf16(bf16* p, int lane, const f32x4 (&v)[4]) {
#pragma unroll
    for (int j = 0; j < 4; ++j) { u32x2 w; w.x = cvt_pk_bf16(v[j].x, v[j].y); w.y = cvt_pk_bf16(v[j].z, v[j].w); *(u32x2*)(p + 4 * lane + 256 * j) = w; }
}
__device__ __forceinline__ void row_layernorm(f32x4 (&v)[4], const f32x4 (&g)[4], const f32x4 (&b)[4]) {
    float s = 0.f;
#pragma unroll
    for (int j = 0; j < 4; ++j) s += (v[j].x + v[j].y) + (v[j].z + v[j].w);
    const float mean = wave_sum(s) * (1.f / DM); float s2 = 0.f;
#pragma unroll
    for (int j = 0; j < 4; ++j) { v[j] = v[j] - mean; s2 += (v[j].x * v[j].x + v[j].y * v[j].y) + (v[j].z * v[j].z + v[j].w * v[j].w); }
    const float rstd = 1.f / sqrtf(wave_sum(s2) * (1.f / DM) + LN_EPS);
#pragma unroll
    for (int j = 0; j < 4; ++j) v[j] = v[j] * rstd * g[j] + b[j];
}
__device__ __forceinline__ void row_ab(const f32x4 (&v)[4], const LAS float* w8, int lane, float (&ab)[8]) {
#pragma unroll
    for (int e = 0; e < 8; ++e) { float s = 0.f;
#pragma unroll
        for (int j = 0; j < 4; ++j) { const f32x4 w = *(const LAS f32x4*)(w8 + e * 1024 + 4 * lane + 256 * j); s += (v[j].x * w.x + v[j].y * w.y) + (v[j].z * w.z + v[j].w * w.w); }
        ab[e] = wave_sum(s); }
}
__device__ __forceinline__ void load_w8(const Ctx& C, int ei, LAS float* w8) {
    const float* W = C.inp(1) + (size_t)ei * DM * EVEN_IN;
    for (int idx = C.tid; idx < 8 * 1024; idx += NWAVES * 64) { const int k = idx >> 3, e = idx & 7; w8[e * 1024 + k] = W[(size_t)k * EVEN_IN + EVEN_N + e]; }
}

__device__ __forceinline__ void phase_prologue(const Ctx& C0) {
    const Ctx C = phase_ctx(C0);
    const int gw = C.bid * NWAVES + C.wave, NGW = C.G * NWAVES, lane = C.lane;
    LAS float* scr = (LAS float*)(C.lds + C.wave * 16640);
    unsigned char* ws = C.ws;
    constexpr int I0 = 128 * 512, I1 = 128 * 256, I2 = 2 * 768, I3 = 2 * 256, I4 = 2 * 192, I5 = 2 * 144, I6 = 2 * 128, I7 = 2 * 256;
    constexpr int NITEMS = I0 + I1 + I2 + I3 + I4 + I5 + I6 + I7;
    for (int it = gw; it < NITEMS; it += NGW) {
        int r = it;
        if (r < I0) { const int mi = r / 512, q = r % 512; conv_item(C.inp(23) + (size_t)mi * 1024 * 2048, 2048, 0, 2048, 1024, (bf16*)(ws + WS_WGU) + (size_t)mi * 2048 * 1024, nullptr, 0, scr, q / 32, q % 32, lane); continue; } r -= I0;
        if (r < I1) { const int mi = r / 256, q = r % 256; conv_item(C.inp(25) + (size_t)mi * 1024 * 1024, 1024, 0, 1024, 1024, (bf16*)(ws + WS_WDN) + (size_t)mi * 1024 * 1024, nullptr, 0, scr, q / 16, q % 16, lane); continue; } r -= I1;
        if (r < I2) { const int mi = r / 768, q = r % 768; conv_item(C.inp(1) + (size_t)mi * 1024 * EVEN_IN, EVEN_IN, 0, EVEN_N, 1024, (bf16*)(ws + WS_WEIN) + (size_t)mi * EVEN_N * 1024, nullptr, 0, scr, q / 48, q % 48, lane); continue; } r -= I2;
        if (r < I3) { const int mi = r / 256, q = r % 256; conv_item(C.inp(10) + (size_t)mi * 1024 * 1024, 1024, 0, 1024, 1024, (bf16*)(ws + WS_WEOUT) + (size_t)mi * 1024 * 1024, nullptr, 0, scr, q / 16, q % 16, lane); continue; } r -= I3;
        if (r < I4) { const int mi = r / 192, q = r % 192; conv_item(C.inp(11) + (size_t)mi * 1024 * ODD_IN, ODD_IN, 0, ODD_IN, 1024, (bf16*)(ws + WS_WOIN) + (size_t)mi * ODD_N * 1024, nullptr, 0, scr, q / 12, q % 12, lane); continue; } r -= I4;
        if (r < I5) { const int mi = r / 144, q = r % 144; conv_item(C.inp(13) + (size_t)mi * QL * 1536, 1536, 0, 1536, QL, (bf16*)(ws + WS_WUQ) + (size_t)mi * 1536 * QL, C.inp(12) + mi * QL, 1, scr, q / 24, q % 24, lane); continue; } r -= I5;
        if (r < I6) { const int mi = r / 128, q = r % 128; conv_item(C.inp(15) + (size_t)mi * KVL * 2048, 2048, 0, 2048, KVL, (bf16*)(ws + WS_WUKV) + (size_t)mi * 2048 * KVL, C.inp(14) + mi * KVL, 0, scr, q / 32, q % 32, lane); continue; } r -= I6;
        { const int mi = r / 256, q = r % 256; conv_item(C.inp(16) + (size_t)mi * 1024 * 1024, 1024, 0, 1024, 1024, (bf16*)(ws + WS_WOOUT) + (size_t)mi * 1024 * 1024, nullptr, 0, scr, q / 16, q % 16, lane); }
    }
    { f32x2* rope = (f32x2*)(ws + WS_ROPE);
      for (int idx = C.bid * NWAVES * 64 + C.tid; idx < SEQ * 32; idx += C.G * NWAVES * 64) { const int pos = idx >> 5, j = idx & 31;
          const float inv = powf(10000.0f, -(float)(2 * j) / 64.0f); const float ang = (float)pos * inv; rope[idx] = (f32x2){cosf(ang), sinf(ang)}; } }
    __syncthreads();
    LAS float* w8 = (LAS float*)(C.lds);
    load_w8(C, 0, w8);
    __syncthreads();
    const float* x = C.inp(0); bf16* XB = (bf16*)(ws + WS_XB); float* AB = (float*)(ws + WS_AB);
    for (int m = gw; m < T; m += NGW) { f32x4 v[4]; row_load_f32(x + (size_t)m * DM, lane, v); row_store_bf16(XB + (size_t)m * DM, lane, v);
        float ab[8]; row_ab(v, w8, lane, ab); if (lane < 8) { float s = ab[0];
#pragma unroll
            for (int e = 1; e < 8; ++e) s = (lane == e) ? ab[e] : s;
            AB[(size_t)m * 8 + lane] = s; } }
}

using pg8::Unit;
struct EpiBf16 {
    static constexpr bool PERM = true;
    bf16* O; int ldc; int gelu_cols;
    __device__ __forceinline__ void operator()(const f32x4 (&acc)[2][2][4][2], const Unit& u, int wr, int wc, int fr, int fq) const {
        const int row0 = u.pm * 256 + wr * 64 + fr, col0 = u.pn * 256 + wc * 32 + 8 * fq;
        const bool g = (u.pn * 256) < gelu_cols;
#pragma unroll
        for (int ai = 0; ai < 2; ++ai)
#pragma unroll
            for (int m = 0; m < 4; ++m) { bf16* rowp = O + (size_t)(row0 + ai * 128 + m * 16) * ldc + col0;
#pragma unroll
                for (int bj = 0; bj < 2; ++bj) { f32x4 v0 = acc[ai][bj][m][0], v1 = acc[ai][bj][m][1];
                    if (g) { f32x2 a = pg8::gelu_pk((f32x2){v0[0], v0[1]}), b = pg8::gelu_pk((f32x2){v0[2], v0[3]}), c = pg8::gelu_pk((f32x2){v1[0], v1[1]}), d = pg8::gelu_pk((f32x2){v1[2], v1[3]});
                        v0 = (f32x4){a.x, a.y, b.x, b.y}; v1 = (f32x4){c.x, c.y, d.x, d.y}; }
                    u32x4 w; w.x = cvt_pk_bf16(v0[0], v0[1]); w.y = cvt_pk_bf16(v0[2], v0[3]); w.z = cvt_pk_bf16(v1[0], v1[1]); w.w = cvt_pk_bf16(v1[2], v1[3]);
                    *(u32x4*)(rowp + bj * 128) = w; } }
    }
};
struct EpiRes {
    static constexpr bool PERM = true;
    const bf16* X; bf16* Y;
    __device__ __forceinline__ void operator()(const f32x4 (&acc)[2][2][4][2], const Unit& u, int wr, int wc, int fr, int fq) const {
        const int row0 = u.pm * 256 + wr * 64 + fr, col0 = u.pn * 256 + wc * 32 + 8 * fq;
#pragma unroll
        for (int ai = 0; ai < 2; ++ai)
#pragma unroll
            for (int m = 0; m < 4; ++m) { const size_t off = (size_t)(row0 + ai * 128 + m * 16) * DM + col0;
                u32x4 xs[2];
#pragma unroll
                for (int bj = 0; bj < 2; ++bj) xs[bj] = *(const u32x4*)(X + off + bj * 128);
#pragma unroll
                for (int bj = 0; bj < 2; ++bj) { const f32x4 a0 = acc[ai][bj][m][0], a1 = acc[ai][bj][m][1]; u32x4 w;
                    w.x = cvt_pk_bf16(bf_lo(xs[bj].x) * DN_ALPHA + a0[0], bf_hi(xs[bj].x) * DN_ALPHA + a0[1]); w.y = cvt_pk_bf16(bf_lo(xs[bj].y) * DN_ALPHA + a0[2], bf_hi(xs[bj].y) * DN_ALPHA + a0[3]);
                    w.z = cvt_pk_bf16(bf_lo(xs[bj].z) * DN_ALPHA + a1[0], bf_hi(xs[bj].z) * DN_ALPHA + a1[1]); w.w = cvt_pk_bf16(bf_lo(xs[bj].w) * DN_ALPHA + a1[2], bf_hi(xs[bj].w) * DN_ALPHA + a1[3]);
                    *(u32x4*)(Y + off + bj * 128) = w; }
                asm volatile("" ::: "memory"); }
    }
};
struct EpiQ {
    static constexpr bool PERM = true;
    bf16* O; const float* rs; const f32x4* rope;
    __device__ __forceinline__ void operator()(const f32x4 (&acc)[2][2][4][2], const Unit& u, int wr, int wc, int fr, int fq) const {
        const int row0 = u.pm * 256 + wr * 64 + fr, col0 = u.pn * 256 + wc * 32 + 8 * fq;
#pragma unroll
        for (int ai = 0; ai < 2; ++ai)
#pragma unroll
            for (int m = 0; m < 4; ++m) { const int row = row0 + ai * 128 + m * 16; const float s = rs[row]; const int pos = row & (SEQ - 1);
                bf16* rowp = O + (size_t)row * 1536 + col0;
#pragma unroll
                for (int bj = 0; bj < 2; ++bj) { f32x4 v0 = acc[ai][bj][m][0] * s, v1 = acc[ai][bj][m][1] * s;
                    const int c = col0 + bj * 128, o = c % 192;
                    if (o >= 128) { const int jp = (o - 128) >> 1;
                        const f32x4 r0 = rope[(pos * 32 + jp) >> 1], r1 = rope[(pos * 32 + jp + 2) >> 1];
                        v0 = (f32x4){v0[0] * r0[0] - v0[1] * r0[1], v0[0] * r0[1] + v0[1] * r0[0], v0[2] * r0[2] - v0[3] * r0[3], v0[2] * r0[3] + v0[3] * r0[2]};
                        v1 = (f32x4){v1[0] * r1[0] - v1[1] * r1[1], v1[0] * r1[1] + v1[1] * r1[0], v1[2] * r1[2] - v1[3] * r1[3], v1[2] * r1[3] + v1[3] * r1[2]}; }
                    u32x4 w; w.x = cvt_pk_bf16(v0[0], v0[1]); w.y = cvt_pk_bf16(v0[2], v0[3]); w.z = cvt_pk_bf16(v1[0], v1[1]); w.w = cvt_pk_bf16(v1[2], v1[3]);
                    *(u32x4*)(rowp + bj * 128) = w; }
                asm volatile("" ::: "memory"); }
    }
};
struct EpiKV {
    static constexpr bool PERM = true;
    bf16* O; const float* rs;
    __device__ __forceinline__ void operator()(const f32x4 (&acc)[2][2][4][2], const Unit& u, int wr, int wc, int fr, int fq) const {
        const int row0 = u.pm * 256 + wr * 64 + fr, col0 = u.pn * 256 + wc * 32 + 8 * fq;
#pragma unroll
        for (int ai = 0; ai < 2; ++ai)
#pragma unroll
            for (int m = 0; m < 4; ++m) { const int row = row0 + ai * 128 + m * 16; const float s = rs[row]; bf16* rowp = O + (size_t)row * 2048 + col0;
#pragma unroll
                for (int bj = 0; bj < 2; ++bj) { const f32x4 v0 = acc[ai][bj][m][0] * s, v1 = acc[ai][bj][m][1] * s;
                    u32x4 w; w.x = cvt_pk_bf16(v0[0], v0[1]); w.y = cvt_pk_bf16(v0[2], v0[3]); w.z = cvt_pk_bf16(v1[0], v1[1]); w.w = cvt_pk_bf16(v1[2], v1[3]);
                    *(u32x4*)(rowp + bj * 128) = w; }
                asm volatile("" ::: "memory"); }
    }
};
struct EpiSwiglu {
    static constexpr bool PERM = true;
    bf16* HID; const float* bias; const LAS int* rmap;
    __device__ __forceinline__ void operator()(const f32x4 (&acc)[2][2][4][2], const Unit& u, int wr, int wc, int fr, int fq) const {
        const int col0 = u.pn * 256 + wc * 32 + 8 * fq; const float* bp = bias + (size_t)u.e * 2048 + col0;
        f32x4 bv[2][2];
#pragma unroll
        for (int bj = 0; bj < 2; ++bj)
#pragma unroll
            for (int n = 0; n < 2; ++n) bv[bj][n] = *(const f32x4*)(bp + bj * 128 + 4 * n);
#pragma unroll
        for (int ai = 0; ai < 2; ++ai)
#pragma unroll
            for (int m = 0; m < 4; ++m) { const int slot = rmap[u.li * 256 + ai * 128 + wr * 64 + m * 16 + fr];
                if (slot >= 0) { bf16* rowp = HID + (size_t)slot * DFF + (col0 >> 1);
#pragma unroll
                    for (int bj = 0; bj < 2; ++bj) { const f32x4 h0 = acc[ai][bj][m][0] + bv[bj][0], h1 = acc[ai][bj][m][1] + bv[bj][1];
                        float o[4];
#pragma unroll
                        for (int q = 0; q < 4; ++q) { const float glu = fminf(q < 2 ? h0[2 * q] : h1[2 * q - 4], 7.0f); float lin = q < 2 ? h0[2 * q + 1] : h1[2 * q - 3]; lin = fminf(fmaxf(lin, -7.0f), 7.0f);
                            const float sg = __builtin_amdgcn_rcpf(1.0f + __builtin_amdgcn_exp2f(-1.702f * 1.4426950408889634f * glu)); o[q] = glu * sg * (lin + 1.0f); }
                        u32x2 w; w.x = cvt_pk_bf16(o[0], o[1]); w.y = cvt_pk_bf16(o[2], o[3]);
                        *(u32x2*)(rowp + bj * 64) = w; } }
                asm volatile("" ::: "memory"); }
    }
};
struct EpiDown {
    static constexpr bool PERM = true;
    bf16* YE; const float* bias; const float* gate; const LAS int* rmap;
    __device__ __forceinline__ void operator()(const f32x4 (&acc)[2][2][4][2], const Unit& u, int wr, int wc, int fr, int fq) const {
        const int col0 = u.pn * 256 + wc * 32 + 8 * fq; const float* bp = bias + (size_t)u.e * DM + col0;
        f32x4 bv[2][2];
#pragma unroll
        for (int bj = 0; bj < 2; ++bj)
#pragma unroll
            for (int n = 0; n < 2; ++n) bv[bj][n] = *(const f32x4*)(bp + bj * 128 + 4 * n);
#pragma unroll
        for (int ai = 0; ai < 2; ++ai)
#pragma unroll
            for (int m = 0; m < 4; ++m) { const int slot = rmap[u.li * 256 + ai * 128 + wr * 64 + m * 16 + fr];
                if (slot >= 0) { const float gt = gate[slot]; bf16* rowp = YE + (size_t)slot * DM + col0;
#pragma unroll
                    for (int bj = 0; bj < 2; ++bj) { const f32x4 v0 = (acc[ai][bj][m][0] + bv[bj][0]) * gt, v1 = (acc[ai][bj][m][1] + bv[bj][1]) * gt;
                        u32x4 w; w.x = cvt_pk_bf16(v0[0], v0[1]); w.y = cvt_pk_bf16(v0[2], v0[3]); w.z = cvt_pk_bf16(v1[0], v1[1]); w.w = cvt_pk_bf16(v1[2], v1[3]);
                        *(u32x4*)(rowp + bj * 128) = w; } }
                asm volatile("" ::: "memory"); }
    }
};

template <class Epi>
__device__ __forceinline__ void run_plain_gemm(const Ctx& C, const bf16* A, int lda, int K, int N, const bf16* Bt, const Epi& E) {
    pg8::PlainSched S; S.o.init(T, N, C.G, C.bid); S.Bt = (const char*)Bt; S.K = K; S.lda = lda;
    pg8::gemm_phase<Epi, pg8::PlainSched, true>(C.lds, (const char*)A, K, S, E);
}

constexpr int MOE_RMAP_OFF = LDS_SPARE, MOE_MAX_UNITS = 20, MOE_PRE_OFF = LDS_SPARE + MOE_MAX_UNITS * 1024, MOE_CNT_OFF = MOE_PRE_OFF + 256;
struct MoeSched {
    static constexpr bool GATHER = true;
    const LAS int* pre; const LAS int* rmap; const char* Bt; size_t bstride; int K, NT, G, c, lda, shift;
    __device__ __forceinline__ bool next(int i, Unit& u) const {
        const int x = c & 7, k = c >> 3, per = G >> 3;
        const int RT = 32 / NT, tot = pre[32];
        const int slot = i * per + k;
        const int st = (slot >> 5) * 8 + x, within = slot & 31;
        const int rt = st * RT + within / NT;
        if (rt >= tot || i >= MOE_MAX_UNITS) return false;
        int e = 0;
#pragma unroll 1
        for (; e < 31; ++e) if (rt < pre[e + 1]) break;
        u.e = e; u.pn = within % NT; u.pm = rt - pre[e]; u.li = i; return true;
    }
    __device__ __forceinline__ const char* bbase(const Unit& u) const { return Bt + (size_t)u.e * bstride + (size_t)u.pn * 256 * K * 2; }
    __device__ __forceinline__ unsigned aoff(const Unit& u, int r) const { const int slot = rmap[u.li * 256 + r]; const int s = slot < 0 ? 0 : (slot >> shift); return (unsigned)(s * lda) * 2u; }
};
template <class Epi>
__device__ __forceinline__ void run_moe_gemm(const Ctx& C0, int layer, const bf16* A, int lda, int shift, int K, int N, const bf16* Bt, size_t bstride_elems, Epi E) {
    const Ctx C = phase_ctx(C0);
    LAS int* pre = (LAS int*)(C.lds + MOE_PRE_OFF); LAS int* cnt = (LAS int*)(C.lds + MOE_CNT_OFF); LAS int* rmap = (LAS int*)(C.lds + MOE_RMAP_OFF);
    const int* list = (const int*)(C.ws + WS_LIST);
    if (C.tid < 32) cnt[C.tid] = (int)__hip_atomic_load(C.ctl + CW_CNT + (layer * 32 + C.tid) * 64, RLX_AGENT);
    __syncthreads();
    if (C.tid == 0) { int s = 0; for (int e = 0; e < 32; ++e) { pre[e] = s; s += (cnt[e] + 255) >> 8; } pre[32] = s; }
    __syncthreads();
    MoeSched S; S.pre = pre; S.rmap = rmap; S.Bt = (const char*)Bt; S.bstride = bstride_elems * 2; S.K = K; S.NT = N / 256; S.G = C.G; S.c = C.bid; S.lda = lda; S.shift = shift;
    { Unit u; for (int i = 0; S.next(i, u); ++i) { if (C.tid < 256) { const int idx = u.pm * 256 + C.tid; rmap[i * 256 + C.tid] = idx < cnt[u.e] ? list[(size_t)u.e * LCAP + idx] : -1; } } }
    __syncthreads();
    E.rmap = rmap;
    pg8::gemm_phase<Epi, MoeSched, true>(C.lds, (const char*)A, K, S, E);
}

__device__ __forceinline__ void phase_router(const Ctx& C0, int layer) {
    const Ctx C = phase_ctx(C0);
    LAS float* wrT = (LAS float*)C.lds;
    LAS int* lcnt = (LAS int*)(C.lds + 132096); LAS int* lbase = (LAS int*)(C.lds + 132224);
    LAS int* asg_e = (LAS int*)(C.lds + 132352); LAS int* asg_pos = (LAS int*)(C.lds + 134400); LAS float* asg_gate = (LAS float*)(C.lds + 136448);
    const float* Wr = C.inp(21) + (size_t)layer * DM * NEXP; const float* br = C.inp(22) + layer * NEXP;
    const int lane = C.lane, tid = C.tid;
    for (int idx = tid; idx < DM * NEXP; idx += NWAVES * 64) { const int k = idx >> 5, e = idx & 31; wrT[e * 1028 + k] = Wr[idx]; }
    f32x4 g[4], b[4]; row_load_f32(C.inp(17) + layer * DM, lane, g); row_load_f32(C.inp(18) + layer * DM, lane, b);
    const bf16* Y = (const bf16*)(C.ws + WS_Y); bf16* XB = (bf16*)(C.ws + WS_XB);
    int* list = (int*)(C.ws + WS_LIST); float* GATE = (float*)(C.ws + WS_GATE);
    const float mybias = br[lane >> 1];
    for (int rb = C.bid; rb < T / 128; rb += C.G) {
        if (tid < 32) lcnt[tid] = 0;
        __syncthreads();
#pragma unroll 1
        for (int i = 0; i < 16; ++i) {
            const int rl = C.wave * 16 + i, row = rb * 128 + rl;
            f32x4 v[4]; row_load_bf16(Y + (size_t)row * DM, lane, v);
            row_layernorm(v, g, b);
            row_store_bf16(XB + (size_t)row * DM, lane, v);
            float p[32];
#pragma unroll
            for (int e = 0; e < 32; ++e) { float s = 0.f;
#pragma unroll
                for (int j = 0; j < 4; ++j) { const f32x4 w = *(const LAS f32x4*)(wrT + e * 1028 + 4 * lane + 256 * j); s += (v[j].x * w.x + v[j].y * w.y) + (v[j].z * w.z + v[j].w * w.w); }
                p[e] = s; }
#define BFLY(bit, n) { const bool hi_ = (lane & (bit)) != 0; _Pragma("unroll") for (int q = 0; q < (n); ++q) { const float send = hi_ ? p[q] : p[q + (n)]; const float keep = hi_ ? p[q + (n)] : p[q]; p[q] = keep + __shfl_xor(send, (bit)); } }
            BFLY(32, 16) BFLY(16, 8) BFLY(8, 4) BFLY(4, 2) BFLY(2, 1)
#undef BFLY
            float val = p[0] + __shfl_xor(p[0], 1) + mybias; const int me = lane >> 1;
            float tv[4]; int te[4];
#pragma unroll
            for (int k = 0; k < 4; ++k) { float bv = val; int be = me;
#pragma unroll
                for (int off = 1; off < 64; off <<= 1) { const float ov = __shfl_xor(bv, off); const int oe = __shfl_xor(be, off); const bool take = (ov > bv) || (ov == bv && oe < be); bv = take ? ov : bv; be = take ? oe : be; }
                tv[k] = bv; te[k] = be; if (me == be) val = -__builtin_inff(); }
            const float e1 = __expf(tv[1] - tv[0]), e2 = __expf(tv[2] - tv[0]), e3 = __expf(tv[3] - tv[0]); const float inv = 1.0f / (1.0f + e1 + e2 + e3);
            if (lane < 4) { const int my_e = lane == 0 ? te[0] : lane == 1 ? te[1] : lane == 2 ? te[2] : te[3]; const float my_g = (lane == 0 ? 1.0f : lane == 1 ? e1 : lane == 2 ? e2 : e3) * inv;
                const int lpos = __hip_atomic_fetch_add(lcnt + my_e, 1, __ATOMIC_RELAXED, __HIP_MEMORY_SCOPE_WORKGROUP);
                const int a = rl * 4 + lane; asg_e[a] = my_e; asg_pos[a] = lpos; asg_gate[a] = my_g; }
        }
        __syncthreads();
        if (tid < 32) lbase[tid] = (int)__hip_atomic_fetch_add(C.ctl + CW_CNT + (layer * 32 + tid) * 64, (unsigned)lcnt[tid], RLX_AGENT);
        __syncthreads();
        { const int a = tid, e = asg_e[a], slot = (rb * 128 + (a >> 2)) * 4 + (a & 3); list[(size_t)e * LCAP + lbase[e] + asg_pos[a]] = slot; GATE[slot] = asg_gate[a]; }
        __syncthreads();
    }
}

__device__ __forceinline__ void phase_combine(const Ctx& C0, int layer) {
    const Ctx C = phase_ctx(C0);
    const int gw = C.bid * NWAVES + C.wave, NGW = C.G * NWAVES, lane = C.lane;
    LAS float* w8 = (LAS float*)C.lds;
    if (layer == 1) { load_w8(C, 1, w8); __syncthreads(); }
    f32x4 g[4], b[4]; row_load_f32(C.inp(19) + layer * DM, lane, g); row_load_f32(C.inp(20) + layer * DM, lane, b);
    bf16* XB = (bf16*)(C.ws + WS_XB); const bf16* YE = (const bf16*)(C.ws + WS_YE); float* AB = (float*)(C.ws + WS_AB);
    for (int m = gw; m < T; m += NGW) {
        f32x4 v[4]; row_load_bf16(XB + (size_t)m * DM, lane, v);
#pragma unroll
        for (int j = 0; j < 4; ++j) v[j] = v[j] * DN_ALPHA;
#pragma unroll
        for (int k = 0; k < 4; ++k) { const bf16* yr = YE + (size_t)(m * 4 + k) * DM;
#pragma unroll
            for (int j = 0; j < 4; ++j) { const u32x2 w = *(const u32x2*)(yr + 4 * lane + 256 * j); v[j] = v[j] + (f32x4){bf_lo(w.x), bf_hi(w.x), bf_lo(w.y), bf_hi(w.y)}; } }
        row_layernorm(v, g, b);
        if (layer == DEPTH - 1) row_store_f32(C.out + (size_t)m * DM, lane, v);
        else row_store_bf16(XB + (size_t)m * DM, lane, v);
        if (layer == 1) { float ab[8]; row_ab(v, w8, lane, ab); if (lane < 8) { float s = ab[0];
#pragma unroll
                for (int e = 1; e < 8; ++e) s = (lane == e) ? ab[e] : s;
                AB[(size_t)m * 8 + lane] = s; } }
    }
}

__device__ __forceinline__ void phase_o1b(const Ctx& C0) {
    const Ctx C = phase_ctx(C0);
    const int gw = C.bid * NWAVES + C.wave, NGW = C.G * NWAVES, lane = C.lane;
    const bf16* C1 = (const bf16*)(C.ws + WS_ARENA + AR_C1); bf16* KPE = (bf16*)(C.ws + WS_ARENA + AR_KPE);
    float* RSQ = (float*)(C.ws + WS_RS); float* RKV = RSQ + T; const f32x2* rope = (const f32x2*)(C.ws + WS_ROPE);
    for (int m = gw; m < T; m += NGW) {
        const bf16* rp = C1 + (size_t)m * ODD_N;
        const u32x4 a = *(const u32x4*)(rp + 8 * lane);
        float s = 0.f;
#pragma unroll
        for (int q = 0; q < 4; ++q) { const float lo = bf_lo(a[q]), hi = bf_hi(a[q]); s += lo * lo + hi * hi; }
        float sq = lane < 48 ? s : 0.f, skv = lane < 48 ? 0.f : s;
        if (lane < 16) { const u32x4 b = *(const u32x4*)(rp + 8 * (64 + lane)); float s2 = 0.f;
#pragma unroll
            for (int q = 0; q < 4; ++q) { const float lo = bf_lo(b[q]), hi = bf_hi(b[q]); s2 += lo * lo + hi * hi; }
            skv += s2; }
        sq = wave_sum(sq); skv = wave_sum(skv);
        if (lane == 0) { RSQ[m] = 1.0f / sqrtf(sq * (1.0f / QL) + RMS_EPS); RKV[m] = 1.0f / sqrtf(skv * (1.0f / KVL) + RMS_EPS); }
        if (lane < 32) { const float x1 = bf2f(rp[640 + lane]), x2 = bf2f(rp[672 + lane]); const f32x2 cs = rope[(m & (SEQ - 1)) * 32 + lane];
            *(unsigned*)(KPE + (size_t)m * 64 + 2 * lane) = cvt_pk_bf16(x1 * cs.x - x2 * cs.y, x1 * cs.y + x2 * cs.x); }
    }
}

namespace att {
constexpr int SHM_V = 16384, SHM_K = 16384, SHM_KR = 8192;
constexpr int OFF_V = 0, OFF_K = 2 * SHM_V, OFF_KR = OFF_K + 2 * SHM_K, OFF_WS = OFF_KR + 2 * SHM_KR, OFF_QR = OFF_WS + 2048;
constexpr float THR = 8.f, SCALE = ATT_SCALE;
#define KSWZ(row, colB) ((row) * 256 + ((colB) ^ (((row) & 7) << 4)))
#define KRSWZ(row, colB) ((row) * 128 + ((colB) ^ (((row) & 7) << 4)))
#define SBAR() __builtin_amdgcn_sched_barrier(0)
__device__ __forceinline__ int v_st(int k, int c) { const int kk = (k & ~0xC) | ((k & 4) << 1) | ((k & 8) >> 1); return ((kk >> 3) * 4 + (c >> 5)) * 512 + ((kk & 7) * 32 + (c & 31)) * 2; }
__device__ __forceinline__ int v_rd_base(int lane) { return ((lane & 3) << 3) | (((lane >> 2) & 3) << 6) | (((lane >> 4) & 1) << 5) | (((lane >> 5) & 1) << 8); }
constexpr int v_rd_off(int d0, int ks, int half) { return d0 * 512 + ks * 4096 + half * 2048; }
__device__ __forceinline__ int crow(int r, int hi) { return (r & 3) + 8 * (r >> 2) + 4 * hi; }
__device__ __forceinline__ void partialSM(f32x16& p0, f32x16& p1, float& m_reg, float& mn, float& alpha) {
    float pmax = p0[0];
#pragma unroll
    for (int r = 1; r < 16; ++r) pmax = fmaxf(pmax, p0[r]);
#pragma unroll
    for (int r = 0; r < 16; ++r) pmax = fmaxf(pmax, p1[r]);
    { auto rr = __builtin_amdgcn_permlane32_swap(__float_as_uint(pmax), __float_as_uint(pmax), false, false);
      pmax = fmaxf(__uint_as_float(rr[0]), __uint_as_float(rr[1])); }
    constexpr float C2 = 1.4426950408889634f * SCALE;
    if (__builtin_expect(__all((pmax - m_reg) * SCALE <= THR), 1)) { mn = m_reg; alpha = 1.f; }
    else { mn = fmaxf(m_reg, pmax); alpha = __builtin_amdgcn_exp2f((m_reg - mn) * C2); m_reg = mn; }
    const float mnL = -mn * C2;
#pragma unroll
    for (int r = 0; r < 16; ++r) p0[r] = fmaf(p0[r], C2, mnL);
#pragma unroll
    for (int r = 0; r < 16; ++r) p1[r] = fmaf(p1[r], C2, mnL);
#pragma unroll
    for (int r = 0; r < 16; ++r) p0[r] = __builtin_amdgcn_exp2f(p0[r]);
}
__device__ __forceinline__ void finishSM(f32x16& p0, f32x16& p1, float alpha, float& l_reg, bf16x8& pa0, bf16x8& pa1, bf16x8& pa2, bf16x8& pa3) {
#pragma unroll
    for (int r = 0; r < 16; ++r) p1[r] = __builtin_amdgcn_exp2f(p1[r]);
    float ps = 0;
#pragma unroll
    for (int r = 0; r < 16; ++r) ps += p0[r];
#pragma unroll
    for (int r = 0; r < 16; ++r) ps += p1[r];
    { auto rr = __builtin_amdgcn_permlane32_swap(__float_as_uint(ps), __float_as_uint(ps), false, false);
      ps = __uint_as_float(rr[0]) + __uint_as_float(rr[1]); }
    l_reg = l_reg * alpha + ps;
#define PK4(P, B_, OUT) do { unsigned a0 = cvt_pk_bf16(P[B_+0], P[B_+1]), a1 = cvt_pk_bf16(P[B_+2], P[B_+3]);                          \
        unsigned b0 = cvt_pk_bf16(P[B_+4], P[B_+5]), b1 = cvt_pk_bf16(P[B_+6], P[B_+7]);                                             \
        auto r0 = __builtin_amdgcn_permlane32_swap(a0, b0, false, false); auto r1 = __builtin_amdgcn_permlane32_swap(a1, b1, false, false); \
        u32x4 w = {r0[0], r1[0], r0[1], r1[1]}; OUT = *reinterpret_cast<bf16x8*>(&w); } while (0)
    PK4(p0, 0, pa0); PK4(p0, 8, pa1); PK4(p1, 0, pa2); PK4(p1, 8, pa3);
#undef PK4
}
template <int KB>
__device__ __forceinline__ void qkt(f32x16& p0, f32x16& p1, const LAS char* lds, int r32, int hi, const bf16x8* qr, const LAS char* qrl) {
    p0 = f32x16{}; p1 = f32x16{};
    const LAS char* kb[4]; const LAS char* kr[4];
#pragma unroll
    for (int dd = 0; dd < 4; ++dd) { kb[dd] = lds + OFF_K + KB * SHM_K + KSWZ(r32, (dd * 16 + hi * 8) * 2); kr[dd] = lds + OFF_KR + KB * SHM_KR + KRSWZ(r32, (dd * 16 + hi * 8) * 2); }
#pragma unroll
    for (int d0 = 0; d0 < 8; ++d0) { const LAS char* a = kb[d0 & 3] + (d0 >> 2) * 128;
        const bf16x8 b0 = *reinterpret_cast<const LAS bf16x8*>(a);
        const bf16x8 b1 = *reinterpret_cast<const LAS bf16x8*>(a + 32 * 256);
        p0 = __builtin_amdgcn_mfma_f32_32x32x16_bf16(b0, qr[d0], p0, 0, 0, 0);
        p1 = __builtin_amdgcn_mfma_f32_32x32x16_bf16(b1, qr[d0], p1, 0, 0, 0); }
#pragma unroll
    for (int d0 = 0; d0 < 4; ++d0) { const LAS char* a = kr[d0];
        const bf16x8 b0 = *reinterpret_cast<const LAS bf16x8*>(a);
        const bf16x8 b1 = *reinterpret_cast<const LAS bf16x8*>(a + 32 * 128);
        const bf16x8 qf = *reinterpret_cast<const LAS bf16x8*>(qrl + d0 * 1024);
        p0 = __builtin_amdgcn_mfma_f32_32x32x16_bf16(b0, qf, p0, 0, 0, 0);
        p1 = __builtin_amdgcn_mfma_f32_32x32x16_bf16(b1, qf, p1, 0, 0, 0); }
}
template <int VB>
__device__ __forceinline__ void pv_tile(f32x16* o, int vb0, bf16x8 pa0, bf16x8 pa1, bf16x8 pa2, bf16x8 pa3) {
#define TRRD(dst, off) asm volatile("ds_read_b64_tr_b16 %0, %1 offset:%2" : "=&v"(dst) : "v"(vb0), "i"(off) : "memory")
#define PV_D0(d0) do { s16x4 l0, l1, l2, l3, h0, h1, h2, h3; constexpr int b_ = OFF_V + VB * SHM_V + v_rd_off(d0, 0, 0); \
        TRRD(l0, b_); TRRD(h0, b_ + 2048); TRRD(l1, b_ + 4096); TRRD(h1, b_ + 6144); TRRD(l2, b_ + 8192); TRRD(h2, b_ + 10240); TRRD(l3, b_ + 12288); TRRD(h3, b_ + 14336); \
        asm volatile("s_waitcnt lgkmcnt(0)" ::: "memory"); SBAR();   \
        o[d0] = __builtin_amdgcn_mfma_f32_32x32x16_bf16(pa0, (bf16x8){l0[0], l0[1], l0[2], l0[3], h0[0], h0[1], h0[2], h0[3]}, o[d0], 0, 0, 0);   \
        o[d0] = __builtin_amdgcn_mfma_f32_32x32x16_bf16(pa1, (bf16x8){l1[0], l1[1], l1[2], l1[3], h1[0], h1[1], h1[2], h1[3]}, o[d0], 0, 0, 0);   \
        o[d0] = __builtin_amdgcn_mfma_f32_32x32x16_bf16(pa2, (bf16x8){l2[0], l2[1], l2[2], l2[3], h2[0], h2[1], h2[2], h2[3]}, o[d0], 0, 0, 0);   \
        o[d0] = __builtin_amdgcn_mfma_f32_32x32x16_bf16(pa3, (bf16x8){l3[0], l3[1], l3[2], l3[3], h3[0], h3[1], h3[2], h3[3]}, o[d0], 0, 0, 0); } while (0)
    PV_D0(0); PV_D0(1); PV_D0(2); PV_D0(3);
#undef PV_D0
#undef TRRD
}

__device__ __forceinline__ void attn_block(const Ctx& C, int b, int h, int qb) {
    LAS char* lds = (LAS char*)C.lds;
    const int tid = C.tid, wid = C.wave, lane = C.lane, r32 = lane & 31, hi = lane >> 5;
    const bf16* Qg = (const bf16*)(C.ws + WS_ARENA + AR_Q); const bf16* KVg = (const bf16*)(C.ws + WS_ARENA + AR_KV); const bf16* KPE = (const bf16*)(C.ws + WS_ARENA + AR_KPE);
    bf16* MIX = (bf16*)(C.ws + WS_MIX);
    const size_t tok0 = (size_t)b * SEQ; const int P0 = qb * 256;
    const int NT = 4 * (qb + 1), jmax = (P0 + wid * 32) >> 6;
    bf16x8 qr[8];
    LAS char* qrl = lds + OFF_QR + wid * 4096 + lane * 16;
    { const bf16* qp = Qg + (tok0 + P0 + wid * 32 + r32) * 1536 + h * 192 + hi * 8;
#pragma unroll
      for (int d0 = 0; d0 < 8; ++d0) qr[d0] = *(const bf16x8*)(qp + d0 * 16);
#pragma unroll
      for (int d0 = 0; d0 < 4; ++d0) *(LAS bf16x8*)(qrl + d0 * 1024) = *(const bf16x8*)(qp + (8 + d0) * 16); }
    const bf16* kvp = KVg + tok0 * 2048 + h * 256; const bf16* kpp = KPE + tok0 * 64;
#define A_LOAD(kb, bf) do { const bf16* p_ = kvp + (size_t)(kb) * 2048; int ln_ = lane; asm volatile("" : "+v"(ln_)); \
        _Pragma("unroll") for (int i_ = 0; i_ < 2; ++i_) { const int B_ = (wid * 2 + i_) * 1024 + ln_ * 16; \
            const int row_ = B_ >> 8, c_ = ((B_ & 255) >> 4) ^ (row_ & 7); \
            const int sub_ = B_ >> 9, kk_ = (sub_ >> 2) * 8 + ((B_ & 511) >> 6), k_ = (kk_ & ~0xC) | ((kk_ & 4) << 1) | ((kk_ & 8) >> 1), cc_ = (sub_ & 3) * 32 + ((B_ & 63) >> 1); \
            __builtin_amdgcn_global_load_lds((const unsigned*)(p_ + (unsigned)(row_ * 2048 + c_ * 8)), (LAS unsigned*)(lds + OFF_K + (bf) * SHM_K + (wid * 2 + i_) * 1024), 16, 0, 0); \
            __builtin_amdgcn_global_load_lds((const unsigned*)(p_ + (unsigned)(k_ * 2048 + 128 + cc_)), (LAS unsigned*)(lds + OFF_V + (bf) * SHM_V + (wid * 2 + i_) * 1024), 16, 0, 0); } \
        { const int B_ = wid * 1024 + ln_ * 16, row_ = B_ >> 7, c_ = ((B_ & 127) >> 4) ^ (row_ & 7); \
          __builtin_amdgcn_global_load_lds((const unsigned*)(kpp + (size_t)(kb) * 64 + (unsigned)(row_ * 64 + c_ * 8)), (LAS unsigned*)(lds + OFF_KR + (bf) * SHM_KR + wid * 1024), 16, 0, 0); } } while (0)
    LAS float* wsl = (LAS float*)(lds + OFF_WS) + wid * 64; LAS float* li_l = wsl; LAS float* al_l = wsl + 32;
    float m_reg = -1e30f, l_reg = 0.f; f32x16 o[4] = {};
    const int vb0 = (int)(uintptr_t)lds + v_rd_base(lane);
    A_LOAD(0, 0);
    asm volatile("s_waitcnt vmcnt(0)" ::: "memory");
    __syncthreads();
    f32x16 p0, p1; float mn, al; bf16x8 pa0, pa1, pa2, pa3;
#define A_STEP(KB) do { \
        if (t + 1 < NT) A_LOAD((t + 1) * 64, 1 - KB); \
        if (t <= jmax) { qkt<KB>(p0, p1, lds, r32, hi, qr, qrl); partialSM(p0, p1, m_reg, mn, al); \
            if (__any(al < 1.f)) { if (hi == 0) al_l[r32] = al; asm volatile("s_waitcnt lgkmcnt(0)" ::: "memory"); \
                _Pragma("unroll") for (int d_ = 0; d_ < 4; ++d_) _Pragma("unroll") for (int r = 0; r < 16; ++r) o[d_][r] *= al_l[crow(r, hi)]; } \
            finishSM(p0, p1, al, l_reg, pa0, pa1, pa2, pa3); SBAR(); pv_tile<KB>(o, vb0, pa0, pa1, pa2, pa3); } \
        asm volatile("s_waitcnt vmcnt(0)" ::: "memory"); \
        __syncthreads(); } while (0)
    for (int t = 0; t < NT; t += 2) { A_STEP(0); ++t; A_STEP(1); --t; }
#undef A_STEP
#undef A_LOAD
    if (hi == 0) li_l[r32] = l_reg;
    asm volatile("s_waitcnt lgkmcnt(0)" ::: "memory");
    float rli[16];
#pragma unroll
    for (int r = 0; r < 16; ++r) rli[r] = __builtin_amdgcn_rcpf(li_l[crow(r, hi)]);
    bf16* Ow = MIX + (tok0 + P0 + wid * 32) * DM + h * 128;
#pragma unroll
    for (int r = 0; r < 16; ++r) { const int orow = crow(r, hi);
#pragma unroll
        for (int d0 = 0; d0 < 4; ++d0) { const float v = o[d0][r] * rli[r]; const float vn = __shfl_xor(v, 1);
            if ((r32 & 1) == 0) *(unsigned*)(Ow + (size_t)orow * DM + d0 * 32 + r32) = cvt_pk_bf16(v, vn); } }
    __syncthreads();
}
#undef KSWZ
#undef KRSWZ
#undef SBAR
}

__device__ __forceinline__ void phase_attn(const Ctx& C0) {
    const Ctx C = phase_ctx(C0);
    const int x = C.bid & 7, k = C.bid >> 3, per = C.G >> 3;
    for (int u = k; u < 64; u += per) {
        const int bh = x * 8 + (u >> 3), p = u & 7;
        att::attn_block(C, bh >> 3, bh & 7, 15 - p);
        att::attn_block(C, bh >> 3, bh & 7, p);
    }
}

namespace sm {
__device__ __forceinline__ bf16x8 frag_n(const LAS char* base, int S, int x0, int k0, int lane) { return *(const LAS bf16x8*)(base + (x0 + (lane & 15)) * S + (k0 + 8 * (lane >> 4)) * 2); }
__device__ __forceinline__ bf16x8 frag_t(const LAS char* base, int S, int x0, int k0, int lane) {
    const int g = lane >> 4, q = (lane >> 2) & 3, p = lane & 3;
    const LAS char* a = base + (k0 + 8 * g + q) * S + (x0 + 4 * p) * 2;
    const s16x4 lo = __builtin_amdgcn_ds_read_tr16_b64_v4i16((LAS s16x4*)a);
    const s16x4 hi = __builtin_amdgcn_ds_read_tr16_b64_v4i16((LAS s16x4*)(a + 4 * S));
    return (bf16x8){lo[0], lo[1], lo[2], lo[3], hi[0], hi[1], hi[2], hi[3]};
}
__device__ __forceinline__ f32x4 mma(bf16x8 a, bf16x8 b, f32x4 c) { return __builtin_amdgcn_mfma_f32_16x16x32_bf16(a, b, c, 0, 0, 0); }
__device__ __forceinline__ u32x2 pack4(f32x4 v) { u32x2 w; w.x = cvt_pk_bf16(v[0], v[1]); w.y = cvt_pk_bf16(v[2], v[3]); return w; }
__device__ __forceinline__ f32x4 unpack4(u32x2 w) { return (f32x4){bf_lo(w.x), bf_hi(w.x), bf_lo(w.y), bf_hi(w.y)}; }
}

constexpr int H1LD = EVEN_N;

__device__ __forceinline__ void sgu_unit(const Ctx& C, int ei, int unit) {
    const int g4 = unit & 3, blk = (unit >> 2) & 31, b = unit >> 7;
    const int tid = C.tid, lane = C.lane, w = C.wave;
    const bf16* H1 = (const bf16*)(C.ws + WS_ARENA); bf16* MIX = (bf16*)(C.ws + WS_MIX);
    LAS char* Vn = (LAS char*)C.lds; LAS char* Wm = Vn + 34816;
    const size_t t0 = (size_t)b * SEQ + blk * 128;
    const float* lng = C.inp(2) + ei * 512 + g4 * 128; const float* lnb = C.inp(3) + ei * 512 + g4 * 128;
    const float* Wg = C.inp(4) + (size_t)(ei * 4 + g4) * 128 * 128; const float* bs = C.inp(5) + (ei * 4 + g4) * 128;
    { const int l16 = tid & 15; f32x4 ga = *(const f32x4*)(lng + 8 * l16), gb = *(const f32x4*)(lng + 8 * l16 + 4), ba = *(const f32x4*)(lnb + 8 * l16), bb = *(const f32x4*)(lnb + 8 * l16 + 4);
#pragma unroll
      for (int pp = 0; pp < 4; ++pp) { const int j = pp * 32 + (tid >> 4);
        const u32x4 raw = *(const u32x4*)(H1 + (t0 + j) * H1LD + 512 + g4 * 128 + 8 * l16);
        float x[8];
#pragma unroll
        for (int q = 0; q < 4; ++q) { x[2 * q] = bf_lo(raw[q]); x[2 * q + 1] = bf_hi(raw[q]); }
        float s = 0.f;
#pragma unroll
        for (int q = 0; q < 8; ++q) s += x[q];
        s += __shfl_xor(s, 1); s += __shfl_xor(s, 2); s += __shfl_xor(s, 4); s += __shfl_xor(s, 8);
        const float mean = s * (1.f / 128.f); float s2 = 0.f;
#pragma unroll
        for (int q = 0; q < 8; ++q) { x[q] -= mean; s2 += x[q] * x[q]; }
        s2 += __shfl_xor(s2, 1); s2 += __shfl_xor(s2, 2); s2 += __shfl_xor(s2, 4); s2 += __shfl_xor(s2, 8);
        const float rstd = 1.f / sqrtf(s2 * (1.f / 128.f) + LN_EPS);
        u32x4 o; o.x = cvt_pk_bf16(x[0] * rstd * ga[0] + ba[0], x[1] * rstd * ga[1] + ba[1]); o.y = cvt_pk_bf16(x[2] * rstd * ga[2] + ba[2], x[3] * rstd * ga[3] + ba[3]);
        o.z = cvt_pk_bf16(x[4] * rstd * gb[0] + bb[0], x[5] * rstd * gb[1] + bb[1]); o.w = cvt_pk_bf16(x[6] * rstd * gb[2] + bb[2], x[7] * rstd * gb[3] + bb[3]);
        *(LAS u32x4*)(Vn + j * 272 + l16 * 16) = o; } }
#pragma unroll
    for (int q = 0; q < 8; ++q) { const int f = (tid + 512 * q) * 4, i = f >> 7, j = f & 127; const f32x4 wv = *(const f32x4*)(Wg + f);
        *(LAS u32x2*)(Wm + i * 272 + j * 2) = sm::pack4(wv); }
    __syncthreads();
    const int i0 = 16 * w, nks = (w < 4) ? 2 : 4;
    bf16x8 f2[4];
#pragma unroll
    for (int ks = 0; ks < 4; ++ks) f2[ks] = sm::frag_n(Wm, 272, i0, 32 * ks, lane);
    const int i = i0 + (lane & 15), gq = lane >> 4; const float bsi = bs[i];
    const bf16* urow = H1 + (t0 + i) * H1LD + g4 * 128; bf16* orow = MIX + (t0 + i) * DM + g4 * 128;
#pragma unroll
    for (int ct = 0; ct < 8; ++ct) { f32x4 acc = (f32x4){0.f, 0.f, 0.f, 0.f};
#pragma unroll
        for (int ks = 0; ks < 4; ++ks) if (ks < nks) acc = sm::mma(sm::frag_t(Vn, 272, 16 * ct, 32 * ks, lane), f2[ks], acc);
        const int c = 16 * ct + 4 * gq; const f32x4 u = sm::unpack4(*(const u32x2*)(urow + c));
        *(u32x2*)(orow + c) = sm::pack4(u * (acc + bsi)); }
    __syncthreads();
}

namespace gdn {
constexpr int LF = 0, T1 = 17408, T2 = 26624, INM = 35840, VEC = 45056, QS = 46080, KS = 63488, VS = 80896, KDS = 98304, WT = 115712, UT = 133120;
__device__ __forceinline__ float silu(float x) { return x * __builtin_amdgcn_rcpf(1.0f + __expf(-x)); }
__device__ __forceinline__ void prep_unit(const Ctx& C, int ei, int unit) {
    const int n = unit & 63, h = (unit >> 6) & 3, b = unit >> 8;
    const int tid = C.tid, lane = C.lane, w = C.wave;
    LAS char* L = (LAS char*)C.lds;
    LAS float* gcs = (LAS float*)(L + VEC); LAS float* bet = gcs + 64; LAS float* egs = gcs + 128; LAS float* eks = gcs + 192;
    const bf16* H1 = (const bf16*)(C.ws + WS_ARENA);
    const size_t tok0 = (size_t)b * SEQ + n * 64;
    const int chunk = (b * 4 + h) * 64 + n;
    { const int i = tid >> 3, dc = (tid & 7) * 16, pos = n * 64 + i;
      const float* cw = C.inp(6) + (size_t)ei * 4 * 1536;
#pragma unroll 1
      for (int X = 0; X < 3; ++X) {
        float acc[16];
#pragma unroll
        for (int q = 0; q < 16; ++q) acc[q] = 0.f;
        const int chb = X * 512 + h * 128 + dc;
#pragma unroll
        for (int jj = 0; jj < 4; ++jj) { if (pos - 3 + jj >= 0) {
            const bf16* rp = H1 + (tok0 + i - 3 + jj) * H1LD + 1024 + chb;
            const u32x4 r0 = *(const u32x4*)rp, r1 = *(const u32x4*)(rp + 8);
            const float* wp = cw + jj * 1536 + chb; const f32x4 w0 = *(const f32x4*)wp, w1 = *(const f32x4*)(wp + 4), w2 = *(const f32x4*)(wp + 8), w3 = *(const f32x4*)(wp + 12);
            acc[0] += w0[0] * bf_lo(r0[0]); acc[1] += w0[1] * bf_hi(r0[0]); acc[2] += w0[2] * bf_lo(r0[1]); acc[3] += w0[3] * bf_hi(r0[1]);
            acc[4] += w1[0] * bf_lo(r0[2]); acc[5] += w1[1] * bf_hi(r0[2]); acc[6] += w1[2] * bf_lo(r0[3]); acc[7] += w1[3] * bf_hi(r0[3]);
            acc[8] += w2[0] * bf_lo(r1[0]); acc[9] += w2[1] * bf_hi(r1[0]); acc[10] += w2[2] * bf_lo(r1[1]); acc[11] += w2[3] * bf_hi(r1[1]);
            acc[12] += w3[0] * bf_lo(r1[2]); acc[13] += w3[1] * bf_hi(r1[2]); acc[14] += w3[2] * bf_lo(r1[3]); acc[15] += w3[3] * bf_hi(r1[3]); } }
        float ss = 0.f;
#pragma unroll
        for (int q = 0; q < 16; ++q) { acc[q] = silu(acc[q]); ss += acc[q] * acc[q]; }
        float sc = 1.f;
        if (X < 2) { ss += __shfl_xor(ss, 1); ss += __shfl_xor(ss, 2); ss += __shfl_xor(ss, 4); sc = 1.0f / sqrtf(ss + RMS_EPS); if (X == 0) sc *= 0.08838834764831845f; }
        u32x4 o0, o1;
        o0.x = cvt_pk_bf16(acc[0] * sc, acc[1] * sc); o0.y = cvt_pk_bf16(acc[2] * sc, acc[3] * sc); o0.z = cvt_pk_bf16(acc[4] * sc, acc[5] * sc); o0.w = cvt_pk_bf16(acc[6] * sc, acc[7] * sc);
        o1.x = cvt_pk_bf16(acc[8] * sc, acc[9] * sc); o1.y = cvt_pk_bf16(acc[10] * sc, acc[11] * sc); o1.z = cvt_pk_bf16(acc[12] * sc, acc[13] * sc); o1.w = cvt_pk_bf16(acc[14] * sc, acc[15] * sc);
        LAS char* dst = L + (X == 0 ? QS : X == 1 ? KS : VS) + i * 272 + dc * 2;
        *(LAS u32x4*)dst = o0; *(LAS u32x4*)(dst + 16) = o1; } }
    if (w == 0) { const float* AB = (const float*)(C.ws + WS_AB) + (tok0 + lane) * 8;
        const float a = AB[h], bb = AB[4 + h]; const float alog = C.inp(7)[ei * 4 + h], dtb = C.inp(8)[ei * 4 + h];
        const float xs = a + dtb; const float sp = xs > 20.f ? xs : log1pf(__expf(xs));
        float gv = -__expf(alog) * sp;
#pragma unroll
        for (int o = 1; o < 64; o <<= 1) { const float t_ = __shfl_up(gv, o); if (lane >= o) gv += t_; }
        const float gl = __shfl(gv, 63);
        gcs[lane] = gv; bet[lane] = 1.0f / (1.0f + __expf(-bb)); egs[lane] = __expf(gv); eks[lane] = __expf(gl - gv);
        if (lane == 0) ((float*)(C.ws + WS_GAM))[chunk] = __expf(gl); }
    __syncthreads();
    { const int i = tid >> 3, dc = (tid & 7) * 16; const float e = eks[i];
#pragma unroll
      for (int hh = 0; hh < 2; ++hh) { const u32x4 r = *(const LAS u32x4*)(L + KS + i * 272 + dc * 2 + 16 * hh); u32x4 o;
#pragma unroll
        for (int q = 0; q < 4; ++q) o[q] = cvt_pk_bf16(bf_lo(r[q]) * e, bf_hi(r[q]) * e);
        *(LAS u32x4*)(L + KDS + i * 272 + dc * 2 + 16 * hh) = o; } }
#pragma unroll
    for (int q = 0; q < 2; ++q) { const int tt = 2 * w + q, it = tt >> 2, jt = tt & 3;
        if (jt <= it) { f32x4 acc = (f32x4){0.f, 0.f, 0.f, 0.f};
#pragma unroll
            for (int ks = 0; ks < 4; ++ks) acc = sm::mma(sm::frag_n(L + KS, 272, 16 * jt, 32 * ks, lane), sm::frag_n(L + KS, 272, 16 * it, 32 * ks, lane), acc);
            const int i = 16 * it + (lane & 15), j0 = 16 * jt + 4 * (lane >> 4); const float gi = gcs[i], bi = bet[i]; f32x4 o;
#pragma unroll
            for (int r = 0; r < 4; ++r) o[r] = (i > j0 + r) ? bi * acc[r] * __expf(gi - gcs[j0 + r]) : 0.f;
            *(LAS f32x4*)(L + LF + (i * 68 + j0) * 4) = o; } }
    __syncthreads();
    if (w == 0) {
        float t[64];
#pragma unroll
        for (int i = 0; i < 64; ++i) t[i] = 0.f;
#pragma unroll
        for (int i = 0; i < 64; ++i) { float s0 = 0.f, s1 = 0.f, s2 = 0.f, s3 = 0.f;
#pragma unroll
            for (int m = 0; m < i; m += 4) { const f32x4 l = *(const LAS f32x4*)(L + LF + (i * 68 + m) * 4); s0 += l[0] * t[m]; s1 += l[1] * t[m + 1]; s2 += l[2] * t[m + 2]; s3 += l[3] * t[m + 3]; }
            t[i] = ((lane == i) ? 1.f : 0.f) - ((s0 + s1) + (s2 + s3)); }
        const float bj = bet[lane], bej = bj * egs[lane];
#pragma unroll
        for (int i = 0; i < 64; ++i) { *(LAS bf16*)(L + T1 + i * 144 + lane * 2) = f2bf(t[i] * bej); *(LAS bf16*)(L + T2 + i * 144 + lane * 2) = f2bf(t[i] * bj); }
    } else {
        for (int tt = w - 1; tt < 16; tt += 7) { const int it = tt >> 2, jt = tt & 3; f32x4 acc = (f32x4){0.f, 0.f, 0.f, 0.f};
            if (jt <= it) {
#pragma unroll
                for (int ks = 0; ks < 4; ++ks) acc = sm::mma(sm::frag_n(L + KS, 272, 16 * jt, 32 * ks, lane), sm::frag_n(L + QS, 272, 16 * it, 32 * ks, lane), acc); }
            const int i = 16 * it + (lane & 15), j0 = 16 * jt + 4 * (lane >> 4); const float gi = gcs[i]; f32x4 o;
#pragma unroll
            for (int r = 0; r < 4; ++r) o[r] = (i >= j0 + r) ? acc[r] * __expf(gi - gcs[j0 + r]) : 0.f;
            *(LAS u32x2*)(L + INM + i * 144 + j0 * 2) = sm::pack4(o); }
    }
    __syncthreads();
#pragma unroll 1
    for (int q = 0; q < 8; ++q) { const int tt = w * 8 + q, which = tt >> 5, xt = (tt & 31) >> 2, it = tt & 3; f32x4 acc = (f32x4){0.f, 0.f, 0.f, 0.f};
        const LAS char* src = L + (which ? VS : KS); const LAS char* tm = L + (which ? T2 : T1);
#pragma unroll
        for (int ks = 0; ks < 2; ++ks) acc = sm::mma(sm::frag_t(src, 272, 16 * xt, 32 * ks, lane), sm::frag_n(tm, 144, 16 * it, 32 * ks, lane), acc);
        *(LAS u32x2*)(L + (which ? UT : WT) + (16 * it + (lane & 15)) * 272 + (16 * xt + 4 * (lane >> 4)) * 2) = sm::pack4(acc); }
    __syncthreads();
    { bf16* Mg = (bf16*)(C.ws + WS_GM) + (size_t)chunk * 16384; bf16* Bg = (bf16*)(C.ws + WS_GB) + (size_t)chunk * 16384;
      bf16* Cg = (bf16*)(C.ws + WS_GC) + (size_t)chunk * 8192; bf16* Dg = (bf16*)(C.ws + WS_GD) + (size_t)chunk * 8192;
      const int x2 = lane & 15, x1 = 4 * (lane >> 4);
#pragma unroll 1
      for (int q = 0; q < 8; ++q) { const int tt = w * 8 + q, at = tt >> 3, bt = tt & 7;
        f32x4 am = (f32x4){0.f, 0.f, 0.f, 0.f}, ab = (f32x4){0.f, 0.f, 0.f, 0.f};
#pragma unroll
        for (int ks = 0; ks < 2; ++ks) { const bf16x8 fkd_b = sm::frag_t(L + KDS, 272, 16 * bt, 32 * ks, lane), fw = sm::frag_t(L + WT, 272, 16 * at, 32 * ks, lane);
            const bf16x8 fkd_a = sm::frag_t(L + KDS, 272, 16 * at, 32 * ks, lane), fu = sm::frag_t(L + UT, 272, 16 * bt, 32 * ks, lane);
            am = sm::mma(fw, fkd_b, am);
            ab = sm::mma(fkd_a, fu, ab); }
        *(u32x2*)(Mg + (16 * bt + x2) * 128 + 16 * at + x1) = sm::pack4(-am);
        *(u32x2*)(Bg + (16 * bt + x2) * 128 + 16 * at + x1) = sm::pack4(ab); }
#pragma unroll 1
      for (int q = 0; q < 4; ++q) { const int tt = w * 4 + q, at = tt >> 2, it = tt & 3;
        f32x4 ac = (f32x4){0.f, 0.f, 0.f, 0.f}, ad = (f32x4){0.f, 0.f, 0.f, 0.f};
#pragma unroll
        for (int ks = 0; ks < 2; ++ks) { const bf16x8 fin = sm::frag_n(L + INM, 144, 16 * it, 32 * ks, lane);
            ac = sm::mma(sm::frag_t(L + WT, 272, 16 * at, 32 * ks, lane), fin, ac);
            ad = sm::mma(sm::frag_t(L + UT, 272, 16 * at, 32 * ks, lane), fin, ad); }
        const int i = 16 * it + x2, d = 16 * at + x1; const f32x4 qv = sm::unpack4(*(const LAS u32x2*)(L + QS + i * 272 + d * 2));
        *(u32x2*)(Cg + i * 128 + d) = sm::pack4(qv * egs[i] - ac);
        *(u32x2*)(Dg + i * 128 + d) = sm::pack4(ad); } }
#ifdef DBG_DUMP
    { unsigned char* dst = C.ws + WS_HID + (size_t)chunk * 150528; for (int o = tid * 16; o < 150528; o += 512 * 16) *(u32x4*)(dst + o) = *(const LAS u32x4*)(L + o); }
#endif
    __syncthreads();
}

__device__ __forceinline__ void scan_unit(const Ctx& C, int unit) {
    const int cs = unit & 7, bh = unit >> 3;
    const int lane = C.lane, w = C.wave, x2 = lane & 15, g = lane >> 4;
    LAS char* ST = (LAS char*)C.lds;
    const bf16* Mg = (const bf16*)(C.ws + WS_GM) + (size_t)bh * 64 * 16384; const bf16* Bg = (const bf16*)(C.ws + WS_GB) + (size_t)bh * 64 * 16384;
    bf16* Sg = (bf16*)(C.ws + WS_GS) + (size_t)bh * 64 * 16384; const float* GAM = (const float*)(C.ws + WS_GAM) + bh * 64;
    const int c = cs * 16 + x2, d0 = 16 * w + 4 * g;
    { unsigned zz = 0u; asm volatile("" : "+v"(zz));
      if (C.tid < 272) *(LAS u32x4*)(ST + C.tid * 16) = (u32x4){zz, zz, zz, zz}; }
    __syncthreads();
    f32x4 acc = (f32x4){0.f, 0.f, 0.f, 0.f};
    const bf16* mrow = Mg + (16 * w + x2) * 128 + 8 * g; const bf16* brow = Bg + c * 128 + d0; bf16* srow = Sg + c * 128 + d0;
    bf16x8 fm[4]; u32x2 bv; float gam;
#pragma unroll
    for (int ks = 0; ks < 4; ++ks) fm[ks] = *(const bf16x8*)(mrow + 32 * ks);
    bv = *(const u32x2*)brow; gam = GAM[0];
#pragma unroll 1
    for (int n = 0; n < 64; ++n) {
        *(u32x2*)(srow + (size_t)n * 16384) = sm::pack4(acc);
        bf16x8 fmn[4]; u32x2 bvn = bv; float gamn = gam;
#pragma unroll
        for (int ks = 0; ks < 4; ++ks) fmn[ks] = fm[ks];
        if (n + 1 < 64) {
#pragma unroll
            for (int ks = 0; ks < 4; ++ks) fmn[ks] = *(const bf16x8*)(mrow + (size_t)(n + 1) * 16384 + 32 * ks);
            bvn = *(const u32x2*)(brow + (size_t)(n + 1) * 16384); gamn = GAM[n + 1]; }
        f32x4 a = acc * gam + sm::unpack4(bv);
        const LAS char* sb = ST + (n & 1) * 4352;
#pragma unroll
        for (int ks = 0; ks < 4; ++ks) a = sm::mma(fm[ks], sm::frag_n(sb, 272, 0, 32 * ks, lane), a);
        acc = a;
        *(LAS u32x2*)(ST + ((n + 1) & 1) * 4352 + x2 * 272 + d0 * 2) = sm::pack4(acc);
#pragma unroll
        for (int ks = 0; ks < 4; ++ks) fm[ks] = fmn[ks];
        bv = bvn; gam = gamn;
        __syncthreads();
    }
}

__device__ __forceinline__ void out_unit(const Ctx& C, int ei, int unit) {
    const int pr = unit & 31, h = (unit >> 5) & 3, b = unit >> 7;
    const int lane = C.lane, w = C.wave, x2 = lane & 15, g = lane >> 4;
    const int n = 2 * pr + (w >> 2), it = w & 3, chunk = (b * 4 + h) * 64 + n;
    const bf16* Sg = (const bf16*)(C.ws + WS_GS) + (size_t)chunk * 16384; const bf16* Cg = (const bf16*)(C.ws + WS_GC) + (size_t)chunk * 8192; const bf16* Dg = (const bf16*)(C.ws + WS_GD) + (size_t)chunk * 8192;
    const bf16* H1 = (const bf16*)(C.ws + WS_ARENA); bf16* MIX = (bf16*)(C.ws + WS_MIX);
    const int i = 16 * it + x2; const size_t tok = (size_t)b * SEQ + n * 64 + i;
    bf16x8 fc[4];
#pragma unroll
    for (int ks = 0; ks < 4; ++ks) fc[ks] = *(const bf16x8*)(Cg + i * 128 + 32 * ks + 8 * g);
    f32x4 o[8]; float ss = 0.f;
#pragma unroll
    for (int ct = 0; ct < 8; ++ct) { f32x4 a = sm::unpack4(*(const u32x2*)(Dg + i * 128 + 16 * ct + 4 * g));
#pragma unroll
        for (int ks = 0; ks < 4; ++ks) a = sm::mma(*(const bf16x8*)(Sg + (16 * ct + x2) * 128 + 32 * ks + 8 * g), fc[ks], a);
        o[ct] = a; ss += (a[0] * a[0] + a[1] * a[1]) + (a[2] * a[2] + a[3] * a[3]); }
    ss += __shfl_xor(ss, 16); ss += __shfl_xor(ss, 32);
    const float rstd = 1.0f / sqrtf(ss * (1.f / 128.f) + RMS_EPS);
    const float* nw = C.inp(9) + ei * 128; const bf16* zrow = H1 + tok * H1LD + 2560 + h * 128; bf16* orow = MIX + tok * DM + 512 + h * 128;
#pragma unroll
    for (int ct = 0; ct < 8; ++ct) { const int c = 16 * ct + 4 * g; const f32x4 z = sm::unpack4(*(const u32x2*)(zrow + c)); const f32x4 nv = *(const f32x4*)(nw + c); f32x4 y;
#pragma unroll
        for (int r = 0; r < 4; ++r) y[r] = o[ct][r] * rstd * nv[r] * silu(z[r]);
        *(u32x2*)(orow + c) = sm::pack4(y); }
}
}

__device__ __forceinline__ void phase_even_local(const Ctx& C0, int ei) {
    { const Ctx C = phase_ctx(C0); for (int u = C.bid; u < 1024; u += C.G) sgu_unit(C, ei, u); }
    { const Ctx C = phase_ctx(C0); for (int u = C.bid; u < 2048; u += C.G) gdn::prep_unit(C, ei, u); }
}
__device__ __forceinline__ void phase_scan(const Ctx& C0) { const Ctx C = phase_ctx(C0); for (int u = C.bid; u < 256; u += C.G) { gdn::scan_unit(C, u); __syncthreads(); } }
__device__ __forceinline__ void phase_gdn_out(const Ctx& C0, int ei) { const Ctx C = phase_ctx(C0); for (int u = C.bid; u < 1024; u += C.G) gdn::out_unit(C, ei, u); }

#ifndef MK_PER_PHASE
#define MK_PER_PHASE 0
#endif
constexpr int N_PHASES = 1 + DEPTH * 9;
#ifndef PH_EN
#define PH_EN 0x7fff
#endif
#define PEN(k) ((PH_EN >> (k)) & 1)
#ifndef MK_REP
#define MK_REP -1
#endif
#define REPF(k) for (int r_ = 0; r_ < ((MK_REP == (k)) ? 2 : 1); ++r_)
struct Args { const float* in[27]; float* out; unsigned char* ws; int ph_lo, ph_hi; };

__global__ void __launch_bounds__(NWAVES * 64, 2) mk_fwd(Args args) {
    extern __shared__ __attribute__((aligned(16))) unsigned char lds_raw[];
    Ctx C;
    C.lds = (LAS unsigned char*)lds_raw;
    C.tid = threadIdx.x; C.lane = C.tid & 63; C.wave = __builtin_amdgcn_readfirstlane(C.tid >> 6); C.G = gridDim.x; C.bid = blockIdx.x;
    C.ka = (const __attribute__((address_space(4))) char*)__builtin_amdgcn_kernarg_segment_ptr();
    C.out = nullptr; C.ws = nullptr; C.ctl = nullptr;
    for (int u = C.tid; u < 128; u += NWAVES * 64) ((LAS unsigned*)(C.lds + LDS_CTL_OFF))[u] = 0u;
    __syncthreads();
#if !MK_PER_PHASE
    { const Ctx P = phase_ctx(C); (void)xcd_barrier_post((unsigned*)P.ws + CW_BAR, (volatile LAS unsigned*)(C.lds + LDS_CTL_OFF) + 8); }
#define GRID_BAR() do { const Ctx P_ = phase_ctx(C); XcdBarrier b_; b_.bar = (unsigned*)P_.ws + CW_BAR; b_.x = xb_xcc_id(); b_.st = (volatile LAS unsigned*)(C.lds + LDS_CTL_OFF) + 8; xcd_barrier(b_); } while (0)
#else
#define GRID_BAR() do {} while (0)
#endif
    const int lo = args.ph_lo, hi = args.ph_hi;
#define IN(k) (lo <= (k) && (k) < hi)
#define SEAM(k) do { if (IN((k) + 1)) GRID_BAR(); } while (0)
    if (PEN(0) && IN(0)) { REPF(0) phase_prologue(C); SEAM(0); }
#pragma unroll 1
    for (int L = 0; L < DEPTH; ++L) {
        const int pb = 1 + L * 9, li = L >> 1;
        if ((L & 1) == 0) {
            if (PEN(1) && IN(pb + 0)) {
                const Ctx P = phase_ctx(C); unsigned char* ws = P.ws;
                EpiBf16 E{(bf16*)(ws + WS_ARENA), EVEN_N, 1024};
                REPF(1) run_plain_gemm(P, (const bf16*)(ws + WS_XB), DM, DM, EVEN_N, (const bf16*)(ws + WS_WEIN) + (size_t)li * EVEN_N * DM, E);
                SEAM(pb + 0); }
            if (PEN(2) && IN(pb + 1)) { REPF(2) phase_even_local(C, li); SEAM(pb + 1); }
            if (PEN(3) && IN(pb + 2)) { REPF(3) phase_scan(C); SEAM(pb + 2); }
            if (PEN(4) && IN(pb + 3)) { REPF(4) phase_gdn_out(C, li); SEAM(pb + 3); }
            if (PEN(5) && IN(pb + 4)) {
                const Ctx P = phase_ctx(C); unsigned char* ws = P.ws;
                EpiRes E{(const bf16*)(ws + WS_XB), (bf16*)(ws + WS_Y)};
                REPF(5) run_plain_gemm(P, (const bf16*)(ws + WS_MIX), DM, DM, DM, (const bf16*)(ws + WS_WEOUT) + (size_t)li * DM * DM, E);
                SEAM(pb + 4); }
        } else {
            if (PEN(6) && IN(pb + 0)) {
                const Ctx P = phase_ctx(C); unsigned char* ws = P.ws;
                EpiBf16 E{(bf16*)(ws + WS_ARENA + AR_C1), ODD_N, 0};
                REPF(6) run_plain_gemm(P, (const bf16*)(ws + WS_XB), DM, DM, ODD_N, (const bf16*)(ws + WS_WOIN) + (size_t)li * ODD_N * DM, E);
                SEAM(pb + 0); }
            if (PEN(7) && IN(pb + 1)) { REPF(7) phase_o1b(C); SEAM(pb + 1); }
            if (PEN(8) && IN(pb + 2)) {
                { const Ctx P = phase_ctx(C); unsigned char* ws = P.ws;
                  EpiQ E{(bf16*)(ws + WS_ARENA + AR_Q), (const float*)(ws + WS_RS), (const f32x4*)(ws + WS_ROPE)};
                  REPF(8) run_plain_gemm(P, (const bf16*)(ws + WS_ARENA + AR_C1), ODD_N, QL, 1536, (const bf16*)(ws + WS_WUQ) + (size_t)li * 1536 * QL, E); }
                { const Ctx P = phase_ctx(C); unsigned char* ws = P.ws;
                  EpiKV E{(bf16*)(ws + WS_ARENA + AR_KV), (const float*)(ws + WS_RS) + T};
                  REPF(8) run_plain_gemm(P, (const bf16*)(ws + WS_ARENA + AR_C1) + QL, ODD_N, KVL, 2048, (const bf16*)(ws + WS_WUKV) + (size_t)li * 2048 * KVL, E); }
                SEAM(pb + 2); }
            if (PEN(9) && IN(pb + 3)) { REPF(9) phase_attn(C); SEAM(pb + 3); }
            if (PEN(10) && IN(pb + 4)) {
                const Ctx P = phase_ctx(C); unsigned char* ws = P.ws;
                EpiRes E{(const bf16*)(ws + WS_XB), (bf16*)(ws + WS_Y)};
                REPF(10) run_plain_gemm(P, (const bf16*)(ws + WS_MIX), DM, DM, DM, (const bf16*)(ws + WS_WOOUT) + (size_t)li * DM * DM, E);
                SEAM(pb + 4); }
        }
        if (PEN(11) && IN(pb + 5)) { phase_router(C, L); SEAM(pb + 5); }
        if (PEN(12) && IN(pb + 6)) {
            const Ctx P = phase_ctx(C); unsigned char* ws = P.ws;
            EpiSwiglu E{(bf16*)(ws + WS_HID), P.inp(24) + (size_t)L * NEXP * 2048, nullptr};
            REPF(12) run_moe_gemm(P, L, (const bf16*)(ws + WS_XB), DM, 2, DM, 2048, (const bf16*)(ws + WS_WGU) + (size_t)L * NEXP * 2048 * DM, (size_t)2048 * DM, E);
            SEAM(pb + 6); }
        if (PEN(13) && IN(pb + 7)) {
            const Ctx P = phase_ctx(C); unsigned char* ws = P.ws;
            EpiDown E{(bf16*)(ws + WS_YE), P.inp(26) + (size_t)L * NEXP * DM, (const float*)(ws + WS_GATE), nullptr};
            REPF(13) run_moe_gemm(P, L, (const bf16*)(ws + WS_HID), DFF, 0, DFF, DM, (const bf16*)(ws + WS_WDN) + (size_t)L * NEXP * DM * DFF, (size_t)DM * DFF, E);
            SEAM(pb + 7); }
        if (PEN(14) && IN(pb + 8)) { phase_combine(C, L); SEAM(pb + 8); }
    }
#undef IN
#undef SEAM
}

extern "C" void kernel_launch(void* const* d_in, const int* in_sizes, int n_in, void* d_out, int out_size, void* d_ws, size_t ws_size, hipStream_t stream) {
    static int grid = 0;
    if (grid == 0) {
        if (n_in != 27 || in_sizes[0] != T * DM || out_size != T * DM || ws_size < WS_END) { fprintf(stderr, "kernel_launch: unexpected shapes (n_in %d, in0 %d, out %d, ws %zu)\n", n_in, n_in > 0 ? in_sizes[0] : -1, out_size, ws_size); grid = -1; return; }
        int dev = 0, cus = 0, per_cu = 0;
        if (hipGetDevice(&dev) != hipSuccess || hipDeviceGetAttribute(&cus, hipDeviceAttributeMultiprocessorCount, dev) != hipSuccess) { grid = -1; return; }
        if (hipFuncSetAttribute((const void*)mk_fwd, hipFuncAttributeMaxDynamicSharedMemorySize, LDS_BYTES) != hipSuccess) { fprintf(stderr, "kernel_launch: hipFuncSetAttribute failed\n"); grid = -1; return; }
        if (hipOccupancyMaxActiveBlocksPerMultiprocessor(&per_cu, (const void*)mk_fwd, NWAVES * 64, LDS_BYTES) != hipSuccess || per_cu < 1) fprintf(stderr, "kernel_launch: occupancy query reports %d\n", per_cu);
        (void)hipGetLastError();
        grid = cus;
        if (grid != 256) fprintf(stderr, "kernel_launch: %d CUs (built for 256)\n", grid);
    }
    if (grid < 0) return;
    if (hipMemsetAsync((char*)d_ws + WS_CTL, 0, CTL_ZERO_BYTES, stream) != hipSuccess) return;
    Args a{};
    for (int i = 0; i < 27; ++i) a.in[i] = (const float*)d_in[i];
    a.out = (float*)d_out; a.ws = (unsigned char*)d_ws;
#if MK_PER_PHASE
    for (int p = 0; p < N_PHASES; ++p) { a.ph_lo = p; a.ph_hi = p + 1; hipLaunchKernelGGL(mk_fwd, dim3(grid), dim3(NWAVES * 64), LDS_BYTES, stream, a); }
#else
    a.ph_lo = 0; a.ph_hi = N_PHASES;
    hipLaunchKernelGGL(mk_fwd, dim3(grid), dim3(NWAVES * 64), LDS_BYTES, stream, a);
#endif
    const hipError_t le = hipPeekAtLastError();
    if (le != hipSuccess) fprintf(stderr, "kernel_launch: launch failed: %s\n", hipGetErrorName(le));
}
```

```cpp
#define MK_PER_PHASE 0
#include <hip/hip_runtime.h>
#include <cstdio>
#include <cstdint>

#define GAS __attribute__((address_space(1)))
#define LAS __attribute__((address_space(3)))
typedef unsigned short bf16;
typedef short bf16x8 __attribute__((ext_vector_type(8)));
typedef short s16x4 __attribute__((ext_vector_type(4)));
typedef float f32x2 __attribute__((ext_vector_type(2)));
typedef float f32x4 __attribute__((ext_vector_type(4)));
typedef float f32x16 __attribute__((ext_vector_type(16)));
typedef unsigned u32x2 __attribute__((ext_vector_type(2)));
typedef unsigned u32x4 __attribute__((ext_vector_type(4)));
typedef GAS unsigned gu32;

typedef __bf16 bf16v2_t __attribute__((ext_vector_type(2)));
__device__ __forceinline__ unsigned cvt_pk_bf16(float lo, float hi) { const bf16v2_t v = __builtin_convertvector((f32x2){lo, hi}, bf16v2_t); return __builtin_bit_cast(unsigned, v); }
__device__ __forceinline__ float bf_lo(unsigned w) { return __uint_as_float(w << 16); }
__device__ __forceinline__ float bf_hi(unsigned w) { return __uint_as_float(w & 0xffff0000u); }
__device__ __forceinline__ float bf2f(bf16 b) { return __uint_as_float(((unsigned)b) << 16); }
__device__ __forceinline__ bf16 f2bf(float f) { return (bf16)(cvt_pk_bf16(f, 0.f) & 0xffffu); }
__device__ __forceinline__ float wave_sum(float v) {
#pragma unroll
    for (int o = 1; o < 64; o <<= 1) v += __shfl_xor(v, o);
    return v;
}

namespace pg8 {
constexpr int BM = 256, BK = 64, HALF = 128, HTB = HALF * BK * 2, STAGE_BYTES = 8 * HTB, NXCD = 8, WGM = 8;
__host__ __device__ __forceinline__ int lds_byte(int r, int c) { const int st = (r >> 4) * 2 + (c >> 5), rr = r & 15, cc = c & 31, ob = rr * 64 + cc * 2; return st * 1024 + (ob ^ (((ob >> 9) & 1) << 5)); }
__host__ __device__ __forceinline__ void stage_rc(int b, int& R, int& C) { const int st = b / 1024, sb = b % 1024, swz = sb ^ (((sb >> 9) & 1) << 5); R = (st >> 1) * 16 + swz / 64; C = (st & 1) * 32 + (swz % 64) / 2; }
__host__ __device__ __forceinline__ int perm32(int rho) { const int n = rho >> 4, i = rho & 15; return 8 * (i >> 2) + 4 * n + (i & 3); }

struct Unit { int pm, pn, e, li; };

struct StaticOrder {
    int nM, nN, nwg, G, c;
    __device__ void init(int M, int N, int G_, int c_) { nM = M / BM; nN = N / BM; nwg = nM * nN; G = G_; c = c_; }
    __device__ bool next(int i, Unit& u) const {
        const long L = (long)i * G + c; if (L >= nwg) return false;
        int wgid = (int)L; { const int q = nwg / NXCD, r = nwg % NXCD, xcd = wgid % NXCD, off = wgid / NXCD; wgid = (xcd < r ? xcd * (q + 1) : r * (q + 1) + (xcd - r) * q) + off; }
        const int nig = WGM * nN, gid = wgid / nig, fm = gid * WGM, gsz = (nM - fm) < WGM ? (nM - fm) : WGM;
        u.pm = fm + ((wgid % nig) % gsz); u.pn = (wgid % nig) / gsz; u.e = 0; u.li = 0; return true;
    }
};
struct PlainSched {
    static constexpr bool GATHER = false;
    StaticOrder o; const char* Bt; int K; int lda;
    __device__ __forceinline__ size_t arow0(const Unit& u) const { return (size_t)u.pm * BM * lda * 2; }
    __device__ __forceinline__ bool next(int i, Unit& u) const { return o.next(i, u); }
    __device__ __forceinline__ const char* bbase(const Unit& u) const { return Bt + (size_t)u.pn * BM * K * 2; }
};

__device__ __forceinline__ f32x2 gelu_pk(f32x2 v) {
    const f32x2 av = __builtin_elementwise_abs(v), d = av * 0.2316418882f + 1.0f;
    f32x2 t; t.x = __builtin_amdgcn_rcpf(d.x); t.y = __builtin_amdgcn_rcpf(d.y);
    f32x2 q = t * 0.5307027145f + (-0.7265760135f); q = q * t + 0.7107068705f; q = q * t + (-0.142248368f); q = q * t + 0.127414796f; q = q * t;
    const f32x2 s = (v * v) * (-0.72134752044f);
    f32x2 e; e.x = __builtin_amdgcn_exp2f(s.x); e.y = __builtin_amdgcn_exp2f(s.y);
    const f32x2 m = v * (q * e), r = v - m;
    f32x2 o; o.x = v.x < 0.f ? m.x : r.x; o.y = v.y < 0.f ? m.y : r.y; return o;
}

template <class Epi, class Sched, bool ALIGN_EPI>
__device__ __forceinline__ void gemm_phase(LAS unsigned char* lds, const char* Abase, int K, const Sched& S, const Epi& E) {
    int tid_ = threadIdx.x; asm volatile("" : "+v"(tid_));
    const int tid = tid_, wid = __builtin_amdgcn_readfirstlane(tid >> 6), lane = tid & 63, wr = wid >> 2, wc = wid & 3, fr = lane & 15, fq = lane >> 4;
    int nt = K / BK; asm volatile("" : "+s"(nt));
    int Rr[2], Cc[2]; unsigned voffB[2], voffA[2];
#pragma unroll
    for (int i = 0; i < 2; ++i) { stage_rc(tid * 16 + i * 8192, Rr[i], Cc[i]); const int Rb = Epi::PERM ? ((Rr[i] & ~31) + perm32(Rr[i] & 31)) : Rr[i]; voffB[i] = (unsigned)(Rb * K + Cc[i]) * 2u;
        voffA[i] = 0u; if constexpr (!Sched::GATHER) voffA[i] = (unsigned)(Rr[i] * S.lda + Cc[i]) * 2u; }
    const size_t hstepA = (size_t)HALF * S.lda * 2;
    const size_t kstep = (size_t)(BK * 2);
    const size_t hstepB = (size_t)HALF * K * 2;
    const unsigned ldsw = (unsigned)wid * 1024u;
    const int aoff = lds_byte(wr * 64 + fr, fq * 8), boff = lds_byte(wc * 32 + fr, fq * 8);
#define PG8_SA(b, h) (((b) * 2 + (h)) * HTB)
#define PG8_SB(b, h) ((4 + (b) * 2 + (h)) * HTB)
#define PG8_STAGEB(bufoff, gbase) do { _Pragma("unroll") for (int _i = 0; _i < 2; ++_i) \
        __builtin_amdgcn_global_load_lds((const unsigned*)((const char*)(gbase) + voffB[_i]), (LAS unsigned*)(lds + (bufoff) + ldsw + _i * 8192), 16, 0, 0); } while (0)
#define PG8_STAGEA(bufoff, h, koff) do { _Pragma("unroll") for (int _i = 0; _i < 2; ++_i) { \
        if constexpr (Sched::GATHER) __builtin_amdgcn_global_load_lds((const unsigned*)(Abase + (size_t)va[h][_i] + (koff)), (LAS unsigned*)(lds + (bufoff) + ldsw + _i * 8192), 16, 0, 0); \
        else __builtin_amdgcn_global_load_lds((const unsigned*)(cA + (h) * hstepA + (koff) + voffA[_i]), (LAS unsigned*)(lds + (bufoff) + ldsw + _i * 8192), 16, 0, 0); } } while (0)
#define PG8_LDA(dst, b, h) do { _Pragma("unroll") for (int m = 0; m < 4; ++m) _Pragma("unroll") for (int k = 0; k < 2; ++k) dst[m][k] = *(const LAS bf16x8*)(lds + PG8_SA(b, h) + aoff + m * 2048 + k * 1024); } while (0)
#define PG8_LDB(dst, b, h) do { _Pragma("unroll") for (int n = 0; n < 2; ++n) _Pragma("unroll") for (int k = 0; k < 2; ++k) dst[n][k] = *(const LAS bf16x8*)(lds + PG8_SB(b, h) + boff + n * 2048 + k * 1024); } while (0)
#define PG8_MMA(ai, bj, At, Bt) do { __builtin_amdgcn_s_setprio(1); _Pragma("unroll") for (int m = 0; m < 4; ++m) _Pragma("unroll") for (int n = 0; n < 2; ++n) _Pragma("unroll") for (int k = 0; k < 2; ++k) \
        acc[ai][bj][m][n] = __builtin_amdgcn_mfma_f32_16x16x32_bf16(Bt[n][k], At[m][k], acc[ai][bj][m][n], 0, 0, 0); __builtin_amdgcn_s_setprio(0); } while (0)
#define PG8_WAIT_V(n) asm volatile("s_waitcnt vmcnt(" #n ")" ::: "memory")
#define PG8_WAIT_L(n) asm volatile("s_waitcnt lgkmcnt(" #n ")" ::: "memory")
#define PG8_BAR __builtin_amdgcn_s_barrier()
#define PG8_SCHED __builtin_amdgcn_sched_barrier(0)
    Unit cur, nxt; int ui = 0;
    if (!S.next(0, cur)) return;
    f32x4 acc[2][2][4][2];
#pragma unroll
    for (int a = 0; a < 2; ++a)
#pragma unroll
        for (int b = 0; b < 2; ++b)
#pragma unroll
            for (int m = 0; m < 4; ++m)
#pragma unroll
                for (int n = 0; n < 2; ++n) acc[a][b][m][n] = (f32x4){0.f, 0.f, 0.f, 0.f};
    bf16x8 At[4][2], B0[2][2], B1[2][2];
    unsigned va[2][2], vn[2][2]; const char* cA = Abase; const char* nA = Abase;
    if constexpr (Sched::GATHER) {
#pragma unroll
        for (int h = 0; h < 2; ++h)
#pragma unroll
            for (int i = 0; i < 2; ++i) va[h][i] = S.aoff(cur, h * HALF + Rr[i]) + (unsigned)Cc[i] * 2u;
    } else { cA = Abase + S.arow0(cur); }
    const char* cB = S.bbase(cur);
    PG8_STAGEB(PG8_SB(0, 0), cB); PG8_STAGEB(PG8_SB(0, 1), cB + hstepB); PG8_STAGEA(PG8_SA(0, 0), 0, 0); PG8_STAGEA(PG8_SA(0, 1), 1, 0);
    if (wr == 1) PG8_BAR;
    PG8_WAIT_V(2); PG8_BAR;
    PG8_STAGEB(PG8_SB(1, 0), cB + kstep); PG8_STAGEA(PG8_SA(1, 0), 0, kstep); PG8_STAGEB(PG8_SB(1, 1), cB + hstepB + kstep);
    PG8_WAIT_V(6); PG8_BAR;
    for (;;) {
        const bool has_next = S.next(ui + 1, nxt);
        const char* nB = has_next ? S.bbase(nxt) : cB;
        if constexpr (Sched::GATHER) {
            if (has_next) {
#pragma unroll
                for (int h = 0; h < 2; ++h)
#pragma unroll
                    for (int i = 0; i < 2; ++i) vn[h][i] = S.aoff(nxt, h * HALF + Rr[i]) + (unsigned)Cc[i] * 2u;
            } else {
#pragma unroll
                for (int h = 0; h < 2; ++h)
#pragma unroll
                    for (int i = 0; i < 2; ++i) vn[h][i] = va[h][i];
            }
        } else { nA = has_next ? Abase + S.arow0(nxt) : cA; }
        for (int t = 0; t < nt; t += 2) {
            const bool last = (t == nt - 2);
            const size_t k1 = (size_t)(t + 1) * kstep;
            PG8_LDB(B0, 0, 0); PG8_LDB(B1, 0, 1); PG8_SCHED; PG8_LDA(At, 0, 0); PG8_STAGEA(PG8_SA(1, 1), 1, k1);
            PG8_WAIT_V(8); PG8_WAIT_L(0); PG8_BAR; PG8_MMA(0, 0, At, B0); PG8_MMA(0, 1, At, B1); PG8_BAR; PG8_SCHED;
            if (last) {
                if constexpr (Sched::GATHER) {
#pragma unroll
                    for (int h = 0; h < 2; ++h)
#pragma unroll
                        for (int i = 0; i < 2; ++i) va[h][i] = vn[h][i];
                } else { cA = nA; }
            }
            const char* bX = last ? nB : cB;
            const size_t k2 = last ? (size_t)0 : (size_t)(t + 2) * kstep, k3 = k2 + kstep;
            PG8_LDA(At, 0, 1); PG8_STAGEB(PG8_SB(0, 0), bX + k2); PG8_STAGEB(PG8_SB(0, 1), bX + hstepB + k2); PG8_STAGEA(PG8_SA(0, 0), 0, k2);
            PG8_WAIT_V(8); PG8_WAIT_L(0); PG8_BAR; PG8_MMA(1, 0, At, B0); PG8_MMA(1, 1, At, B1); PG8_BAR; PG8_SCHED;
            PG8_LDB(B0, 1, 0); PG8_LDB(B1, 1, 1); PG8_SCHED; PG8_LDA(At, 1, 0); PG8_STAGEA(PG8_SA(0, 1), 1, k2);
            PG8_WAIT_V(8); PG8_WAIT_L(0); PG8_BAR; PG8_MMA(0, 0, At, B0); PG8_MMA(0, 1, At, B1); PG8_BAR; PG8_SCHED;
            PG8_LDA(At, 1, 1); PG8_STAGEB(PG8_SB(1, 0), bX + k3); PG8_STAGEB(PG8_SB(1, 1), bX + hstepB + k3); PG8_STAGEA(PG8_SA(1, 0), 0, k3);
            PG8_WAIT_V(8); PG8_WAIT_L(0); PG8_BAR; PG8_MMA(1, 0, At, B0); PG8_MMA(1, 1, At, B1); PG8_BAR; PG8_SCHED;
        }
        if constexpr (ALIGN_EPI) { if (wr == 0) PG8_BAR; }
        E(acc, cur, wr, wc, fr, fq);
        if (!has_next) break;
#pragma unroll
        for (int a = 0; a < 2; ++a)
#pragma unroll
            for (int b = 0; b < 2; ++b)
#pragma unroll
                for (int m = 0; m < 4; ++m)
#pragma unroll
                    for (int n = 0; n < 2; ++n) acc[a][b][m][n] = (f32x4){0.f, 0.f, 0.f, 0.f};
        cur = nxt; cB = nB; ++ui;
        if constexpr (ALIGN_EPI) { if (wr == 1) PG8_BAR; }
    }
    PG8_WAIT_V(0);
    if constexpr (!ALIGN_EPI) { if (wr == 0) PG8_BAR; }
    PG8_BAR;
#undef PG8_SA
#undef PG8_SB
#undef PG8_STAGEA
#undef PG8_STAGEB
#undef PG8_LDA
#undef PG8_LDB
#undef PG8_MMA
#undef PG8_WAIT_V
#undef PG8_WAIT_L
#undef PG8_BAR
#undef PG8_SCHED
}
}

constexpr int NWAVES = 8;
constexpr int BATCH = 8, SEQ = 4096, DM = 1024, DEPTH = 4;
constexpr int T = BATCH * SEQ;
constexpr int EVEN_IN = 3080, EVEN_N = 3072;
constexpr int ODD_IN = 704, ODD_N = 768, QL = 384, KVL = 256;
constexpr int NEXP = 32, TOPK = 4, DFF = 1024;
constexpr int NSLOT = T * TOPK;
constexpr int LCAP = T;
constexpr float LN_EPS = 1e-5f, RMS_EPS = 1e-6f;
constexpr float DN_ALPHA = 1.681792830507429f;
constexpr float ATT_SCALE = 0.07216878364870323f;

constexpr size_t MiB = 1u << 20;
constexpr size_t WS_CTL = 0, CTL_ZERO_BYTES = 1 * MiB;
constexpr size_t WS_WGU = 16 * MiB, WS_WDN = 528 * MiB, WS_WEIN = 784 * MiB, WS_WEOUT = 796 * MiB, WS_WOIN = 800 * MiB, WS_WUQ = 804 * MiB, WS_WUKV = 808 * MiB, WS_WOOUT = 810 * MiB;
constexpr size_t WS_ROPE = 814 * MiB, WS_AB = 815 * MiB, WS_RS = 816 * MiB, WS_GATE = 817 * MiB, WS_LIST = 818 * MiB, WS_GAM = 822 * MiB;
constexpr size_t WS_XF = 832 * MiB, WS_XB = 960 * MiB, WS_Y = 1024 * MiB, WS_ARENA = 1152 * MiB, WS_MIX = 1440 * MiB;
constexpr size_t WS_GM = 1504 * MiB, WS_GB = 1568 * MiB, WS_GC = 1632 * MiB, WS_GD = 1664 * MiB, WS_GS = 1696 * MiB, WS_HID = 1760 * MiB, WS_YE = 2016 * MiB, WS_END = 2272 * MiB;
constexpr size_t AR_C1 = 0, AR_Q = 48 * MiB, AR_KV = 144 * MiB, AR_KPE = 272 * MiB;
constexpr int CW_TMO = 0, CW_CODE = 1, CW_BAR = 4096, CW_CNT = 16384;

constexpr int LDS_BYTES = 163840;
constexpr int LDS_CTL_OFF = 163840 - 512;
constexpr int LDS_SPARE = 131072;

#define RLX_AGENT __ATOMIC_RELAXED, __HIP_MEMORY_SCOPE_AGENT
#define LDS_WAIT() asm volatile("s_waitcnt lgkmcnt(0)" ::: "memory")
#define VM_WAIT() asm volatile("s_waitcnt vmcnt(0)" ::: "memory")

#define XB_TMO      128
#define XB_XCNT(j)  (256  + 64 * (j))
#define XB_XSUB(j)  (1280 + 64 * (j))
#define XB_XGEN(j)  (2304 + 64 * (j))
#define XB_TOP      3328
#define XB_TOPGEN   3392
#define XCD_BAR_WORDS 3456
#define XB_SPIN_CAP (1u << 18)
__device__ __forceinline__ unsigned xb_ld(unsigned* p)              { return __hip_atomic_load(p, __ATOMIC_RELAXED, __HIP_MEMORY_SCOPE_AGENT); }
__device__ __forceinline__ unsigned xb_add(unsigned* p, unsigned v) { return __hip_atomic_fetch_add(p, v, __ATOMIC_RELAXED, __HIP_MEMORY_SCOPE_AGENT); }
__device__ __forceinline__ unsigned xb_xcc_id() { return (unsigned)__builtin_amdgcn_s_getreg((3 << 11) | 20) & 0xFu; }
#define XB_SPIN(cond, bar) do { unsigned _sp = 0; while (cond) { __builtin_amdgcn_s_sleep(1); \
    if ((++_sp & 255u) == 0u) { if (xb_ld(&(bar)[XB_TMO])) break; if (_sp > XB_SPIN_CAP) { atomicAdd(&(bar)[XB_TMO], 1u); break; } } } } while (0)
struct XcdBarrier { unsigned* bar; unsigned x; volatile LAS unsigned* st; };
__device__ __forceinline__ XcdBarrier xcd_barrier_post(unsigned* bar, volatile LAS unsigned* st) {
    XcdBarrier b; b.bar = bar; b.x = xb_xcc_id(); b.st = st;
    if (threadIdx.x == 0) (void)xb_add(&bar[XB_XCNT(b.x)], 1u);
    return b;
}
__device__ __forceinline__ void xcd_barrier_complete(unsigned* bar, unsigned x, unsigned& nloc, unsigned& nx) {
    const unsigned G = gridDim.x * gridDim.y * gridDim.z;
    unsigned sum, cnt, mine, sp = 0u;
    for (;;) {
        sum = 0u; cnt = 0u; mine = 0u;
#pragma unroll
        for (unsigned j = 0; j < 16; ++j) { const unsigned c = xb_ld(&bar[XB_XCNT(j)]); sum += c; cnt += (c > 0u) ? 1u : 0u; mine = (j == x) ? c : mine; }
        if (sum == G) break;
        __builtin_amdgcn_s_sleep(1);
        if ((++sp & 255u) == 0u) { if (xb_ld(&bar[XB_TMO])) break; if (sp > XB_SPIN_CAP) { atomicAdd(&bar[XB_TMO], 1u); break; } }
    }
    nloc = mine > 0u ? mine : 1u; nx = cnt > 0u ? cnt : 1u;
}
__device__ __forceinline__ void xcd_barrier(const XcdBarrier& b) {
    asm volatile("s_waitcnt vmcnt(0)" ::: "memory");
    __syncthreads();
    if (threadIdx.x == 0) {
        unsigned* bar = b.bar;
        __builtin_amdgcn_s_waitcnt(0);
        unsigned nloc = b.st[0], nx = b.st[1];
        if (nloc == 0u) { xcd_barrier_complete(bar, b.x, nloc, nx); b.st[0] = nloc; b.st[1] = nx; }
        const unsigned old = xb_add(&bar[XB_XSUB(b.x)], 1u);
        const unsigned gen = old / nloc;
        if (old + 1u == (gen + 1u) * nloc) {
            __builtin_amdgcn_fence(__ATOMIC_RELEASE, "agent");
            asm volatile("s_waitcnt vmcnt(0)" ::: "memory");
            const unsigned og = xb_add(&bar[XB_TOP], 1u);
            const unsigned tg = og / nx;
            if (og + 1u == (tg + 1u) * nx) xb_add(&bar[XB_TOPGEN], 1u);
            else XB_SPIN(xb_ld(&bar[XB_TOPGEN]) == tg, bar);
            __builtin_amdgcn_fence(__ATOMIC_ACQUIRE, "agent");
            xb_add(&bar[XB_XGEN(b.x)], 1u);
            asm volatile("s_waitcnt vmcnt(0)" ::: "memory");
        } else {
            XB_SPIN(xb_ld(&bar[XB_XGEN(b.x)]) == gen, bar);
            __builtin_amdgcn_fence(__ATOMIC_ACQUIRE, "agent");
            asm volatile("s_waitcnt vmcnt(0)" ::: "memory");
        }
    }
    __syncthreads();
}

struct Ctx {
    LAS unsigned char* lds;
    int tid, lane, wave, G, bid;
    const __attribute__((address_space(4))) char* ka;
    __device__ __forceinline__ const float* inp(int i) const { return ((const float* const __attribute__((address_space(4)))*)ka)[i]; }
    float* out;
    unsigned char* ws;
    unsigned* ctl;
};

__device__ __forceinline__ Ctx phase_ctx(const Ctx& C0) { Ctx C; C.lds = C0.lds; { int g_ = C0.G, b_ = C0.bid; asm volatile("" : "+s"(g_), "+s"(b_)); C.G = g_; C.bid = b_; } int t = threadIdx.x; asm volatile("" : "+v"(t)); C.tid = t; C.lane = t & 63; C.wave = __builtin_amdgcn_readfirstlane(t >> 6);
    const __attribute__((address_space(4))) char* ka = C0.ka; asm volatile("" : "+s"(ka)); C.ka = ka;
    C.out = *(float* const __attribute__((address_space(4)))*)(ka + 216); C.ws = *(unsigned char* const __attribute__((address_space(4)))*)(ka + 224); C.ctl = (unsigned*)C.ws; return C; }

__device__ __forceinline__ int uq_rowmap(int n) { const int h = n / 192, o = n - h * 192; if (o < 128) return n; const int j = o - 128; return h * 192 + 128 + (j < 32 ? 2 * j : 2 * (j - 32) + 1); }
__device__ __forceinline__ void conv_item(const float* W, int ldn, int c0, int nvalid, int K, bf16* WT, const float* kscale, int mode, LAS float* scr, int kb, int nb, int lane) {
    const int k0 = 64 * kb, n0 = 64 * nb;
    const int lc = (lane & 15) * 4, lr = lane >> 4;
#pragma unroll
    for (int i = 0; i < 16; ++i) {
        const int kk = lr + 4 * i;
        f32x4 v = (f32x4){0.f, 0.f, 0.f, 0.f};
        if (n0 + lc < nvalid) v = *(const f32x4*)(W + (size_t)(k0 + kk) * ldn + c0 + n0 + lc);
        if (kscale) { const float s = kscale[k0 + kk]; v = v * s; }
        scr[kk * 65 + lc + 0] = v.x; scr[kk * 65 + lc + 1] = v.y; scr[kk * 65 + lc + 2] = v.z; scr[kk * 65 + lc + 3] = v.w;
    }
    LDS_WAIT(); asm volatile("" ::: "memory");
    const int c = lane & 7;
#pragma unroll
    for (int j = 0; j < 8; ++j) {
        const int n = (lane >> 3) + 8 * j; const LAS float* s = scr + (8 * c) * 65 + n;
        u32x4 o; o.x = cvt_pk_bf16(s[0 * 65], s[1 * 65]); o.y = cvt_pk_bf16(s[2 * 65], s[3 * 65]); o.z = cvt_pk_bf16(s[4 * 65], s[5 * 65]); o.w = cvt_pk_bf16(s[6 * 65], s[7 * 65]);
        const int dn = mode == 1 ? uq_rowmap(n0 + n) : (n0 + n);
        *(u32x4*)(WT + (size_t)dn * K + k0 + 8 * c) = o;
    }
    LDS_WAIT(); asm volatile("" ::: "memory");
}

__device__ __forceinline__ void row_load_f32(const float* p, int lane, f32x4 (&v)[4]) {
#pragma unroll
    for (int j = 0; j < 4; ++j) v[j] = *(const f32x4*)(p + 4 * lane + 256 * j);
}
__device__ __forceinline__ void row_load_bf16(const bf16* p, int lane, f32x4 (&v)[4]) {
#pragma unroll
    for (int j = 0; j < 4; ++j) { const u32x2 w = *(const u32x2*)(p + 4 * lane + 256 * j); v[j] = (f32x4){bf_lo(w.x), bf_hi(w.x), bf_lo(w.y), bf_hi(w.y)}; }
}
__device__ __forceinline__ void row_store_f32(float* p, int lane, const f32x4 (&v)[4]) {
#pragma unroll
    for (int j = 0; j < 4; ++j) *(f32x4*)(p + 4 * lane + 256 * j) = v[j];
}
__device__ __forceinline__ void row_store_bf16(bf16* p, int lane, const f32x4 (&v)[4]) {
#pragma unroll
    for (int j = 0; j < 4; ++j) { u32x2 w; w.x = cvt_pk_bf16(v[j].x, v[j].y); w.y = cvt_pk_bf16(v[j].z, v[j].w); *(u32x2*)(p + 4 * lane + 256 * j) = w; }
}
__device__ __forceinline__ void row_layernorm(f32x4 (&v)[4], const f32x4 (&g)[4], const f32x4 (&b)[4]) {
    float s = 0.f;
#pragma unroll
    for (int j = 0; j < 4; ++j) s += (v[j].x + v[j].y) + (v[j].z + v[j].w);
    const float mean = wave_sum(s) * (1.f / DM); float s2 = 0.f;
#pragma unroll
    for (int j = 0; j < 4; ++j) { v[j] = v[j] - mean; s2 += (v[j].x * v[j].x + v[j].y * v[j].y) + (v[j].z * v[j].z + v[j].w * v[j].w); }
    const float rstd = 1.f / sqrtf(wave_sum(s2) * (1.f / DM) + LN_EPS);
#pragma unroll
    for (int j = 0; j < 4; ++j) v[j] = v[j] * rstd * g[j] + b[j];
}
__device__ __forceinline__ void row_ab(const f32x4 (&v)[4], const LAS float* w8, int lane, float (&ab)[8]) {
#pragma unroll
    for (int e = 0; e < 8; ++e) { float s = 0.f;
#pragma unroll
        for (int j = 0; j < 4; ++j) { const f32x4 w = *(const LAS f32x4*)(w8 + e * 1024 + 4 * lane + 256 * j); s += (v[j].x * w.x + v[j].y * w.y) + (v[j].z * w.z + v[j].w * w.w); }
        ab[e] = wave_sum(s); }
}
__device__ __forceinline__ void load_w8(const Ctx& C, int ei, LAS float* w8) {
    const float* W = C.inp(1) + (size_t)ei * DM * EVEN_IN;
    for (int idx = C.tid; idx < 8 * 1024; idx += NWAVES * 64) { const int k = idx >> 3, e = idx & 7; w8[e * 1024 + k] = W[(size_t)k * EVEN_IN + EVEN_N + e]; }
}

__device__ __forceinline__ void phase_prologue(const Ctx& C0) {
    const Ctx C = phase_ctx(C0);
    const int gw = C.bid * NWAVES + C.wave, NGW = C.G * NWAVES, lane = C.lane;
    LAS float* scr = (LAS float*)(C.lds + C.wave * 16640);
    unsigned char* ws = C.ws;
    constexpr int I0 = 128 * 512, I1 = 128 * 256, I2 = 2 * 768, I3 = 2 * 256, I4 = 2 * 192, I5 = 2 * 144, I6 = 2 * 128, I7 = 2 * 256;
    constexpr int NITEMS = I0 + I1 + I2 + I3 + I4 + I5 + I6 + I7;
    for (int it = gw; it < NITEMS; it += NGW) {
        int r = it;
        if (r < I0) { const int mi = r / 512, q = r % 512; conv_item(C.inp(23) + (size_t)mi * 1024 * 2048, 2048, 0, 2048, 1024, (bf16*)(ws + WS_WGU) + (size_t)mi * 2048 * 1024, nullptr, 0, scr, q / 32, q % 32, lane); continue; } r -= I0;
        if (r < I1) { const int mi = r / 256, q = r % 256; conv_item(C.inp(25) + (size_t)mi * 1024 * 1024, 1024, 0, 1024, 1024, (bf16*)(ws + WS_WDN) + (size_t)mi * 1024 * 1024, nullptr, 0, scr, q / 16, q % 16, lane); continue; } r -= I1;
        if (r < I2) { const int mi = r / 768, q = r % 768; conv_item(C.inp(1) + (size_t)mi * 1024 * EVEN_IN, EVEN_IN, 0, EVEN_N, 1024, (bf16*)(ws + WS_WEIN) + (size_t)mi * EVEN_N * 1024, nullptr, 0, scr, q / 48, q % 48, lane); continue; } r -= I2;
        if (r < I3) { const int mi = r / 256, q = r % 256; conv_item(C.inp(10) + (size_t)mi * 1024 * 1024, 1024, 0, 1024, 1024, (bf16*)(ws + WS_WEOUT) + (size_t)mi * 1024 * 1024, nullptr, 0, scr, q / 16, q % 16, lane); continue; } r -= I3;
        if (r < I4) { const int mi = r / 192, q = r % 192; conv_item(C.inp(11) + (size_t)mi * 1024 * ODD_IN, ODD_IN, 0, ODD_IN, 1024, (bf16*)(ws + WS_WOIN) + (size_t)mi * ODD_N * 1024, nullptr, 0, scr, q / 12, q % 12, lane); continue; } r -= I4;
        if (r < I5) { const int mi = r / 144, q = r % 144; conv_item(C.inp(13) + (size_t)mi * QL * 1536, 1536, 0, 1536, QL, (bf16*)(ws + WS_WUQ) + (size_t)mi * 1536 * QL, C.inp(12) + mi * QL, 1, scr, q / 24, q % 24, lane); continue; } r -= I5;
        if (r < I6) { const int mi = r / 128, q = r % 128; conv_item(C.inp(15) + (size_t)mi * KVL * 2048, 2048, 0, 2048, KVL, (bf16*)(ws + WS_WUKV) + (size_t)mi * 2048 * KVL, C.inp(14) + mi * KVL, 0, scr, q / 32, q % 32, lane); continue; } r -= I6;
        { const int mi = r / 256, q = r % 256; conv_item(C.inp(16) + (size_t)mi * 1024 * 1024, 1024, 0, 1024, 1024, (bf16*)(ws + WS_WOOUT) + (size_t)mi * 1024 * 1024, nullptr, 0, scr, q / 16, q % 16, lane); }
    }
    { f32x2* rope = (f32x2*)(ws + WS_ROPE);
      for (int idx = C.bid * NWAVES * 64 + C.tid; idx < SEQ * 32; idx += C.G * NWAVES * 64) { const int pos = idx >> 5, j = idx & 31;
          const float inv = powf(10000.0f, -(float)(2 * j) / 64.0f); const float ang = (float)pos * inv; rope[idx] = (f32x2){cosf(ang), sinf(ang)}; } }
    __syncthreads();
    LAS float* w8 = (LAS float*)(C.lds);
    load_w8(C, 0, w8);
    __syncthreads();
    const float* x = C.inp(0); bf16* XB = (bf16*)(ws + WS_XB); float* AB = (float*)(ws + WS_AB);
    for (int m = gw; m < T; m += NGW) { f32x4 v[4]; row_load_f32(x + (size_t)m * DM, lane, v); row_store_bf16(XB + (size_t)m * DM, lane, v);
        float ab[8]; row_ab(v, w8, lane, ab); if (lane < 8) { float s = ab[0];
#pragma unroll
            for (int e = 1; e < 8; ++e) s = (lane == e) ? ab[e] : s;
            AB[(size_t)m * 8 + lane] = s; } }
}

using pg8::Unit;
struct EpiBf16 {
    static constexpr bool PERM = true;
    bf16* O; int ldc; int gelu_cols;
    __device__ __forceinline__ void operator()(const f32x4 (&acc)[2][2][4][2], const Unit& u, int wr, int wc, int fr, int fq) const {
        const int row0 = u.pm * 256 + wr * 64 + fr, col0 = u.pn * 256 + wc * 32 + 8 * fq;
        const bool g = (u.pn * 256) < gelu_cols;
#pragma unroll
        for (int ai = 0; ai < 2; ++ai)
#pragma unroll
            for (int m = 0; m < 4; ++m) { bf16* rowp = O + (size_t)(row0 + ai * 128 + m * 16) * ldc + col0;
#pragma unroll
                for (int bj = 0; bj < 2; ++bj) { f32x4 v0 = acc[ai][bj][m][0], v1 = acc[ai][bj][m][1];
                    if (g) { f32x2 a = pg8::gelu_pk((f32x2){v0[0], v0[1]}), b = pg8::gelu_pk((f32x2){v0[2], v0[3]}), c = pg8::gelu_pk((f32x2){v1[0], v1[1]}), d = pg8::gelu_pk((f32x2){v1[2], v1[3]});
                        v0 = (f32x4){a.x, a.y, b.x, b.y}; v1 = (f32x4){c.x, c.y, d.x, d.y}; }
                    u32x4 w; w.x = cvt_pk_bf16(v0[0], v0[1]); w.y = cvt_pk_bf16(v0[2], v0[3]); w.z = cvt_pk_bf16(v1[0], v1[1]); w.w = cvt_pk_bf16(v1[2], v1[3]);
                    *(u32x4*)(rowp + bj * 128) = w; } }
    }
};
struct EpiRes {
    static constexpr bool PERM = true;
    const bf16* X; bf16* Y;
    __device__ __forceinline__ void operator()(const f32x4 (&acc)[2][2][4][2], const Unit& u, int wr, int wc, int fr, int fq) const {
        const int row0 = u.pm * 256 + wr * 64 + fr, col0 = u.pn * 256 + wc * 32 + 8 * fq;
#pragma unroll
        for (int ai = 0; ai < 2; ++ai)
#pragma unroll
            for (int m = 0; m < 4; ++m) { const size_t off = (size_t)(row0 + ai * 128 + m * 16) * DM + col0;
                u32x4 xs[2];
#pragma unroll
                for (int bj = 0; bj < 2; ++bj) xs[bj] = *(const u32x4*)(X + off + bj * 128);
#pragma unroll
                for (int bj = 0; bj < 2; ++bj) { const f32x4 a0 = acc[ai][bj][m][0], a1 = acc[ai][bj][m][1]; u32x4 w;
                    w.x = cvt_pk_bf16(bf_lo(xs[bj].x) * DN_ALPHA + a0[0], bf_hi(xs[bj].x) * DN_ALPHA + a0[1]); w.y = cvt_pk_bf16(bf_lo(xs[bj].y) * DN_ALPHA + a0[2], bf_hi(xs[bj].y) * DN_ALPHA + a0[3]);
                    w.z = cvt_pk_bf16(bf_lo(xs[bj].z) * DN_ALPHA + a1[0], bf_hi(xs[bj].z) * DN_ALPHA + a1[1]); w.w = cvt_pk_bf16(bf_lo(xs[bj].w) * DN_ALPHA + a1[2], bf_hi(xs[bj].w) * DN_ALPHA + a1[3]);
                    *(u32x4*)(Y + off + bj * 128) = w; }
                asm volatile("" ::: "memory"); }
    }
};
struct EpiQ {
    static constexpr bool PERM = true;
    bf16* O; const float* rs; const f32x4* rope;
    __device__ __forceinline__ void operator()(const f32x4 (&acc)[2][2][4][2], const Unit& u, int wr, int wc, int fr, int fq) const {
        const int row0 = u.pm * 256 + wr * 64 + fr, col0 = u.pn * 256 + wc * 32 + 8 * fq;
#pragma unroll
        for (int ai = 0; ai < 2; ++ai)
#pragma unroll
            for (int m = 0; m < 4; ++m) { const int row = row0 + ai * 128 + m * 16; const float s = rs[row]; const int pos = row & (SEQ - 1);
                bf16* rowp = O + (size_t)row * 1536 + col0;
#pragma unroll
                for (int bj = 0; bj < 2; ++bj) { f32x4 v0 = acc[ai][bj][m][0] * s, v1 = acc[ai][bj][m][1] * s;
                    const int c = col0 + bj * 128, o = c % 192;
                    if (o >= 128) { const int jp = (o - 128) >> 1;
                        const f32x4 r0 = rope[(pos * 32 + jp) >> 1], r1 = rope[(pos * 32 + jp + 2) >> 1];
                        v0 = (f32x4){v0[0] * r0[0] - v0[1] * r0[1], v0[0] * r0[1] + v0[1] * r0[0], v0[2] * r0[2] - v0[3] * r0[3], v0[2] * r0[3] + v0[3] * r0[2]};
                        v1 = (f32x4){v1[0] * r1[0] - v1[1] * r1[1], v1[0] * r1[1] + v1[1] * r1[0], v1[2] * r1[2] - v1[3] * r1[3], v1[2] * r1[3] + v1[3] * r1[2]}; }
                    u32x4 w; w.x = cvt_pk_bf16(v0[0], v0[1]); w.y = cvt_pk_bf16(v0[2], v0[3]); w.z = cvt_pk_bf16(v1[0], v1[1]); w.w = cvt_pk_bf16(v1[2], v1[3]);
                    *(u32x4*)(rowp + bj * 128) = w; }
                asm volatile("" ::: "memory"); }
    }
};
struct EpiKV {
    static constexpr bool PERM = true;
    bf16* O; const float* rs;
    __device__ __forceinline__ void operator()(const f32x4 (&acc)[2][2][4][2], const Unit& u, int wr, int wc, int fr, int fq) const {
        const int row0 = u.pm * 256 + wr * 64 + fr, col0 = u.pn * 256 + wc * 32 + 8 * fq;
#pragma unroll
        for (int ai = 0; ai < 2; ++ai)
#pragma unroll
            for (int m = 0; m < 4; ++m) { const int row = row0 + ai * 128 + m * 16; const float s = rs[row]; bf16* rowp = O + (size_t)row * 2048 + col0;
#pragma unroll
                for (int bj = 0; bj < 2; ++bj) { const f32x4 v0 = acc[ai][bj][m][0] * s, v1 = acc[ai][bj][m][1] * s;
                    u32x4 w; w.x = cvt_pk_bf16(v0[0], v0[1]); w.y = cvt_pk_bf16(v0[2], v0[3]); w.z = cvt_pk_bf16(v1[0], v1[1]); w.w = cvt_pk_bf16(v1[2], v1[3]);
                    *(u32x4*)(rowp + bj * 128) = w; }
                asm volatile("" ::: "memory"); }
    }
};
struct EpiSwiglu {
    static constexpr bool PERM = true;
    bf16* HID; const float* bias; const LAS int* rmap;
    __device__ __forceinline__ void operator()(const f32x4 (&acc)[2][2][4][2], const Unit& u, int wr, int wc, int fr, int fq) const {
        const int col0 = u.pn * 256 + wc * 32 + 8 * fq; const float* bp = bias + (size_t)u.e * 2048 + col0;
        f32x4 bv[2][2];
#pragma unroll
        for (int bj = 0; bj < 2; ++bj)
#pragma unroll
            for (int n = 0; n < 2; ++n) bv[bj][n] = *(const f32x4*)(bp + bj * 128 + 4 * n);
#pragma unroll
        for (int ai = 0; ai < 2; ++ai)
#pragma unroll
            for (int m = 0; m < 4; ++m) { const int slot = rmap[u.li * 256 + ai * 128 + wr * 64 + m * 16 + fr];
                if (slot >= 0) { bf16* rowp = HID + (size_t)slot * DFF + (col0 >> 1);
#pragma unroll
                    for (int bj = 0; bj < 2; ++bj) { const f32x4 h0 = acc[ai][bj][m][0] + bv[bj][0], h1 = acc[ai][bj][m][1] + bv[bj][1];
                        float o[4];
#pragma unroll
                        for (int q = 0; q < 4; ++q) { const float glu = fminf(q < 2 ? h0[2 * q] : h1[2 * q - 4], 7.0f); float lin = q < 2 ? h0[2 * q + 1] : h1[2 * q - 3]; lin = fminf(fmaxf(lin, -7.0f), 7.0f);
                            const float sg = __builtin_amdgcn_rcpf(1.0f + __builtin_amdgcn_exp2f(-1.702f * 1.4426950408889634f * glu)); o[q] = glu * sg * (lin + 1.0f); }
                        u32x2 w; w.x = cvt_pk_bf16(o[0], o[1]); w.y = cvt_pk_bf16(o[2], o[3]);
                        *(u32x2*)(rowp + bj * 64) = w; } }
                asm volatile("" ::: "memory"); }
    }
};
struct EpiDown {
    static constexpr bool PERM = true;
    bf16* YE; const float* bias; const float* gate; const LAS int* rmap;
    __device__ __forceinline__ void operator()(const f32x4 (&acc)[2][2][4][2], const Unit& u, int wr, int wc, int fr, int fq) const {
        const int col0 = u.pn * 256 + wc * 32 + 8 * fq; const float* bp = bias + (size_t)u.e * DM + col0;
        f32x4 bv[2][2];
#pragma unroll
        for (int bj = 0; bj < 2; ++bj)
#pragma unroll
            for (int n = 0; n < 2; ++n) bv[bj][n] = *(const f32x4*)(bp + bj * 128 + 4 * n);
#pragma unroll
        for (int ai = 0; ai < 2; ++ai)
#pragma unroll
            for (int m = 0; m < 4; ++m) { const int slot = rmap[u.li * 256 + ai * 128 + wr * 64 + m * 16 + fr];
                if (slot >= 0) { const float gt = gate[slot]; bf16* rowp = YE + (size_t)slot * DM + col0;
#pragma unroll
                    for (int bj = 0; bj < 2; ++bj) { const f32x4 v0 = (acc[ai][bj][m][0] + bv[bj][0]) * gt, v1 = (acc[ai][bj][m][1] + bv[bj][1]) * gt;
                        u32x4 w; w.x = cvt_pk_bf16(v0[0], v0[1]); w.y = cvt_pk_bf16(v0[2], v0[3]); w.z = cvt_pk_bf16(v1[0], v1[1]); w.w = cvt_pk_bf16(v1[2], v1[3]);
                        *(u32x4*)(rowp + bj * 128) = w; } }
                asm volatile("" ::: "memory"); }
    }
};

template <class Epi>
__device__ __forceinline__ void run_plain_gemm(const Ctx& C, const bf16* A, int lda, int K, int N, const bf16* Bt, const Epi& E) {
    pg8::PlainSched S; S.o.init(T, N, C.G, C.bid); S.Bt = (const char*)Bt; S.K = K; S.lda = lda;
    pg8::gemm_phase<Epi, pg8::PlainSched, true>(C.lds, (const char*)A, K, S, E);
}

constexpr int MOE_RMAP_OFF = LDS_SPARE, MOE_MAX_UNITS = 20, MOE_PRE_OFF = LDS_SPARE + MOE_MAX_UNITS * 1024, MOE_CNT_OFF = MOE_PRE_OFF + 256;
struct MoeSched {
    static constexpr bool GATHER = true;
    const LAS int* pre; const LAS int* rmap; const char* Bt; size_t bstride; int K, NT, G, c, lda, shift;
    __device__ __forceinline__ bool next(int i, Unit& u) const {
        const int x = c & 7, k = c >> 3, per = G >> 3;
        const int RT = 32 / NT, tot = pre[32];
        const int slot = i * per + k;
        const int st = (slot >> 5) * 8 + x, within = slot & 31;
        const int rt = st * RT + within / NT;
        if (rt >= tot || i >= MOE_MAX_UNITS) return false;
        int e = 0;
#pragma unroll 1
        for (; e < 31; ++e) if (rt < pre[e + 1]) break;
        u.e = e; u.pn = within % NT; u.pm = rt - pre[e]; u.li = i; return true;
    }
    __device__ __forceinline__ const char* bbase(const Unit& u) const { return Bt + (size_t)u.e * bstride + (size_t)u.pn * 256 * K * 2; }
    __device__ __forceinline__ unsigned aoff(const Unit& u, int r) const { const int slot = rmap[u.li * 256 + r]; const int s = slot < 0 ? 0 : (slot >> shift); return (unsigned)(s * lda) * 2u; }
};
template <class Epi>
__device__ __forceinline__ void run_moe_gemm(const Ctx& C0, int layer, const bf16* A, int lda, int shift, int K, int N, const bf16* Bt, size_t bstride_elems, Epi E) {
    const Ctx C = phase_ctx(C0);
    LAS int* pre = (LAS int*)(C.lds + MOE_PRE_OFF); LAS int* cnt = (LAS int*)(C.lds + MOE_CNT_OFF); LAS int* rmap = (LAS int*)(C.lds + MOE_RMAP_OFF);
    const int* list = (const int*)(C.ws + WS_LIST);
    if (C.tid < 32) cnt[C.tid] = (int)__hip_atomic_load(C.ctl + CW_CNT + (layer * 32 + C.tid) * 64, RLX_AGENT);
    __syncthreads();
    if (C.tid == 0) { int s = 0; for (int e = 0; e < 32; ++e) { pre[e] = s; s += (cnt[e] + 255) >> 8; } pre[32] = s; }
    __syncthreads();
    MoeSched S; S.pre = pre; S.rmap = rmap; S.Bt = (const char*)Bt; S.bstride = bstride_elems * 2; S.K = K; S.NT = N / 256; S.G = C.G; S.c = C.bid; S.lda = lda; S.shift = shift;
    { Unit u; for (int i = 0; S.next(i, u); ++i) { if (C.tid < 256) { const int idx = u.pm * 256 + C.tid; rmap[i * 256 + C.tid] = idx < cnt[u.e] ? list[(size_t)u.e * LCAP + idx] : -1; } } }
    __syncthreads();
    E.rmap = rmap;
    pg8::gemm_phase<Epi, MoeSched, true>(C.lds, (const char*)A, K, S, E);
}

__device__ __forceinline__ void phase_router(const Ctx& C0, int layer) {
    const Ctx C = phase_ctx(C0);
    LAS float* wrT = (LAS float*)C.lds;
    LAS int* lcnt = (LAS int*)(C.lds + 132096); LAS int* lbase = (LAS int*)(C.lds + 132224);
    LAS int* asg_e = (LAS int*)(C.lds + 132352); LAS int* asg_pos = (LAS int*)(C.lds + 134400); LAS float* asg_gate = (LAS float*)(C.lds + 136448);
    const float* Wr = C.inp(21) + (size_t)layer * DM * NEXP; const float* br = C.inp(22) + layer * NEXP;
    const int lane = C.lane, tid = C.tid;
    for (int idx = tid; idx < DM * NEXP; idx += NWAVES * 64) { const int k = idx >> 5, e = idx & 31; wrT[e * 1028 + k] = Wr[idx]; }
    f32x4 g[4], b[4]; row_load_f32(C.inp(17) + layer * DM, lane, g); row_load_f32(C.inp(18) + layer * DM, lane, b);
    const bf16* Y = (const bf16*)(C.ws + WS_Y); bf16* XB = (bf16*)(C.ws + WS_XB);
    int* list = (int*)(C.ws + WS_LIST); float* GATE = (float*)(C.ws + WS_GATE);
    const float mybias = br[lane >> 1];
    for (int rb = C.bid; rb < T / 128; rb += C.G) {
        if (tid < 32) lcnt[tid] = 0;
        __syncthreads();
#pragma unroll 1
        for (int i = 0; i < 16; ++i) {
            const int rl = C.wave * 16 + i, row = rb * 128 + rl;
            f32x4 v[4]; row_load_bf16(Y + (size_t)row * DM, lane, v);
            row_layernorm(v, g, b);
            row_store_bf16(XB + (size_t)row * DM, lane, v);
            float p[32];
#pragma unroll
            for (int e = 0; e < 32; ++e) { float s = 0.f;
#pragma unroll
                for (int j = 0; j < 4; ++j) { const f32x4 w = *(const LAS f32x4*)(wrT + e * 1028 + 4 * lane + 256 * j); s += (v[j].x * w.x + v[j].y * w.y) + (v[j].z * w.z + v[j].w * w.w); }
                p[e] = s; }
#define BFLY(bit, n) { const bool hi_ = (lane & (bit)) != 0; _Pragma("unroll") for (int q = 0; q < (n); ++q) { const float send = hi_ ? p[q] : p[q + (n)]; const float keep = hi_ ? p[q + (n)] : p[q]; p[q] = keep + __shfl_xor(send, (bit)); } }
            BFLY(32, 16) BFLY(16, 8) BFLY(8, 4) BFLY(4, 2) BFLY(2, 1)
#undef BFLY
            float val = p[0] + __shfl_xor(p[0], 1) + mybias; const int me = lane >> 1;
            float tv[4]; int te[4];
#pragma unroll
            for (int k = 0; k < 4; ++k) { float bv = val; int be = me;
#pragma unroll
                for (int off = 1; off < 64; off <<= 1) { const float ov = __shfl_xor(bv, off); const int oe = __shfl_xor(be, off); const bool take = (ov > bv) || (ov == bv && oe < be); bv = take ? ov : bv; be = take ? oe : be; }
                tv[k] = bv; te[k] = be; if (me == be) val = -__builtin_inff(); }
            const float e1 = __expf(tv[1] - tv[0]), e2 = __expf(tv[2] - tv[0]), e3 = __expf(tv[3] - tv[0]); const float inv = 1.0f / (1.0f + e1 + e2 + e3);
            if (lane < 4) { const int my_e = lane == 0 ? te[0] : lane == 1 ? te[1] : lane == 2 ? te[2] : te[3]; const float my_g = (lane == 0 ? 1.0f : lane == 1 ? e1 : lane == 2 ? e2 : e3) * inv;
                const int lpos = __hip_atomic_fetch_add(lcnt + my_e, 1, __ATOMIC_RELAXED, __HIP_MEMORY_SCOPE_WORKGROUP);
                const int a = rl * 4 + lane; asg_e[a] = my_e; asg_pos[a] = lpos; asg_gate[a] = my_g; }
        }
        __syncthreads();
        if (tid < 32) lbase[tid] = (int)__hip_atomic_fetch_add(C.ctl + CW_CNT + (layer * 32 + tid) * 64, (unsigned)lcnt[tid], RLX_AGENT);
        __syncthreads();
        { const int a = tid, e = asg_e[a], slot = (rb * 128 + (a >> 2)) * 4 + (a & 3); list[(size_t)e * LCAP + lbase[e] + asg_pos[a]] = slot; GATE[slot] = asg_gate[a]; }
        __syncthreads();
    }
}

__device__ __forceinline__ void phase_combine(const Ctx& C0, int layer) {
    const Ctx C = phase_ctx(C0);
    const int gw = C.bid * NWAVES + C.wave, NGW = C.G * NWAVES, lane = C.lane;
    LAS float* w8 = (LAS float*)C.lds;
    if (layer == 1) { load_w8(C, 1, w8); __syncthreads(); }
    f32x4 g[4], b[4]; row_load_f32(C.inp(19) + layer * DM, lane, g); row_load_f32(C.inp(20) + layer * DM, lane, b);
    bf16* XB = (bf16*)(C.ws + WS_XB); const bf16* YE = (const bf16*)(C.ws + WS_YE); float* AB = (float*)(C.ws + WS_AB);
    for (int m = gw; m < T; m += NGW) {
        f32x4 v[4]; row_load_bf16(XB + (size_t)m * DM, lane, v);
#pragma unroll
        for (int j = 0; j < 4; ++j) v[j] = v[j] * DN_ALPHA;
#pragma unroll
        for (int k = 0; k < 4; ++k) { const bf16* yr = YE + (size_t)(m * 4 + k) * DM;
#pragma unroll
            for (int j = 0; j < 4; ++j) { const u32x2 w = *(const u32x2*)(yr + 4 * lane + 256 * j); v[j] = v[j] + (f32x4){bf_lo(w.x), bf_hi(w.x), bf_lo(w.y), bf_hi(w.y)}; } }
        row_layernorm(v, g, b);
        if (layer == DEPTH - 1) row_store_f32(C.out + (size_t)m * DM, lane, v);
        else row_store_bf16(XB + (size_t)m * DM, lane, v);
        if (layer == 1) { float ab[8]; row_ab(v, w8, lane, ab); if (lane < 8) { float s = ab[0];
#pragma unroll
                for (int e = 1; e < 8; ++e) s = (lane == e) ? ab[e] : s;
                AB[(size_t)m * 8 + lane] = s; } }
    }
}

__device__ __forceinline__ void phase_o1b(const Ctx& C0) {
    const Ctx C = phase_ctx(C0);
    const int gw = C.bid * NWAVES + C.wave, NGW = C.G * NWAVES, lane = C.lane;
    const bf16* C1 = (const bf16*)(C.ws + WS_ARENA + AR_C1); bf16* KPE = (bf16*)(C.ws + WS_ARENA + AR_KPE);
    float* RSQ = (float*)(C.ws + WS_RS); float* RKV = RSQ + T; const f32x2* rope = (const f32x2*)(C.ws + WS_ROPE);
    for (int m = gw; m < T; m += NGW) {
        const bf16* rp = C1 + (size_t)m * ODD_N;
        const u32x4 a = *(const u32x4*)(rp + 8 * lane);
        float s = 0.f;
#pragma unroll
        for (int q = 0; q < 4; ++q) { const float lo = bf_lo(a[q]), hi = bf_hi(a[q]); s += lo * lo + hi * hi; }
        float sq = lane < 48 ? s : 0.f, skv = lane < 48 ? 0.f : s;
        if (lane < 16) { const u32x4 b = *(const u32x4*)(rp + 8 * (64 + lane)); float s2 = 0.f;
#pragma unroll
            for (int q = 0; q < 4; ++q) { const float lo = bf_lo(b[q]), hi = bf_hi(b[q]); s2 += lo * lo + hi * hi; }
            skv += s2; }
        sq = wave_sum(sq); skv = wave_sum(skv);
        if (lane == 0) { RSQ[m] = 1.0f / sqrtf(sq * (1.0f / QL) + RMS_EPS); RKV[m] = 1.0f / sqrtf(skv * (1.0f / KVL) + RMS_EPS); }
        if (lane < 32) { const float x1 = bf2f(rp[640 + lane]), x2 = bf2f(rp[672 + lane]); const f32x2 cs = rope[(m & (SEQ - 1)) * 32 + lane];
            *(unsigned*)(KPE + (size_t)m * 64 + 2 * lane) = cvt_pk_bf16(x1 * cs.x - x2 * cs.y, x1 * cs.y + x2 * cs.x); }
    }
}

namespace att {
constexpr int SHM_V = 16384, SHM_K = 16384, SHM_KR = 8192;
constexpr int OFF_V = 0, OFF_K = 2 * SHM_V, OFF_KR = OFF_K + 2 * SHM_K, OFF_WS = OFF_KR + 2 * SHM_KR, OFF_QR = OFF_WS + 2048;
constexpr float THR = 8.f, SCALE = ATT_SCALE;
#define KSWZ(row, colB) ((row) * 256 + ((colB) ^ (((row) & 7) << 4)))
#define KRSWZ(row, colB) ((row) * 128 + ((colB) ^ (((row) & 7) << 4)))
#define SBAR() __builtin_amdgcn_sched_barrier(0)
__device__ __forceinline__ int v_st(int k, int c) { const int kk = (k & ~0xC) | ((k & 4) << 1) | ((k & 8) >> 1); return ((kk >> 3) * 4 + (c >> 5)) * 512 + ((kk & 7) * 32 + (c & 31)) * 2; }
__device__ __forceinline__ int v_rd_base(int lane) { return ((lane & 3) << 3) | (((lane >> 2) & 3) << 6) | (((lane >> 4) & 1) << 5) | (((lane >> 5) & 1) << 8); }
constexpr int v_rd_off(int d0, int ks, int half) { return d0 * 512 + ks * 4096 + half * 2048; }
__device__ __forceinline__ int crow(int r, int hi) { return (r & 3) + 8 * (r >> 2) + 4 * hi; }
__device__ __forceinline__ void partialSM(f32x16& p0, f32x16& p1, float& m_reg, float& mn, float& alpha) {
    float pmax = p0[0];
#pragma unroll
    for (int r = 1; r < 16; ++r) pmax = fmaxf(pmax, p0[r]);
#pragma unroll
    for (int r = 0; r < 16; ++r) pmax = fmaxf(pmax, p1[r]);
    { auto rr = __builtin_amdgcn_permlane32_swap(__float_as_uint(pmax), __float_as_uint(pmax), false, false);
      pmax = fmaxf(__uint_as_float(rr[0]), __uint_as_float(rr[1])); }
    constexpr float C2 = 1.4426950408889634f * SCALE;
    if (__builtin_expect(__all((pmax - m_reg) * SCALE <= THR), 1)) { mn = m_reg; alpha = 1.f; }
    else { mn = fmaxf(m_reg, pmax); alpha = __builtin_amdgcn_exp2f((m_reg - mn) * C2); m_reg = mn; }
    const float mnL = -mn * C2;
#pragma unroll
    for (int r = 0; r < 16; ++r) p0[r] = fmaf(p0[r], C2, mnL);
#pragma unroll
    for (int r = 0; r < 16; ++r) p1[r] = fmaf(p1[r], C2, mnL);
#pragma unroll
    for (int r = 0; r < 16; ++r) p0[r] = __builtin_amdgcn_exp2f(p0[r]);
}
__device__ __forceinline__ void finishSM(f32x16& p0, f32x16& p1, float alpha, float& l_reg, bf16x8& pa0, bf16x8& pa1, bf16x8& pa2, bf16x8& pa3) {
#pragma unroll
    for (int r = 0; r < 16; ++r) p1[r] = __builtin_amdgcn_exp2f(p1[r]);
    float ps = 0;
#pragma unroll
    for (int r = 0; r < 16; ++r) ps += p0[r];
#pragma unroll
    for (int r = 0; r < 16; ++r) ps += p1[r];
    { auto rr = __builtin_amdgcn_permlane32_swap(__float_as_uint(ps), __float_as_uint(ps), false, false);
      ps = __uint_as_float(rr[0]) + __uint_as_float(rr[1]); }
    l_reg = l_reg * alpha + ps;
#define PK4(P, B_, OUT) do { unsigned a0 = cvt_pk_bf16(P[B_+0], P[B_+1]), a1 = cvt_pk_bf16(P[B_+2], P[B_+3]);                          \
        unsigned b0 = cvt_pk_bf16(P[B_+4], P[B_+5]), b1 = cvt_pk_bf16(P[B_+6], P[B_+7]);                                             \
        auto r0 = __builtin_amdgcn_permlane32_swap(a0, b0, false, false); auto r1 = __builtin_amdgcn_permlane32_swap(a1, b1, false, false); \
        u32x4 w = {r0[0], r1[0], r0[1], r1[1]}; OUT = *reinterpret_cast<bf16x8*>(&w); } while (0)
    PK4(p0, 0, pa0); PK4(p0, 8, pa1); PK4(p1, 0, pa2); PK4(p1, 8, pa3);
#undef PK4
}
template <int KB>
__device__ __forceinline__ void qkt(f32x16& p0, f32x16& p1, const LAS char* lds, int r32, int hi, const bf16x8* qr, const LAS char* qrl) {
    p0 = f32x16{}; p1 = f32x16{};
    const LAS char* kb[4]; const LAS char* kr[4];
#pragma unroll
    for (int dd = 0; dd < 4; ++dd) { kb[dd] = lds + OFF_K + KB * SHM_K + KSWZ(r32, (dd * 16 + hi * 8) * 2); kr[dd] = lds + OFF_KR + KB * SHM_KR + KRSWZ(r32, (dd * 16 + hi * 8) * 2); }
#pragma unroll
    for (int d0 = 0; d0 < 8; ++d0) { const LAS char* a = kb[d0 & 3] + (d0 >> 2) * 128;
        const bf16x8 b0 = *reinterpret_cast<const LAS bf16x8*>(a);
        const bf16x8 b1 = *reinterpret_cast<const LAS bf16x8*>(a + 32 * 256);
        p0 = __builtin_amdgcn_mfma_f32_32x32x16_bf16(b0, qr[d0], p0, 0, 0, 0);
        p1 = __builtin_amdgcn_mfma_f32_32x32x16_bf16(b1, qr[d0], p1, 0, 0, 0); }
#pragma unroll
    for (int d0 = 0; d0 < 4; ++d0) { const LAS char* a = kr[d0];
        const bf16x8 b0 = *reinterpret_cast<const LAS bf16x8*>(a);
        const bf16x8 b1 = *reinterpret_cast<const LAS bf16x8*>(a + 32 * 128);
        const bf16x8 qf = *reinterpret_cast<const LAS bf16x8*>(qrl + d0 * 1024);
        p0 = __builtin_amdgcn_mfma_f32_32x32x16_bf16(b0, qf, p0, 0, 0, 0);
        p1 = __builtin_amdgcn_mfma_f32_32x32x16_bf16(b1, qf, p1, 0, 0, 0); }
}
template <int VB>
__device__ __forceinline__ void pv_tile(f32x16* o, int vb0, bf16x8 pa0, bf16x8 pa1, bf16x8 pa2, bf16x8 pa3) {
#define TRRD(dst, off) asm volatile("ds_read_b64_tr_b16 %0, %1 offset:%2" : "=&v"(dst) : "v"(vb0), "i"(off) : "memory")
#define PV_D0(d0) do { s16x4 l0, l1, l2, l3, h0, h1, h2, h3; constexpr int b_ = OFF_V + VB * SHM_V + v_rd_off(d0, 0, 0); \
        TRRD(l0, b_); TRRD(h0, b_ + 2048); TRRD(l1, b_ + 4096); TRRD(h1, b_ + 6144); TRRD(l2, b_ + 8192); TRRD(h2, b_ + 10240); TRRD(l3, b_ + 12288); TRRD(h3, b_ + 14336); \
        asm volatile("s_waitcnt lgkmcnt(0)" ::: "memory"); SBAR();   \
        o[d0] = __builtin_amdgcn_mfma_f32_32x32x16_bf16(pa0, (bf16x8){l0[0], l0[1], l0[2], l0[3], h0[0], h0[1], h0[2], h0[3]}, o[d0], 0, 0, 0);   \
        o[d0] = __builtin_amdgcn_mfma_f32_32x32x16_bf16(pa1, (bf16x8){l1[0], l1[1], l1[2], l1[3], h1[0], h1[1], h1[2], h1[3]}, o[d0], 0, 0, 0);   \
        o[d0] = __builtin_amdgcn_mfma_f32_32x32x16_bf16(pa2, (bf16x8){l2[0], l2[1], l2[2], l2[3], h2[0], h2[1], h2[2], h2[3]}, o[d0], 0, 0, 0);   \
        o[d0] = __builtin_amdgcn_mfma_f32_32x32x16_bf16(pa3, (bf16x8){l3[0], l3[1], l3[2], l3[3], h3[0], h3[1], h3[2], h3[3]}, o[d0], 0, 0, 0); } while (0)
    PV_D0(0); PV_D0(1); PV_D0(2); PV_D0(3);
#undef PV_D0
#undef TRRD
}

__device__ __forceinline__ void attn_block(const Ctx& C, int b, int h, int qb) {
    LAS char* lds = (LAS char*)C.lds;
    const int tid = C.tid, wid = C.wave, lane = C.lane, r32 = lane & 31, hi = lane >> 5;
    const bf16* Qg = (const bf16*)(C.ws + WS_ARENA + AR_Q); const bf16* KVg = (const bf16*)(C.ws + WS_ARENA + AR_KV); const bf16* KPE = (const bf16*)(C.ws + WS_ARENA + AR_KPE);
    bf16* MIX = (bf16*)(C.ws + WS_MIX);
    const size_t tok0 = (size_t)b * SEQ; const int P0 = qb * 256;
    const int NT = 4 * (qb + 1), jmax = (P0 + wid * 32) >> 6;
    bf16x8 qr[8];
    LAS char* qrl = lds + OFF_QR + wid * 4096 + lane * 16;
    { const bf16* qp = Qg + (tok0 + P0 + wid * 32 + r32) * 1536 + h * 192 + hi * 8;
#pragma unroll
      for (int d0 = 0; d0 < 8; ++d0) qr[d0] = *(const bf16x8*)(qp + d0 * 16);
#pragma unroll
      for (int d0 = 0; d0 < 4; ++d0) *(LAS bf16x8*)(qrl + d0 * 1024) = *(const bf16x8*)(qp + (8 + d0) * 16); }
    const bf16* kvp = KVg + tok0 * 2048 + h * 256; const bf16* kpp = KPE + tok0 * 64;
#define A_LOAD(kb, bf) do { const bf16* p_ = kvp + (size_t)(kb) * 2048; int ln_ = lane; asm volatile("" : "+v"(ln_)); \
        _Pragma("unroll") for (int i_ = 0; i_ < 2; ++i_) { const int B_ = (wid * 2 + i_) * 1024 + ln_ * 16; \
            const int row_ = B_ >> 8, c_ = ((B_ & 255) >> 4) ^ (row_ & 7); \
            const int sub_ = B_ >> 9, kk_ = (sub_ >> 2) * 8 + ((B_ & 511) >> 6), k_ = (kk_ & ~0xC) | ((kk_ & 4) << 1) | ((kk_ & 8) >> 1), cc_ = (sub_ & 3) * 32 + ((B_ & 63) >> 1); \
            __builtin_amdgcn_global_load_lds((const unsigned*)(p_ + (unsigned)(row_ * 2048 + c_ * 8)), (LAS unsigned*)(lds + OFF_K + (bf) * SHM_K + (wid * 2 + i_) * 1024), 16, 0, 0); \
            __builtin_amdgcn_global_load_lds((const unsigned*)(p_ + (unsigned)(k_ * 2048 + 128 + cc_)), (LAS unsigned*)(lds + OFF_V + (bf) * SHM_V + (wid * 2 + i_) * 1024), 16, 0, 0); } \
        { const int B_ = wid * 1024 + ln_ * 16, row_ = B_ >> 7, c_ = ((B_ & 127) >> 4) ^ (row_ & 7); \
          __builtin_amdgcn_global_load_lds((const unsigned*)(kpp + (size_t)(kb) * 64 + (unsigned)(row_ * 64 + c_ * 8)), (LAS unsigned*)(lds + OFF_KR + (bf) * SHM_KR + wid * 1024), 16, 0, 0); } } while (0)
    LAS float* wsl = (LAS float*)(lds + OFF_WS) + wid * 64; LAS float* li_l = wsl; LAS float* al_l = wsl + 32;
    float m_reg = -1e30f, l_reg = 0.f; f32x16 o[4] = {};
    const int vb0 = (int)(uintptr_t)lds + v_rd_base(lane);
    A_LOAD(0, 0);
    asm volatile("s_waitcnt vmcnt(0)" ::: "memory");
    __syncthreads();
    f32x16 p0, p1; float mn, al; bf16x8 pa0, pa1, pa2, pa3;
#define A_STEP(KB) do { \
        if (t + 1 < NT) A_LOAD((t + 1) * 64, 1 - KB); \
        if (t <= jmax) { qkt<KB>(p0, p1, lds, r32, hi, qr, qrl); partialSM(p0, p1, m_reg, mn, al); \
            if (__any(al < 1.f)) { if (hi == 0) al_l[r32] = al; asm volatile("s_waitcnt lgkmcnt(0)" ::: "memory"); \
                _Pragma("unroll") for (int d_ = 0; d_ < 4; ++d_) _Pragma("unroll") for (int r = 0; r < 16; ++r) o[d_][r] *= al_l[crow(r, hi)]; } \
            finishSM(p0, p1, al, l_reg, pa0, pa1, pa2, pa3); SBAR(); pv_tile<KB>(o, vb0, pa0, pa1, pa2, pa3); } \
        asm volatile("s_waitcnt vmcnt(0)" ::: "memory"); \
        __syncthreads(); } while (0)
    for (int t = 0; t < NT; t += 2) { A_STEP(0); ++t; A_STEP(1); --t; }
#undef A_STEP
#undef A_LOAD
    if (hi == 0) li_l[r32] = l_reg;
    asm volatile("s_waitcnt lgkmcnt(0)" ::: "memory");
    float rli[16];
#pragma unroll
    for (int r = 0; r < 16; ++r) rli[r] = __builtin_amdgcn_rcpf(li_l[crow(r, hi)]);
    bf16* Ow = MIX + (tok0 + P0 + wid * 32) * DM + h * 128;
#pragma unroll
    for (int r = 0; r < 16; ++r) { const int orow = crow(r, hi);
#pragma unroll
        for (int d0 = 0; d0 < 4; ++d0) { const float v = o[d0][r] * rli[r]; const float vn = __shfl_xor(v, 1);
            if ((r32 & 1) == 0) *(unsigned*)(Ow + (size_t)orow * DM + d0 * 32 + r32) = cvt_pk_bf16(v, vn); } }
    __syncthreads();
}
#undef KSWZ
#undef KRSWZ
#undef SBAR
}

__device__ __forceinline__ void phase_attn(const Ctx& C0) {
    const Ctx C = phase_ctx(C0);
    const int x = C.bid & 7, k = C.bid >> 3, per = C.G >> 3;
    for (int u = k; u < 64; u += per) {
        const int bh = x * 8 + (u >> 3), p = u & 7;
        att::attn_block(C, bh >> 3, bh & 7, 15 - p);
        att::attn_block(C, bh >> 3, bh & 7, p);
    }
}

namespace sm {
__device__ __forceinline__ bf16x8 frag_n(const LAS char* base, int S, int x0, int k0, int lane) { return *(const LAS bf16x8*)(base + (x0 + (lane & 15)) * S + (k0 + 8 * (lane >> 4)) * 2); }
__device__ __forceinline__ bf16x8 frag_t(const LAS char* base, int S, int x0, int k0, int lane) {
    const int g = lane >> 4, q = (lane >> 2) & 3, p = lane & 3;
    const LAS char* a = base + (k0 + 8 * g + q) * S + (x0 + 4 * p) * 2;
    const s16x4 lo = __builtin_amdgcn_ds_read_tr16_b64_v4i16((LAS s16x4*)a);
    const s16x4 hi = __builtin_amdgcn_ds_read_tr16_b64_v4i16((LAS s16x4*)(a + 4 * S));
    return (bf16x8){lo[0], lo[1], lo[2], lo[3], hi[0], hi[1], hi[2], hi[3]};
}
__device__ __forceinline__ f32x4 mma(bf16x8 a, bf16x8 b, f32x4 c) { return __builtin_amdgcn_mfma_f32_16x16x32_bf16(a, b, c, 0, 0, 0); }
__device__ __forceinline__ u32x2 pack4(f32x4 v) { u32x2 w; w.x = cvt_pk_bf16(v[0], v[1]); w.y = cvt_pk_bf16(v[2], v[3]); return w; }
__device__ __forceinline__ f32x4 unpack4(u32x2 w) { return (f32x4){bf_lo(w.x), bf_hi(w.x), bf_lo(w.y), bf_hi(w.y)}; }
}

constexpr int H1LD = EVEN_N;

__device__ __forceinline__ void sgu_unit(const Ctx& C, int ei, int unit) {
    const int g4 = unit & 3, blk = (unit >> 2) & 31, b = unit >> 7;
    const int tid = C.tid, lane = C.lane, w = C.wave;
    const bf16* H1 = (const bf16*)(C.ws + WS_ARENA); bf16* MIX = (bf16*)(C.ws + WS_MIX);
    LAS char* Vn = (LAS char*)C.lds; LAS char* Wm = Vn + 34816;
    const size_t t0 = (size_t)b * SEQ + blk * 128;
    const float* lng = C.inp(2) + ei * 512 + g4 * 128; const float* lnb = C.inp(3) + ei * 512 + g4 * 128;
    const float* Wg = C.inp(4) + (size_t)(ei * 4 + g4) * 128 * 128; const float* bs = C.inp(5) + (ei * 4 + g4) * 128;
    { const int l16 = tid & 15; f32x4 ga = *(const f32x4*)(lng + 8 * l16), gb = *(const f32x4*)(lng + 8 * l16 + 4), ba = *(const f32x4*)(lnb + 8 * l16), bb = *(const f32x4*)(lnb + 8 * l16 + 4);
#pragma unroll
      for (int pp = 0; pp < 4; ++pp) { const int j = pp * 32 + (tid >> 4);
        const u32x4 raw = *(const u32x4*)(H1 + (t0 + j) * H1LD + 512 + g4 * 128 + 8 * l16);
        float x[8];
#pragma unroll
        for (int q = 0; q < 4; ++q) { x[2 * q] = bf_lo(raw[q]); x[2 * q + 1] = bf_hi(raw[q]); }
        float s = 0.f;
#pragma unroll
        for (int q = 0; q < 8; ++q) s += x[q];
        s += __shfl_xor(s, 1); s += __shfl_xor(s, 2); s += __shfl_xor(s, 4); s += __shfl_xor(s, 8);
        const float mean = s * (1.f / 128.f); float s2 = 0.f;
#pragma unroll
        for (int q = 0; q < 8; ++q) { x[q] -= mean; s2 += x[q] * x[q]; }
        s2 += __shfl_xor(s2, 1); s2 += __shfl_xor(s2, 2); s2 += __shfl_xor(s2, 4); s2 += __shfl_xor(s2, 8);
        const float rstd = 1.f / sqrtf(s2 * (1.f / 128.f) + LN_EPS);
        u32x4 o; o.x = cvt_pk_bf16(x[0] * rstd * ga[0] + ba[0], x[1] * rstd * ga[1] + ba[1]); o.y = cvt_pk_bf16(x[2] * rstd * ga[2] + ba[2], x[3] * rstd * ga[3] + ba[3]);
        o.z = cvt_pk_bf16(x[4] * rstd * gb[0] + bb[0], x[5] * rstd * gb[1] + bb[1]); o.w = cvt_pk_bf16(x[6] * rstd * gb[2] + bb[2], x[7] * rstd * gb[3] + bb[3]);
        *(LAS u32x4*)(Vn + j * 272 + l16 * 16) = o; } }
#pragma unroll
    for (int q = 0; q < 8; ++q) { const int f = (tid + 512 * q) * 4, i = f >> 7, j = f & 127; const f32x4 wv = *(const f32x4*)(Wg + f);
        *(LAS u32x2*)(Wm + i * 272 + j * 2) = sm::pack4(wv); }
    __syncthreads();
    const int i0 = 16 * w, nks = (w < 4) ? 2 : 4;
    bf16x8 f2[4];
#pragma unroll
    for (int ks = 0; ks < 4; ++ks) f2[ks] = sm::frag_n(Wm, 272, i0, 32 * ks, lane);
    const int i = i0 + (lane & 15), gq = lane >> 4; const float bsi = bs[i];
    const bf16* urow = H1 + (t0 + i) * H1LD + g4 * 128; bf16* orow = MIX + (t0 + i) * DM + g4 * 128;
#pragma unroll
    for (int ct = 0; ct < 8; ++ct) { f32x4 acc = (f32x4){0.f, 0.f, 0.f, 0.f};
#pragma unroll
        for (int ks = 0; ks < 4; ++ks) if (ks < nks) acc = sm::mma(sm::frag_t(Vn, 272, 16 * ct, 32 * ks, lane), f2[ks], acc);
        const int c = 16 * ct + 4 * gq; const f32x4 u = sm::unpack4(*(const u32x2*)(urow + c));
        *(u32x2*)(orow + c) = sm::pack4(u * (acc + bsi)); }
    __syncthreads();
}

namespace gdn {
constexpr int LF = 0, T1 = 17408, T2 = 26624, INM = 35840, VEC = 45056, QS = 46080, KS = 63488, VS = 80896, KDS = 98304, WT = 115712, UT = 133120;
__device__ __forceinline__ float silu(float x) { return x * __builtin_amdgcn_rcpf(1.0f + __expf(-x)); }
__device__ __forceinline__ void prep_unit(const Ctx& C, int ei, int unit) {
    const int n = unit & 63, h = (unit >> 6) & 3, b = unit >> 8;
    const int tid = C.tid, lane = C.lane, w = C.wave;
    LAS char* L = (LAS char*)C.lds;
    LAS float* gcs = (LAS float*)(L + VEC); LAS float* bet = gcs + 64; LAS float* egs = gcs + 128; LAS float* eks = gcs + 192;
    const bf16* H1 = (const bf16*)(C.ws + WS_ARENA);
    const size_t tok0 = (size_t)b * SEQ + n * 64;
    const int chunk = (b * 4 + h) * 64 + n;
    { const int i = tid >> 3, dc = (tid & 7) * 16, pos = n * 64 + i;
      const float* cw = C.inp(6) + (size_t)ei * 4 * 1536;
#pragma unroll 1
      for (int X = 0; X < 3; ++X) {
        float acc[16];
#pragma unroll
        for (int q = 0; q < 16; ++q) acc[q] = 0.f;
        const int chb = X * 512 + h * 128 + dc;
#pragma unroll
        for (int jj = 0; jj < 4; ++jj) { if (pos - 3 + jj >= 0) {
            const bf16* rp = H1 + (tok0 + i - 3 + jj) * H1LD + 1024 + chb;
            const u32x4 r0 = *(const u32x4*)rp, r1 = *(const u32x4*)(rp + 8);
            const float* wp = cw + jj * 1536 + chb; const f32x4 w0 = *(const f32x4*)wp, w1 = *(const f32x4*)(wp + 4), w2 = *(const f32x4*)(wp + 8), w3 = *(const f32x4*)(wp + 12);
            acc[0] += w0[0] * bf_lo(r0[0]); acc[1] += w0[1] * bf_hi(r0[0]); acc[2] += w0[2] * bf_lo(r0[1]); acc[3] += w0[3] * bf_hi(r0[1]);
            acc[4] += w1[0] * bf_lo(r0[2]); acc[5] += w1[1] * bf_hi(r0[2]); acc[6] += w1[2] * bf_lo(r0[3]); acc[7] += w1[3] * bf_hi(r0[3]);
            acc[8] += w2[0] * bf_lo(r1[0]); acc[9] += w2[1] * bf_hi(r1[0]); acc[10] += w2[2] * bf_lo(r1[1]); acc[11] += w2[3] * bf_hi(r1[1]);
            acc[12] += w3[0] * bf_lo(r1[2]); acc[13] += w3[1] * bf_hi(r1[2]); acc[14] += w3[2] * bf_lo(r1[3]); acc[15] += w3[3] * bf_hi(r1[3]); } }
        float ss = 0.f;
#pragma unroll
        for (int q = 0; q < 16; ++q) { acc[q] = silu(acc[q]); ss += acc[q] * acc[q]; }
        float sc = 1.f;
        if (X < 2) { ss += __shfl_xor(ss, 1); ss += __shfl_xor(ss, 2); ss += __shfl_xor(ss, 4); sc = 1.0f / sqrtf(ss + RMS_EPS); if (X == 0) sc *= 0.08838834764831845f; }
        u32x4 o0, o1;
        o0.x = cvt_pk_bf16(acc[0] * sc, acc[1] * sc); o0.y = cvt_pk_bf16(acc[2] * sc, acc[3] * sc); o0.z = cvt_pk_bf16(acc[4] * sc, acc[5] * sc); o0.w = cvt_pk_bf16(acc[6] * sc, acc[7] * sc);
        o1.x = cvt_pk_bf16(acc[8] * sc, acc[9] * sc); o1.y = cvt_pk_bf16(acc[10] * sc, acc[11] * sc); o1.z = cvt_pk_bf16(acc[12] * sc, acc[13] * sc); o1.w = cvt_pk_bf16(acc[14] * sc, acc[15] * sc);
        LAS char* dst = L + (X == 0 ? QS : X == 1 ? KS : VS) + i * 272 + dc * 2;
        *(LAS u32x4*)dst = o0; *(LAS u32x4*)(dst + 16) = o1; } }
    if (w == 0) { const float* AB = (const float*)(C.ws + WS_AB) + (tok0 + lane) * 8;
        const float a = AB[h], bb = AB[4 + h]; const float alog = C.inp(7)[ei * 4 + h], dtb = C.inp(8)[ei * 4 + h];
        const float xs = a + dtb; const float sp = xs > 20.f ? xs : log1pf(__expf(xs));
        float gv = -__expf(alog) * sp;
#pragma unroll
        for (int o = 1; o < 64; o <<= 1) { const float t_ = __shfl_up(gv, o); if (lane >= o) gv += t_; }
        const float gl = __shfl(gv, 63);
        gcs[lane] = gv; bet[lane] = 1.0f / (1.0f + __expf(-bb)); egs[lane] = __expf(gv); eks[lane] = __expf(gl - gv);
        if (lane == 0) ((float*)(C.ws + WS_GAM))[chunk] = __expf(gl); }
    __syncthreads();
    { const int i = tid >> 3, dc = (tid & 7) * 16; const float e = eks[i];
#pragma unroll
      for (int hh = 0; hh < 2; ++hh) { const u32x4 r = *(const LAS u32x4*)(L + KS + i * 272 + dc * 2 + 16 * hh); u32x4 o;
#pragma unroll
        for (int q = 0; q < 4; ++q) o[q] = cvt_pk_bf16(bf_lo(r[q]) * e, bf_hi(r[q]) * e);
        *(LAS u32x4*)(L + KDS + i * 272 + dc * 2 + 16 * hh) = o; } }
#pragma unroll
    for (int q = 0; q < 2; ++q) { const int tt = 2 * w + q, it = tt >> 2, jt = tt & 3;
        if (jt <= it) { f32x4 acc = (f32x4){0.f, 0.f, 0.f, 0.f};
#pragma unroll
            for (int ks = 0; ks < 4; ++ks) acc = sm::mma(sm::frag_n(L + KS, 272, 16 * jt, 32 * ks, lane), sm::frag_n(L + KS, 272, 16 * it, 32 * ks, lane), acc);
            const int i = 16 * it + (lane & 15), j0 = 16 * jt + 4 * (lane >> 4); const float gi = gcs[i], bi = bet[i]; f32x4 o;
#pragma unroll
            for (int r = 0; r < 4; ++r) o[r] = (i > j0 + r) ? bi * acc[r] * __expf(gi - gcs[j0 + r]) : 0.f;
            *(LAS f32x4*)(L + LF + (i * 68 + j0) * 4) = o; } }
    __syncthreads();
    if (w == 0) {
        float t[64];
#pragma unroll
        for (int i = 0; i < 64; ++i) t[i] = 0.f;
#pragma unroll
        for (int i = 0; i < 64; ++i) { float s0 = 0.f, s1 = 0.f, s2 = 0.f, s3 = 0.f;
#pragma unroll
            for (int m = 0; m < i; m += 4) { const f32x4 l = *(const LAS f32x4*)(L + LF + (i * 68 + m) * 4); s0 += l[0] * t[m]; s1 += l[1] * t[m + 1]; s2 += l[2] * t[m + 2]; s3 += l[3] * t[m + 3]; }
            t[i] = ((lane == i) ? 1.f : 0.f) - ((s0 + s1) + (s2 + s3)); }
        const float bj = bet[lane], bej = bj * egs[lane];
#pragma unroll
        for (int i = 0; i < 64; ++i) { *(LAS bf16*)(L + T1 + i * 144 + lane * 2) = f2bf(t[i] * bej); *(LAS bf16*)(L + T2 + i * 144 + lane * 2) = f2bf(t[i] * bj); }
    } else {
        for (int tt = w - 1; tt < 16; tt += 7) { const int it = tt >> 2, jt = tt & 3; f32x4 acc = (f32x4){0.f, 0.f, 0.f, 0.f};
            if (jt <= it) {
#pragma unroll
                for (int ks = 0; ks < 4; ++ks) acc = sm::mma(sm::frag_n(L + KS, 272, 16 * jt, 32 * ks, lane), sm::frag_n(L + QS, 272, 16 * it, 32 * ks, lane), acc); }
            const int i = 16 * it + (lane & 15), j0 = 16 * jt + 4 * (lane >> 4); const float gi = gcs[i]; f32x4 o;
#pragma unroll
            for (int r = 0; r < 4; ++r) o[r] = (i >= j0 + r) ? acc[r] * __expf(gi - gcs[j0 + r]) : 0.f;
            *(LAS u32x2*)(L + INM + i * 144 + j0 * 2) = sm::pack4(o); }
    }
    __syncthreads();
#pragma unroll 1
    for (int q = 0; q < 8; ++q) { const int tt = w * 8 + q, which = tt >> 5, xt = (tt & 31) >> 2, it = tt & 3; f32x4 acc = (f32x4){0.f, 0.f, 0.f, 0.f};
        const LAS char* src = L + (which ? VS : KS); const LAS char* tm = L + (which ? T2 : T1);
#pragma unroll
        for (int ks = 0; ks < 2; ++ks) acc = sm::mma(sm::frag_t(src, 272, 16 * xt, 32 * ks, lane), sm::frag_n(tm, 144, 16 * it, 32 * ks, lane), acc);
        *(LAS u32x2*)(L + (which ? UT : WT) + (16 * it + (lane & 15)) * 272 + (16 * xt + 4 * (lane >> 4)) * 2) = sm::pack4(acc); }
    __syncthreads();
    { bf16* Mg = (bf16*)(C.ws + WS_GM) + (size_t)chunk * 16384; bf16* Bg = (bf16*)(C.ws + WS_GB) + (size_t)chunk * 16384;
      bf16* Cg = (bf16*)(C.ws + WS_GC) + (size_t)chunk * 8192; bf16* Dg = (bf16*)(C.ws + WS_GD) + (size_t)chunk * 8192;
      const int x2 = lane & 15, x1 = 4 * (lane >> 4);
#pragma unroll 1
      for (int q = 0; q < 8; ++q) { const int tt = w * 8 + q, at = tt >> 3, bt = tt & 7;
        f32x4 am = (f32x4){0.f, 0.f, 0.f, 0.f}, ab = (f32x4){0.f, 0.f, 0.f, 0.f};
#pragma unroll
        for (int ks = 0; ks < 2; ++ks) { const bf16x8 fkd_b = sm::frag_t(L + KDS, 272, 16 * bt, 32 * ks, lane), fw = sm::frag_t(L + WT, 272, 16 * at, 32 * ks, lane);
            const bf16x8 fkd_a = sm::frag_t(L + KDS, 272, 16 * at, 32 * ks, lane), fu = sm::frag_t(L + UT, 272, 16 * bt, 32 * ks, lane);
            am = sm::mma(fw, fkd_b, am);
            ab = sm::mma(fkd_a, fu, ab); }
        *(u32x2*)(Mg + (16 * bt + x2) * 128 + 16 * at + x1) = sm::pack4(-am);
        *(u32x2*)(Bg + (16 * bt + x2) * 128 + 16 * at + x1) = sm::pack4(ab); }
#pragma unroll 1
      for (int q = 0; q < 4; ++q) { const int tt = w * 4 + q, at = tt >> 2, it = tt & 3;
        f32x4 ac = (f32x4){0.f, 0.f, 0.f, 0.f}, ad = (f32x4){0.f, 0.f, 0.f, 0.f};
#pragma unroll
        for (int ks = 0; ks < 2; ++ks) { const bf16x8 fin = sm::frag_n(L + INM, 144, 16 * it, 32 * ks, lane);
            ac = sm::mma(sm::frag_t(L + WT, 272, 16 * at, 32 * ks, lane), fin, ac);
            ad = sm::mma(sm::frag_t(L + UT, 272, 16 * at, 32 * ks, lane), fin, ad); }
        const int i = 16 * it + x2, d = 16 * at + x1; const f32x4 qv = sm::unpack4(*(const LAS u32x2*)(L + QS + i * 272 + d * 2));
        *(u32x2*)(Cg + i * 128 + d) = sm::pack4(qv * egs[i] - ac);
        *(u32x2*)(Dg + i * 128 + d) = sm::pack4(ad); } }
#ifdef DBG_DUMP
    { unsigned char* dst = C.ws + WS_HID + (size_t)chunk * 150528; for (int o = tid * 16; o < 150528; o += 512 * 16) *(u32x4*)(dst + o) = *(const LAS u32x4*)(L + o); }
#endif
    __syncthreads();
}

__device__ __forceinline__ void scan_unit(const Ctx& C, int unit) {
    const int cs = unit & 7, bh = unit >> 3;
    const int lane = C.lane, w = C.wave, x2 = lane & 15, g = lane >> 4;
    LAS char* ST = (LAS char*)C.lds;
    const bf16* Mg = (const bf16*)(C.ws + WS_GM) + (size_t)bh * 64 * 16384; const bf16* Bg = (const bf16*)(C.ws + WS_GB) + (size_t)bh * 64 * 16384;
    bf16* Sg = (bf16*)(C.ws + WS_GS) + (size_t)bh * 64 * 16384; const float* GAM = (const float*)(C.ws + WS_GAM) + bh * 64;
    const int c = cs * 16 + x2, d0 = 16 * w + 4 * g;
    { unsigned zz = 0u; asm volatile("" : "+v"(zz));
      if (C.tid < 272) *(LAS u32x4*)(ST + C.tid * 16) = (u32x4){zz, zz, zz, zz}; }
    __syncthreads();
    f32x4 acc = (f32x4){0.f, 0.f, 0.f, 0.f};
    const bf16* mrow = Mg + (16 * w + x2) * 128 + 8 * g; const bf16* brow = Bg + c * 128 + d0; bf16* srow = Sg + c * 128 + d0;
    bf16x8 fm[4]; u32x2 bv; float gam;
#pragma unroll
    for (int ks = 0; ks < 4; ++ks) fm[ks] = *(const bf16x8*)(mrow + 32 * ks);
    bv = *(const u32x2*)brow; gam = GAM[0];
#pragma unroll 1
    for (int n = 0; n < 64; ++n) {
        *(u32x2*)(srow + (size_t)n * 16384) = sm::pack4(acc);
        bf16x8 fmn[4]; u32x2 bvn = bv; float gamn = gam;
#pragma unroll
        for (int ks = 0; ks < 4; ++ks) fmn[ks] = fm[ks];
        if (n + 1 < 64) {
#pragma unroll
            for (int ks = 0; ks < 4; ++ks) fmn[ks] = *(const bf16x8*)(mrow + (size_t)(n + 1) * 16384 + 32 * ks);
            bvn = *(const u32x2*)(brow + (size_t)(n + 1) * 16384); gamn = GAM[n + 1]; }
        f32x4 a = acc * gam + sm::unpack4(bv);
        const LAS char* sb = ST + (n & 1) * 4352;
#pragma unroll
        for (int ks = 0; ks < 4; ++ks) a = sm::mma(fm[ks], sm::frag_n(sb, 272, 0, 32 * ks, lane), a);
        acc = a;
        *(LAS u32x2*)(ST + ((n + 1) & 1) * 4352 + x2 * 272 + d0 * 2) = sm::pack4(acc);
#pragma unroll
        for (int ks = 0; ks < 4; ++ks) fm[ks] = fmn[ks];
        bv = bvn; gam = gamn;
        __syncthreads();
    }
}

__device__ __forceinline__ void out_unit(const Ctx& C, int ei, int unit) {
    const int pr = unit & 31, h = (unit >> 5) & 3, b = unit >> 7;
    const int lane = C.lane, w = C.wave, x2 = lane & 15, g = lane >> 4;
    const int n = 2 * pr + (w >> 2), it = w & 3, chunk = (b * 4 + h) * 64 + n;
    const bf16* Sg = (const bf16*)(C.ws + WS_GS) + (size_t)chunk * 16384; const bf16* Cg = (const bf16*)(C.ws + WS_GC) + (size_t)chunk * 8192; const bf16* Dg = (const bf16*)(C.ws + WS_GD) + (size_t)chunk * 8192;
    const bf16* H1 = (const bf16*)(C.ws + WS_ARENA); bf16* MIX = (bf16*)(C.ws + WS_MIX);
    const int i = 16 * it + x2; const size_t tok = (size_t)b * SEQ + n * 64 + i;
    bf16x8 fc[4];
#pragma unroll
    for (int ks = 0; ks < 4; ++ks) fc[ks] = *(const bf16x8*)(Cg + i * 128 + 32 * ks + 8 * g);
    f32x4 o[8]; float ss = 0.f;
#pragma unroll
    for (int ct = 0; ct < 8; ++ct) { f32x4 a = sm::unpack4(*(const u32x2*)(Dg + i * 128 + 16 * ct + 4 * g));
#pragma unroll
        for (int ks = 0; ks < 4; ++ks) a = sm::mma(*(const bf16x8*)(Sg + (16 * ct + x2) * 128 + 32 * ks + 8 * g), fc[ks], a);
        o[ct] = a; ss += (a[0] * a[0] + a[1] * a[1]) + (a[2] * a[2] + a[3] * a[3]); }
    ss += __shfl_xor(ss, 16); ss += __shfl_xor(ss, 32);
    const float rstd = 1.0f / sqrtf(ss * (1.f / 128.f) + RMS_EPS);
    const float* nw = C.inp(9) + ei * 128; const bf16* zrow = H1 + tok * H1LD + 2560 + h * 128; bf16* orow = MIX + tok * DM + 512 + h * 128;
#pragma unroll
    for (int ct = 0; ct < 8; ++ct) { const int c = 16 * ct + 4 * g; const f32x4 z = sm::unpack4(*(const u32x2*)(zrow + c)); const f32x4 nv = *(const f32x4*)(nw + c); f32x4 y;
#pragma unroll
        for (int r = 0; r < 4; ++r) y[r] = o[ct][r] * rstd * nv[r] * silu(z[r]);
        *(u32x2*)(orow + c) = sm::pack4(y); }
}
}

__device__ __forceinline__ void phase_even_local(const Ctx& C0, int ei) {
    { const Ctx C = phase_ctx(C0); for (int u = C.bid; u < 1024; u += C.G) sgu_unit(C, ei, u); }
    { const Ctx C = phase_ctx(C0); for (int u = C.bid; u < 2048; u += C.G) gdn::prep_unit(C, ei, u); }
}
__device__ __forceinline__ void phase_scan(const Ctx& C0) { const Ctx C = phase_ctx(C0); for (int u = C.bid; u < 256; u += C.G) { gdn::scan_unit(C, u); __syncthreads(); } }
__device__ __forceinline__ void phase_gdn_out(const Ctx& C0, int ei) { const Ctx C = phase_ctx(C0); for (int u = C.bid; u < 1024; u += C.G) gdn::out_unit(C, ei, u); }

#ifndef MK_PER_PHASE
#define MK_PER_PHASE 0
#endif
constexpr int N_PHASES = 1 + DEPTH * 9;
#ifndef PH_EN
#define PH_EN 0x7fff
#endif
#define PEN(k) ((PH_EN >> (k)) & 1)
#ifndef MK_REP
#define MK_REP -1
#endif
#define REPF(k) for (int r_ = 0; r_ < ((MK_REP == (k)) ? 2 : 1); ++r_)
struct Args { const float* in[27]; float* out; unsigned char* ws; int ph_lo, ph_hi; };

__global__ void __launch_bounds__(NWAVES * 64, 2) mk_fwd(Args args) {
    extern __shared__ __attribute__((aligned(16))) unsigned char lds_raw[];
    Ctx C;
    C.lds = (LAS unsigned char*)lds_raw;
    C.tid = threadIdx.x; C.lane = C.tid & 63; C.wave = __builtin_amdgcn_readfirstlane(C.tid >> 6); C.G = gridDim.x; C.bid = blockIdx.x;
    C.ka = (const __attribute__((address_space(4))) char*)__builtin_amdgcn_kernarg_segment_ptr();
    C.out = nullptr; C.ws = nullptr; C.ctl = nullptr;
    for (int u = C.tid; u < 128; u += NWAVES * 64) ((LAS unsigned*)(C.lds + LDS_CTL_OFF))[u] = 0u;
    __syncthreads();
#if !MK_PER_PHASE
    { const Ctx P = phase_ctx(C); (void)xcd_barrier_post((unsigned*)P.ws + CW_BAR, (volatile LAS unsigned*)(C.lds + LDS_CTL_OFF) + 8); }
#define GRID_BAR() do { const Ctx P_ = phase_ctx(C); XcdBarrier b_; b_.bar = (unsigned*)P_.ws + CW_BAR; b_.x = xb_xcc_id(); b_.st = (volatile LAS unsigned*)(C.lds + LDS_CTL_OFF) + 8; xcd_barrier(b_); } while (0)
#else
#define GRID_BAR() do {} while (0)
#endif
    const int lo = args.ph_lo, hi = args.ph_hi;
#define IN(k) (lo <= (k) && (k) < hi)
#define SEAM(k) do { if (IN((k) + 1)) GRID_BAR(); } while (0)
    if (PEN(0) && IN(0)) { REPF(0) phase_prologue(C); SEAM(0); }
#define MK_LAYER(L) { \
        const int pb = 1 + L * 9, li = L >> 1; \
        if ((L & 1) == 0) { \
            if (PEN(1) && IN(pb + 0)) { \
                const Ctx P = phase_ctx(C); unsigned char* ws = P.ws; \
                EpiBf16 E{(bf16*)(ws + WS_ARENA), EVEN_N, 1024}; \
                REPF(1) run_plain_gemm(P, (const bf16*)(ws + WS_XB), DM, DM, EVEN_N, (const bf16*)(ws + WS_WEIN) + (size_t)li * EVEN_N * DM, E); \
                SEAM(pb + 0); } \
            if (PEN(2) && IN(pb + 1)) { REPF(2) phase_even_local(C, li); SEAM(pb + 1); } \
            if (PEN(3) && IN(pb + 2)) { REPF(3) phase_scan(C); SEAM(pb + 2); } \
            if (PEN(4) && IN(pb + 3)) { REPF(4) phase_gdn_out(C, li); SEAM(pb + 3); } \
            if (PEN(5) && IN(pb + 4)) { \
                const Ctx P = phase_ctx(C); unsigned char* ws = P.ws; \
                EpiRes E{(const bf16*)(ws + WS_XB), (bf16*)(ws + WS_Y)}; \
                REPF(5) run_plain_gemm(P, (const bf16*)(ws + WS_MIX), DM, DM, DM, (const bf16*)(ws + WS_WEOUT) + (size_t)li * DM * DM, E); \
                SEAM(pb + 4); } \
        } else { \
            if (PEN(6) && IN(pb + 0)) { \
                const Ctx P = phase_ctx(C); unsigned char* ws = P.ws; \
                EpiBf16 E{(bf16*)(ws + WS_ARENA + AR_C1), ODD_N, 0}; \
                REPF(6) run_plain_gemm(P, (const bf16*)(ws + WS_XB), DM, DM, ODD_N, (const bf16*)(ws + WS_WOIN) + (size_t)li * ODD_N * DM, E); \
                SEAM(pb + 0); } \
            if (PEN(7) && IN(pb + 1)) { REPF(7) phase_o1b(C); SEAM(pb + 1); } \
            if (PEN(8) && IN(pb + 2)) { \
                { const Ctx P = phase_ctx(C); unsigned char* ws = P.ws; \
                  EpiQ E{(bf16*)(ws + WS_ARENA + AR_Q), (const float*)(ws + WS_RS), (const f32x4*)(ws + WS_ROPE)}; \
                  REPF(8) run_plain_gemm(P, (const bf16*)(ws + WS_ARENA + AR_C1), ODD_N, QL, 1536, (const bf16*)(ws + WS_WUQ) + (size_t)li * 1536 * QL, E); } \
                { const Ctx P = phase_ctx(C); unsigned char* ws = P.ws; \
                  EpiKV E{(bf16*)(ws + WS_ARENA + AR_KV), (const float*)(ws + WS_RS) + T}; \
                  REPF(8) run_plain_gemm(P, (const bf16*)(ws + WS_ARENA + AR_C1) + QL, ODD_N, KVL, 2048, (const bf16*)(ws + WS_WUKV) + (size_t)li * 2048 * KVL, E); } \
                SEAM(pb + 2); } \
            if (PEN(9) && IN(pb + 3)) { REPF(9) phase_attn(C); SEAM(pb + 3); } \
            if (PEN(10) && IN(pb + 4)) { \
                const Ctx P = phase_ctx(C); unsigned char* ws = P.ws; \
                EpiRes E{(const bf16*)(ws + WS_XB), (bf16*)(ws + WS_Y)}; \
                REPF(10) run_plain_gemm(P, (const bf16*)(ws + WS_MIX), DM, DM, DM, (const bf16*)(ws + WS_WOOUT) + (size_t)li * DM * DM, E); \
                SEAM(pb + 4); } \
        } \
        if (PEN(11) && IN(pb + 5)) { phase_router(C, L); SEAM(pb + 5); } \
        if (PEN(12) && IN(pb + 6)) { \
            const Ctx P = phase_ctx(C); unsigned char* ws = P.ws; \
            EpiSwiglu E{(bf16*)(ws + WS_HID), P.inp(24) + (size_t)L * NEXP * 2048, nullptr}; \
            REPF(12) run_moe_gemm(P, L, (const bf16*)(ws + WS_XB), DM, 2, DM, 2048, (const bf16*)(ws + WS_WGU) + (size_t)L * NEXP * 2048 * DM, (size_t)2048 * DM, E); \
            SEAM(pb + 6); } \
        if (PEN(13) && IN(pb + 7)) { \
            const Ctx P = phase_ctx(C); unsigned char* ws = P.ws; \
            EpiDown E{(bf16*)(ws + WS_YE), P.inp(26) + (size_t)L * NEXP * DM, (const float*)(ws + WS_GATE), nullptr}; \
            REPF(13) run_moe_gemm(P, L, (const bf16*)(ws + WS_HID), DFF, 0, DFF, DM, (const bf16*)(ws + WS_WDN) + (size_t)L * NEXP * DM * DFF, (size_t)DM * DFF, E); \
            SEAM(pb + 7); } \
        if (PEN(14) && IN(pb + 8)) { phase_combine(C, L); SEAM(pb + 8); } \
    }
    MK_LAYER(0) MK_LAYER(1) MK_LAYER(2) MK_LAYER(3)
#undef MK_LAYER
#undef IN
#undef SEAM
}

extern "C" void kernel_launch(void* const* d_in, const int* in_sizes, int n_in, void* d_out, int out_size, void* d_ws, size_t ws_size, hipStream_t stream) {
    static int grid = 0;
    if (grid == 0) {
        if (n_in != 27 || in_sizes[0] != T * DM || out_size != T * DM || ws_size < WS_END) { fprintf(stderr, "kernel_launch: unexpected shapes (n_in %d, in0 %d, out %d, ws %zu)\n", n_in, n_in > 0 ? in_sizes[0] : -1, out_size, ws_size); grid = -1; return; }
        int dev = 0, cus = 0, per_cu = 0;
        if (hipGetDevice(&dev) != hipSuccess || hipDeviceGetAttribute(&cus, hipDeviceAttributeMultiprocessorCount, dev) != hipSuccess) { grid = -1; return; }
        if (hipFuncSetAttribute((const void*)mk_fwd, hipFuncAttributeMaxDynamicSharedMemorySize, LDS_BYTES) != hipSuccess) { fprintf(stderr, "kernel_launch: hipFuncSetAttribute failed\n"); grid = -1; return; }
        if (hipOccupancyMaxActiveBlocksPerMultiprocessor(&per_cu, (const void*)mk_fwd, NWAVES * 64, LDS_BYTES) != hipSuccess || per_cu < 1) fprintf(stderr, "kernel_launch: occupancy query reports %d\n", per_cu);
        (void)hipGetLastError();
        grid = cus;
        if (grid != 256) fprintf(stderr, "kernel_launch: %d CUs (built for 256)\n", grid);
    }
    if (grid < 0) return;
    if (hipMemsetAsync((char*)d_ws + WS_CTL, 0, CTL_ZERO_BYTES, stream) != hipSuccess) return;
    Args a{};
    for (int i = 0; i < 27; ++i) a.in[i] = (const float*)d_in[i];
    a.out = (float*)d_out; a.ws = (unsigned char*)d_ws;
#if MK_PER_PHASE
    for (int p = 0; p < N_PHASES; ++p) { a.ph_lo = p; a.ph_hi = p + 1; hipLaunchKernelGGL(mk_fwd, dim3(grid), dim3(NWAVES * 64), LDS_BYTES, stream, a); }
#else
    a.ph_lo = 0; a.ph_hi = N_PHASES;
    hipLaunchKernelGGL(mk_fwd, dim3(grid), dim3(NWAVES * 64), LDS_BYTES, stream, a);
#endif
    const hipError_t le = hipPeekAtLastError();
    if (le != hipSuccess) fprintf(stderr, "kernel_launch: launch failed: %s\n", hipGetErrorName(le));
}
```

```cpp
#define MK_PER_PHASE 0
#include <hip/hip_runtime.h>
#include <cstdio>
#include <cstdint>

#define GAS __attribute__((address_space(1)))
#define LAS __attribute__((address_space(3)))
typedef unsigned short bf16;
typedef short bf16x8 __attribute__((ext_vector_type(8)));
typedef short s16x4 __attribute__((ext_vector_type(4)));
typedef float f32x2 __attribute__((ext_vector_type(2)));
typedef float f32x4 __attribute__((ext_vector_type(4)));
typedef float f32x16 __attribute__((ext_vector_type(16)));
typedef unsigned u32x2 __attribute__((ext_vector_type(2)));
typedef unsigned u32x4 __attribute__((ext_vector_type(4)));
typedef GAS unsigned gu32;

typedef __bf16 bf16v2_t __attribute__((ext_vector_type(2)));
__device__ __forceinline__ unsigned cvt_pk_bf16(float lo, float hi) { const bf16v2_t v = __builtin_convertvector((f32x2){lo, hi}, bf16v2_t); return __builtin_bit_cast(unsigned, v); }
__device__ __forceinline__ float bf_lo(unsigned w) { return __uint_as_float(w << 16); }
__device__ __forceinline__ float bf_hi(unsigned w) { return __uint_as_float(w & 0xffff0000u); }
__device__ __forceinline__ float bf2f(bf16 b) { return __uint_as_float(((unsigned)b) << 16); }
__device__ __forceinline__ bf16 f2bf(float f) { return (bf16)(cvt_pk_bf16(f, 0.f) & 0xffffu); }
__device__ __forceinline__ float wave_sum(float v) {
#pragma unroll
    for (int o = 1; o < 64; o <<= 1) v += __shfl_xor(v, o);
    return v;
}

namespace pg8 {
constexpr int BM = 256, BK = 64, HALF = 128, HTB = HALF * BK * 2, STAGE_BYTES = 8 * HTB, NXCD = 8, WGM = 8;
__host__ __device__ __forceinline__ int lds_byte(int r, int c) { const int st = (r >> 4) * 2 + (c >> 5), rr = r & 15, cc = c & 31, ob = rr * 64 + cc * 2; return st * 1024 + (ob ^ (((ob >> 9) & 1) << 5)); }
__host__ __device__ __forceinline__ void stage_rc(int b, int& R, int& C) { const int st = b / 1024, sb = b % 1024, swz = sb ^ (((sb >> 9) & 1) << 5); R = (st >> 1) * 16 + swz / 64; C = (st & 1) * 32 + (swz % 64) / 2; }
__host__ __device__ __forceinline__ int perm32(int rho) { const int n = rho >> 4, i = rho & 15; return 8 * (i >> 2) + 4 * n + (i & 3); }

struct Unit { int pm, pn, e, li; };

struct StaticOrder {
    int nM, nN, nwg, G, c;
    __device__ void init(int M, int N, int G_, int c_) { nM = M / BM; nN = N / BM; nwg = nM * nN; G = G_; c = c_; }
    __device__ bool next(int i, Unit& u) const {
        const long L = (long)i * G + c; if (L >= nwg) return false;
        int wgid = (int)L; { const int q = nwg / NXCD, r = nwg % NXCD, xcd = wgid % NXCD, off = wgid / NXCD; wgid = (xcd < r ? xcd * (q + 1) : r * (q + 1) + (xcd - r) * q) + off; }
        const int nig = WGM * nN, gid = wgid / nig, fm = gid * WGM, gsz = (nM - fm) < WGM ? (nM - fm) : WGM;
        u.pm = fm + ((wgid % nig) % gsz); u.pn = (wgid % nig) / gsz; u.e = 0; u.li = 0; return true;
    }
};
struct PlainSched {
    static constexpr bool GATHER = false;
    StaticOrder o; const char* Bt; int K; int lda;
    __device__ __forceinline__ size_t arow0(const Unit& u) const { return (size_t)u.pm * BM * lda * 2; }
    __device__ __forceinline__ bool next(int i, Unit& u) const { return o.next(i, u); }
    __device__ __forceinline__ const char* bbase(const Unit& u) const { return Bt + (size_t)u.pn * BM * K * 2; }
};

__device__ __forceinline__ f32x2 gelu_pk(f32x2 v) {
    const f32x2 av = __builtin_elementwise_abs(v), d = av * 0.2316418882f + 1.0f;
    f32x2 t; t.x = __builtin_amdgcn_rcpf(d.x); t.y = __builtin_amdgcn_rcpf(d.y);
    f32x2 q = t * 0.5307027145f + (-0.7265760135f); q = q * t + 0.7107068705f; q = q * t + (-0.142248368f); q = q * t + 0.127414796f; q = q * t;
    const f32x2 s = (v * v) * (-0.72134752044f);
    f32x2 e; e.x = __builtin_amdgcn_exp2f(s.x); e.y = __builtin_amdgcn_exp2f(s.y);
    const f32x2 m = v * (q * e), r = v - m;
    f32x2 o; o.x = v.x < 0.f ? m.x : r.x; o.y = v.y < 0.f ? m.y : r.y; return o;
}

template <class Epi, class Sched, bool ALIGN_EPI>
__device__ __forceinline__ void gemm_phase(LAS unsigned char* lds, const char* Abase, int K, const Sched& S, const Epi& E) {
    int tid_ = threadIdx.x; asm volatile("" : "+v"(tid_));
    const int tid = tid_, wid = __builtin_amdgcn_readfirstlane(tid >> 6), lane = tid & 63, wr = wid >> 2, wc = wid & 3, fr = lane & 15, fq = lane >> 4;
    int nt = K / BK; asm volatile("" : "+s"(nt));
    int Rr[2], Cc[2]; unsigned voffB[2], voffA[2];
#pragma unroll
    for (int i = 0; i < 2; ++i) { stage_rc(tid * 16 + i * 8192, Rr[i], Cc[i]); const int Rb = Epi::PERM ? ((Rr[i] & ~31) + perm32(Rr[i] & 31)) : Rr[i]; voffB[i] = (unsigned)(Rb * K + Cc[i]) * 2u;
        voffA[i] = 0u; if constexpr (!Sched::GATHER) voffA[i] = (unsigned)(Rr[i] * S.lda + Cc[i]) * 2u; }
    const size_t hstepA = (size_t)HALF * S.lda * 2;
    const size_t kstep = (size_t)(BK * 2);
    const size_t hstepB = (size_t)HALF * K * 2;
    const unsigned ldsw = (unsigned)wid * 1024u;
    const int aoff = lds_byte(wr * 64 + fr, fq * 8), boff = lds_byte(wc * 32 + fr, fq * 8);
#define PG8_SA(b, h) (((b) * 2 + (h)) * HTB)
#define PG8_SB(b, h) ((4 + (b) * 2 + (h)) * HTB)
#define PG8_STAGEB(bufoff, gbase) do { _Pragma("unroll") for (int _i = 0; _i < 2; ++_i) \
        __builtin_amdgcn_global_load_lds((const unsigned*)((const char*)(gbase) + voffB[_i]), (LAS unsigned*)(lds + (bufoff) + ldsw + _i * 8192), 16, 0, 0); } while (0)
#define PG8_STAGEA(bufoff, h, koff) do { _Pragma("unroll") for (int _i = 0; _i < 2; ++_i) { \
        if constexpr (Sched::GATHER) __builtin_amdgcn_global_load_lds((const unsigned*)(Abase + (size_t)va[h][_i] + (koff)), (LAS unsigned*)(lds + (bufoff) + ldsw + _i * 8192), 16, 0, 0); \
        else __builtin_amdgcn_global_load_lds((const unsigned*)(cA + (h) * hstepA + (koff) + voffA[_i]), (LAS unsigned*)(lds + (bufoff) + ldsw + _i * 8192), 16, 0, 0); } } while (0)
#define PG8_LDA(dst, b, h) do { _Pragma("unroll") for (int m = 0; m < 4; ++m) _Pragma("unroll") for (int k = 0; k < 2; ++k) dst[m][k] = *(const LAS bf16x8*)(lds + PG8_SA(b, h) + aoff + m * 2048 + k * 1024); } while (0)
#define PG8_LDB(dst, b, h) do { _Pragma("unroll") for (int n = 0; n < 2; ++n) _Pragma("unroll") for (int k = 0; k < 2; ++k) dst[n][k] = *(const LAS bf16x8*)(lds + PG8_SB(b, h) + boff + n * 2048 + k * 1024); } while (0)
#define PG8_MMA(ai, bj, At, Bt) do { __builtin_amdgcn_s_setprio(1); _Pragma("unroll") for (int m = 0; m < 4; ++m) _Pragma("unroll") for (int n = 0; n < 2; ++n) _Pragma("unroll") for (int k = 0; k < 2; ++k) \
        acc[ai][bj][m][n] = __builtin_amdgcn_mfma_f32_16x16x32_bf16(Bt[n][k], At[m][k], acc[ai][bj][m][n], 0, 0, 0); __builtin_amdgcn_s_setprio(0); } while (0)
#define PG8_WAIT_V(n) asm volatile("s_waitcnt vmcnt(" #n ")" ::: "memory")
#define PG8_WAIT_L(n) asm volatile("s_waitcnt lgkmcnt(" #n ")" ::: "memory")
#define PG8_BAR __builtin_amdgcn_s_barrier()
#define PG8_SCHED __builtin_amdgcn_sched_barrier(0)
    Unit cur, nxt; int ui = 0;
    if (!S.next(0, cur)) return;
    f32x4 acc[2][2][4][2];
#pragma unroll
    for (int a = 0; a < 2; ++a)
#pragma unroll
        for (int b = 0; b < 2; ++b)
#pragma unroll
            for (int m = 0; m < 4; ++m)
#pragma unroll
                for (int n = 0; n < 2; ++n) acc[a][b][m][n] = (f32x4){0.f, 0.f, 0.f, 0.f};
    bf16x8 At[4][2], B0[2][2], B1[2][2];
    unsigned va[2][2], vn[2][2]; const char* cA = Abase; const char* nA = Abase;
    if constexpr (Sched::GATHER) {
#pragma unroll
        for (int h = 0; h < 2; ++h)
#pragma unroll
            for (int i = 0; i < 2; ++i) va[h][i] = S.aoff(cur, h * HALF + Rr[i]) + (unsigned)Cc[i] * 2u;
    } else { cA = Abase + S.arow0(cur); }
    const char* cB = S.bbase(cur);
    PG8_STAGEB(PG8_SB(0, 0), cB); PG8_STAGEB(PG8_SB(0, 1), cB + hstepB); PG8_STAGEA(PG8_SA(0, 0), 0, 0); PG8_STAGEA(PG8_SA(0, 1), 1, 0);
    if (wr == 1) PG8_BAR;
    PG8_WAIT_V(2); PG8_BAR;
    PG8_STAGEB(PG8_SB(1, 0), cB + kstep); PG8_STAGEA(PG8_SA(1, 0), 0, kstep); PG8_STAGEB(PG8_SB(1, 1), cB + hstepB + kstep);
    PG8_WAIT_V(6); PG8_BAR;
    for (;;) {
        const bool has_next = S.next(ui + 1, nxt);
        const char* nB = has_next ? S.bbase(nxt) : cB;
        if constexpr (Sched::GATHER) {
            if (has_next) {
#pragma unroll
                for (int h = 0; h < 2; ++h)
#pragma unroll
                    for (int i = 0; i < 2; ++i) vn[h][i] = S.aoff(nxt, h * HALF + Rr[i]) + (unsigned)Cc[i] * 2u;
            } else {
#pragma unroll
                for (int h = 0; h < 2; ++h)
#pragma unroll
                    for (int i = 0; i < 2; ++i) vn[h][i] = va[h][i];
            }
        } else { nA = has_next ? Abase + S.arow0(nxt) : cA; }
        for (int t = 0; t < nt; t += 2) {
            const bool last = (t == nt - 2);
            const size_t k1 = (size_t)(t + 1) * kstep;
            PG8_LDB(B0, 0, 0); PG8_LDB(B1, 0, 1); PG8_SCHED; PG8_LDA(At, 0, 0); PG8_STAGEA(PG8_SA(1, 1), 1, k1);
            PG8_WAIT_V(8); PG8_WAIT_L(0); PG8_BAR; PG8_MMA(0, 0, At, B0); PG8_MMA(0, 1, At, B1); PG8_BAR; PG8_SCHED;
            if (last) {
                if constexpr (Sched::GATHER) {
#pragma unroll
                    for (int h = 0; h < 2; ++h)
#pragma unroll
                        for (int i = 0; i < 2; ++i) va[h][i] = vn[h][i];
                } else { cA = nA; }
            }
            const char* bX = last ? nB : cB;
            const size_t k2 = last ? (size_t)0 : (size_t)(t + 2) * kstep, k3 = k2 + kstep;
            PG8_LDA(At, 0, 1); PG8_STAGEB(PG8_SB(0, 0), bX + k2); PG8_STAGEB(PG8_SB(0, 1), bX + hstepB + k2); PG8_STAGEA(PG8_SA(0, 0), 0, k2);
            PG8_WAIT_V(8); PG8_WAIT_L(0); PG8_BAR; PG8_MMA(1, 0, At, B0); PG8_MMA(1, 1, At, B1); PG8_BAR; PG8_SCHED;
            PG8_LDB(B0, 1, 0); PG8_LDB(B1, 1, 1); PG8_SCHED; PG8_LDA(At, 1, 0); PG8_STAGEA(PG8_SA(0, 1), 1, k2);
            PG8_WAIT_V(8); PG8_WAIT_L(0); PG8_BAR; PG8_MMA(0, 0, At, B0); PG8_MMA(0, 1, At, B1); PG8_BAR; PG8_SCHED;
            PG8_LDA(At, 1, 1); PG8_STAGEB(PG8_SB(1, 0), bX + k3); PG8_STAGEB(PG8_SB(1, 1), bX + hstepB + k3); PG8_STAGEA(PG8_SA(1, 0), 0, k3);
            PG8_WAIT_V(8); PG8_WAIT_L(0); PG8_BAR; PG8_MMA(1, 0, At, B0); PG8_MMA(1, 1, At, B1); PG8_BAR; PG8_SCHED;
        }
        if constexpr (ALIGN_EPI) { if (wr == 0) PG8_BAR; }
        E(acc, cur, wr, wc, fr, fq);
        if (!has_next) break;
#pragma unroll
        for (int a = 0; a < 2; ++a)
#pragma unroll
            for (int b = 0; b < 2; ++b)
#pragma unroll
                for (int m = 0; m < 4; ++m)
#pragma unroll
                    for (int n = 0; n < 2; ++n) acc[a][b][m][n] = (f32x4){0.f, 0.f, 0.f, 0.f};
        cur = nxt; cB = nB; ++ui;
        if constexpr (ALIGN_EPI) { if (wr == 1) PG8_BAR; }
    }
    PG8_WAIT_V(0);
    if constexpr (!ALIGN_EPI) { if (wr == 0) PG8_BAR; }
    PG8_BAR;
#undef PG8_SA
#undef PG8_SB
#undef PG8_STAGEA
#undef PG8_STAGEB
#undef PG8_LDA
#undef PG8_LDB
#undef PG8_MMA
#undef PG8_WAIT_V
#undef PG8_WAIT_L
#undef PG8_BAR
#undef PG8_SCHED
}
}

constexpr int NWAVES = 8;
constexpr int BATCH = 8, SEQ = 4096, DM = 1024, DEPTH = 4;
constexpr int T = BATCH * SEQ;
constexpr int EVEN_IN = 3080, EVEN_N = 3072;
constexpr int ODD_IN = 704, ODD_N = 768, QL = 384, KVL = 256;
constexpr int NEXP = 32, TOPK = 4, DFF = 1024;
constexpr int NSLOT = T * TOPK;
constexpr int LCAP = T;
constexpr float LN_EPS = 1e-5f, RMS_EPS = 1e-6f;
constexpr float DN_ALPHA = 1.681792830507429f;
constexpr float ATT_SCALE = 0.07216878364870323f;

constexpr size_t MiB = 1u << 20;
constexpr size_t WS_CTL = 0, CTL_ZERO_BYTES = 1 * MiB;
constexpr size_t WS_WGU = 16 * MiB, WS_WDN = 528 * MiB, WS_WEIN = 784 * MiB, WS_WEOUT = 796 * MiB, WS_WOIN = 800 * MiB, WS_WUQ = 804 * MiB, WS_WUKV = 808 * MiB, WS_WOOUT = 810 * MiB;
constexpr size_t WS_ROPE = 814 * MiB, WS_AB = 815 * MiB, WS_RS = 816 * MiB, WS_GATE = 817 * MiB, WS_LIST = 818 * MiB, WS_GAM = 822 * MiB;
constexpr size_t WS_XF = 832 * MiB, WS_XB = 960 * MiB, WS_Y = 1024 * MiB, WS_ARENA = 1152 * MiB, WS_MIX = 1440 * MiB;
constexpr size_t WS_GM = 1504 * MiB, WS_GB = 1568 * MiB, WS_GC = 1632 * MiB, WS_GD = 1664 * MiB, WS_GS = 1696 * MiB, WS_HID = 1760 * MiB, WS_YE = 2016 * MiB, WS_END = 2272 * MiB;
constexpr size_t AR_C1 = 0, AR_Q = 48 * MiB, AR_KV = 144 * MiB, AR_KPE = 272 * MiB;
constexpr int CW_TMO = 0, CW_CODE = 1, CW_BAR = 4096, CW_CNT = 16384;

constexpr int LDS_BYTES = 163840;
constexpr int LDS_CTL_OFF = 163840 - 512;
constexpr int LDS_SPARE = 131072;

#define RLX_AGENT __ATOMIC_RELAXED, __HIP_MEMORY_SCOPE_AGENT
#define LDS_WAIT() asm volatile("s_waitcnt lgkmcnt(0)" ::: "memory")
#define VM_WAIT() asm volatile("s_waitcnt vmcnt(0)" ::: "memory")
__device__ __forceinline__ void lds_barrier() { asm volatile("s_waitcnt lgkmcnt(0)" ::: "memory"); __builtin_amdgcn_s_barrier(); asm volatile("" ::: "memory"); }

#define XB_TMO      128
#define XB_XCNT(j)  (256  + 64 * (j))
#define XB_XSUB(j)  (1280 + 64 * (j))
#define XB_XGEN(j)  (2304 + 64 * (j))
#define XB_TOP      3328
#define XB_TOPGEN   3392
#define XCD_BAR_WORDS 3456
#define XB_SPIN_CAP (1u << 18)
__device__ __forceinline__ unsigned xb_ld(unsigned* p)              { return __hip_atomic_load(p, __ATOMIC_RELAXED, __HIP_MEMORY_SCOPE_AGENT); }
__device__ __forceinline__ unsigned xb_add(unsigned* p, unsigned v) { return __hip_atomic_fetch_add(p, v, __ATOMIC_RELAXED, __HIP_MEMORY_SCOPE_AGENT); }
__device__ __forceinline__ unsigned xb_xcc_id() { return (unsigned)__builtin_amdgcn_s_getreg((3 << 11) | 20) & 0xFu; }
#define XB_SPIN(cond, bar) do { unsigned _sp = 0; while (cond) { __builtin_amdgcn_s_sleep(1); \
    if ((++_sp & 255u) == 0u) { if (xb_ld(&(bar)[XB_TMO])) break; if (_sp > XB_SPIN_CAP) { atomicAdd(&(bar)[XB_TMO], 1u); break; } } } } while (0)
struct XcdBarrier { unsigned* bar; unsigned x; volatile LAS unsigned* st; };
__device__ __forceinline__ XcdBarrier xcd_barrier_post(unsigned* bar, volatile LAS unsigned* st) {
    XcdBarrier b; b.bar = bar; b.x = xb_xcc_id(); b.st = st;
    if (threadIdx.x == 0) (void)xb_add(&bar[XB_XCNT(b.x)], 1u);
    return b;
}
__device__ __forceinline__ void xcd_barrier_complete(unsigned* bar, unsigned x, unsigned& nloc, unsigned& nx) {
    const unsigned G = gridDim.x * gridDim.y * gridDim.z;
    unsigned sum, cnt, mine, sp = 0u;
    for (;;) {
        sum = 0u; cnt = 0u; mine = 0u;
#pragma unroll
        for (unsigned j = 0; j < 16; ++j) { const unsigned c = xb_ld(&bar[XB_XCNT(j)]); sum += c; cnt += (c > 0u) ? 1u : 0u; mine = (j == x) ? c : mine; }
        if (sum == G) break;
        __builtin_amdgcn_s_sleep(1);
        if ((++sp & 255u) == 0u) { if (xb_ld(&bar[XB_TMO])) break; if (sp > XB_SPIN_CAP) { atomicAdd(&bar[XB_TMO], 1u); break; } }
    }
    nloc = mine > 0u ? mine : 1u; nx = cnt > 0u ? cnt : 1u;
}
__device__ __forceinline__ void xcd_barrier(const XcdBarrier& b) {
    asm volatile("s_waitcnt vmcnt(0)" ::: "memory");
    __syncthreads();
    if (threadIdx.x == 0) {
        unsigned* bar = b.bar;
        __builtin_amdgcn_s_waitcnt(0);
        unsigned nloc = b.st[0], nx = b.st[1];
        if (nloc == 0u) { xcd_barrier_complete(bar, b.x, nloc, nx); b.st[0] = nloc; b.st[1] = nx; }
        const unsigned old = xb_add(&bar[XB_XSUB(b.x)], 1u);
        const unsigned gen = old / nloc;
        if (old + 1u == (gen + 1u) * nloc) {
            __builtin_amdgcn_fence(__ATOMIC_RELEASE, "agent");
            asm volatile("s_waitcnt vmcnt(0)" ::: "memory");
            const unsigned og = xb_add(&bar[XB_TOP], 1u);
            const unsigned tg = og / nx;
            if (og + 1u == (tg + 1u) * nx) xb_add(&bar[XB_TOPGEN], 1u);
            else XB_SPIN(xb_ld(&bar[XB_TOPGEN]) == tg, bar);
            __builtin_amdgcn_fence(__ATOMIC_ACQUIRE, "agent");
            xb_add(&bar[XB_XGEN(b.x)], 1u);
            asm volatile("s_waitcnt vmcnt(0)" ::: "memory");
        } else {
            XB_SPIN(xb_ld(&bar[XB_XGEN(b.x)]) == gen, bar);
            __builtin_amdgcn_fence(__ATOMIC_ACQUIRE, "agent");
            asm volatile("s_waitcnt vmcnt(0)" ::: "memory");
        }
    }
    __syncthreads();
}

struct Ctx {
    LAS unsigned char* lds;
    int tid, lane, wave, G, bid;
    const __attribute__((address_space(4))) char* ka;
    __device__ __forceinline__ const float* inp(int i) const { return ((const float* const __attribute__((address_space(4)))*)ka)[i]; }
    float* out;
    unsigned char* ws;
    unsigned* ctl;
};

__device__ __forceinline__ Ctx phase_ctx(const Ctx& C0) { Ctx C; C.lds = C0.lds; { int g_ = C0.G, b_ = C0.bid; asm volatile("" : "+s"(g_), "+s"(b_)); C.G = g_; C.bid = b_; } int t = threadIdx.x; asm volatile("" : "+v"(t)); C.tid = t; C.lane = t & 63; C.wave = __builtin_amdgcn_readfirstlane(t >> 6);
    const __attribute__((address_space(4))) char* ka = C0.ka; asm volatile("" : "+s"(ka)); C.ka = ka;
    C.out = *(float* const __attribute__((address_space(4)))*)(ka + 216); C.ws = *(unsigned char* const __attribute__((address_space(4)))*)(ka + 224); C.ctl = (unsigned*)C.ws; return C; }

__device__ __forceinline__ int uq_rowmap(int n) { const int h = n / 192, o = n - h * 192; if (o < 128) return n; const int j = o - 128; return h * 192 + 128 + (j < 32 ? 2 * j : 2 * (j - 32) + 1); }
__device__ __forceinline__ void conv_item(const float* W, int ldn, int c0, int nvalid, int K, bf16* WT, const float* kscale, int mode, LAS float* scr, int kb, int nb, int lane) {
    const int k0 = 64 * kb, n0 = 64 * nb;
    const int lc = (lane & 15) * 4, lr = lane >> 4;
#pragma unroll
    for (int i = 0; i < 16; ++i) {
        const int kk = lr + 4 * i;
        f32x4 v = (f32x4){0.f, 0.f, 0.f, 0.f};
        if (n0 + lc < nvalid) v = *(const f32x4*)(W + (size_t)(k0 + kk) * ldn + c0 + n0 + lc);
        if (kscale) { const float s = kscale[k0 + kk]; v = v * s; }
        scr[kk * 65 + lc + 0] = v.x; scr[kk * 65 + lc + 1] = v.y; scr[kk * 65 + lc + 2] = v.z; scr[kk * 65 + lc + 3] = v.w;
    }
    LDS_WAIT(); asm volatile("" ::: "memory");
    const int c = lane & 7;
#pragma unroll
    for (int j = 0; j < 8; ++j) {
        const int n = (lane >> 3) + 8 * j; const LAS float* s = scr + (8 * c) * 65 + n;
        u32x4 o; o.x = cvt_pk_bf16(s[0 * 65], s[1 * 65]); o.y = cvt_pk_bf16(s[2 * 65], s[3 * 65]); o.z = cvt_pk_bf16(s[4 * 65], s[5 * 65]); o.w = cvt_pk_bf16(s[6 * 65], s[7 * 65]);
        const int dn = mode == 1 ? uq_rowmap(n0 + n) : (n0 + n);
        *(u32x4*)(WT + (size_t)dn * K + k0 + 8 * c) = o;
    }
    LDS_WAIT(); asm volatile("" ::: "memory");
}

__device__ __forceinline__ void row_load_f32(const float* p, int lane, f32x4 (&v)[4]) {
#pragma unroll
    for (int j = 0; j < 4; ++j) v[j] = *(const f32x4*)(p + 4 * lane + 256 * j);
}
__device__ __forceinline__ void row_load_bf16(const bf16* p, int lane, f32x4 (&v)[4]) {
#pragma unroll
    for (int j = 0; j < 4; ++j) { const u32x2 w = *(const u32x2*)(p + 4 * lane + 256 * j); v[j] = (f32x4){bf_lo(w.x), bf_hi(w.x), bf_lo(w.y), bf_hi(w.y)}; }
}
__device__ __forceinline__ void row_store_f32(float* p, int lane, const f32x4 (&v)[4]) {
#pragma unroll
    for (int j = 0; j < 4; ++j) *(f32x4*)(p + 4 * lane + 256 * j) = v[j];
}
__device__ __forceinline__ void row_store_bf16(bf16* p, int lane, const f32x4 (&v)[4]) {
#pragma unroll
    for (int j = 0; j < 4; ++j) { u32x2 w; w.x = cvt_pk_bf16(v[j].x, v[j].y); w.y = cvt_pk_bf16(v[j].z, v[j].w); *(u32x2*)(p + 4 * lane + 256 * j) = w; }
}
__device__ __forceinline__ void row_layernorm(f32x4 (&v)[4], const f32x4 (&g)[4], const f32x4 (&b)[4]) {
    float s = 0.f;
#pragma unroll
    for (int j = 0; j < 4; ++j) s += (v[j].x + v[j].y) + (v[j].z + v[j].w);
    const float mean = wave_sum(s) * (1.f / DM); float s2 = 0.f;
#pragma unroll
    for (int j = 0; j < 4; ++j) { v[j] = v[j] - mean; s2 += (v[j].x * v[j].x + v[j].y * v[j].y) + (v[j].z * v[j].z + v[j].w * v[j].w); }
    const float rstd = 1.f / sqrtf(wave_sum(s2) * (1.f / DM) + LN_EPS);
#pragma unroll
    for (int j = 0; j < 4; ++j) v[j] = v[j] * rstd * g[j] + b[j];
}
__device__ __forceinline__ void row_ab(const f32x4 (&v)[4], const LAS float* w8, int lane, float (&ab)[8]) {
#pragma unroll
    for (int e = 0; e < 8; ++e) { float s = 0.f;
#pragma unroll
        for (int j = 0; j < 4; ++j) { const f32x4 w = *(const LAS f32x4*)(w8 + e * 1024 + 4 * lane + 256 * j); s += (v[j].x * w.x + v[j].y * w.y) + (v[j].z * w.z + v[j].w * w.w); }
        ab[e] = wave_sum(s); }
}
__device__ __forceinline__ void load_w8(const Ctx& C, int ei, LAS float* w8) {
    const float* W = C.inp(1) + (size_t)ei * DM * EVEN_IN;
    for (int idx = C.tid; idx < 8 * 1024; idx += NWAVES * 64) { const int k = idx >> 3, e = idx & 7; w8[e * 1024 + k] = W[(size_t)k * EVEN_IN + EVEN_N + e]; }
}

__device__ __forceinline__ void phase_prologue(const Ctx& C0) {
    const Ctx C = phase_ctx(C0);
    const int gw = C.bid * NWAVES + C.wave, NGW = C.G * NWAVES, lane = C.lane;
    LAS float* scr = (LAS float*)(C.lds + C.wave * 16640);
    unsigned char* ws = C.ws;
    constexpr int I0 = 128 * 512, I1 = 128 * 256, I2 = 2 * 768, I3 = 2 * 256, I4 = 2 * 192, I5 = 2 * 144, I6 = 2 * 128, I7 = 2 * 256;
    constexpr int NITEMS = I0 + I1 + I2 + I3 + I4 + I5 + I6 + I7;
    for (int it = gw; it < NITEMS; it += NGW) {
        int r = it;
        if (r < I0) { const int mi = r / 512, q = r % 512; conv_item(C.inp(23) + (size_t)mi * 1024 * 2048, 2048, 0, 2048, 1024, (bf16*)(ws + WS_WGU) + (size_t)mi * 2048 * 1024, nullptr, 0, scr, q / 32, q % 32, lane); continue; } r -= I0;
        if (r < I1) { const int mi = r / 256, q = r % 256; conv_item(C.inp(25) + (size_t)mi * 1024 * 1024, 1024, 0, 1024, 1024, (bf16*)(ws + WS_WDN) + (size_t)mi * 1024 * 1024, nullptr, 0, scr, q / 16, q % 16, lane); continue; } r -= I1;
        if (r < I2) { const int mi = r / 768, q = r % 768; conv_item(C.inp(1) + (size_t)mi * 1024 * EVEN_IN, EVEN_IN, 0, EVEN_N, 1024, (bf16*)(ws + WS_WEIN) + (size_t)mi * EVEN_N * 1024, nullptr, 0, scr, q / 48, q % 48, lane); continue; } r -= I2;
        if (r < I3) { const int mi = r / 256, q = r % 256; conv_item(C.inp(10) + (size_t)mi * 1024 * 1024, 1024, 0, 1024, 1024, (bf16*)(ws + WS_WEOUT) + (size_t)mi * 1024 * 1024, nullptr, 0, scr, q / 16, q % 16, lane); continue; } r -= I3;
        if (r < I4) { const int mi = r / 192, q = r % 192; conv_item(C.inp(11) + (size_t)mi * 1024 * ODD_IN, ODD_IN, 0, ODD_IN, 1024, (bf16*)(ws + WS_WOIN) + (size_t)mi * ODD_N * 1024, nullptr, 0, scr, q / 12, q % 12, lane); continue; } r -= I4;
        if (r < I5) { const int mi = r / 144, q = r % 144; conv_item(C.inp(13) + (size_t)mi * QL * 1536, 1536, 0, 1536, QL, (bf16*)(ws + WS_WUQ) + (size_t)mi * 1536 * QL, C.inp(12) + mi * QL, 1, scr, q / 24, q % 24, lane); continue; } r -= I5;
        if (r < I6) { const int mi = r / 128, q = r % 128; conv_item(C.inp(15) + (size_t)mi * KVL * 2048, 2048, 0, 2048, KVL, (bf16*)(ws + WS_WUKV) + (size_t)mi * 2048 * KVL, C.inp(14) + mi * KVL, 0, scr, q / 32, q % 32, lane); continue; } r -= I6;
        { const int mi = r / 256, q = r % 256; conv_item(C.inp(16) + (size_t)mi * 1024 * 1024, 1024, 0, 1024, 1024, (bf16*)(ws + WS_WOOUT) + (size_t)mi * 1024 * 1024, nullptr, 0, scr, q / 16, q % 16, lane); }
    }
    { f32x2* rope = (f32x2*)(ws + WS_ROPE);
      for (int idx = C.bid * NWAVES * 64 + C.tid; idx < SEQ * 32; idx += C.G * NWAVES * 64) { const int pos = idx >> 5, j = idx & 31;
          const float inv = powf(10000.0f, -(float)(2 * j) / 64.0f); const float ang = (float)pos * inv; rope[idx] = (f32x2){cosf(ang), sinf(ang)}; } }
    __syncthreads();
    LAS float* w8 = (LAS float*)(C.lds);
    load_w8(C, 0, w8);
    __syncthreads();
    const float* x = C.inp(0); bf16* XB = (bf16*)(ws + WS_XB); float* AB = (float*)(ws + WS_AB);
    for (int m = gw; m < T; m += NGW) { f32x4 v[4]; row_load_f32(x + (size_t)m * DM, lane, v); row_store_bf16(XB + (size_t)m * DM, lane, v);
        float ab[8]; row_ab(v, w8, lane, ab); if (lane < 8) { float s = ab[0];
#pragma unroll
            for (int e = 1; e < 8; ++e) s = (lane == e) ? ab[e] : s;
            AB[(size_t)m * 8 + lane] = s; } }
}

using pg8::Unit;
struct EpiBf16 {
    static constexpr bool PERM = true;
    bf16* O; int ldc; int gelu_cols;
    __device__ __forceinline__ void operator()(const f32x4 (&acc)[2][2][4][2], const Unit& u, int wr, int wc, int fr, int fq) const {
        const int row0 = u.pm * 256 + wr * 64 + fr, col0 = u.pn * 256 + wc * 32 + 8 * fq;
        const bool g = (u.pn * 256) < gelu_cols;
#pragma unroll
        for (int ai = 0; ai < 2; ++ai)
#pragma unroll
            for (int m = 0; m < 4; ++m) { bf16* rowp = O + (size_t)(row0 + ai * 128 + m * 16) * ldc + col0;
#pragma unroll
                for (int bj = 0; bj < 2; ++bj) { f32x4 v0 = acc[ai][bj][m][0], v1 = acc[ai][bj][m][1];
                    if (g) { f32x2 a = pg8::gelu_pk((f32x2){v0[0], v0[1]}), b = pg8::gelu_pk((f32x2){v0[2], v0[3]}), c = pg8::gelu_pk((f32x2){v1[0], v1[1]}), d = pg8::gelu_pk((f32x2){v1[2], v1[3]});
                        v0 = (f32x4){a.x, a.y, b.x, b.y}; v1 = (f32x4){c.x, c.y, d.x, d.y}; }
                    u32x4 w; w.x = cvt_pk_bf16(v0[0], v0[1]); w.y = cvt_pk_bf16(v0[2], v0[3]); w.z = cvt_pk_bf16(v1[0], v1[1]); w.w = cvt_pk_bf16(v1[2], v1[3]);
                    *(u32x4*)(rowp + bj * 128) = w; } }
    }
};
struct EpiRes {
    static constexpr bool PERM = true;
    const bf16* X; bf16* Y;
    __device__ __forceinline__ void operator()(const f32x4 (&acc)[2][2][4][2], const Unit& u, int wr, int wc, int fr, int fq) const {
        const int row0 = u.pm * 256 + wr * 64 + fr, col0 = u.pn * 256 + wc * 32 + 8 * fq;
#pragma unroll
        for (int ai = 0; ai < 2; ++ai)
#pragma unroll
            for (int m = 0; m < 4; ++m) { const size_t off = (size_t)(row0 + ai * 128 + m * 16) * DM + col0;
                u32x4 xs[2];
#pragma unroll
                for (int bj = 0; bj < 2; ++bj) xs[bj] = *(const u32x4*)(X + off + bj * 128);
#pragma unroll
                for (int bj = 0; bj < 2; ++bj) { const f32x4 a0 = acc[ai][bj][m][0], a1 = acc[ai][bj][m][1]; u32x4 w;
                    w.x = cvt_pk_bf16(bf_lo(xs[bj].x) * DN_ALPHA + a0[0], bf_hi(xs[bj].x) * DN_ALPHA + a0[1]); w.y = cvt_pk_bf16(bf_lo(xs[bj].y) * DN_ALPHA + a0[2], bf_hi(xs[bj].y) * DN_ALPHA + a0[3]);
                    w.z = cvt_pk_bf16(bf_lo(xs[bj].z) * DN_ALPHA + a1[0], bf_hi(xs[bj].z) * DN_ALPHA + a1[1]); w.w = cvt_pk_bf16(bf_lo(xs[bj].w) * DN_ALPHA + a1[2], bf_hi(xs[bj].w) * DN_ALPHA + a1[3]);
                    *(u32x4*)(Y + off + bj * 128) = w; }
                asm volatile("" ::: "memory"); }
    }
};
struct EpiQ {
    static constexpr bool PERM = true;
    bf16* O; const float* rs; const f32x4* rope;
    __device__ __forceinline__ void operator()(const f32x4 (&acc)[2][2][4][2], const Unit& u, int wr, int wc, int fr, int fq) const {
        const int row0 = u.pm * 256 + wr * 64 + fr, col0 = u.pn * 256 + wc * 32 + 8 * fq;
#pragma unroll
        for (int ai = 0; ai < 2; ++ai)
#pragma unroll
            for (int m = 0; m < 4; ++m) { const int row = row0 + ai * 128 + m * 16; const float s = rs[row]; const int pos = row & (SEQ - 1);
                bf16* rowp = O + (size_t)row * 1536 + col0;
#pragma unroll
                for (int bj = 0; bj < 2; ++bj) { f32x4 v0 = acc[ai][bj][m][0] * s, v1 = acc[ai][bj][m][1] * s;
                    const int c = col0 + bj * 128, o = c % 192;
                    if (o >= 128) { const int jp = (o - 128) >> 1;
                        const f32x4 r0 = rope[(pos * 32 + jp) >> 1], r1 = rope[(pos * 32 + jp + 2) >> 1];
                        v0 = (f32x4){v0[0] * r0[0] - v0[1] * r0[1], v0[0] * r0[1] + v0[1] * r0[0], v0[2] * r0[2] - v0[3] * r0[3], v0[2] * r0[3] + v0[3] * r0[2]};
                        v1 = (f32x4){v1[0] * r1[0] - v1[1] * r1[1], v1[0] * r1[1] + v1[1] * r1[0], v1[2] * r1[2] - v1[3] * r1[3], v1[2] * r1[3] + v1[3] * r1[2]}; }
                    u32x4 w; w.x = cvt_pk_bf16(v0[0], v0[1]); w.y = cvt_pk_bf16(v0[2], v0[3]); w.z = cvt_pk_bf16(v1[0], v1[1]); w.w = cvt_pk_bf16(v1[2], v1[3]);
                    *(u32x4*)(rowp + bj * 128) = w; }
                asm volatile("" ::: "memory"); }
    }
};
struct EpiKV {
    static constexpr bool PERM = true;
    bf16* O; const float* rs;
    __device__ __forceinline__ void operator()(const f32x4 (&acc)[2][2][4][2], const Unit& u, int wr, int wc, int fr, int fq) const {
        const int row0 = u.pm * 256 + wr * 64 + fr, col0 = u.pn * 256 + wc * 32 + 8 * fq;
#pragma unroll
        for (int ai = 0; ai < 2; ++ai)
#pragma unroll
            for (int m = 0; m < 4; ++m) { const int row = row0 + ai * 128 + m * 16; const float s = rs[row]; bf16* rowp = O + (size_t)row * 2048 + col0;
#pragma unroll
                for (int bj = 0; bj < 2; ++bj) { const f32x4 v0 = acc[ai][bj][m][0] * s, v1 = acc[ai][bj][m][1] * s;
                    u32x4 w; w.x = cvt_pk_bf16(v0[0], v0[1]); w.y = cvt_pk_bf16(v0[2], v0[3]); w.z = cvt_pk_bf16(v1[0], v1[1]); w.w = cvt_pk_bf16(v1[2], v1[3]);
                    *(u32x4*)(rowp + bj * 128) = w; }
                asm volatile("" ::: "memory"); }
    }
};
struct EpiSwiglu {
    static constexpr bool PERM = true;
    bf16* HID; const float* bias; const LAS int* rmap;
    __device__ __forceinline__ void operator()(const f32x4 (&acc)[2][2][4][2], const Unit& u, int wr, int wc, int fr, int fq) const {
        const int col0 = u.pn * 256 + wc * 32 + 8 * fq; const float* bp = bias + (size_t)u.e * 2048 + col0;
        f32x4 bv[2][2];
#pragma unroll
        for (int bj = 0; bj < 2; ++bj)
#pragma unroll
            for (int n = 0; n < 2; ++n) bv[bj][n] = *(const f32x4*)(bp + bj * 128 + 4 * n);
#pragma unroll
        for (int ai = 0; ai < 2; ++ai)
#pragma unroll
            for (int m = 0; m < 4; ++m) { const int slot = rmap[u.li * 256 + ai * 128 + wr * 64 + m * 16 + fr];
                if (slot >= 0) { bf16* rowp = HID + (size_t)slot * DFF + (col0 >> 1);
#pragma unroll
                    for (int bj = 0; bj < 2; ++bj) { const f32x4 h0 = acc[ai][bj][m][0] + bv[bj][0], h1 = acc[ai][bj][m][1] + bv[bj][1];
                        float o[4];
#pragma unroll
                        for (int q = 0; q < 4; ++q) { const float glu = fminf(q < 2 ? h0[2 * q] : h1[2 * q - 4], 7.0f); float lin = q < 2 ? h0[2 * q + 1] : h1[2 * q - 3]; lin = fminf(fmaxf(lin, -7.0f), 7.0f);
                            const float sg = __builtin_amdgcn_rcpf(1.0f + __builtin_amdgcn_exp2f(-1.702f * 1.4426950408889634f * glu)); o[q] = glu * sg * (lin + 1.0f); }
                        u32x2 w; w.x = cvt_pk_bf16(o[0], o[1]); w.y = cvt_pk_bf16(o[2], o[3]);
                        *(u32x2*)(rowp + bj * 64) = w; } }
                asm volatile("" ::: "memory"); }
    }
};
struct EpiDown {
    static constexpr bool PERM = true;
    bf16* YE; const float* bias; const float* gate; const LAS int* rmap;
    __device__ __forceinline__ void operator()(const f32x4 (&acc)[2][2][4][2], const Unit& u, int wr, int wc, int fr, int fq) const {
        const int col0 = u.pn * 256 + wc * 32 + 8 * fq; const float* bp = bias + (size_t)u.e * DM + col0;
        f32x4 bv[2][2];
#pragma unroll
        for (int bj = 0; bj < 2; ++bj)
#pragma unroll
            for (int n = 0; n < 2; ++n) bv[bj][n] = *(const f32x4*)(bp + bj * 128 + 4 * n);
#pragma unroll
        for (int ai = 0; ai < 2; ++ai)
#pragma unroll
            for (int m = 0; m < 4; ++m) { const int slot = rmap[u.li * 256 + ai * 128 + wr * 64 + m * 16 + fr];
                if (slot >= 0) { const float gt = gate[slot]; bf16* rowp = YE + (size_t)slot * DM + col0;
#pragma unroll
                    for (int bj = 0; bj < 2; ++bj) { const f32x4 v0 = (acc[ai][bj][m][0] + bv[bj][0]) * gt, v1 = (acc[ai][bj][m][1] + bv[bj][1]) * gt;
                        u32x4 w; w.x = cvt_pk_bf16(v0[0], v0[1]); w.y = cvt_pk_bf16(v0[2], v0[3]); w.z = cvt_pk_bf16(v1[0], v1[1]); w.w = cvt_pk_bf16(v1[2], v1[3]);
                        *(u32x4*)(rowp + bj * 128) = w; } }
                asm volatile("" ::: "memory"); }
    }
};

template <class Epi>
__device__ __forceinline__ void run_plain_gemm(const Ctx& C, const bf16* A, int lda, int K, int N, const bf16* Bt, const Epi& E) {
    pg8::PlainSched S; S.o.init(T, N, C.G, C.bid); S.Bt = (const char*)Bt; S.K = K; S.lda = lda;
    pg8::gemm_phase<Epi, pg8::PlainSched, true>(C.lds, (const char*)A, K, S, E);
}

constexpr int MOE_RMAP_OFF = LDS_SPARE, MOE_MAX_UNITS = 20, MOE_PRE_OFF = LDS_SPARE + MOE_MAX_UNITS * 1024, MOE_CNT_OFF = MOE_PRE_OFF + 256;
struct MoeSched {
    static constexpr bool GATHER = true;
    const LAS int* pre; const LAS int* rmap; const char* Bt; size_t bstride; int K, NT, G, c, lda, shift;
    __device__ __forceinline__ bool next(int i, Unit& u) const {
        const int x = c & 7, k = c >> 3, per = G >> 3;
        const int RT = 32 / NT, tot = pre[32];
        const int slot = i * per + k;
        const int st = (slot >> 5) * 8 + x, within = slot & 31;
        const int rt = st * RT + within / NT;
        if (rt >= tot || i >= MOE_MAX_UNITS) return false;
        int e = 0;
#pragma unroll 1
        for (; e < 31; ++e) if (rt < pre[e + 1]) break;
        u.e = e; u.pn = within % NT; u.pm = rt - pre[e]; u.li = i; return true;
    }
    __device__ __forceinline__ const char* bbase(const Unit& u) const { return Bt + (size_t)u.e * bstride + (size_t)u.pn * 256 * K * 2; }
    __device__ __forceinline__ unsigned aoff(const Unit& u, int r) const { const int slot = rmap[u.li * 256 + r]; const int s = slot < 0 ? 0 : (slot >> shift); return (unsigned)(s * lda) * 2u; }
};
template <class Epi>
__device__ __forceinline__ void run_moe_gemm(const Ctx& C0, int layer, const bf16* A, int lda, int shift, int K, int N, const bf16* Bt, size_t bstride_elems, Epi E) {
    const Ctx C = phase_ctx(C0);
    LAS int* pre = (LAS int*)(C.lds + MOE_PRE_OFF); LAS int* cnt = (LAS int*)(C.lds + MOE_CNT_OFF); LAS int* rmap = (LAS int*)(C.lds + MOE_RMAP_OFF);
    const int* list = (const int*)(C.ws + WS_LIST);
    if (C.tid < 32) cnt[C.tid] = (int)__hip_atomic_load(C.ctl + CW_CNT + (layer * 32 + C.tid) * 64, RLX_AGENT);
    __syncthreads();
    if (C.tid == 0) { int s = 0; for (int e = 0; e < 32; ++e) { pre[e] = s; s += (cnt[e] + 255) >> 8; } pre[32] = s; }
    __syncthreads();
    MoeSched S; S.pre = pre; S.rmap = rmap; S.Bt = (const char*)Bt; S.bstride = bstride_elems * 2; S.K = K; S.NT = N / 256; S.G = C.G; S.c = C.bid; S.lda = lda; S.shift = shift;
    { Unit u; for (int i = 0; S.next(i, u); ++i) { if (C.tid < 256) { const int idx = u.pm * 256 + C.tid; rmap[i * 256 + C.tid] = idx < cnt[u.e] ? list[(size_t)u.e * LCAP + idx] : -1; } } }
    __syncthreads();
    E.rmap = rmap;
    pg8::gemm_phase<Epi, MoeSched, true>(C.lds, (const char*)A, K, S, E);
}

__device__ __forceinline__ void phase_router(const Ctx& C0, int layer) {
    const Ctx C = phase_ctx(C0);
    LAS float* wrT = (LAS float*)C.lds;
    LAS int* lcnt = (LAS int*)(C.lds + 132096); LAS int* lbase = (LAS int*)(C.lds + 132224);
    LAS int* asg_e = (LAS int*)(C.lds + 132352); LAS int* asg_pos = (LAS int*)(C.lds + 134400); LAS float* asg_gate = (LAS float*)(C.lds + 136448);
    const float* Wr = C.inp(21) + (size_t)layer * DM * NEXP; const float* br = C.inp(22) + layer * NEXP;
    const int lane = C.lane, tid = C.tid;
    for (int idx = tid; idx < DM * NEXP; idx += NWAVES * 64) { const int k = idx >> 5, e = idx & 31; wrT[e * 1028 + k] = Wr[idx]; }
    f32x4 g[4], b[4]; row_load_f32(C.inp(17) + layer * DM, lane, g); row_load_f32(C.inp(18) + layer * DM, lane, b);
    const bf16* Y = (const bf16*)(C.ws + WS_Y); bf16* XB = (bf16*)(C.ws + WS_XB);
    int* list = (int*)(C.ws + WS_LIST); float* GATE = (float*)(C.ws + WS_GATE);
    const float mybias = br[lane >> 1];
    for (int rb = C.bid; rb < T / 128; rb += C.G) {
        if (tid < 32) lcnt[tid] = 0;
        __syncthreads();
#pragma unroll 1
        for (int i = 0; i < 16; ++i) {
            const int rl = C.wave * 16 + i, row = rb * 128 + rl;
            f32x4 v[4]; row_load_bf16(Y + (size_t)row * DM, lane, v);
            row_layernorm(v, g, b);
            row_store_bf16(XB + (size_t)row * DM, lane, v);
            float p[32];
#pragma unroll
            for (int e = 0; e < 32; ++e) { float s = 0.f;
#pragma unroll
                for (int j = 0; j < 4; ++j) { const f32x4 w = *(const LAS f32x4*)(wrT + e * 1028 + 4 * lane + 256 * j); s += (v[j].x * w.x + v[j].y * w.y) + (v[j].z * w.z + v[j].w * w.w); }
                p[e] = s; }
#define BFLY(bit, n) { const bool hi_ = (lane & (bit)) != 0; _Pragma("unroll") for (int q = 0; q < (n); ++q) { const float send = hi_ ? p[q] : p[q + (n)]; const float keep = hi_ ? p[q + (n)] : p[q]; p[q] = keep + __shfl_xor(send, (bit)); } }
            BFLY(32, 16) BFLY(16, 8) BFLY(8, 4) BFLY(4, 2) BFLY(2, 1)
#undef BFLY
            float val = p[0] + __shfl_xor(p[0], 1) + mybias; const int me = lane >> 1;
            float tv[4]; int te[4];
#pragma unroll
            for (int k = 0; k < 4; ++k) { float bv = val; int be = me;
#pragma unroll
                for (int off = 1; off < 64; off <<= 1) { const float ov = __shfl_xor(bv, off); const int oe = __shfl_xor(be, off); const bool take = (ov > bv) || (ov == bv && oe < be); bv = take ? ov : bv; be = take ? oe : be; }
                tv[k] = bv; te[k] = be; if (me == be) val = -__builtin_inff(); }
            const float e1 = __expf(tv[1] - tv[0]), e2 = __expf(tv[2] - tv[0]), e3 = __expf(tv[3] - tv[0]); const float inv = 1.0f / (1.0f + e1 + e2 + e3);
            if (lane < 4) { const int my_e = lane == 0 ? te[0] : lane == 1 ? te[1] : lane == 2 ? te[2] : te[3]; const float my_g = (lane == 0 ? 1.0f : lane == 1 ? e1 : lane == 2 ? e2 : e3) * inv;
                const int lpos = __hip_atomic_fetch_add(lcnt + my_e, 1, __ATOMIC_RELAXED, __HIP_MEMORY_SCOPE_WORKGROUP);
                const int a = rl * 4 + lane; asg_e[a] = my_e; asg_pos[a] = lpos; asg_gate[a] = my_g; }
        }
        __syncthreads();
        if (tid < 32) lbase[tid] = (int)__hip_atomic_fetch_add(C.ctl + CW_CNT + (layer * 32 + tid) * 64, (unsigned)lcnt[tid], RLX_AGENT);
        __syncthreads();
        { const int a = tid, e = asg_e[a], slot = (rb * 128 + (a >> 2)) * 4 + (a & 3); list[(size_t)e * LCAP + lbase[e] + asg_pos[a]] = slot; GATE[slot] = asg_gate[a]; }
        __syncthreads();
    }
}

__device__ __forceinline__ void phase_combine(const Ctx& C0, int layer) {
    const Ctx C = phase_ctx(C0);
    const int gw = C.bid * NWAVES + C.wave, NGW = C.G * NWAVES, lane = C.lane;
    LAS float* w8 = (LAS float*)C.lds;
    if (layer == 1) { load_w8(C, 1, w8); __syncthreads(); }
    f32x4 g[4], b[4]; row_load_f32(C.inp(19) + layer * DM, lane, g); row_load_f32(C.inp(20) + layer * DM, lane, b);
    bf16* XB = (bf16*)(C.ws + WS_XB); const bf16* YE = (const bf16*)(C.ws + WS_YE); float* AB = (float*)(C.ws + WS_AB);
    for (int m = gw; m < T; m += NGW) {
        f32x4 v[4]; row_load_bf16(XB + (size_t)m * DM, lane, v);
#pragma unroll
        for (int j = 0; j < 4; ++j) v[j] = v[j] * DN_ALPHA;
#pragma unroll
        for (int k = 0; k < 4; ++k) { const bf16* yr = YE + (size_t)(m * 4 + k) * DM;
#pragma unroll
            for (int j = 0; j < 4; ++j) { const u32x2 w = *(const u32x2*)(yr + 4 * lane + 256 * j); v[j] = v[j] + (f32x4){bf_lo(w.x), bf_hi(w.x), bf_lo(w.y), bf_hi(w.y)}; } }
        row_layernorm(v, g, b);
        if (layer == DEPTH - 1) row_store_f32(C.out + (size_t)m * DM, lane, v);
        else row_store_bf16(XB + (size_t)m * DM, lane, v);
        if (layer == 1) { float ab[8]; row_ab(v, w8, lane, ab); if (lane < 8) { float s = ab[0];
#pragma unroll
                for (int e = 1; e < 8; ++e) s = (lane == e) ? ab[e] : s;
                AB[(size_t)m * 8 + lane] = s; } }
    }
}

__device__ __forceinline__ void phase_o1b(const Ctx& C0) {
    const Ctx C = phase_ctx(C0);
    const int gw = C.bid * NWAVES + C.wave, NGW = C.G * NWAVES, lane = C.lane;
    const bf16* C1 = (const bf16*)(C.ws + WS_ARENA + AR_C1); bf16* KPE = (bf16*)(C.ws + WS_ARENA + AR_KPE);
    float* RSQ = (float*)(C.ws + WS_RS); float* RKV = RSQ + T; const f32x2* rope = (const f32x2*)(C.ws + WS_ROPE);
    for (int m = gw; m < T; m += NGW) {
        const bf16* rp = C1 + (size_t)m * ODD_N;
        const u32x4 a = *(const u32x4*)(rp + 8 * lane);
        float s = 0.f;
#pragma unroll
        for (int q = 0; q < 4; ++q) { const float lo = bf_lo(a[q]), hi = bf_hi(a[q]); s += lo * lo + hi * hi; }
        float sq = lane < 48 ? s : 0.f, skv = lane < 48 ? 0.f : s;
        if (lane < 16) { const u32x4 b = *(const u32x4*)(rp + 8 * (64 + lane)); float s2 = 0.f;
#pragma unroll
            for (int q = 0; q < 4; ++q) { const float lo = bf_lo(b[q]), hi = bf_hi(b[q]); s2 += lo * lo + hi * hi; }
            skv += s2; }
        sq = wave_sum(sq); skv = wave_sum(skv);
        if (lane == 0) { RSQ[m] = 1.0f / sqrtf(sq * (1.0f / QL) + RMS_EPS); RKV[m] = 1.0f / sqrtf(skv * (1.0f / KVL) + RMS_EPS); }
        if (lane < 32) { const float x1 = bf2f(rp[640 + lane]), x2 = bf2f(rp[672 + lane]); const f32x2 cs = rope[(m & (SEQ - 1)) * 32 + lane];
            *(unsigned*)(KPE + (size_t)m * 64 + 2 * lane) = cvt_pk_bf16(x1 * cs.x - x2 * cs.y, x1 * cs.y + x2 * cs.x); }
    }
}

namespace att {
constexpr int SHM_V = 16384, SHM_K = 16384, SHM_KR = 8192;
constexpr int OFF_V = 0, OFF_K = 2 * SHM_V, OFF_KR = OFF_K + 2 * SHM_K, OFF_WS = OFF_KR + 2 * SHM_KR, OFF_QR = OFF_WS + 2048;
constexpr float THR = 8.f, SCALE = ATT_SCALE;
#define KSWZ(row, colB) ((row) * 256 + ((colB) ^ (((row) & 7) << 4)))
#define KRSWZ(row, colB) ((row) * 128 + ((colB) ^ (((row) & 7) << 4)))
#define SBAR() __builtin_amdgcn_sched_barrier(0)
__device__ __forceinline__ int v_st(int k, int c) { const int kk = (k & ~0xC) | ((k & 4) << 1) | ((k & 8) >> 1); return ((kk >> 3) * 4 + (c >> 5)) * 512 + ((kk & 7) * 32 + (c & 31)) * 2; }
__device__ __forceinline__ int v_rd_base(int lane) { return ((lane & 3) << 3) | (((lane >> 2) & 3) << 6) | (((lane >> 4) & 1) << 5) | (((lane >> 5) & 1) << 8); }
constexpr int v_rd_off(int d0, int ks, int half) { return d0 * 512 + ks * 4096 + half * 2048; }
__device__ __forceinline__ int crow(int r, int hi) { return (r & 3) + 8 * (r >> 2) + 4 * hi; }
__device__ __forceinline__ void partialSM(f32x16& p0, f32x16& p1, float& m_reg, float& mn, float& alpha) {
    float pmax = p0[0];
#pragma unroll
    for (int r = 1; r < 16; ++r) pmax = fmaxf(pmax, p0[r]);
#pragma unroll
    for (int r = 0; r < 16; ++r) pmax = fmaxf(pmax, p1[r]);
    { auto rr = __builtin_amdgcn_permlane32_swap(__float_as_uint(pmax), __float_as_uint(pmax), false, false);
      pmax = fmaxf(__uint_as_float(rr[0]), __uint_as_float(rr[1])); }
    constexpr float C2 = 1.4426950408889634f * SCALE;
    if (__builtin_expect(__all((pmax - m_reg) * SCALE <= THR), 1)) { mn = m_reg; alpha = 1.f; }
    else { mn = fmaxf(m_reg, pmax); alpha = __builtin_amdgcn_exp2f((m_reg - mn) * C2); m_reg = mn; }
    const float mnL = -mn * C2;
#pragma unroll
    for (int r = 0; r < 16; ++r) p0[r] = fmaf(p0[r], C2, mnL);
#pragma unroll
    for (int r = 0; r < 16; ++r) p1[r] = fmaf(p1[r], C2, mnL);
#pragma unroll
    for (int r = 0; r < 16; ++r) p0[r] = __builtin_amdgcn_exp2f(p0[r]);
}
__device__ __forceinline__ void finishSM(f32x16& p0, f32x16& p1, float alpha, float& l_reg, bf16x8& pa0, bf16x8& pa1, bf16x8& pa2, bf16x8& pa3) {
#pragma unroll
    for (int r = 0; r < 16; ++r) p1[r] = __builtin_amdgcn_exp2f(p1[r]);
    float ps = 0;
#pragma unroll
    for (int r = 0; r < 16; ++r) ps += p0[r];
#pragma unroll
    for (int r = 0; r < 16; ++r) ps += p1[r];
    { auto rr = __builtin_amdgcn_permlane32_swap(__float_as_uint(ps), __float_as_uint(ps), false, false);
      ps = __uint_as_float(rr[0]) + __uint_as_float(rr[1]); }
    l_reg = l_reg * alpha + ps;
#define PK4(P, B_, OUT) do { unsigned a0 = cvt_pk_bf16(P[B_+0], P[B_+1]), a1 = cvt_pk_bf16(P[B_+2], P[B_+3]);                          \
        unsigned b0 = cvt_pk_bf16(P[B_+4], P[B_+5]), b1 = cvt_pk_bf16(P[B_+6], P[B_+7]);                                             \
        auto r0 = __builtin_amdgcn_permlane32_swap(a0, b0, false, false); auto r1 = __builtin_amdgcn_permlane32_swap(a1, b1, false, false); \
        u32x4 w = {r0[0], r1[0], r0[1], r1[1]}; OUT = *reinterpret_cast<bf16x8*>(&w); } while (0)
    PK4(p0, 0, pa0); PK4(p0, 8, pa1); PK4(p1, 0, pa2); PK4(p1, 8, pa3);
#undef PK4
}
template <int KB>
__device__ __forceinline__ void qkt(f32x16& p0, f32x16& p1, const LAS char* lds, int r32, int hi, const bf16x8* qr, const LAS char* qrl) {
    p0 = f32x16{}; p1 = f32x16{};
    const LAS char* kb[4]; const LAS char* kr[4];
#pragma unroll
    for (int dd = 0; dd < 4; ++dd) { kb[dd] = lds + OFF_K + KB * SHM_K + KSWZ(r32, (dd * 16 + hi * 8) * 2); kr[dd] = lds + OFF_KR + KB * SHM_KR + KRSWZ(r32, (dd * 16 + hi * 8) * 2); }
#pragma unroll
    for (int d0 = 0; d0 < 8; ++d0) { const LAS char* a = kb[d0 & 3] + (d0 >> 2) * 128;
        const bf16x8 b0 = *reinterpret_cast<const LAS bf16x8*>(a);
        const bf16x8 b1 = *reinterpret_cast<const LAS bf16x8*>(a + 32 * 256);
        p0 = __builtin_amdgcn_mfma_f32_32x32x16_bf16(b0, qr[d0], p0, 0, 0, 0);
        p1 = __builtin_amdgcn_mfma_f32_32x32x16_bf16(b1, qr[d0], p1, 0, 0, 0); }
#pragma unroll
    for (int d0 = 0; d0 < 4; ++d0) { const LAS char* a = kr[d0];
        const bf16x8 b0 = *reinterpret_cast<const LAS bf16x8*>(a);
        const bf16x8 b1 = *reinterpret_cast<const LAS bf16x8*>(a + 32 * 128);
        const bf16x8 qf = *reinterpret_cast<const LAS bf16x8*>(qrl + d0 * 1024);
        p0 = __builtin_amdgcn_mfma_f32_32x32x16_bf16(b0, qf, p0, 0, 0, 0);
        p1 = __builtin_amdgcn_mfma_f32_32x32x16_bf16(b1, qf, p1, 0, 0, 0); }
}
template <int VB>
__device__ __forceinline__ void pv_tile(f32x16* o, int vb0, bf16x8 pa0, bf16x8 pa1, bf16x8 pa2, bf16x8 pa3) {
#define TRRD(dst, off) asm volatile("ds_read_b64_tr_b16 %0, %1 offset:%2" : "=&v"(dst) : "v"(vb0), "i"(off) : "memory")
#define PV_D0(d0) do { s16x4 l0, l1, l2, l3, h0, h1, h2, h3; constexpr int b_ = OFF_V + VB * SHM_V + v_rd_off(d0, 0, 0); \
        TRRD(l0, b_); TRRD(h0, b_ + 2048); TRRD(l1, b_ + 4096); TRRD(h1, b_ + 6144); TRRD(l2, b_ + 8192); TRRD(h2, b_ + 10240); TRRD(l3, b_ + 12288); TRRD(h3, b_ + 14336); \
        asm volatile("s_waitcnt lgkmcnt(0)" ::: "memory"); SBAR();   \
        o[d0] = __builtin_amdgcn_mfma_f32_32x32x16_bf16(pa0, (bf16x8){l0[0], l0[1], l0[2], l0[3], h0[0], h0[1], h0[2], h0[3]}, o[d0], 0, 0, 0);   \
        o[d0] = __builtin_amdgcn_mfma_f32_32x32x16_bf16(pa1, (bf16x8){l1[0], l1[1], l1[2], l1[3], h1[0], h1[1], h1[2], h1[3]}, o[d0], 0, 0, 0);   \
        o[d0] = __builtin_amdgcn_mfma_f32_32x32x16_bf16(pa2, (bf16x8){l2[0], l2[1], l2[2], l2[3], h2[0], h2[1], h2[2], h2[3]}, o[d0], 0, 0, 0);   \
        o[d0] = __builtin_amdgcn_mfma_f32_32x32x16_bf16(pa3, (bf16x8){l3[0], l3[1], l3[2], l3[3], h3[0], h3[1], h3[2], h3[3]}, o[d0], 0, 0, 0); } while (0)
    PV_D0(0); PV_D0(1); PV_D0(2); PV_D0(3);
#undef PV_D0
#undef TRRD
}

__device__ __forceinline__ void attn_block(const Ctx& C, int b, int h, int qb) {
    LAS char* lds = (LAS char*)C.lds;
    const int tid = C.tid, wid = C.wave, lane = C.lane, r32 = lane & 31, hi = lane >> 5;
    const bf16* Qg = (const bf16*)(C.ws + WS_ARENA + AR_Q); const bf16* KVg = (const bf16*)(C.ws + WS_ARENA + AR_KV); const bf16* KPE = (const bf16*)(C.ws + WS_ARENA + AR_KPE);
    bf16* MIX = (bf16*)(C.ws + WS_MIX);
    const size_t tok0 = (size_t)b * SEQ; const int P0 = qb * 256;
    const int NT = 4 * (qb + 1), jmax = (P0 + wid * 32) >> 6;
    bf16x8 qr[8];
    LAS char* qrl = lds + OFF_QR + wid * 4096 + lane * 16;
    { const bf16* qp = Qg + (tok0 + P0 + wid * 32 + r32) * 1536 + h * 192 + hi * 8;
#pragma unroll
      for (int d0 = 0; d0 < 8; ++d0) qr[d0] = *(const bf16x8*)(qp + d0 * 16);
#pragma unroll
      for (int d0 = 0; d0 < 4; ++d0) *(LAS bf16x8*)(qrl + d0 * 1024) = *(const bf16x8*)(qp + (8 + d0) * 16); }
    const bf16* kvp = KVg + tok0 * 2048 + h * 256; const bf16* kpp = KPE + tok0 * 64;
#define A_LOAD(kb, bf) do { const bf16* p_ = kvp + (size_t)(kb) * 2048; int ln_ = lane; asm volatile("" : "+v"(ln_)); \
        _Pragma("unroll") for (int i_ = 0; i_ < 2; ++i_) { const int B_ = (wid * 2 + i_) * 1024 + ln_ * 16; \
            const int row_ = B_ >> 8, c_ = ((B_ & 255) >> 4) ^ (row_ & 7); \
            const int sub_ = B_ >> 9, kk_ = (sub_ >> 2) * 8 + ((B_ & 511) >> 6), k_ = (kk_ & ~0xC) | ((kk_ & 4) << 1) | ((kk_ & 8) >> 1), cc_ = (sub_ & 3) * 32 + ((B_ & 63) >> 1); \
            __builtin_amdgcn_global_load_lds((const unsigned*)(p_ + (unsigned)(row_ * 2048 + c_ * 8)), (LAS unsigned*)(lds + OFF_K + (bf) * SHM_K + (wid * 2 + i_) * 1024), 16, 0, 0); \
            __builtin_amdgcn_global_load_lds((const unsigned*)(p_ + (unsigned)(k_ * 2048 + 128 + cc_)), (LAS unsigned*)(lds + OFF_V + (bf) * SHM_V + (wid * 2 + i_) * 1024), 16, 0, 0); } \
        { const int B_ = wid * 1024 + ln_ * 16, row_ = B_ >> 7, c_ = ((B_ & 127) >> 4) ^ (row_ & 7); \
          __builtin_amdgcn_global_load_lds((const unsigned*)(kpp + (size_t)(kb) * 64 + (unsigned)(row_ * 64 + c_ * 8)), (LAS unsigned*)(lds + OFF_KR + (bf) * SHM_KR + wid * 1024), 16, 0, 0); } } while (0)
    LAS float* wsl = (LAS float*)(lds + OFF_WS) + wid * 64; LAS float* li_l = wsl; LAS float* al_l = wsl + 32;
    float m_reg = -1e30f, l_reg = 0.f; f32x16 o[4] = {};
    const int vb0 = (int)(uintptr_t)lds + v_rd_base(lane);
    A_LOAD(0, 0);
    asm volatile("s_waitcnt vmcnt(0)" ::: "memory");
    __syncthreads();
    f32x16 p0, p1; float mn, al; bf16x8 pa0, pa1, pa2, pa3;
#define A_STEP(KB) do { \
        if (t + 1 < NT) A_LOAD((t + 1) * 64, 1 - KB); \
        if (t <= jmax) { qkt<KB>(p0, p1, lds, r32, hi, qr, qrl); partialSM(p0, p1, m_reg, mn, al); \
            if (__any(al < 1.f)) { if (hi == 0) al_l[r32] = al; asm volatile("s_waitcnt lgkmcnt(0)" ::: "memory"); \
                _Pragma("unroll") for (int d_ = 0; d_ < 4; ++d_) _Pragma("unroll") for (int r = 0; r < 16; ++r) o[d_][r] *= al_l[crow(r, hi)]; } \
            finishSM(p0, p1, al, l_reg, pa0, pa1, pa2, pa3); SBAR(); pv_tile<KB>(o, vb0, pa0, pa1, pa2, pa3); } \
        asm volatile("s_waitcnt vmcnt(0)" ::: "memory"); \
        __syncthreads(); } while (0)
    for (int t = 0; t < NT; t += 2) { A_STEP(0); ++t; A_STEP(1); --t; }
#undef A_STEP
#undef A_LOAD
    if (hi == 0) li_l[r32] = l_reg;
    asm volatile("s_waitcnt lgkmcnt(0)" ::: "memory");
    float rli[16];
#pragma unroll
    for (int r = 0; r < 16; ++r) rli[r] = __builtin_amdgcn_rcpf(li_l[crow(r, hi)]);
    bf16* Ow = MIX + (tok0 + P0 + wid * 32) * DM + h * 128;
#pragma unroll
    for (int r = 0; r < 16; ++r) { const int orow = crow(r, hi);
#pragma unroll
        for (int d0 = 0; d0 < 4; ++d0) { const float v = o[d0][r] * rli[r]; const float vn = __shfl_xor(v, 1);
            if ((r32 & 1) == 0) *(unsigned*)(Ow + (size_t)orow * DM + d0 * 32 + r32) = cvt_pk_bf16(v, vn); } }
    __syncthreads();
}
#undef KSWZ
#undef KRSWZ
#undef SBAR
}

__device__ __forceinline__ void phase_attn(const Ctx& C0) {
    const Ctx C = phase_ctx(C0);
    const int x = C.bid & 7, k = C.bid >> 3, per = C.G >> 3;
    for (int u = k; u < 64; u += per) {
        const int bh = x * 8 + (u >> 3), p = u & 7;
        att::attn_block(C, bh >> 3, bh & 7, 15 - p);
        att::attn_block(C, bh >> 3, bh & 7, p);
    }
}

namespace sm {
__device__ __forceinline__ bf16x8 frag_n(const LAS char* base, int S, int x0, int k0, int lane) { return *(const LAS bf16x8*)(base + (x0 + (lane & 15)) * S + (k0 + 8 * (lane >> 4)) * 2); }
__device__ __forceinline__ bf16x8 frag_t(const LAS char* base, int S, int x0, int k0, int lane) {
    const int g = lane >> 4, q = (lane >> 2) & 3, p = lane & 3;
    const LAS char* a = base + (k0 + 8 * g + q) * S + (x0 + 4 * p) * 2;
    const s16x4 lo = __builtin_amdgcn_ds_read_tr16_b64_v4i16((LAS s16x4*)a);
    const s16x4 hi = __builtin_amdgcn_ds_read_tr16_b64_v4i16((LAS s16x4*)(a + 4 * S));
    return (bf16x8){lo[0], lo[1], lo[2], lo[3], hi[0], hi[1], hi[2], hi[3]};
}
__device__ __forceinline__ f32x4 mma(bf16x8 a, bf16x8 b, f32x4 c) { return __builtin_amdgcn_mfma_f32_16x16x32_bf16(a, b, c, 0, 0, 0); }
__device__ __forceinline__ u32x2 pack4(f32x4 v) { u32x2 w; w.x = cvt_pk_bf16(v[0], v[1]); w.y = cvt_pk_bf16(v[2], v[3]); return w; }
__device__ __forceinline__ f32x4 unpack4(u32x2 w) { return (f32x4){bf_lo(w.x), bf_hi(w.x), bf_lo(w.y), bf_hi(w.y)}; }
}

constexpr int H1LD = EVEN_N;

__device__ __forceinline__ void sgu_unit(const Ctx& C, int ei, int unit) {
    const int g4 = unit & 3, blk = (unit >> 2) & 31, b = unit >> 7;
    const int tid = C.tid, lane = C.lane, w = C.wave;
    const bf16* H1 = (const bf16*)(C.ws + WS_ARENA); bf16* MIX = (bf16*)(C.ws + WS_MIX);
    LAS char* Vn = (LAS char*)C.lds; LAS char* Wm = Vn + 34816;
    const size_t t0 = (size_t)b * SEQ + blk * 128;
    const float* lng = C.inp(2) + ei * 512 + g4 * 128; const float* lnb = C.inp(3) + ei * 512 + g4 * 128;
    const float* Wg = C.inp(4) + (size_t)(ei * 4 + g4) * 128 * 128; const float* bs = C.inp(5) + (ei * 4 + g4) * 128;
    { const int l16 = tid & 15; f32x4 ga = *(const f32x4*)(lng + 8 * l16), gb = *(const f32x4*)(lng + 8 * l16 + 4), ba = *(const f32x4*)(lnb + 8 * l16), bb = *(const f32x4*)(lnb + 8 * l16 + 4);
#pragma unroll
      for (int pp = 0; pp < 4; ++pp) { const int j = pp * 32 + (tid >> 4);
        const u32x4 raw = *(const u32x4*)(H1 + (t0 + j) * H1LD + 512 + g4 * 128 + 8 * l16);
        float x[8];
#pragma unroll
        for (int q = 0; q < 4; ++q) { x[2 * q] = bf_lo(raw[q]); x[2 * q + 1] = bf_hi(raw[q]); }
        float s = 0.f;
#pragma unroll
        for (int q = 0; q < 8; ++q) s += x[q];
        s += __shfl_xor(s, 1); s += __shfl_xor(s, 2); s += __shfl_xor(s, 4); s += __shfl_xor(s, 8);
        const float mean = s * (1.f / 128.f); float s2 = 0.f;
#pragma unroll
        for (int q = 0; q < 8; ++q) { x[q] -= mean; s2 += x[q] * x[q]; }
        s2 += __shfl_xor(s2, 1); s2 += __shfl_xor(s2, 2); s2 += __shfl_xor(s2, 4); s2 += __shfl_xor(s2, 8);
        const float rstd = 1.f / sqrtf(s2 * (1.f / 128.f) + LN_EPS);
        u32x4 o; o.x = cvt_pk_bf16(x[0] * rstd * ga[0] + ba[0], x[1] * rstd * ga[1] + ba[1]); o.y = cvt_pk_bf16(x[2] * rstd * ga[2] + ba[2], x[3] * rstd * ga[3] + ba[3]);
        o.z = cvt_pk_bf16(x[4] * rstd * gb[0] + bb[0], x[5] * rstd * gb[1] + bb[1]); o.w = cvt_pk_bf16(x[6] * rstd * gb[2] + bb[2], x[7] * rstd * gb[3] + bb[3]);
        *(LAS u32x4*)(Vn + j * 272 + l16 * 16) = o; } }
#pragma unroll
    for (int q = 0; q < 8; ++q) { const int f = (tid + 512 * q) * 4, i = f >> 7, j = f & 127; const f32x4 wv = *(const f32x4*)(Wg + f);
        *(LAS u32x2*)(Wm + i * 272 + j * 2) = sm::pack4(wv); }
    lds_barrier();
    const int i0 = 16 * w, nks = (w < 4) ? 2 : 4;
    bf16x8 f2[4];
#pragma unroll
    for (int ks = 0; ks < 4; ++ks) f2[ks] = sm::frag_n(Wm, 272, i0, 32 * ks, lane);
    const int i = i0 + (lane & 15), gq = lane >> 4; const float bsi = bs[i];
    const bf16* urow = H1 + (t0 + i) * H1LD + g4 * 128; bf16* orow = MIX + (t0 + i) * DM + g4 * 128;
#pragma unroll
    for (int ct = 0; ct < 8; ++ct) { f32x4 acc = (f32x4){0.f, 0.f, 0.f, 0.f};
#pragma unroll
        for (int ks = 0; ks < 4; ++ks) if (ks < nks) acc = sm::mma(sm::frag_t(Vn, 272, 16 * ct, 32 * ks, lane), f2[ks], acc);
        const int c = 16 * ct + 4 * gq; const f32x4 u = sm::unpack4(*(const u32x2*)(urow + c));
        *(u32x2*)(orow + c) = sm::pack4(u * (acc + bsi)); }
    lds_barrier();
}

namespace gdn {
constexpr int LF = 0, T1 = 17408, T2 = 26624, INM = 35840, VEC = 45056, QS = 46080, KS = 63488, VS = 80896, KDS = 98304, WT = 115712, UT = 133120;
__device__ __forceinline__ float silu(float x) { return x * __builtin_amdgcn_rcpf(1.0f + __expf(-x)); }
__device__ __forceinline__ void prep_unit(const Ctx& C, int ei, int unit) {
    const int n = unit & 63, h = (unit >> 6) & 3, b = unit >> 8;
    const int tid = C.tid, lane = C.lane, w = C.wave;
    LAS char* L = (LAS char*)C.lds;
    LAS float* gcs = (LAS float*)(L + VEC); LAS float* bet = gcs + 64; LAS float* egs = gcs + 128; LAS float* eks = gcs + 192;
    const bf16* H1 = (const bf16*)(C.ws + WS_ARENA);
    const size_t tok0 = (size_t)b * SEQ + n * 64;
    const int chunk = (b * 4 + h) * 64 + n;
    { const int i = tid >> 3, dc = (tid & 7) * 16, pos = n * 64 + i;
      const float* cw = C.inp(6) + (size_t)ei * 4 * 1536;
#pragma unroll 1
      for (int X = 0; X < 3; ++X) {
        float acc[16];
#pragma unroll
        for (int q = 0; q < 16; ++q) acc[q] = 0.f;
        const int chb = X * 512 + h * 128 + dc;
#pragma unroll
        for (int jj = 0; jj < 4; ++jj) { if (pos - 3 + jj >= 0) {
            const bf16* rp = H1 + (tok0 + i - 3 + jj) * H1LD + 1024 + chb;
            const u32x4 r0 = *(const u32x4*)rp, r1 = *(const u32x4*)(rp + 8);
            const float* wp = cw + jj * 1536 + chb; const f32x4 w0 = *(const f32x4*)wp, w1 = *(const f32x4*)(wp + 4), w2 = *(const f32x4*)(wp + 8), w3 = *(const f32x4*)(wp + 12);
            acc[0] += w0[0] * bf_lo(r0[0]); acc[1] += w0[1] * bf_hi(r0[0]); acc[2] += w0[2] * bf_lo(r0[1]); acc[3] += w0[3] * bf_hi(r0[1]);
            acc[4] += w1[0] * bf_lo(r0[2]); acc[5] += w1[1] * bf_hi(r0[2]); acc[6] += w1[2] * bf_lo(r0[3]); acc[7] += w1[3] * bf_hi(r0[3]);
            acc[8] += w2[0] * bf_lo(r1[0]); acc[9] += w2[1] * bf_hi(r1[0]); acc[10] += w2[2] * bf_lo(r1[1]); acc[11] += w2[3] * bf_hi(r1[1]);
            acc[12] += w3[0] * bf_lo(r1[2]); acc[13] += w3[1] * bf_hi(r1[2]); acc[14] += w3[2] * bf_lo(r1[3]); acc[15] += w3[3] * bf_hi(r1[3]); } }
        float ss = 0.f;
#pragma unroll
        for (int q = 0; q < 16; ++q) { acc[q] = silu(acc[q]); ss += acc[q] * acc[q]; }
        float sc = 1.f;
        if (X < 2) { ss += __shfl_xor(ss, 1); ss += __shfl_xor(ss, 2); ss += __shfl_xor(ss, 4); sc = 1.0f / sqrtf(ss + RMS_EPS); if (X == 0) sc *= 0.08838834764831845f; }
        u32x4 o0, o1;
        o0.x = cvt_pk_bf16(acc[0] * sc, acc[1] * sc); o0.y = cvt_pk_bf16(acc[2] * sc, acc[3] * sc); o0.z = cvt_pk_bf16(acc[4] * sc, acc[5] * sc); o0.w = cvt_pk_bf16(acc[6] * sc, acc[7] * sc);
        o1.x = cvt_pk_bf16(acc[8] * sc, acc[9] * sc); o1.y = cvt_pk_bf16(acc[10] * sc, acc[11] * sc); o1.z = cvt_pk_bf16(acc[12] * sc, acc[13] * sc); o1.w = cvt_pk_bf16(acc[14] * sc, acc[15] * sc);
        LAS char* dst = L + (X == 0 ? QS : X == 1 ? KS : VS) + i * 272 + dc * 2;
        *(LAS u32x4*)dst = o0; *(LAS u32x4*)(dst + 16) = o1; } }
    if (w == 0) { const float* AB = (const float*)(C.ws + WS_AB) + (tok0 + lane) * 8;
        const float a = AB[h], bb = AB[4 + h]; const float alog = C.inp(7)[ei * 4 + h], dtb = C.inp(8)[ei * 4 + h];
        const float xs = a + dtb; const float sp = xs > 20.f ? xs : log1pf(__expf(xs));
        float gv = -__expf(alog) * sp;
#pragma unroll
        for (int o = 1; o < 64; o <<= 1) { const float t_ = __shfl_up(gv, o); if (lane >= o) gv += t_; }
        const float gl = __shfl(gv, 63);
        gcs[lane] = gv; bet[lane] = 1.0f / (1.0f + __expf(-bb)); egs[lane] = __expf(gv); eks[lane] = __expf(gl - gv);
        if (lane == 0) ((float*)(C.ws + WS_GAM))[chunk] = __expf(gl); }
    lds_barrier();
    { const int i = tid >> 3, dc = (tid & 7) * 16; const float e = eks[i];
#pragma unroll
      for (int hh = 0; hh < 2; ++hh) { const u32x4 r = *(const LAS u32x4*)(L + KS + i * 272 + dc * 2 + 16 * hh); u32x4 o;
#pragma unroll
        for (int q = 0; q < 4; ++q) o[q] = cvt_pk_bf16(bf_lo(r[q]) * e, bf_hi(r[q]) * e);
        *(LAS u32x4*)(L + KDS + i * 272 + dc * 2 + 16 * hh) = o; } }
#pragma unroll
    for (int q = 0; q < 2; ++q) { const int tt = 2 * w + q, it = tt >> 2, jt = tt & 3;
        if (jt <= it) { f32x4 acc = (f32x4){0.f, 0.f, 0.f, 0.f};
#pragma unroll
            for (int ks = 0; ks < 4; ++ks) acc = sm::mma(sm::frag_n(L + KS, 272, 16 * jt, 32 * ks, lane), sm::frag_n(L + KS, 272, 16 * it, 32 * ks, lane), acc);
            const int i = 16 * it + (lane & 15), j0 = 16 * jt + 4 * (lane >> 4); const float gi = gcs[i], bi = bet[i]; f32x4 o;
#pragma unroll
            for (int r = 0; r < 4; ++r) o[r] = (i > j0 + r) ? bi * acc[r] * __expf(gi - gcs[j0 + r]) : 0.f;
            *(LAS f32x4*)(L + LF + (i * 68 + j0) * 4) = o; } }
    lds_barrier();
    if (w == 0) {
        float t[64];
#pragma unroll
        for (int i = 0; i < 64; ++i) t[i] = 0.f;
#pragma unroll
        for (int i = 0; i < 64; ++i) { float s0 = 0.f, s1 = 0.f, s2 = 0.f, s3 = 0.f;
#pragma unroll
            for (int m = 0; m < i; m += 4) { const f32x4 l = *(const LAS f32x4*)(L + LF + (i * 68 + m) * 4); s0 += l[0] * t[m]; s1 += l[1] * t[m + 1]; s2 += l[2] * t[m + 2]; s3 += l[3] * t[m + 3]; }
            t[i] = ((lane == i) ? 1.f : 0.f) - ((s0 + s1) + (s2 + s3)); }
        const float bj = bet[lane], bej = bj * egs[lane];
#pragma unroll
        for (int i = 0; i < 64; ++i) { *(LAS bf16*)(L + T1 + i * 144 + lane * 2) = f2bf(t[i] * bej); *(LAS bf16*)(L + T2 + i * 144 + lane * 2) = f2bf(t[i] * bj); }
    } else {
        for (int tt = w - 1; tt < 16; tt += 7) { const int it = tt >> 2, jt = tt & 3; f32x4 acc = (f32x4){0.f, 0.f, 0.f, 0.f};
            if (jt <= it) {
#pragma unroll
                for (int ks = 0; ks < 4; ++ks) acc = sm::mma(sm::frag_n(L + KS, 272, 16 * jt, 32 * ks, lane), sm::frag_n(L + QS, 272, 16 * it, 32 * ks, lane), acc); }
            const int i = 16 * it + (lane & 15), j0 = 16 * jt + 4 * (lane >> 4); const float gi = gcs[i]; f32x4 o;
#pragma unroll
            for (int r = 0; r < 4; ++r) o[r] = (i >= j0 + r) ? acc[r] * __expf(gi - gcs[j0 + r]) : 0.f;
            *(LAS u32x2*)(L + INM + i * 144 + j0 * 2) = sm::pack4(o); }
    }
    lds_barrier();
#pragma unroll 1
    for (int q = 0; q < 8; ++q) { const int tt = w * 8 + q, which = tt >> 5, xt = (tt & 31) >> 2, it = tt & 3; f32x4 acc = (f32x4){0.f, 0.f, 0.f, 0.f};
        const LAS char* src = L + (which ? VS : KS); const LAS char* tm = L + (which ? T2 : T1);
#pragma unroll
        for (int ks = 0; ks < 2; ++ks) acc = sm::mma(sm::frag_t(src, 272, 16 * xt, 32 * ks, lane), sm::frag_n(tm, 144, 16 * it, 32 * ks, lane), acc);
        *(LAS u32x2*)(L + (which ? UT : WT) + (16 * it + (lane & 15)) * 272 + (16 * xt + 4 * (lane >> 4)) * 2) = sm::pack4(acc); }
    lds_barrier();
    { bf16* Mg = (bf16*)(C.ws + WS_GM) + (size_t)chunk * 16384; bf16* Bg = (bf16*)(C.ws + WS_GB) + (size_t)chunk * 16384;
      bf16* Cg = (bf16*)(C.ws + WS_GC) + (size_t)chunk * 8192; bf16* Dg = (bf16*)(C.ws + WS_GD) + (size_t)chunk * 8192;
      const int x2 = lane & 15, x1 = 4 * (lane >> 4);
#pragma unroll 1
      for (int q = 0; q < 8; ++q) { const int tt = w * 8 + q, at = tt >> 3, bt = tt & 7;
        f32x4 am = (f32x4){0.f, 0.f, 0.f, 0.f}, ab = (f32x4){0.f, 0.f, 0.f, 0.f};
#pragma unroll
        for (int ks = 0; ks < 2; ++ks) { const bf16x8 fkd_b = sm::frag_t(L + KDS, 272, 16 * bt, 32 * ks, lane), fw = sm::frag_t(L + WT, 272, 16 * at, 32 * ks, lane);
            const bf16x8 fkd_a = sm::frag_t(L + KDS, 272, 16 * at, 32 * ks, lane), fu = sm::frag_t(L + UT, 272, 16 * bt, 32 * ks, lane);
            am = sm::mma(fw, fkd_b, am);
            ab = sm::mma(fkd_a, fu, ab); }
        *(u32x2*)(Mg + (16 * bt + x2) * 128 + 16 * at + x1) = sm::pack4(-am);
        *(u32x2*)(Bg + (16 * bt + x2) * 128 + 16 * at + x1) = sm::pack4(ab); }
#pragma unroll 1
      for (int q = 0; q < 4; ++q) { const int tt = w * 4 + q, at = tt >> 2, it = tt & 3;
        f32x4 ac = (f32x4){0.f, 0.f, 0.f, 0.f}, ad = (f32x4){0.f, 0.f, 0.f, 0.f};
#pragma unroll
        for (int ks = 0; ks < 2; ++ks) { const bf16x8 fin = sm::frag_n(L + INM, 144, 16 * it, 32 * ks, lane);
            ac = sm::mma(sm::frag_t(L + WT, 272, 16 * at, 32 * ks, lane), fin, ac);
            ad = sm::mma(sm::frag_t(L + UT, 272, 16 * at, 32 * ks, lane), fin, ad); }
        const int i = 16 * it + x2, d = 16 * at + x1; const f32x4 qv = sm::unpack4(*(const LAS u32x2*)(L + QS + i * 272 + d * 2));
        *(u32x2*)(Cg + i * 128 + d) = sm::pack4(qv * egs[i] - ac);
        *(u32x2*)(Dg + i * 128 + d) = sm::pack4(ad); } }
#ifdef DBG_DUMP
    { unsigned char* dst = C.ws + WS_HID + (size_t)chunk * 150528; for (int o = tid * 16; o < 150528; o += 512 * 16) *(u32x4*)(dst + o) = *(const LAS u32x4*)(L + o); }
#endif
    lds_barrier();
}

__device__ __forceinline__ void scan_unit(const Ctx& C, int unit) {
    const int cs = unit & 7, bh = unit >> 3;
    const int lane = C.lane, w = C.wave, x2 = lane & 15, g = lane >> 4;
    LAS char* ST = (LAS char*)C.lds;
    const bf16* Mg = (const bf16*)(C.ws + WS_GM) + (size_t)bh * 64 * 16384; const bf16* Bg = (const bf16*)(C.ws + WS_GB) + (size_t)bh * 64 * 16384;
    bf16* Sg = (bf16*)(C.ws + WS_GS) + (size_t)bh * 64 * 16384; const float* GAM = (const float*)(C.ws + WS_GAM) + bh * 64;
    const int c = cs * 16 + x2, d0 = 16 * w + 4 * g;
    { unsigned zz = 0u; asm volatile("" : "+v"(zz));
      if (C.tid < 272) *(LAS u32x4*)(ST + C.tid * 16) = (u32x4){zz, zz, zz, zz}; }
    __syncthreads();
    f32x4 acc = (f32x4){0.f, 0.f, 0.f, 0.f};
    const bf16* mrow = Mg + (16 * w + x2) * 128 + 8 * g; const bf16* brow = Bg + c * 128 + d0; bf16* srow = Sg + c * 128 + d0;
    int zl = 0; asm volatile("" : "+v"(zl));
    const float* gamp = GAM + zl;
    bf16x8 fm0[4], fm1[4], fm2[4], fm3[4]; u32x2 bv0, bv1, bv2, bv3; float gm0, gm1, gm2, gm3;
#define SC_LOAD(FM, BV, GM, n_) do { _Pragma("unroll") for (int ks = 0; ks < 4; ++ks) FM[ks] = *(const bf16x8*)(mrow + (size_t)(n_) * 16384 + 32 * ks); \
        BV = *(const u32x2*)(brow + (size_t)(n_) * 16384); GM = gamp[n_]; } while (0)
#define SC_STEP(FM, BV, GM, n_) do { \
        *(u32x2*)(srow + (size_t)(n_) * 16384) = sm::pack4(acc);            \
        f32x4 a_ = acc * GM + sm::unpack4(BV); const LAS char* sb_ = ST + ((n_) & 1) * 4352; \
        _Pragma("unroll") for (int ks = 0; ks < 4; ++ks) a_ = sm::mma(FM[ks], sm::frag_n(sb_, 272, 0, 32 * ks, lane), a_); \
        acc = a_; *(LAS u32x2*)(ST + (((n_) + 1) & 1) * 4352 + x2 * 272 + d0 * 2) = sm::pack4(acc); \
        if ((n_) + 4 < 64) SC_LOAD(FM, BV, GM, (n_) + 4); \
        lds_barrier(); } while (0)
    SC_LOAD(fm0, bv0, gm0, 0); SC_LOAD(fm1, bv1, gm1, 1); SC_LOAD(fm2, bv2, gm2, 2); SC_LOAD(fm3, bv3, gm3, 3);
#pragma unroll 1
    for (int n = 0; n < 64; n += 4) { SC_STEP(fm0, bv0, gm0, n); SC_STEP(fm1, bv1, gm1, n + 1); SC_STEP(fm2, bv2, gm2, n + 2); SC_STEP(fm3, bv3, gm3, n + 3); }
#undef SC_LOAD
#undef SC_STEP
}

__device__ __forceinline__ void out_unit(const Ctx& C, int ei, int unit) {
    const int pr = unit & 31, h = (unit >> 5) & 3, b = unit >> 7;
    const int lane = C.lane, w = C.wave, x2 = lane & 15, g = lane >> 4;
    const int n = 2 * pr + (w >> 2), it = w & 3, chunk = (b * 4 + h) * 64 + n;
    const bf16* Sg = (const bf16*)(C.ws + WS_GS) + (size_t)chunk * 16384; const bf16* Cg = (const bf16*)(C.ws + WS_GC) + (size_t)chunk * 8192; const bf16* Dg = (const bf16*)(C.ws + WS_GD) + (size_t)chunk * 8192;
    const bf16* H1 = (const bf16*)(C.ws + WS_ARENA); bf16* MIX = (bf16*)(C.ws + WS_MIX);
    const int i = 16 * it + x2; const size_t tok = (size_t)b * SEQ + n * 64 + i;
    bf16x8 fc[4];
#pragma unroll
    for (int ks = 0; ks < 4; ++ks) fc[ks] = *(const bf16x8*)(Cg + i * 128 + 32 * ks + 8 * g);
    f32x4 o[8]; float ss = 0.f;
#pragma unroll
    for (int ct = 0; ct < 8; ++ct) { f32x4 a = sm::unpack4(*(const u32x2*)(Dg + i * 128 + 16 * ct + 4 * g));
#pragma unroll
        for (int ks = 0; ks < 4; ++ks) a = sm::mma(*(const bf16x8*)(Sg + (16 * ct + x2) * 128 + 32 * ks + 8 * g), fc[ks], a);
        o[ct] = a; ss += (a[0] * a[0] + a[1] * a[1]) + (a[2] * a[2] + a[3] * a[3]); }
    ss += __shfl_xor(ss, 16); ss += __shfl_xor(ss, 32);
    const float rstd = 1.0f / sqrtf(ss * (1.f / 128.f) + RMS_EPS);
    const float* nw = C.inp(9) + ei * 128; const bf16* zrow = H1 + tok * H1LD + 2560 + h * 128; bf16* orow = MIX + tok * DM + 512 + h * 128;
#pragma unroll
    for (int ct = 0; ct < 8; ++ct) { const int c = 16 * ct + 4 * g; const f32x4 z = sm::unpack4(*(const u32x2*)(zrow + c)); const f32x4 nv = *(const f32x4*)(nw + c); f32x4 y;
#pragma unroll
        for (int r = 0; r < 4; ++r) y[r] = o[ct][r] * rstd * nv[r] * silu(z[r]);
        *(u32x2*)(orow + c) = sm::pack4(y); }
}
}

__device__ __forceinline__ void phase_even_local(const Ctx& C0, int ei) {
    { const Ctx C = phase_ctx(C0); for (int u = C.bid; u < 1024; u += C.G) sgu_unit(C, ei, u); }
    { const Ctx C = phase_ctx(C0); for (int u = C.bid; u < 2048; u += C.G) gdn::prep_unit(C, ei, u); }
}
__device__ __forceinline__ void phase_scan(const Ctx& C0) { const Ctx C = phase_ctx(C0);
    for (int v = C.bid; v < 256; v += C.G) { const int x = v & 7, k = v >> 3, u = ((x * 4 + (k >> 3)) << 3) | (k & 7); gdn::scan_unit(C, u); __syncthreads(); } }
__device__ __forceinline__ void phase_gdn_out(const Ctx& C0, int ei) { const Ctx C = phase_ctx(C0); for (int u = C.bid; u < 1024; u += C.G) gdn::out_unit(C, ei, u); }

#ifndef MK_PER_PHASE
#define MK_PER_PHASE 0
#endif
constexpr int N_PHASES = 1 + DEPTH * 9;
#ifndef PH_EN
#define PH_EN 0x7fff
#endif
#define PEN(k) ((PH_EN >> (k)) & 1)
#ifndef MK_REP
#define MK_REP -1
#endif
#define REPF(k) for (int r_ = 0; r_ < ((MK_REP == (k)) ? 2 : 1); ++r_)
struct Args { const float* in[27]; float* out; unsigned char* ws; int ph_lo, ph_hi; };

__global__ void __launch_bounds__(NWAVES * 64, 2) mk_fwd(Args args) {
    extern __shared__ __attribute__((aligned(16))) unsigned char lds_raw[];
    Ctx C;
    C.lds = (LAS unsigned char*)lds_raw;
    C.tid = threadIdx.x; C.lane = C.tid & 63; C.wave = __builtin_amdgcn_readfirstlane(C.tid >> 6); C.G = gridDim.x; C.bid = blockIdx.x;
    C.ka = (const __attribute__((address_space(4))) char*)__builtin_amdgcn_kernarg_segment_ptr();
    C.out = nullptr; C.ws = nullptr; C.ctl = nullptr;
    for (int u = C.tid; u < 128; u += NWAVES * 64) ((LAS unsigned*)(C.lds + LDS_CTL_OFF))[u] = 0u;
    __syncthreads();
#if !MK_PER_PHASE
    { const Ctx P = phase_ctx(C); (void)xcd_barrier_post((unsigned*)P.ws + CW_BAR, (volatile LAS unsigned*)(C.lds + LDS_CTL_OFF) + 8); }
#define GRID_BAR() do { const Ctx P_ = phase_ctx(C); XcdBarrier b_; b_.bar = (unsigned*)P_.ws + CW_BAR; b_.x = xb_xcc_id(); b_.st = (volatile LAS unsigned*)(C.lds + LDS_CTL_OFF) + 8; xcd_barrier(b_); } while (0)
#else
#define GRID_BAR() do {} while (0)
#endif
    const int lo = args.ph_lo, hi = args.ph_hi;
#define IN(k) (lo <= (k) && (k) < hi)
#define SEAM(k) do { if (IN((k) + 1)) GRID_BAR(); } while (0)
    if (PEN(0) && IN(0)) { REPF(0) phase_prologue(C); SEAM(0); }
#define MK_LAYER(L) { \
        const int pb = 1 + L * 9, li = L >> 1; \
        if ((L & 1) == 0) { \
            if (PEN(1) && IN(pb + 0)) { \
                const Ctx P = phase_ctx(C); unsigned char* ws = P.ws; \
                EpiBf16 E{(bf16*)(ws + WS_ARENA), EVEN_N, 1024}; \
                REPF(1) run_plain_gemm(P, (const bf16*)(ws + WS_XB), DM, DM, EVEN_N, (const bf16*)(ws + WS_WEIN) + (size_t)li * EVEN_N * DM, E); \
                SEAM(pb + 0); } \
            if (PEN(2) && IN(pb + 1)) { REPF(2) phase_even_local(C, li); SEAM(pb + 1); } \
            if (PEN(3) && IN(pb + 2)) { REPF(3) phase_scan(C); SEAM(pb + 2); } \
            if (PEN(4) && IN(pb + 3)) { REPF(4) phase_gdn_out(C, li); SEAM(pb + 3); } \
            if (PEN(5) && IN(pb + 4)) { \
                const Ctx P = phase_ctx(C); unsigned char* ws = P.ws; \
                EpiRes E{(const bf16*)(ws + WS_XB), (bf16*)(ws + WS_Y)}; \
                REPF(5) run_plain_gemm(P, (const bf16*)(ws + WS_MIX), DM, DM, DM, (const bf16*)(ws + WS_WEOUT) + (size_t)li * DM * DM, E); \
                SEAM(pb + 4); } \
        } else { \
            if (PEN(6) && IN(pb + 0)) { \
                const Ctx P = phase_ctx(C); unsigned char* ws = P.ws; \
                EpiBf16 E{(bf16*)(ws + WS_ARENA + AR_C1), ODD_N, 0}; \
                REPF(6) run_plain_gemm(P, (const bf16*)(ws + WS_XB), DM, DM, ODD_N, (const bf16*)(ws + WS_WOIN) + (size_t)li * ODD_N * DM, E); \
                SEAM(pb + 0); } \
            if (PEN(7) && IN(pb + 1)) { REPF(7) phase_o1b(C); SEAM(pb + 1); } \
            if (PEN(8) && IN(pb + 2)) { \
                { const Ctx P = phase_ctx(C); unsigned char* ws = P.ws; \
                  EpiQ E{(bf16*)(ws + WS_ARENA + AR_Q), (const float*)(ws + WS_RS), (const f32x4*)(ws + WS_ROPE)}; \
                  REPF(8) run_plain_gemm(P, (const bf16*)(ws + WS_ARENA + AR_C1), ODD_N, QL, 1536, (const bf16*)(ws + WS_WUQ) + (size_t)li * 1536 * QL, E); } \
                { const Ctx P = phase_ctx(C); unsigned char* ws = P.ws; \
                  EpiKV E{(bf16*)(ws + WS_ARENA + AR_KV), (const float*)(ws + WS_RS) + T}; \
                  REPF(8) run_plain_gemm(P, (const bf16*)(ws + WS_ARENA + AR_C1) + QL, ODD_N, KVL, 2048, (const bf16*)(ws + WS_WUKV) + (size_t)li * 2048 * KVL, E); } \
                SEAM(pb + 2); } \
            if (PEN(9) && IN(pb + 3)) { REPF(9) phase_attn(C); SEAM(pb + 3); } \
            if (PEN(10) && IN(pb + 4)) { \
                const Ctx P = phase_ctx(C); unsigned char* ws = P.ws; \
                EpiRes E{(const bf16*)(ws + WS_XB), (bf16*)(ws + WS_Y)}; \
                REPF(10) run_plain_gemm(P, (const bf16*)(ws + WS_MIX), DM, DM, DM, (const bf16*)(ws + WS_WOOUT) + (size_t)li * DM * DM, E); \
                SEAM(pb + 4); } \
        } \
        if (PEN(11) && IN(pb + 5)) { phase_router(C, L); SEAM(pb + 5); } \
        if (PEN(12) && IN(pb + 6)) { \
            const Ctx P = phase_ctx(C); unsigned char* ws = P.ws; \
            EpiSwiglu E{(bf16*)(ws + WS_HID), P.inp(24) + (size_t)L * NEXP * 2048, nullptr}; \
            REPF(12) run_moe_gemm(P, L, (const bf16*)(ws + WS_XB), DM, 2, DM, 2048, (const bf16*)(ws + WS_WGU) + (size_t)L * NEXP * 2048 * DM, (size_t)2048 * DM, E); \
            SEAM(pb + 6); } \
        if (PEN(13) && IN(pb + 7)) { \
            const Ctx P = phase_ctx(C); unsigned char* ws = P.ws; \
            EpiDown E{(bf16*)(ws + WS_YE), P.inp(26) + (size_t)L * NEXP * DM, (const float*)(ws + WS_GATE), nullptr}; \
            REPF(13) run_moe_gemm(P, L, (const bf16*)(ws + WS_HID), DFF, 0, DFF, DM, (const bf16*)(ws + WS_WDN) + (size_t)L * NEXP * DM * DFF, (size_t)DM * DFF, E); \
            SEAM(pb + 7); } \
        if (PEN(14) && IN(pb + 8)) { phase_combine(C, L); SEAM(pb + 8); } \
    }
    MK_LAYER(0) MK_LAYER(1) MK_LAYER(2) MK_LAYER(3)
#undef MK_LAYER
#undef IN
#undef SEAM
}

extern "C" void kernel_launch(void* const* d_in, const int* in_sizes, int n_in, void* d_out, int out_size, void* d_ws, size_t ws_size, hipStream_t stream) {
    static int grid = 0;
    if (grid == 0) {
        if (n_in != 27 || in_sizes[0] != T * DM || out_size != T * DM || ws_size < WS_END) { fprintf(stderr, "kernel_launch: unexpected shapes (n_in %d, in0 %d, out %d, ws %zu)\n", n_in, n_in > 0 ? in_sizes[0] : -1, out_size, ws_size); grid = -1; return; }
        int dev = 0, cus = 0, per_cu = 0;
        if (hipGetDevice(&dev) != hipSuccess || hipDeviceGetAttribute(&cus, hipDeviceAttributeMultiprocessorCount, dev) != hipSuccess) { grid = -1; return; }
        if (hipFuncSetAttribute((const void*)mk_fwd, hipFuncAttributeMaxDynamicSharedMemorySize, LDS_BYTES) != hipSuccess) { fprintf(stderr, "kernel_launch: hipFuncSetAttribute failed\n"); grid = -1; return; }
        if (hipOccupancyMaxActiveBlocksPerMultiprocessor(&per_cu, (const void*)mk_fwd, NWAVES * 64, LDS_BYTES) != hipSuccess || per_cu < 1) fprintf(stderr, "kernel_launch: occupancy query reports %d\n", per_cu);
        (void)hipGetLastError();
        grid = cus;
        if (grid != 256) fprintf(stderr, "kernel_launch: %d CUs (built for 256)\n", grid);
    }
    if (grid < 0) return;
    if (hipMemsetAsync((char*)d_ws + WS_CTL, 0, CTL_ZERO_BYTES, stream) != hipSuccess) return;
    Args a{};
    for (int i = 0; i < 27; ++i) a.in[i] = (const float*)d_in[i];
    a.out = (float*)d_out; a.ws = (unsigned char*)d_ws;
#if MK_PER_PHASE
    for (int p = 0; p < N_PHASES; ++p) { a.ph_lo = p; a.ph_hi = p + 1; hipLaunchKernelGGL(mk_fwd, dim3(grid), dim3(NWAVES * 64), LDS_BYTES, stream, a); }
#else
    a.ph_lo = 0; a.ph_hi = N_PHASES;
    hipLaunchKernelGGL(mk_fwd, dim3(grid), dim3(NWAVES * 64), LDS_BYTES, stream, a);
#endif
    const hipError_t le = hipPeekAtLastError();
    if (le != hipSuccess) fprintf(stderr, "kernel_launch: launch failed: %s\n", hipGetErrorName(le));
}
```

```cpp
#define MK_PER_PHASE 0
#include <hip/hip_runtime.h>
#include <cstdio>
#include <cstdint>

#define GAS __attribute__((address_space(1)))
#define LAS __attribute__((address_space(3)))
typedef unsigned short bf16;
typedef short bf16x8 __attribute__((ext_vector_type(8)));
typedef short s16x4 __attribute__((ext_vector_type(4)));
typedef float f32x2 __attribute__((ext_vector_type(2)));
typedef float f32x4 __attribute__((ext_vector_type(4)));
typedef float f32x16 __attribute__((ext_vector_type(16)));
typedef unsigned u32x2 __attribute__((ext_vector_type(2)));
typedef unsigned u32x4 __attribute__((ext_vector_type(4)));
typedef GAS unsigned gu32;

typedef __bf16 bf16v2_t __attribute__((ext_vector_type(2)));
__device__ __forceinline__ unsigned cvt_pk_bf16(float lo, float hi) { const bf16v2_t v = __builtin_convertvector((f32x2){lo, hi}, bf16v2_t); return __builtin_bit_cast(unsigned, v); }
__device__ __forceinline__ float bf_lo(unsigned w) { return __uint_as_float(w << 16); }
__device__ __forceinline__ float bf_hi(unsigned w) { return __uint_as_float(w & 0xffff0000u); }
__device__ __forceinline__ float bf2f(bf16 b) { return __uint_as_float(((unsigned)b) << 16); }
__device__ __forceinline__ bf16 f2bf(float f) { return (bf16)(cvt_pk_bf16(f, 0.f) & 0xffffu); }
__device__ __forceinline__ float wave_sum(float v) {
#pragma unroll
    for (int o = 1; o < 64; o <<= 1) v += __shfl_xor(v, o);
    return v;
}

namespace pg8 {
constexpr int BM = 256, BK = 64, HALF = 128, HTB = HALF * BK * 2, STAGE_BYTES = 8 * HTB, NXCD = 8, WGM = 8;
__host__ __device__ __forceinline__ int lds_byte(int r, int c) { const int st = (r >> 4) * 2 + (c >> 5), rr = r & 15, cc = c & 31, ob = rr * 64 + cc * 2; return st * 1024 + (ob ^ (((ob >> 9) & 1) << 5)); }
__host__ __device__ __forceinline__ void stage_rc(int b, int& R, int& C) { const int st = b / 1024, sb = b % 1024, swz = sb ^ (((sb >> 9) & 1) << 5); R = (st >> 1) * 16 + swz / 64; C = (st & 1) * 32 + (swz % 64) / 2; }
__host__ __device__ __forceinline__ int perm32(int rho) { const int n = rho >> 4, i = rho & 15; return 8 * (i >> 2) + 4 * n + (i & 3); }

struct Unit { int pm, pn, e, li; };

struct StaticOrder {
    int nM, nN, nwg, G, c;
    __device__ void init(int M, int N, int G_, int c_) { nM = M / BM; nN = N / BM; nwg = nM * nN; G = G_; c = c_; }
    __device__ bool next(int i, Unit& u) const {
        const long L = (long)i * G + c; if (L >= nwg) return false;
        int wgid = (int)L; { const int q = nwg / NXCD, r = nwg % NXCD, xcd = wgid % NXCD, off = wgid / NXCD; wgid = (xcd < r ? xcd * (q + 1) : r * (q + 1) + (xcd - r) * q) + off; }
        const int nig = WGM * nN, gid = wgid / nig, fm = gid * WGM, gsz = (nM - fm) < WGM ? (nM - fm) : WGM;
        u.pm = fm + ((wgid % nig) % gsz); u.pn = (wgid % nig) / gsz; u.e = 0; u.li = 0; return true;
    }
};
struct PlainSched {
    static constexpr bool GATHER = false;
    StaticOrder o; const char* Bt; int K; int lda;
    __device__ __forceinline__ size_t arow0(const Unit& u) const { return (size_t)u.pm * BM * lda * 2; }
    __device__ __forceinline__ bool next(int i, Unit& u) const { return o.next(i, u); }
    __device__ __forceinline__ const char* bbase(const Unit& u) const { return Bt + (size_t)u.pn * BM * K * 2; }
};

__device__ __forceinline__ f32x2 gelu_pk(f32x2 v) {
    const f32x2 av = __builtin_elementwise_abs(v), d = av * 0.2316418882f + 1.0f;
    f32x2 t; t.x = __builtin_amdgcn_rcpf(d.x); t.y = __builtin_amdgcn_rcpf(d.y);
    f32x2 q = t * 0.5307027145f + (-0.7265760135f); q = q * t + 0.7107068705f; q = q * t + (-0.142248368f); q = q * t + 0.127414796f; q = q * t;
    const f32x2 s = (v * v) * (-0.72134752044f);
    f32x2 e; e.x = __builtin_amdgcn_exp2f(s.x); e.y = __builtin_amdgcn_exp2f(s.y);
    const f32x2 m = v * (q * e), r = v - m;
    f32x2 o; o.x = v.x < 0.f ? m.x : r.x; o.y = v.y < 0.f ? m.y : r.y; return o;
}

template <class Epi, class Sched, bool ALIGN_EPI>
__device__ __forceinline__ void gemm_phase(LAS unsigned char* lds, const char* Abase, int K, const Sched& S, const Epi& E) {
    int tid_ = threadIdx.x; asm volatile("" : "+v"(tid_));
    const int tid = tid_, wid = __builtin_amdgcn_readfirstlane(tid >> 6), lane = tid & 63, wr = wid >> 2, wc = wid & 3, fr = lane & 15, fq = lane >> 4;
    int nt = K / BK; asm volatile("" : "+s"(nt));
    int Rr[2], Cc[2]; unsigned voffB[2], voffA[2];
#pragma unroll
    for (int i = 0; i < 2; ++i) { stage_rc(tid * 16 + i * 8192, Rr[i], Cc[i]); const int Rb = Epi::PERM ? ((Rr[i] & ~31) + perm32(Rr[i] & 31)) : Rr[i]; voffB[i] = (unsigned)(Rb * K + Cc[i]) * 2u;
        voffA[i] = 0u; if constexpr (!Sched::GATHER) voffA[i] = (unsigned)(Rr[i] * S.lda + Cc[i]) * 2u; }
    const size_t hstepA = (size_t)HALF * S.lda * 2;
    const size_t kstep = (size_t)(BK * 2);
    const size_t hstepB = (size_t)HALF * K * 2;
    const unsigned ldsw = (unsigned)wid * 1024u;
    const int aoff = lds_byte(wr * 64 + fr, fq * 8), boff = lds_byte(wc * 32 + fr, fq * 8);
#define PG8_SA(b, h) (((b) * 2 + (h)) * HTB)
#define PG8_SB(b, h) ((4 + (b) * 2 + (h)) * HTB)
#define PG8_STAGEB(bufoff, gbase) do { _Pragma("unroll") for (int _i = 0; _i < 2; ++_i) \
        __builtin_amdgcn_global_load_lds((const unsigned*)((const char*)(gbase) + voffB[_i]), (LAS unsigned*)(lds + (bufoff) + ldsw + _i * 8192), 16, 0, 0); } while (0)
#define PG8_STAGEA(bufoff, h, koff) do { _Pragma("unroll") for (int _i = 0; _i < 2; ++_i) { \
        if constexpr (Sched::GATHER) __builtin_amdgcn_global_load_lds((const unsigned*)(Abase + (size_t)va[h][_i] + (koff)), (LAS unsigned*)(lds + (bufoff) + ldsw + _i * 8192), 16, 0, 0); \
        else __builtin_amdgcn_global_load_lds((const unsigned*)(cA + (h) * hstepA + (koff) + voffA[_i]), (LAS unsigned*)(lds + (bufoff) + ldsw + _i * 8192), 16, 0, 0); } } while (0)
#define PG8_LDA(dst, b, h) do { _Pragma("unroll") for (int m = 0; m < 4; ++m) _Pragma("unroll") for (int k = 0; k < 2; ++k) dst[m][k] = *(const LAS bf16x8*)(lds + PG8_SA(b, h) + aoff + m * 2048 + k * 1024); } while (0)
#define PG8_LDB(dst, b, h) do { _Pragma("unroll") for (int n = 0; n < 2; ++n) _Pragma("unroll") for (int k = 0; k < 2; ++k) dst[n][k] = *(const LAS bf16x8*)(lds + PG8_SB(b, h) + boff + n * 2048 + k * 1024); } while (0)
#define PG8_MMA(ai, bj, At, Bt) do { __builtin_amdgcn_s_setprio(1); _Pragma("unroll") for (int m = 0; m < 4; ++m) _Pragma("unroll") for (int n = 0; n < 2; ++n) _Pragma("unroll") for (int k = 0; k < 2; ++k) \
        acc[ai][bj][m][n] = __builtin_amdgcn_mfma_f32_16x16x32_bf16(Bt[n][k], At[m][k], acc[ai][bj][m][n], 0, 0, 0); __builtin_amdgcn_s_setprio(0); } while (0)
#define PG8_WAIT_V(n) asm volatile("s_waitcnt vmcnt(" #n ")" ::: "memory")
#define PG8_WAIT_L(n) asm volatile("s_waitcnt lgkmcnt(" #n ")" ::: "memory")
#define PG8_BAR __builtin_amdgcn_s_barrier()
#define PG8_SCHED __builtin_amdgcn_sched_barrier(0)
    Unit cur, nxt; int ui = 0;
    if (!S.next(0, cur)) return;
    f32x4 acc[2][2][4][2];
#pragma unroll
    for (int a = 0; a < 2; ++a)
#pragma unroll
        for (int b = 0; b < 2; ++b)
#pragma unroll
            for (int m = 0; m < 4; ++m)
#pragma unroll
                for (int n = 0; n < 2; ++n) acc[a][b][m][n] = (f32x4){0.f, 0.f, 0.f, 0.f};
    bf16x8 At[4][2], B0[2][2], B1[2][2];
    unsigned va[2][2], vn[2][2]; const char* cA = Abase; const char* nA = Abase;
    if constexpr (Sched::GATHER) {
#pragma unroll
        for (int h = 0; h < 2; ++h)
#pragma unroll
            for (int i = 0; i < 2; ++i) va[h][i] = S.aoff(cur, h * HALF + Rr[i]) + (unsigned)Cc[i] * 2u;
    } else { cA = Abase + S.arow0(cur); }
    const char* cB = S.bbase(cur);
    PG8_STAGEB(PG8_SB(0, 0), cB); PG8_STAGEB(PG8_SB(0, 1), cB + hstepB); PG8_STAGEA(PG8_SA(0, 0), 0, 0); PG8_STAGEA(PG8_SA(0, 1), 1, 0);
    if (wr == 1) PG8_BAR;
    PG8_WAIT_V(2); PG8_BAR;
    PG8_STAGEB(PG8_SB(1, 0), cB + kstep); PG8_STAGEA(PG8_SA(1, 0), 0, kstep); PG8_STAGEB(PG8_SB(1, 1), cB + hstepB + kstep);
    PG8_WAIT_V(6); PG8_BAR;
    for (;;) {
        const bool has_next = S.next(ui + 1, nxt);
        const char* nB = has_next ? S.bbase(nxt) : cB;
        if constexpr (Sched::GATHER) {
            if (has_next) {
#pragma unroll
                for (int h = 0; h < 2; ++h)
#pragma unroll
                    for (int i = 0; i < 2; ++i) vn[h][i] = S.aoff(nxt, h * HALF + Rr[i]) + (unsigned)Cc[i] * 2u;
            } else {
#pragma unroll
                for (int h = 0; h < 2; ++h)
#pragma unroll
                    for (int i = 0; i < 2; ++i) vn[h][i] = va[h][i];
            }
        } else { nA = has_next ? Abase + S.arow0(nxt) : cA; }
        for (int t = 0; t < nt; t += 2) {
            const bool last = (t == nt - 2);
            const size_t k1 = (size_t)(t + 1) * kstep;
            PG8_LDB(B0, 0, 0); PG8_LDB(B1, 0, 1); PG8_SCHED; PG8_LDA(At, 0, 0); PG8_STAGEA(PG8_SA(1, 1), 1, k1);
            PG8_WAIT_V(8); PG8_WAIT_L(0); PG8_BAR; PG8_MMA(0, 0, At, B0); PG8_MMA(0, 1, At, B1); PG8_BAR; PG8_SCHED;
            if (last) {
                if constexpr (Sched::GATHER) {
#pragma unroll
                    for (int h = 0; h < 2; ++h)
#pragma unroll
                        for (int i = 0; i < 2; ++i) va[h][i] = vn[h][i];
                } else { cA = nA; }
            }
            const char* bX = last ? nB : cB;
            const size_t k2 = last ? (size_t)0 : (size_t)(t + 2) * kstep, k3 = k2 + kstep;
            PG8_LDA(At, 0, 1); PG8_STAGEB(PG8_SB(0, 0), bX + k2); PG8_STAGEB(PG8_SB(0, 1), bX + hstepB + k2); PG8_STAGEA(PG8_SA(0, 0), 0, k2);
            PG8_WAIT_V(8); PG8_WAIT_L(0); PG8_BAR; PG8_MMA(1, 0, At, B0); PG8_MMA(1, 1, At, B1); PG8_BAR; PG8_SCHED;
            PG8_LDB(B0, 1, 0); PG8_LDB(B1, 1, 1); PG8_SCHED; PG8_LDA(At, 1, 0); PG8_STAGEA(PG8_SA(0, 1), 1, k2);
            PG8_WAIT_V(8); PG8_WAIT_L(0); PG8_BAR; PG8_MMA(0, 0, At, B0); PG8_MMA(0, 1, At, B1); PG8_BAR; PG8_SCHED;
            PG8_LDA(At, 1, 1); PG8_STAGEB(PG8_SB(1, 0), bX + k3); PG8_STAGEB(PG8_SB(1, 1), bX + hstepB + k3); PG8_STAGEA(PG8_SA(1, 0), 0, k3);
            PG8_WAIT_V(8); PG8_WAIT_L(0); PG8_BAR; PG8_MMA(1, 0, At, B0); PG8_MMA(1, 1, At, B1); PG8_BAR; PG8_SCHED;
        }
        if constexpr (ALIGN_EPI) { if (wr == 0) PG8_BAR; }
        E(acc, cur, wr, wc, fr, fq);
        if (!has_next) break;
#pragma unroll
        for (int a = 0; a < 2; ++a)
#pragma unroll
            for (int b = 0; b < 2; ++b)
#pragma unroll
                for (int m = 0; m < 4; ++m)
#pragma unroll
                    for (int n = 0; n < 2; ++n) acc[a][b][m][n] = (f32x4){0.f, 0.f, 0.f, 0.f};
        cur = nxt; cB = nB; ++ui;
        if constexpr (ALIGN_EPI) { if (wr == 1) PG8_BAR; }
    }
    PG8_WAIT_V(0);
    if constexpr (!ALIGN_EPI) { if (wr == 0) PG8_BAR; }
    PG8_BAR;
#undef PG8_SA
#undef PG8_SB
#undef PG8_STAGEA
#undef PG8_STAGEB
#undef PG8_LDA
#undef PG8_LDB
#undef PG8_MMA
#undef PG8_WAIT_V
#undef PG8_WAIT_L
#undef PG8_BAR
#undef PG8_SCHED
}
}

constexpr int NWAVES = 8;
constexpr int BATCH = 8, SEQ = 4096, DM = 1024, DEPTH = 4;
constexpr int T = BATCH * SEQ;
constexpr int EVEN_IN = 3080, EVEN_N = 3072;
constexpr int ODD_IN = 704, ODD_N = 768, QL = 384, KVL = 256;
constexpr int NEXP = 32, TOPK = 4, DFF = 1024;
constexpr int NSLOT = T * TOPK;
constexpr int LCAP = T;
constexpr float LN_EPS = 1e-5f, RMS_EPS = 1e-6f;
constexpr float DN_ALPHA = 1.681792830507429f;
constexpr float ATT_SCALE = 0.07216878364870323f;

constexpr size_t MiB = 1u << 20;
constexpr size_t WS_CTL = 0, CTL_ZERO_BYTES = 1 * MiB;
constexpr size_t WS_WGU = 16 * MiB, WS_WDN = 528 * MiB, WS_WEIN = 784 * MiB, WS_WEOUT = 796 * MiB, WS_WOIN = 800 * MiB, WS_WUQ = 804 * MiB, WS_WUKV = 808 * MiB, WS_WOOUT = 810 * MiB;
constexpr size_t WS_ROPE = 814 * MiB, WS_AB = 815 * MiB, WS_RS = 816 * MiB, WS_GATE = 817 * MiB, WS_LIST = 818 * MiB, WS_GAM = 822 * MiB;
constexpr size_t WS_XF = 832 * MiB, WS_XB = 960 * MiB, WS_Y = 1024 * MiB, WS_ARENA = 1152 * MiB, WS_MIX = 1440 * MiB;
constexpr size_t WS_GM = 1504 * MiB, WS_GB = 1568 * MiB, WS_GC = 1632 * MiB, WS_GD = 1664 * MiB, WS_GS = 1696 * MiB, WS_HID = 1760 * MiB, WS_YE = 2016 * MiB, WS_END = 2272 * MiB;
constexpr size_t AR_C1 = 0, AR_Q = 48 * MiB, AR_KV = 144 * MiB, AR_KPE = 272 * MiB;
constexpr int CW_TMO = 0, CW_CODE = 1, CW_BAR = 4096, CW_CNT = 16384;

constexpr int LDS_BYTES = 163840;
constexpr int LDS_CTL_OFF = 163840 - 512;
constexpr int LDS_SPARE = 131072;

#define RLX_AGENT __ATOMIC_RELAXED, __HIP_MEMORY_SCOPE_AGENT
#define LDS_WAIT() asm volatile("s_waitcnt lgkmcnt(0)" ::: "memory")
#define VM_WAIT() asm volatile("s_waitcnt vmcnt(0)" ::: "memory")
__device__ __forceinline__ void lds_barrier() { asm volatile("s_waitcnt lgkmcnt(0)" ::: "memory"); __builtin_amdgcn_s_barrier(); asm volatile("" ::: "memory"); }

#define XB_TMO      128
#define XB_XCNT(j)  (256  + 64 * (j))
#define XB_XSUB(j)  (1280 + 64 * (j))
#define XB_XGEN(j)  (2304 + 64 * (j))
#define XB_TOP      3328
#define XB_TOPGEN   3392
#define XCD_BAR_WORDS 3456
#define XB_SPIN_CAP (1u << 18)
__device__ __forceinline__ unsigned xb_ld(unsigned* p)              { return __hip_atomic_load(p, __ATOMIC_RELAXED, __HIP_MEMORY_SCOPE_AGENT); }
__device__ __forceinline__ unsigned xb_add(unsigned* p, unsigned v) { return __hip_atomic_fetch_add(p, v, __ATOMIC_RELAXED, __HIP_MEMORY_SCOPE_AGENT); }
__device__ __forceinline__ unsigned xb_xcc_id() { return (unsigned)__builtin_amdgcn_s_getreg((3 << 11) | 20) & 0xFu; }
#define XB_SPIN(cond, bar) do { unsigned _sp = 0; while (cond) { __builtin_amdgcn_s_sleep(1); \
    if ((++_sp & 255u) == 0u) { if (xb_ld(&(bar)[XB_TMO])) break; if (_sp > XB_SPIN_CAP) { atomicAdd(&(bar)[XB_TMO], 1u); break; } } } } while (0)
struct XcdBarrier { unsigned* bar; unsigned x; volatile LAS unsigned* st; };
__device__ __forceinline__ XcdBarrier xcd_barrier_post(unsigned* bar, volatile LAS unsigned* st) {
    XcdBarrier b; b.bar = bar; b.x = xb_xcc_id(); b.st = st;
    if (threadIdx.x == 0) (void)xb_add(&bar[XB_XCNT(b.x)], 1u);
    return b;
}
__device__ __forceinline__ void xcd_barrier_complete(unsigned* bar, unsigned x, unsigned& nloc, unsigned& nx) {
    const unsigned G = gridDim.x * gridDim.y * gridDim.z;
    unsigned sum, cnt, mine, sp = 0u;
    for (;;) {
        sum = 0u; cnt = 0u; mine = 0u;
#pragma unroll
        for (unsigned j = 0; j < 16; ++j) { const unsigned c = xb_ld(&bar[XB_XCNT(j)]); sum += c; cnt += (c > 0u) ? 1u : 0u; mine = (j == x) ? c : mine; }
        if (sum == G) break;
        __builtin_amdgcn_s_sleep(1);
        if ((++sp & 255u) == 0u) { if (xb_ld(&bar[XB_TMO])) break; if (sp > XB_SPIN_CAP) { atomicAdd(&bar[XB_TMO], 1u); break; } }
    }
    nloc = mine > 0u ? mine : 1u; nx = cnt > 0u ? cnt : 1u;
}
__device__ __forceinline__ void xcd_barrier(const XcdBarrier& b) {
    asm volatile("s_waitcnt vmcnt(0)" ::: "memory");
    __syncthreads();
    if (threadIdx.x == 0) {
        unsigned* bar = b.bar;
        __builtin_amdgcn_s_waitcnt(0);
        unsigned nloc = b.st[0], nx = b.st[1];
        if (nloc == 0u) { xcd_barrier_complete(bar, b.x, nloc, nx); b.st[0] = nloc; b.st[1] = nx; }
        const unsigned old = xb_add(&bar[XB_XSUB(b.x)], 1u);
        const unsigned gen = old / nloc;
        if (old + 1u == (gen + 1u) * nloc) {
            __builtin_amdgcn_fence(__ATOMIC_RELEASE, "agent");
            asm volatile("s_waitcnt vmcnt(0)" ::: "memory");
            const unsigned og = xb_add(&bar[XB_TOP], 1u);
            const unsigned tg = og / nx;
            if (og + 1u == (tg + 1u) * nx) xb_add(&bar[XB_TOPGEN], 1u);
            else XB_SPIN(xb_ld(&bar[XB_TOPGEN]) == tg, bar);
            __builtin_amdgcn_fence(__ATOMIC_ACQUIRE, "agent");
            xb_add(&bar[XB_XGEN(b.x)], 1u);
            asm volatile("s_waitcnt vmcnt(0)" ::: "memory");
        } else {
            XB_SPIN(xb_ld(&bar[XB_XGEN(b.x)]) == gen, bar);
            __builtin_amdgcn_fence(__ATOMIC_ACQUIRE, "agent");
            asm volatile("s_waitcnt vmcnt(0)" ::: "memory");
        }
    }
    __syncthreads();
}

struct Ctx {
    LAS unsigned char* lds;
    int tid, lane, wave, G, bid;
    const __attribute__((address_space(4))) char* ka;
    __device__ __forceinline__ const float* inp(int i) const { return ((const float* const __attribute__((address_space(4)))*)ka)[i]; }
    float* out;
    unsigned char* ws;
    unsigned* ctl;
};

__device__ __forceinline__ Ctx phase_ctx(const Ctx& C0) { Ctx C; C.lds = C0.lds; { int g_ = C0.G, b_ = C0.bid; asm volatile("" : "+s"(g_), "+s"(b_)); C.G = g_; C.bid = b_; } int t = threadIdx.x; asm volatile("" : "+v"(t)); C.tid = t; C.lane = t & 63; C.wave = __builtin_amdgcn_readfirstlane(t >> 6);
    const __attribute__((address_space(4))) char* ka = C0.ka; asm volatile("" : "+s"(ka)); C.ka = ka;
    C.out = *(float* const __attribute__((address_space(4)))*)(ka + 216); C.ws = *(unsigned char* const __attribute__((address_space(4)))*)(ka + 224); C.ctl = (unsigned*)C.ws; return C; }

__device__ __forceinline__ int uq_rowmap(int n) { const int h = n / 192, o = n - h * 192; if (o < 128) return n; const int j = o - 128; return h * 192 + 128 + (j < 32 ? 2 * j : 2 * (j - 32) + 1); }
__device__ __forceinline__ void conv_item(const float* W, int ldn, int c0, int nvalid, int K, bf16* WT, const float* kscale, int mode, LAS float* scr, int kb, int nb, int lane) {
    const int k0 = 64 * kb, n0 = 64 * nb;
    const int lc = (lane & 15) * 4, lr = lane >> 4;
#pragma unroll
    for (int i = 0; i < 16; ++i) {
        const int kk = lr + 4 * i;
        f32x4 v = (f32x4){0.f, 0.f, 0.f, 0.f};
        if (n0 + lc < nvalid) v = *(const f32x4*)(W + (size_t)(k0 + kk) * ldn + c0 + n0 + lc);
        if (kscale) { const float s = kscale[k0 + kk]; v = v * s; }
        scr[kk * 65 + lc + 0] = v.x; scr[kk * 65 + lc + 1] = v.y; scr[kk * 65 + lc + 2] = v.z; scr[kk * 65 + lc + 3] = v.w;
    }
    LDS_WAIT(); asm volatile("" ::: "memory");
    const int c = lane & 7;
#pragma unroll
    for (int j = 0; j < 8; ++j) {
        const int n = (lane >> 3) + 8 * j; const LAS float* s = scr + (8 * c) * 65 + n;
        u32x4 o; o.x = cvt_pk_bf16(s[0 * 65], s[1 * 65]); o.y = cvt_pk_bf16(s[2 * 65], s[3 * 65]); o.z = cvt_pk_bf16(s[4 * 65], s[5 * 65]); o.w = cvt_pk_bf16(s[6 * 65], s[7 * 65]);
        const int dn = mode == 1 ? uq_rowmap(n0 + n) : (n0 + n);
        *(u32x4*)(WT + (size_t)dn * K + k0 + 8 * c) = o;
    }
    LDS_WAIT(); asm volatile("" ::: "memory");
}

__device__ __forceinline__ void row_load_f32(const float* p, int lane, f32x4 (&v)[4]) {
#pragma unroll
    for (int j = 0; j < 4; ++j) v[j] = *(const f32x4*)(p + 4 * lane + 256 * j);
}
__device__ __forceinline__ void row_load_bf16(const bf16* p, int lane, f32x4 (&v)[4]) {
#pragma unroll
    for (int j = 0; j < 4; ++j) { const u32x2 w = *(const u32x2*)(p + 4 * lane + 256 * j); v[j] = (f32x4){bf_lo(w.x), bf_hi(w.x), bf_lo(w.y), bf_hi(w.y)}; }
}
__device__ __forceinline__ void row_store_f32(float* p, int lane, const f32x4 (&v)[4]) {
#pragma unroll
    for (int j = 0; j < 4; ++j) *(f32x4*)(p + 4 * lane + 256 * j) = v[j];
}
__device__ __forceinline__ void row_store_bf16(bf16* p, int lane, const f32x4 (&v)[4]) {
#pragma unroll
    for (int j = 0; j < 4; ++j) { u32x2 w; w.x = cvt_pk_bf16(v[j].x, v[j].y); w.y = cvt_pk_bf16(v[j].z, v[j].w); *(u32x2*)(p + 4 * lane + 256 * j) = w; }
}
__device__ __forceinline__ void row_layernorm(f32x4 (&v)[4], const f32x4 (&g)[4], const f32x4 (&b)[4]) {
    float s = 0.f;
#pragma unroll
    for (int j = 0; j < 4; ++j) s += (v[j].x + v[j].y) + (v[j].z + v[j].w);
    const float mean = wave_sum(s) * (1.f / DM); float s2 = 0.f;
#pragma unroll
    for (int j = 0; j < 4; ++j) { v[j] = v[j] - mean; s2 += (v[j].x * v[j].x + v[j].y * v[j].y) + (v[j].z * v[j].z + v[j].w * v[j].w); }
    const float rstd = 1.f / sqrtf(wave_sum(s2) * (1.f / DM) + LN_EPS);
#pragma unroll
    for (int j = 0; j < 4; ++j) v[j] = v[j] * rstd * g[j] + b[j];
}
__device__ __forceinline__ void row_ab(const f32x4 (&v)[4], const LAS float* w8, int lane, float (&ab)[8]) {
#pragma unroll
    for (int e = 0; e < 8; ++e) { float s = 0.f;
#pragma unroll
        for (int j = 0; j < 4; ++j) { const f32x4 w = *(const LAS f32x4*)(w8 + e * 1024 + 4 * lane + 256 * j); s += (v[j].x * w.x + v[j].y * w.y) + (v[j].z * w.z + v[j].w * w.w); }
        ab[e] = wave_sum(s); }
}
__device__ __forceinline__ void load_w8(const Ctx& C, int ei, LAS float* w8) {
    const float* W = C.inp(1) + (size_t)ei * DM * EVEN_IN;
    for (int idx = C.tid; idx < 8 * 1024; idx += NWAVES * 64) { const int k = idx >> 3, e = idx & 7; w8[e * 1024 + k] = W[(size_t)k * EVEN_IN + EVEN_N + e]; }
}

__device__ __forceinline__ void phase_prologue(const Ctx& C0) {
    const Ctx C = phase_ctx(C0);
    const int gw = C.bid * NWAVES + C.wave, NGW = C.G * NWAVES, lane = C.lane;
    LAS float* scr = (LAS float*)(C.lds + C.wave * 16640);
    unsigned char* ws = C.ws;
    constexpr int I0 = 128 * 512, I1 = 128 * 256, I2 = 2 * 768, I3 = 2 * 256, I4 = 2 * 192, I5 = 2 * 144, I6 = 2 * 128, I7 = 2 * 256;
    constexpr int NITEMS = I0 + I1 + I2 + I3 + I4 + I5 + I6 + I7;
    for (int it = gw; it < NITEMS; it += NGW) {
        int r = it;
        if (r < I0) { const int mi = r / 512, q = r % 512; conv_item(C.inp(23) + (size_t)mi * 1024 * 2048, 2048, 0, 2048, 1024, (bf16*)(ws + WS_WGU) + (size_t)mi * 2048 * 1024, nullptr, 0, scr, q / 32, q % 32, lane); continue; } r -= I0;
        if (r < I1) { const int mi = r / 256, q = r % 256; conv_item(C.inp(25) + (size_t)mi * 1024 * 1024, 1024, 0, 1024, 1024, (bf16*)(ws + WS_WDN) + (size_t)mi * 1024 * 1024, nullptr, 0, scr, q / 16, q % 16, lane); continue; } r -= I1;
        if (r < I2) { const int mi = r / 768, q = r % 768; conv_item(C.inp(1) + (size_t)mi * 1024 * EVEN_IN, EVEN_IN, 0, EVEN_N, 1024, (bf16*)(ws + WS_WEIN) + (size_t)mi * EVEN_N * 1024, nullptr, 0, scr, q / 48, q % 48, lane); continue; } r -= I2;
        if (r < I3) { const int mi = r / 256, q = r % 256; conv_item(C.inp(10) + (size_t)mi * 1024 * 1024, 1024, 0, 1024, 1024, (bf16*)(ws + WS_WEOUT) + (size_t)mi * 1024 * 1024, nullptr, 0, scr, q / 16, q % 16, lane); continue; } r -= I3;
        if (r < I4) { const int mi = r / 192, q = r % 192; conv_item(C.inp(11) + (size_t)mi * 1024 * ODD_IN, ODD_IN, 0, ODD_IN, 1024, (bf16*)(ws + WS_WOIN) + (size_t)mi * ODD_N * 1024, nullptr, 0, scr, q / 12, q % 12, lane); continue; } r -= I4;
        if (r < I5) { const int mi = r / 144, q = r % 144; conv_item(C.inp(13) + (size_t)mi * QL * 1536, 1536, 0, 1536, QL, (bf16*)(ws + WS_WUQ) + (size_t)mi * 1536 * QL, C.inp(12) + mi * QL, 1, scr, q / 24, q % 24, lane); continue; } r -= I5;
        if (r < I6) { const int mi = r / 128, q = r % 128; conv_item(C.inp(15) + (size_t)mi * KVL * 2048, 2048, 0, 2048, KVL, (bf16*)(ws + WS_WUKV) + (size_t)mi * 2048 * KVL, C.inp(14) + mi * KVL, 0, scr, q / 32, q % 32, lane); continue; } r -= I6;
        { const int mi = r / 256, q = r % 256; conv_item(C.inp(16) + (size_t)mi * 1024 * 1024, 1024, 0, 1024, 1024, (bf16*)(ws + WS_WOOUT) + (size_t)mi * 1024 * 1024, nullptr, 0, scr, q / 16, q % 16, lane); }
    }
    { f32x2* rope = (f32x2*)(ws + WS_ROPE);
      for (int idx = C.bid * NWAVES * 64 + C.tid; idx < SEQ * 32; idx += C.G * NWAVES * 64) { const int pos = idx >> 5, j = idx & 31;
          const float inv = powf(10000.0f, -(float)(2 * j) / 64.0f); const float ang = (float)pos * inv; rope[idx] = (f32x2){cosf(ang), sinf(ang)}; } }
    __syncthreads();
    LAS float* w8 = (LAS float*)(C.lds);
    load_w8(C, 0, w8);
    __syncthreads();
    const float* x = C.inp(0); bf16* XB = (bf16*)(ws + WS_XB); float* AB = (float*)(ws + WS_AB);
    for (int m = gw; m < T; m += NGW) { f32x4 v[4]; row_load_f32(x + (size_t)m * DM, lane, v); row_store_bf16(XB + (size_t)m * DM, lane, v);
        float ab[8]; row_ab(v, w8, lane, ab); if (lane < 8) { float s = ab[0];
#pragma unroll
            for (int e = 1; e < 8; ++e) s = (lane == e) ? ab[e] : s;
            AB[(size_t)m * 8 + lane] = s; } }
}

using pg8::Unit;
struct EpiBf16 {
    static constexpr bool PERM = true;
    bf16* O; int ldc; int gelu_cols;
    __device__ __forceinline__ void operator()(const f32x4 (&acc)[2][2][4][2], const Unit& u, int wr, int wc, int fr, int fq) const {
        const int row0 = u.pm * 256 + wr * 64 + fr, col0 = u.pn * 256 + wc * 32 + 8 * fq;
        const bool g = (u.pn * 256) < gelu_cols;
#pragma unroll
        for (int ai = 0; ai < 2; ++ai)
#pragma unroll
            for (int m = 0; m < 4; ++m) { bf16* rowp = O + (size_t)(row0 + ai * 128 + m * 16) * ldc + col0;
#pragma unroll
                for (int bj = 0; bj < 2; ++bj) { f32x4 v0 = acc[ai][bj][m][0], v1 = acc[ai][bj][m][1];
                    if (g) { f32x2 a = pg8::gelu_pk((f32x2){v0[0], v0[1]}), b = pg8::gelu_pk((f32x2){v0[2], v0[3]}), c = pg8::gelu_pk((f32x2){v1[0], v1[1]}), d = pg8::gelu_pk((f32x2){v1[2], v1[3]});
                        v0 = (f32x4){a.x, a.y, b.x, b.y}; v1 = (f32x4){c.x, c.y, d.x, d.y}; }
                    u32x4 w; w.x = cvt_pk_bf16(v0[0], v0[1]); w.y = cvt_pk_bf16(v0[2], v0[3]); w.z = cvt_pk_bf16(v1[0], v1[1]); w.w = cvt_pk_bf16(v1[2], v1[3]);
                    *(u32x4*)(rowp + bj * 128) = w; } }
    }
};
struct EpiRes {
    static constexpr bool PERM = true;
    const bf16* X; bf16* Y;
    __device__ __forceinline__ void operator()(const f32x4 (&acc)[2][2][4][2], const Unit& u, int wr, int wc, int fr, int fq) const {
        const int row0 = u.pm * 256 + wr * 64 + fr, col0 = u.pn * 256 + wc * 32 + 8 * fq;
#pragma unroll
        for (int ai = 0; ai < 2; ++ai)
#pragma unroll
            for (int m = 0; m < 4; ++m) { const size_t off = (size_t)(row0 + ai * 128 + m * 16) * DM + col0;
                u32x4 xs[2];
#pragma unroll
                for (int bj = 0; bj < 2; ++bj) xs[bj] = *(const u32x4*)(X + off + bj * 128);
#pragma unroll
                for (int bj = 0; bj < 2; ++bj) { const f32x4 a0 = acc[ai][bj][m][0], a1 = acc[ai][bj][m][1]; u32x4 w;
                    w.x = cvt_pk_bf16(bf_lo(xs[bj].x) * DN_ALPHA + a0[0], bf_hi(xs[bj].x) * DN_ALPHA + a0[1]); w.y = cvt_pk_bf16(bf_lo(xs[bj].y) * DN_ALPHA + a0[2], bf_hi(xs[bj].y) * DN_ALPHA + a0[3]);
                    w.z = cvt_pk_bf16(bf_lo(xs[bj].z) * DN_ALPHA + a1[0], bf_hi(xs[bj].z) * DN_ALPHA + a1[1]); w.w = cvt_pk_bf16(bf_lo(xs[bj].w) * DN_ALPHA + a1[2], bf_hi(xs[bj].w) * DN_ALPHA + a1[3]);
                    *(u32x4*)(Y + off + bj * 128) = w; }
                if (m & 1) asm volatile("" ::: "memory"); }
    }
};
struct EpiQ {
    static constexpr bool PERM = true;
    bf16* O; const float* rs; const f32x4* rope;
    __device__ __forceinline__ void operator()(const f32x4 (&acc)[2][2][4][2], const Unit& u, int wr, int wc, int fr, int fq) const {
        const int row0 = u.pm * 256 + wr * 64 + fr, col0 = u.pn * 256 + wc * 32 + 8 * fq;
        float sc[2][4];
#pragma unroll
        for (int ai = 0; ai < 2; ++ai)
#pragma unroll
            for (int m = 0; m < 4; ++m) sc[ai][m] = rs[row0 + ai * 128 + m * 16];
#pragma unroll
        for (int ai = 0; ai < 2; ++ai)
#pragma unroll
            for (int m = 0; m < 4; ++m) { const int row = row0 + ai * 128 + m * 16; const float s = sc[ai][m]; const int pos = row & (SEQ - 1);
                bf16* rowp = O + (size_t)row * 1536 + col0;
#pragma unroll
                for (int bj = 0; bj < 2; ++bj) { f32x4 v0 = acc[ai][bj][m][0] * s, v1 = acc[ai][bj][m][1] * s;
                    const int c = col0 + bj * 128, o = c % 192;
                    if (o >= 128) { const int jp = (o - 128) >> 1;
                        const f32x4 r0 = rope[(pos * 32 + jp) >> 1], r1 = rope[(pos * 32 + jp + 2) >> 1];
                        v0 = (f32x4){v0[0] * r0[0] - v0[1] * r0[1], v0[0] * r0[1] + v0[1] * r0[0], v0[2] * r0[2] - v0[3] * r0[3], v0[2] * r0[3] + v0[3] * r0[2]};
                        v1 = (f32x4){v1[0] * r1[0] - v1[1] * r1[1], v1[0] * r1[1] + v1[1] * r1[0], v1[2] * r1[2] - v1[3] * r1[3], v1[2] * r1[3] + v1[3] * r1[2]}; }
                    u32x4 w; w.x = cvt_pk_bf16(v0[0], v0[1]); w.y = cvt_pk_bf16(v0[2], v0[3]); w.z = cvt_pk_bf16(v1[0], v1[1]); w.w = cvt_pk_bf16(v1[2], v1[3]);
                    *(u32x4*)(rowp + bj * 128) = w; }
                if (m & 1) asm volatile("" ::: "memory"); }
    }
};
struct EpiKV {
    static constexpr bool PERM = true;
    bf16* O; const float* rs;
    __device__ __forceinline__ void operator()(const f32x4 (&acc)[2][2][4][2], const Unit& u, int wr, int wc, int fr, int fq) const {
        const int row0 = u.pm * 256 + wr * 64 + fr, col0 = u.pn * 256 + wc * 32 + 8 * fq;
        float sc[2][4];
#pragma unroll
        for (int ai = 0; ai < 2; ++ai)
#pragma unroll
            for (int m = 0; m < 4; ++m) sc[ai][m] = rs[row0 + ai * 128 + m * 16];
#pragma unroll
        for (int ai = 0; ai < 2; ++ai)
#pragma unroll
            for (int m = 0; m < 4; ++m) { const int row = row0 + ai * 128 + m * 16; const float s = sc[ai][m]; bf16* rowp = O + (size_t)row * 2048 + col0;
#pragma unroll
                for (int bj = 0; bj < 2; ++bj) { const f32x4 v0 = acc[ai][bj][m][0] * s, v1 = acc[ai][bj][m][1] * s;
                    u32x4 w; w.x = cvt_pk_bf16(v0[0], v0[1]); w.y = cvt_pk_bf16(v0[2], v0[3]); w.z = cvt_pk_bf16(v1[0], v1[1]); w.w = cvt_pk_bf16(v1[2], v1[3]);
                    *(u32x4*)(rowp + bj * 128) = w; } }
    }
};
struct EpiSwiglu {
    static constexpr bool PERM = true;
    bf16* HID; const float* bias; const LAS int* rmap;
    __device__ __forceinline__ void operator()(const f32x4 (&acc)[2][2][4][2], const Unit& u, int wr, int wc, int fr, int fq) const {
        const int col0 = u.pn * 256 + wc * 32 + 8 * fq; const float* bp = bias + (size_t)u.e * 2048 + col0;
        f32x4 bv[2][2];
#pragma unroll
        for (int bj = 0; bj < 2; ++bj)
#pragma unroll
            for (int n = 0; n < 2; ++n) bv[bj][n] = *(const f32x4*)(bp + bj * 128 + 4 * n);
#pragma unroll
        for (int ai = 0; ai < 2; ++ai)
#pragma unroll
            for (int m = 0; m < 4; ++m) { const int slot = rmap[u.li * 256 + ai * 128 + wr * 64 + m * 16 + fr];
                if (slot >= 0) { bf16* rowp = HID + (size_t)slot * DFF + (col0 >> 1);
#pragma unroll
                    for (int bj = 0; bj < 2; ++bj) { const f32x4 h0 = acc[ai][bj][m][0] + bv[bj][0], h1 = acc[ai][bj][m][1] + bv[bj][1];
                        float o[4];
#pragma unroll
                        for (int q = 0; q < 4; ++q) { const float glu = fminf(q < 2 ? h0[2 * q] : h1[2 * q - 4], 7.0f); float lin = q < 2 ? h0[2 * q + 1] : h1[2 * q - 3]; lin = fminf(fmaxf(lin, -7.0f), 7.0f);
                            const float sg = __builtin_amdgcn_rcpf(1.0f + __builtin_amdgcn_exp2f(-1.702f * 1.4426950408889634f * glu)); o[q] = glu * sg * (lin + 1.0f); }
                        u32x2 w; w.x = cvt_pk_bf16(o[0], o[1]); w.y = cvt_pk_bf16(o[2], o[3]);
                        *(u32x2*)(rowp + bj * 64) = w; } } }
    }
};
struct EpiDown {
    static constexpr bool PERM = true;
    bf16* YE; const float* bias; const float* gate; const LAS int* rmap;
    __device__ __forceinline__ void operator()(const f32x4 (&acc)[2][2][4][2], const Unit& u, int wr, int wc, int fr, int fq) const {
        const int col0 = u.pn * 256 + wc * 32 + 8 * fq; const float* bp = bias + (size_t)u.e * DM + col0;
        f32x4 bv[2][2];
#pragma unroll
        for (int bj = 0; bj < 2; ++bj)
#pragma unroll
            for (int n = 0; n < 2; ++n) bv[bj][n] = *(const f32x4*)(bp + bj * 128 + 4 * n);
        int sl[2][4]; float gt[2][4];
#pragma unroll
        for (int ai = 0; ai < 2; ++ai)
#pragma unroll
            for (int m = 0; m < 4; ++m) { sl[ai][m] = rmap[u.li * 256 + ai * 128 + wr * 64 + m * 16 + fr]; gt[ai][m] = gate[sl[ai][m] < 0 ? 0 : sl[ai][m]]; }
#pragma unroll
        for (int ai = 0; ai < 2; ++ai)
#pragma unroll
            for (int m = 0; m < 4; ++m) { const int slot = sl[ai][m];
                if (slot >= 0) { const float g = gt[ai][m]; bf16* rowp = YE + (size_t)slot * DM + col0;
#pragma unroll
                    for (int bj = 0; bj < 2; ++bj) { const f32x4 v0 = (acc[ai][bj][m][0] + bv[bj][0]) * g, v1 = (acc[ai][bj][m][1] + bv[bj][1]) * g;
                        u32x4 w; w.x = cvt_pk_bf16(v0[0], v0[1]); w.y = cvt_pk_bf16(v0[2], v0[3]); w.z = cvt_pk_bf16(v1[0], v1[1]); w.w = cvt_pk_bf16(v1[2], v1[3]);
                        *(u32x4*)(rowp + bj * 128) = w; } } }
    }
};

template <class Epi>
__device__ __forceinline__ void run_plain_gemm(const Ctx& C, const bf16* A, int lda, int K, int N, const bf16* Bt, const Epi& E) {
    pg8::PlainSched S; S.o.init(T, N, C.G, C.bid); S.Bt = (const char*)Bt; S.K = K; S.lda = lda;
    pg8::gemm_phase<Epi, pg8::PlainSched, true>(C.lds, (const char*)A, K, S, E);
}

constexpr int MOE_RMAP_OFF = LDS_SPARE, MOE_MAX_UNITS = 20, MOE_PRE_OFF = LDS_SPARE + MOE_MAX_UNITS * 1024, MOE_CNT_OFF = MOE_PRE_OFF + 256;
struct MoeSched {
    static constexpr bool GATHER = true;
    const LAS int* pre; const LAS int* rmap; const char* Bt; size_t bstride; int K, NT, G, c, lda, shift;
    __device__ __forceinline__ bool next(int i, Unit& u) const {
        const int x = c & 7, k = c >> 3, per = G >> 3;
        const int RT = 32 / NT, tot = pre[32];
        const int slot = i * per + k;
        const int st = (slot >> 5) * 8 + x, within = slot & 31;
        const int rt = st * RT + within / NT;
        if (rt >= tot || i >= MOE_MAX_UNITS) return false;
        int e = 0;
#pragma unroll 1
        for (; e < 31; ++e) if (rt < pre[e + 1]) break;
        u.e = e; u.pn = within % NT; u.pm = rt - pre[e]; u.li = i; return true;
    }
    __device__ __forceinline__ const char* bbase(const Unit& u) const { return Bt + (size_t)u.e * bstride + (size_t)u.pn * 256 * K * 2; }
    __device__ __forceinline__ unsigned aoff(const Unit& u, int r) const { const int slot = rmap[u.li * 256 + r]; const int s = slot < 0 ? 0 : (slot >> shift); return (unsigned)(s * lda) * 2u; }
};
template <class Epi>
__device__ __forceinline__ void run_moe_gemm(const Ctx& C0, int layer, const bf16* A, int lda, int shift, int K, int N, const bf16* Bt, size_t bstride_elems, Epi E) {
    const Ctx C = phase_ctx(C0);
    LAS int* pre = (LAS int*)(C.lds + MOE_PRE_OFF); LAS int* cnt = (LAS int*)(C.lds + MOE_CNT_OFF); LAS int* rmap = (LAS int*)(C.lds + MOE_RMAP_OFF);
    const int* list = (const int*)(C.ws + WS_LIST);
    if (C.tid < 32) cnt[C.tid] = (int)__hip_atomic_load(C.ctl + CW_CNT + (layer * 32 + C.tid) * 64, RLX_AGENT);
    __syncthreads();
    if (C.tid == 0) { int s = 0; for (int e = 0; e < 32; ++e) { pre[e] = s; s += (cnt[e] + 255) >> 8; } pre[32] = s; }
    __syncthreads();
    MoeSched S; S.pre = pre; S.rmap = rmap; S.Bt = (const char*)Bt; S.bstride = bstride_elems * 2; S.K = K; S.NT = N / 256; S.G = C.G; S.c = C.bid; S.lda = lda; S.shift = shift;
    { Unit u; for (int i = 0; S.next(i, u); ++i) { if (C.tid < 256) { const int idx = u.pm * 256 + C.tid; rmap[i * 256 + C.tid] = idx < cnt[u.e] ? list[(size_t)u.e * LCAP + idx] : -1; } } }
    __syncthreads();
    E.rmap = rmap;
    pg8::gemm_phase<Epi, MoeSched, true>(C.lds, (const char*)A, K, S, E);
}

__device__ __forceinline__ void phase_router(const Ctx& C0, int layer) {
    const Ctx C = phase_ctx(C0);
    LAS float* wrT = (LAS float*)C.lds;
    LAS int* lcnt = (LAS int*)(C.lds + 132096); LAS int* lbase = (LAS int*)(C.lds + 132224);
    LAS int* asg_e = (LAS int*)(C.lds + 132352); LAS int* asg_pos = (LAS int*)(C.lds + 134400); LAS float* asg_gate = (LAS float*)(C.lds + 136448);
    const float* Wr = C.inp(21) + (size_t)layer * DM * NEXP; const float* br = C.inp(22) + layer * NEXP;
    const int lane = C.lane, tid = C.tid;
    for (int idx = tid; idx < DM * NEXP; idx += NWAVES * 64) { const int k = idx >> 5, e = idx & 31; wrT[e * 1028 + k] = Wr[idx]; }
    f32x4 g[4], b[4]; row_load_f32(C.inp(17) + layer * DM, lane, g); row_load_f32(C.inp(18) + layer * DM, lane, b);
    const bf16* Y = (const bf16*)(C.ws + WS_Y); bf16* XB = (bf16*)(C.ws + WS_XB);
    int* list = (int*)(C.ws + WS_LIST); float* GATE = (float*)(C.ws + WS_GATE);
    const float mybias = br[lane >> 1];
    for (int rb = C.bid; rb < T / 128; rb += C.G) {
        if (tid < 32) lcnt[tid] = 0;
        __syncthreads();
#pragma unroll 1
        for (int i = 0; i < 16; ++i) {
            const int rl = C.wave * 16 + i, row = rb * 128 + rl;
            f32x4 v[4]; row_load_bf16(Y + (size_t)row * DM, lane, v);
            row_layernorm(v, g, b);
            row_store_bf16(XB + (size_t)row * DM, lane, v);
            float p[32];
#pragma unroll
            for (int e = 0; e < 32; ++e) { float s = 0.f;
#pragma unroll
                for (int j = 0; j < 4; ++j) { const f32x4 w = *(const LAS f32x4*)(wrT + e * 1028 + 4 * lane + 256 * j); s += (v[j].x * w.x + v[j].y * w.y) + (v[j].z * w.z + v[j].w * w.w); }
                p[e] = s; }
#define BFLY(bit, n) { const bool hi_ = (lane & (bit)) != 0; _Pragma("unroll") for (int q = 0; q < (n); ++q) { const float send = hi_ ? p[q] : p[q + (n)]; const float keep = hi_ ? p[q + (n)] : p[q]; p[q] = keep + __shfl_xor(send, (bit)); } }
            BFLY(32, 16) BFLY(16, 8) BFLY(8, 4) BFLY(4, 2) BFLY(2, 1)
#undef BFLY
            float val = p[0] + __shfl_xor(p[0], 1) + mybias; const int me = lane >> 1;
            float tv[4]; int te[4];
#pragma unroll
            for (int k = 0; k < 4; ++k) { float bv = val; int be = me;
#pragma unroll
                for (int off = 1; off < 64; off <<= 1) { const float ov = __shfl_xor(bv, off); const int oe = __shfl_xor(be, off); const bool take = (ov > bv) || (ov == bv && oe < be); bv = take ? ov : bv; be = take ? oe : be; }
                tv[k] = bv; te[k] = be; if (me == be) val = -__builtin_inff(); }
            const float e1 = __expf(tv[1] - tv[0]), e2 = __expf(tv[2] - tv[0]), e3 = __expf(tv[3] - tv[0]); const float inv = 1.0f / (1.0f + e1 + e2 + e3);
            if (lane < 4) { const int my_e = lane == 0 ? te[0] : lane == 1 ? te[1] : lane == 2 ? te[2] : te[3]; const float my_g = (lane == 0 ? 1.0f : lane == 1 ? e1 : lane == 2 ? e2 : e3) * inv;
                const int lpos = __hip_atomic_fetch_add(lcnt + my_e, 1, __ATOMIC_RELAXED, __HIP_MEMORY_SCOPE_WORKGROUP);
                const int a = rl * 4 + lane; asg_e[a] = my_e; asg_pos[a] = lpos; asg_gate[a] = my_g; }
        }
        __syncthreads();
        if (tid < 32) lbase[tid] = (int)__hip_atomic_fetch_add(C.ctl + CW_CNT + (layer * 32 + tid) * 64, (unsigned)lcnt[tid], RLX_AGENT);
        __syncthreads();
        { const int a = tid, e = asg_e[a], slot = (rb * 128 + (a >> 2)) * 4 + (a & 3); list[(size_t)e * LCAP + lbase[e] + asg_pos[a]] = slot; GATE[slot] = asg_gate[a]; }
        __syncthreads();
    }
}

__device__ __forceinline__ void phase_combine(const Ctx& C0, int layer) {
    const Ctx C = phase_ctx(C0);
    const int gw = C.bid * NWAVES + C.wave, NGW = C.G * NWAVES, lane = C.lane;
    LAS float* w8 = (LAS float*)C.lds;
    if (layer == 1) { load_w8(C, 1, w8); __syncthreads(); }
    f32x4 g[4], b[4]; row_load_f32(C.inp(19) + layer * DM, lane, g); row_load_f32(C.inp(20) + layer * DM, lane, b);
    bf16* XB = (bf16*)(C.ws + WS_XB); const bf16* YE = (const bf16*)(C.ws + WS_YE); float* AB = (float*)(C.ws + WS_AB);
    for (int m = gw; m < T; m += NGW) {
        f32x4 v[4]; row_load_bf16(XB + (size_t)m * DM, lane, v);
#pragma unroll
        for (int j = 0; j < 4; ++j) v[j] = v[j] * DN_ALPHA;
#pragma unroll
        for (int k = 0; k < 4; ++k) { const bf16* yr = YE + (size_t)(m * 4 + k) * DM;
#pragma unroll
            for (int j = 0; j < 4; ++j) { const u32x2 w = *(const u32x2*)(yr + 4 * lane + 256 * j); v[j] = v[j] + (f32x4){bf_lo(w.x), bf_hi(w.x), bf_lo(w.y), bf_hi(w.y)}; } }
        row_layernorm(v, g, b);
        if (layer == DEPTH - 1) row_store_f32(C.out + (size_t)m * DM, lane, v);
        else row_store_bf16(XB + (size_t)m * DM, lane, v);
        if (layer == 1) { float ab[8]; row_ab(v, w8, lane, ab); if (lane < 8) { float s = ab[0];
#pragma unroll
                for (int e = 1; e < 8; ++e) s = (lane == e) ? ab[e] : s;
                AB[(size_t)m * 8 + lane] = s; } }
    }
}

__device__ __forceinline__ void phase_o1b(const Ctx& C0) {
    const Ctx C = phase_ctx(C0);
    const int gw = C.bid * NWAVES + C.wave, NGW = C.G * NWAVES, lane = C.lane;
    const bf16* C1 = (const bf16*)(C.ws + WS_ARENA + AR_C1); bf16* KPE = (bf16*)(C.ws + WS_ARENA + AR_KPE);
    float* RSQ = (float*)(C.ws + WS_RS); float* RKV = RSQ + T; const f32x2* rope = (const f32x2*)(C.ws + WS_ROPE);
    for (int m = gw; m < T; m += NGW) {
        const bf16* rp = C1 + (size_t)m * ODD_N;
        const u32x4 a = *(const u32x4*)(rp + 8 * lane);
        float s = 0.f;
#pragma unroll
        for (int q = 0; q < 4; ++q) { const float lo = bf_lo(a[q]), hi = bf_hi(a[q]); s += lo * lo + hi * hi; }
        float sq = lane < 48 ? s : 0.f, skv = lane < 48 ? 0.f : s;
        if (lane < 16) { const u32x4 b = *(const u32x4*)(rp + 8 * (64 + lane)); float s2 = 0.f;
#pragma unroll
            for (int q = 0; q < 4; ++q) { const float lo = bf_lo(b[q]), hi = bf_hi(b[q]); s2 += lo * lo + hi * hi; }
            skv += s2; }
        sq = wave_sum(sq); skv = wave_sum(skv);
        if (lane == 0) { RSQ[m] = 1.0f / sqrtf(sq * (1.0f / QL) + RMS_EPS); RKV[m] = 1.0f / sqrtf(skv * (1.0f / KVL) + RMS_EPS); }
        if (lane < 32) { const float x1 = bf2f(rp[640 + lane]), x2 = bf2f(rp[672 + lane]); const f32x2 cs = rope[(m & (SEQ - 1)) * 32 + lane];
            *(unsigned*)(KPE + (size_t)m * 64 + 2 * lane) = cvt_pk_bf16(x1 * cs.x - x2 * cs.y, x1 * cs.y + x2 * cs.x); }
    }
}

namespace att {
constexpr int SHM_V = 16384, SHM_K = 16384, SHM_KR = 8192;
constexpr int OFF_V = 0, OFF_K = 2 * SHM_V, OFF_KR = OFF_K + 2 * SHM_K, OFF_WS = OFF_KR + 2 * SHM_KR, OFF_QR = OFF_WS + 2048;
constexpr float THR = 8.f, SCALE = ATT_SCALE;
#define KSWZ(row, colB) ((row) * 256 + ((colB) ^ (((row) & 7) << 4)))
#define KRSWZ(row, colB) ((row) * 128 + ((colB) ^ (((row) & 7) << 4)))
#define SBAR() __builtin_amdgcn_sched_barrier(0)
__device__ __forceinline__ int v_st(int k, int c) { const int kk = (k & ~0xC) | ((k & 4) << 1) | ((k & 8) >> 1); return ((kk >> 3) * 4 + (c >> 5)) * 512 + ((kk & 7) * 32 + (c & 31)) * 2; }
__device__ __forceinline__ int v_rd_base(int lane) { return ((lane & 3) << 3) | (((lane >> 2) & 3) << 6) | (((lane >> 4) & 1) << 5) | (((lane >> 5) & 1) << 8); }
constexpr int v_rd_off(int d0, int ks, int half) { return d0 * 512 + ks * 4096 + half * 2048; }
__device__ __forceinline__ int crow(int r, int hi) { return (r & 3) + 8 * (r >> 2) + 4 * hi; }
__device__ __forceinline__ void partialSM(f32x16& p0, f32x16& p1, float& m_reg, float& mn, float& alpha) {
    float pmax = p0[0];
#pragma unroll
    for (int r = 1; r < 16; ++r) pmax = fmaxf(pmax, p0[r]);
#pragma unroll
    for (int r = 0; r < 16; ++r) pmax = fmaxf(pmax, p1[r]);
    { auto rr = __builtin_amdgcn_permlane32_swap(__float_as_uint(pmax), __float_as_uint(pmax), false, false);
      pmax = fmaxf(__uint_as_float(rr[0]), __uint_as_float(rr[1])); }
    constexpr float C2 = 1.4426950408889634f * SCALE;
    if (__builtin_expect(__all((pmax - m_reg) * SCALE <= THR), 1)) { mn = m_reg; alpha = 1.f; }
    else { mn = fmaxf(m_reg, pmax); alpha = __builtin_amdgcn_exp2f((m_reg - mn) * C2); m_reg = mn; }
    const float mnL = -mn * C2;
#pragma unroll
    for (int r = 0; r < 16; ++r) p0[r] = fmaf(p0[r], C2, mnL);
#pragma unroll
    for (int r = 0; r < 16; ++r) p1[r] = fmaf(p1[r], C2, mnL);
#pragma unroll
    for (int r = 0; r < 16; ++r) p0[r] = __builtin_amdgcn_exp2f(p0[r]);
}
__device__ __forceinline__ void finishSM(f32x16& p0, f32x16& p1, float alpha, float& l_reg, bf16x8& pa0, bf16x8& pa1, bf16x8& pa2, bf16x8& pa3) {
#pragma unroll
    for (int r = 0; r < 16; ++r) p1[r] = __builtin_amdgcn_exp2f(p1[r]);
    float ps = 0;
#pragma unroll
    for (int r = 0; r < 16; ++r) ps += p0[r];
#pragma unroll
    for (int r = 0; r < 16; ++r) ps += p1[r];
    { auto rr = __builtin_amdgcn_permlane32_swap(__float_as_uint(ps), __float_as_uint(ps), false, false);
      ps = __uint_as_float(rr[0]) + __uint_as_float(rr[1]); }
    l_reg = l_reg * alpha + ps;
#define PK4(P, B_, OUT) do { unsigned a0 = cvt_pk_bf16(P[B_+0], P[B_+1]), a1 = cvt_pk_bf16(P[B_+2], P[B_+3]);                          \
        unsigned b0 = cvt_pk_bf16(P[B_+4], P[B_+5]), b1 = cvt_pk_bf16(P[B_+6], P[B_+7]);                                             \
        auto r0 = __builtin_amdgcn_permlane32_swap(a0, b0, false, false); auto r1 = __builtin_amdgcn_permlane32_swap(a1, b1, false, false); \
        u32x4 w = {r0[0], r1[0], r0[1], r1[1]}; OUT = *reinterpret_cast<bf16x8*>(&w); } while (0)
    PK4(p0, 0, pa0); PK4(p0, 8, pa1); PK4(p1, 0, pa2); PK4(p1, 8, pa3);
#undef PK4
}
template <int KB>
__device__ __forceinline__ void qkt(f32x16& p0, f32x16& p1, const LAS char* lds, int r32, int hi, const bf16x8* qr, const LAS char* qrl) {
    p0 = f32x16{}; p1 = f32x16{};
    const LAS char* kb[4]; const LAS char* kr[4];
#pragma unroll
    for (int dd = 0; dd < 4; ++dd) { kb[dd] = lds + OFF_K + KB * SHM_K + KSWZ(r32, (dd * 16 + hi * 8) * 2); kr[dd] = lds + OFF_KR + KB * SHM_KR + KRSWZ(r32, (dd * 16 + hi * 8) * 2); }
#pragma unroll
    for (int d0 = 0; d0 < 8; ++d0) { const LAS char* a = kb[d0 & 3] + (d0 >> 2) * 128;
        const bf16x8 b0 = *reinterpret_cast<const LAS bf16x8*>(a);
        const bf16x8 b1 = *reinterpret_cast<const LAS bf16x8*>(a + 32 * 256);
        p0 = __builtin_amdgcn_mfma_f32_32x32x16_bf16(b0, qr[d0], p0, 0, 0, 0);
        p1 = __builtin_amdgcn_mfma_f32_32x32x16_bf16(b1, qr[d0], p1, 0, 0, 0); }
#pragma unroll
    for (int d0 = 0; d0 < 4; ++d0) { const LAS char* a = kr[d0];
        const bf16x8 b0 = *reinterpret_cast<const LAS bf16x8*>(a);
        const bf16x8 b1 = *reinterpret_cast<const LAS bf16x8*>(a + 32 * 128);
        const bf16x8 qf = *reinterpret_cast<const LAS bf16x8*>(qrl + d0 * 1024);
        p0 = __builtin_amdgcn_mfma_f32_32x32x16_bf16(b0, qf, p0, 0, 0, 0);
        p1 = __builtin_amdgcn_mfma_f32_32x32x16_bf16(b1, qf, p1, 0, 0, 0); }
}
template <int VB>
__device__ __forceinline__ void pv_tile(f32x16* o, int vb0, bf16x8 pa0, bf16x8 pa1, bf16x8 pa2, bf16x8 pa3) {
#define TRRD(dst, off) asm volatile("ds_read_b64_tr_b16 %0, %1 offset:%2" : "=&v"(dst) : "v"(vb0), "i"(off) : "memory")
#define PV_D0(d0) do { s16x4 l0, l1, l2, l3, h0, h1, h2, h3; constexpr int b_ = OFF_V + VB * SHM_V + v_rd_off(d0, 0, 0); \
        TRRD(l0, b_); TRRD(h0, b_ + 2048); TRRD(l1, b_ + 4096); TRRD(h1, b_ + 6144); TRRD(l2, b_ + 8192); TRRD(h2, b_ + 10240); TRRD(l3, b_ + 12288); TRRD(h3, b_ + 14336); \
        asm volatile("s_waitcnt lgkmcnt(0)" ::: "memory"); SBAR();   \
        o[d0] = __builtin_amdgcn_mfma_f32_32x32x16_bf16(pa0, (bf16x8){l0[0], l0[1], l0[2], l0[3], h0[0], h0[1], h0[2], h0[3]}, o[d0], 0, 0, 0);   \
        o[d0] = __builtin_amdgcn_mfma_f32_32x32x16_bf16(pa1, (bf16x8){l1[0], l1[1], l1[2], l1[3], h1[0], h1[1], h1[2], h1[3]}, o[d0], 0, 0, 0);   \
        o[d0] = __builtin_amdgcn_mfma_f32_32x32x16_bf16(pa2, (bf16x8){l2[0], l2[1], l2[2], l2[3], h2[0], h2[1], h2[2], h2[3]}, o[d0], 0, 0, 0);   \
        o[d0] = __builtin_amdgcn_mfma_f32_32x32x16_bf16(pa3, (bf16x8){l3[0], l3[1], l3[2], l3[3], h3[0], h3[1], h3[2], h3[3]}, o[d0], 0, 0, 0); } while (0)
    PV_D0(0); PV_D0(1); PV_D0(2); PV_D0(3);
#undef PV_D0
#undef TRRD
}

__device__ __forceinline__ void attn_block(const Ctx& C, int b, int h, int qb) {
    LAS char* lds = (LAS char*)C.lds;
    const int tid = C.tid, wid = C.wave, lane = C.lane, r32 = lane & 31, hi = lane >> 5;
    const bf16* Qg = (const bf16*)(C.ws + WS_ARENA + AR_Q); const bf16* KVg = (const bf16*)(C.ws + WS_ARENA + AR_KV); const bf16* KPE = (const bf16*)(C.ws + WS_ARENA + AR_KPE);
    bf16* MIX = (bf16*)(C.ws + WS_MIX);
    const size_t tok0 = (size_t)b * SEQ; const int P0 = qb * 256;
    const int NT = 4 * (qb + 1), jmax = (P0 + wid * 32) >> 6;
    bf16x8 qr[8];
    LAS char* qrl = lds + OFF_QR + wid * 4096 + lane * 16;
    { const bf16* qp = Qg + (tok0 + P0 + wid * 32 + r32) * 1536 + h * 192 + hi * 8;
#pragma unroll
      for (int d0 = 0; d0 < 8; ++d0) qr[d0] = *(const bf16x8*)(qp + d0 * 16);
#pragma unroll
      for (int d0 = 0; d0 < 4; ++d0) *(LAS bf16x8*)(qrl + d0 * 1024) = *(const bf16x8*)(qp + (8 + d0) * 16); }
    const bf16* kvp = KVg + tok0 * 2048 + h * 256; const bf16* kpp = KPE + tok0 * 64;
#define A_LOAD(kb, bf) do { const bf16* p_ = kvp + (size_t)(kb) * 2048; int ln_ = lane; asm volatile("" : "+v"(ln_)); \
        _Pragma("unroll") for (int i_ = 0; i_ < 2; ++i_) { const int B_ = (wid * 2 + i_) * 1024 + ln_ * 16; \
            const int row_ = B_ >> 8, c_ = ((B_ & 255) >> 4) ^ (row_ & 7); \
            const int sub_ = B_ >> 9, kk_ = (sub_ >> 2) * 8 + ((B_ & 511) >> 6), k_ = (kk_ & ~0xC) | ((kk_ & 4) << 1) | ((kk_ & 8) >> 1), cc_ = (sub_ & 3) * 32 + ((B_ & 63) >> 1); \
            __builtin_amdgcn_global_load_lds((const unsigned*)(p_ + (unsigned)(row_ * 2048 + c_ * 8)), (LAS unsigned*)(lds + OFF_K + (bf) * SHM_K + (wid * 2 + i_) * 1024), 16, 0, 0); \
            __builtin_amdgcn_global_load_lds((const unsigned*)(p_ + (unsigned)(k_ * 2048 + 128 + cc_)), (LAS unsigned*)(lds + OFF_V + (bf) * SHM_V + (wid * 2 + i_) * 1024), 16, 0, 0); } \
        { const int B_ = wid * 1024 + ln_ * 16, row_ = B_ >> 7, c_ = ((B_ & 127) >> 4) ^ (row_ & 7); \
          __builtin_amdgcn_global_load_lds((const unsigned*)(kpp + (size_t)(kb) * 64 + (unsigned)(row_ * 64 + c_ * 8)), (LAS unsigned*)(lds + OFF_KR + (bf) * SHM_KR + wid * 1024), 16, 0, 0); } } while (0)
    LAS float* wsl = (LAS float*)(lds + OFF_WS) + wid * 64; LAS float* li_l = wsl; LAS float* al_l = wsl + 32;
    float m_reg = -1e30f, l_reg = 0.f; f32x16 o[4] = {};
    const int vb0 = (int)(uintptr_t)lds + v_rd_base(lane);
    A_LOAD(0, 0);
    asm volatile("s_waitcnt vmcnt(0)" ::: "memory");
    __syncthreads();
    f32x16 p0, p1; float mn, al; bf16x8 pa0, pa1, pa2, pa3;
#define A_STEP(KB) do { \
        if (t + 1 < NT) A_LOAD((t + 1) * 64, 1 - KB); \
        if (t <= jmax) { qkt<KB>(p0, p1, lds, r32, hi, qr, qrl); partialSM(p0, p1, m_reg, mn, al); \
            if (__any(al < 1.f)) { if (hi == 0) al_l[r32] = al; asm volatile("s_waitcnt lgkmcnt(0)" ::: "memory"); \
                _Pragma("unroll") for (int d_ = 0; d_ < 4; ++d_) _Pragma("unroll") for (int r = 0; r < 16; ++r) o[d_][r] *= al_l[crow(r, hi)]; } \
            finishSM(p0, p1, al, l_reg, pa0, pa1, pa2, pa3); SBAR(); pv_tile<KB>(o, vb0, pa0, pa1, pa2, pa3); } \
        asm volatile("s_waitcnt vmcnt(0)" ::: "memory"); \
        __syncthreads(); } while (0)
    for (int t = 0; t < NT; t += 2) { A_STEP(0); ++t; A_STEP(1); --t; }
#undef A_STEP
#undef A_LOAD
    if (hi == 0) li_l[r32] = l_reg;
    asm volatile("s_waitcnt lgkmcnt(0)" ::: "memory");
    float rli[16];
#pragma unroll
    for (int r = 0; r < 16; ++r) rli[r] = __builtin_amdgcn_rcpf(li_l[crow(r, hi)]);
    bf16* Ow = MIX + (tok0 + P0 + wid * 32) * DM + h * 128;
#pragma unroll
    for (int r = 0; r < 16; ++r) { const int orow = crow(r, hi);
#pragma unroll
        for (int d0 = 0; d0 < 4; ++d0) { const float v = o[d0][r] * rli[r]; const float vn = __shfl_xor(v, 1);
            if ((r32 & 1) == 0) *(unsigned*)(Ow + (size_t)orow * DM + d0 * 32 + r32) = cvt_pk_bf16(v, vn); } }
    __syncthreads();
}
#undef KSWZ
#undef KRSWZ
#undef SBAR
}

__device__ __forceinline__ void phase_attn(const Ctx& C0) {
    const Ctx C = phase_ctx(C0);
    const int x = C.bid & 7, k = C.bid >> 3, per = C.G >> 3;
    for (int u = k; u < 64; u += per) {
        const int bh = x * 8 + (u >> 3), p = u & 7;
        att::attn_block(C, bh >> 3, bh & 7, 15 - p);
        att::attn_block(C, bh >> 3, bh & 7, p);
    }
}

namespace sm {
__device__ __forceinline__ bf16x8 frag_n(const LAS char* base, int S, int x0, int k0, int lane) { return *(const LAS bf16x8*)(base + (x0 + (lane & 15)) * S + (k0 + 8 * (lane >> 4)) * 2); }
__device__ __forceinline__ bf16x8 frag_t(const LAS char* base, int S, int x0, int k0, int lane) {
    const int g = lane >> 4, q = (lane >> 2) & 3, p = lane & 3;
    const LAS char* a = base + (k0 + 8 * g + q) * S + (x0 + 4 * p) * 2;
    const s16x4 lo = __builtin_amdgcn_ds_read_tr16_b64_v4i16((LAS s16x4*)a);
    const s16x4 hi = __builtin_amdgcn_ds_read_tr16_b64_v4i16((LAS s16x4*)(a + 4 * S));
    return (bf16x8){lo[0], lo[1], lo[2], lo[3], hi[0], hi[1], hi[2], hi[3]};
}
__device__ __forceinline__ f32x4 mma(bf16x8 a, bf16x8 b, f32x4 c) { return __builtin_amdgcn_mfma_f32_16x16x32_bf16(a, b, c, 0, 0, 0); }
__device__ __forceinline__ u32x2 pack4(f32x4 v) { u32x2 w; w.x = cvt_pk_bf16(v[0], v[1]); w.y = cvt_pk_bf16(v[2], v[3]); return w; }
__device__ __forceinline__ f32x4 unpack4(u32x2 w) { return (f32x4){bf_lo(w.x), bf_hi(w.x), bf_lo(w.y), bf_hi(w.y)}; }
}

constexpr int H1LD = EVEN_N;

__device__ __forceinline__ void sgu_unit(const Ctx& C, int ei, int unit) {
    const int g4 = unit & 3, blk = (unit >> 2) & 31, b = unit >> 7;
    const int tid = C.tid, lane = C.lane, w = C.wave;
    const bf16* H1 = (const bf16*)(C.ws + WS_ARENA); bf16* MIX = (bf16*)(C.ws + WS_MIX);
    LAS char* Vn = (LAS char*)C.lds; LAS char* Wm = Vn + 34816;
    const size_t t0 = (size_t)b * SEQ + blk * 128;
    const float* lng = C.inp(2) + ei * 512 + g4 * 128; const float* lnb = C.inp(3) + ei * 512 + g4 * 128;
    const float* Wg = C.inp(4) + (size_t)(ei * 4 + g4) * 128 * 128; const float* bs = C.inp(5) + (ei * 4 + g4) * 128;
    { const int l16 = tid & 15; f32x4 ga = *(const f32x4*)(lng + 8 * l16), gb = *(const f32x4*)(lng + 8 * l16 + 4), ba = *(const f32x4*)(lnb + 8 * l16), bb = *(const f32x4*)(lnb + 8 * l16 + 4);
#pragma unroll
      for (int pp = 0; pp < 4; ++pp) { const int j = pp * 32 + (tid >> 4);
        const u32x4 raw = *(const u32x4*)(H1 + (t0 + j) * H1LD + 512 + g4 * 128 + 8 * l16);
        float x[8];
#pragma unroll
        for (int q = 0; q < 4; ++q) { x[2 * q] = bf_lo(raw[q]); x[2 * q + 1] = bf_hi(raw[q]); }
        float s = 0.f;
#pragma unroll
        for (int q = 0; q < 8; ++q) s += x[q];
        s += __shfl_xor(s, 1); s += __shfl_xor(s, 2); s += __shfl_xor(s, 4); s += __shfl_xor(s, 8);
        const float mean = s * (1.f / 128.f); float s2 = 0.f;
#pragma unroll
        for (int q = 0; q < 8; ++q) { x[q] -= mean; s2 += x[q] * x[q]; }
        s2 += __shfl_xor(s2, 1); s2 += __shfl_xor(s2, 2); s2 += __shfl_xor(s2, 4); s2 += __shfl_xor(s2, 8);
        const float rstd = 1.f / sqrtf(s2 * (1.f / 128.f) + LN_EPS);
        u32x4 o; o.x = cvt_pk_bf16(x[0] * rstd * ga[0] + ba[0], x[1] * rstd * ga[1] + ba[1]); o.y = cvt_pk_bf16(x[2] * rstd * ga[2] + ba[2], x[3] * rstd * ga[3] + ba[3]);
        o.z = cvt_pk_bf16(x[4] * rstd * gb[0] + bb[0], x[5] * rstd * gb[1] + bb[1]); o.w = cvt_pk_bf16(x[6] * rstd * gb[2] + bb[2], x[7] * rstd * gb[3] + bb[3]);
        *(LAS u32x4*)(Vn + j * 272 + l16 * 16) = o; } }
#pragma unroll
    for (int q = 0; q < 8; ++q) { const int f = (tid + 512 * q) * 4, i = f >> 7, j = f & 127; const f32x4 wv = *(const f32x4*)(Wg + f);
        *(LAS u32x2*)(Wm + i * 272 + j * 2) = sm::pack4(wv); }
    lds_barrier();
    const int i0 = 16 * w, nks = (w < 4) ? 2 : 4;
    bf16x8 f2[4];
#pragma unroll
    for (int ks = 0; ks < 4; ++ks) f2[ks] = sm::frag_n(Wm, 272, i0, 32 * ks, lane);
    const int i = i0 + (lane & 15), gq = lane >> 4; const float bsi = bs[i];
    const bf16* urow = H1 + (t0 + i) * H1LD + g4 * 128; bf16* orow = MIX + (t0 + i) * DM + g4 * 128;
#pragma unroll
    for (int ct = 0; ct < 8; ++ct) { f32x4 acc = (f32x4){0.f, 0.f, 0.f, 0.f};
#pragma unroll
        for (int ks = 0; ks < 4; ++ks) if (ks < nks) acc = sm::mma(sm::frag_t(Vn, 272, 16 * ct, 32 * ks, lane), f2[ks], acc);
        const int c = 16 * ct + 4 * gq; const f32x4 u = sm::unpack4(*(const u32x2*)(urow + c));
        *(u32x2*)(orow + c) = sm::pack4(u * (acc + bsi)); }
    lds_barrier();
}

namespace gdn {
constexpr int LF = 0, T1 = 17408, T2 = 26624, INM = 35840, VEC = 45056, QS = 46080, KS = 63488, VS = 80896, KDS = 98304, WT = 115712, UT = 133120;
__device__ __forceinline__ float silu(float x) { return x * __builtin_amdgcn_rcpf(1.0f + __expf(-x)); }
struct Pre { u32x4 r[11]; float a, b; };
constexpr int CWL = 150528;
__device__ __forceinline__ void prep_load(const Ctx& C, int ei, int unit, Pre& P) {
    const int n = unit & 63, h = (unit >> 6) & 3, b = unit >> 8; int tid = C.tid; asm volatile("" : "+v"(tid)); const int w = C.wave;
    const long tok0 = (long)b * SEQ + n * 64;
    if (w < 6) { const int X = tid >> 7, t = tid & 127, ck = t & 15, strip = t >> 4;
        const bf16* hp = (const bf16*)(C.ws + WS_ARENA) + 1024 + X * 512 + h * 128 + ck * 8;
#pragma unroll
        for (int idx = 0; idx < 11; ++idx) { const int r = strip * 8 - 3 + idx;
            P.r[idx] = (u32x4){0u, 0u, 0u, 0u}; if (n * 64 + r >= 0) P.r[idx] = *(const u32x4*)(hp + (tok0 + r) * H1LD); }
    } else if (w == 6) { const float* AB = (const float*)(C.ws + WS_AB) + (tok0 + (tid & 63)) * 8; P.a = AB[h]; P.b = AB[4 + h]; }
}
__device__ __forceinline__ void prep_unit(const Ctx& C, int ei, int unit, Pre& P, bool has_next, int unit_next) {
    const int n = unit & 63, h = (unit >> 6) & 3, b = unit >> 8;
    int tid_ = C.tid; asm volatile("" : "+v"(tid_));
    const int tid = tid_, lane = tid & 63, w = C.wave;
    LAS char* L = (LAS char*)C.lds;
    LAS float* gcs = (LAS float*)(L + VEC); LAS float* bet = gcs + 64; LAS float* egs = gcs + 128; LAS float* eks = gcs + 192;
    const int chunk = (b * 4 + h) * 64 + n;
    if (w < 6) { const int X = tid >> 7, t = tid & 127, ck = t & 15, strip = t >> 4;
        LAS char* dstb = L + (X == 0 ? QS : X == 1 ? KS : VS) + (strip * 8) * 272 + ck * 16;
#pragma unroll
        for (int tt = 0; tt < 8; ++tt) { float acc[8];
#pragma unroll
            for (int q = 0; q < 8; ++q) acc[q] = 0.f;
#pragma unroll
            for (int jj = 0; jj < 4; ++jj) { const u32x4 r = P.r[tt + jj]; const LAS float* wl = (const LAS float*)(L + CWL) + jj * 384 + X * 128 + ck * 8; const f32x4 w0 = *(const LAS f32x4*)wl, w1 = *(const LAS f32x4*)(wl + 4);
                acc[0] += w0[0] * bf_lo(r[0]); acc[1] += w0[1] * bf_hi(r[0]); acc[2] += w0[2] * bf_lo(r[1]); acc[3] += w0[3] * bf_hi(r[1]);
                acc[4] += w1[0] * bf_lo(r[2]); acc[5] += w1[1] * bf_hi(r[2]); acc[6] += w1[2] * bf_lo(r[3]); acc[7] += w1[3] * bf_hi(r[3]); }
            float ss = 0.f;
#pragma unroll
            for (int q = 0; q < 8; ++q) { acc[q] = silu(acc[q]); ss += acc[q] * acc[q]; }
            float sc = 1.f;
            if (X < 2) { ss += __shfl_xor(ss, 1); ss += __shfl_xor(ss, 2); ss += __shfl_xor(ss, 4); ss += __shfl_xor(ss, 8); sc = 1.0f / sqrtf(ss + RMS_EPS); if (X == 0) sc *= 0.08838834764831845f; }
            u32x4 o; o.x = cvt_pk_bf16(acc[0] * sc, acc[1] * sc); o.y = cvt_pk_bf16(acc[2] * sc, acc[3] * sc); o.z = cvt_pk_bf16(acc[4] * sc, acc[5] * sc); o.w = cvt_pk_bf16(acc[6] * sc, acc[7] * sc);
            *(LAS u32x4*)(dstb + tt * 272) = o; }
    } else if (w == 6) {
        const float a = P.a, bb = P.b; const float alog = C.inp(7)[ei * 4 + h], dtb = C.inp(8)[ei * 4 + h];
        const float xs = a + dtb; const float sp = xs > 20.f ? xs : log1pf(__expf(xs));
        float gv = -__expf(alog) * sp;
#pragma unroll
        for (int o = 1; o < 64; o <<= 1) { const float t_ = __shfl_up(gv, o); if (lane >= o) gv += t_; }
        const float gl = __shfl(gv, 63);
        gcs[lane] = gv; bet[lane] = 1.0f / (1.0f + __expf(-bb)); egs[lane] = __expf(gv); eks[lane] = __expf(gl - gv);
        if (lane == 0) ((float*)(C.ws + WS_GAM))[chunk] = __expf(gl); }
    lds_barrier();
    { const int i = tid >> 3, dc = (tid & 7) * 16; const float e = eks[i];
#pragma unroll
      for (int hh = 0; hh < 2; ++hh) { const u32x4 r = *(const LAS u32x4*)(L + KS + i * 272 + dc * 2 + 16 * hh); u32x4 o;
#pragma unroll
        for (int q = 0; q < 4; ++q) o[q] = cvt_pk_bf16(bf_lo(r[q]) * e, bf_hi(r[q]) * e);
        *(LAS u32x4*)(L + KDS + i * 272 + dc * 2 + 16 * hh) = o; } }
#pragma unroll
    for (int q = 0; q < 2; ++q) { const int tt = 2 * w + q, it = tt >> 2, jt = tt & 3;
        if (jt <= it) { f32x4 acc = (f32x4){0.f, 0.f, 0.f, 0.f};
#pragma unroll
            for (int ks = 0; ks < 4; ++ks) acc = sm::mma(sm::frag_n(L + KS, 272, 16 * jt, 32 * ks, lane), sm::frag_n(L + KS, 272, 16 * it, 32 * ks, lane), acc);
            const int i = 16 * it + (lane & 15), j0 = 16 * jt + 4 * (lane >> 4); const float gi = gcs[i], bi = bet[i]; f32x4 o;
#pragma unroll
            for (int r = 0; r < 4; ++r) o[r] = (i > j0 + r) ? bi * acc[r] * __expf(gi - gcs[j0 + r]) : 0.f;
            *(LAS f32x4*)(L + LF + (i * 68 + j0) * 4) = o; } }
    lds_barrier();
    if (has_next) prep_load(C, ei, unit_next, P);
#if defined(MK_REP) && MK_REP == 21
    for (int rr_ = 0; rr_ < 2; ++rr_)
#endif
    if (w == 7) {
        float t[64];
#pragma unroll
        for (int i = 0; i < 64; ++i) t[i] = 0.f;
#pragma unroll
        for (int i = 0; i < 64; ++i) { float s0 = 0.f, s1 = 0.f, s2 = 0.f, s3 = 0.f;
#pragma unroll
            for (int m = 0; m < i; m += 4) { const f32x4 l = *(const LAS f32x4*)(L + LF + (i * 68 + m) * 4); s0 += l[0] * t[m]; s1 += l[1] * t[m + 1]; s2 += l[2] * t[m + 2]; s3 += l[3] * t[m + 3]; }
            t[i] = ((lane == i) ? 1.f : 0.f) - ((s0 + s1) + (s2 + s3)); }
        const float bj = bet[lane], bej = bj * egs[lane];
#pragma unroll
        for (int i = 0; i < 64; ++i) { *(LAS bf16*)(L + T1 + i * 144 + lane * 2) = f2bf(t[i] * bej); *(LAS bf16*)(L + T2 + i * 144 + lane * 2) = f2bf(t[i] * bj); }
    } else {
        for (int tt = w; tt < 16; tt += 7) { const int it = tt >> 2, jt = tt & 3; f32x4 acc = (f32x4){0.f, 0.f, 0.f, 0.f};
            if (jt <= it) {
#pragma unroll
                for (int ks = 0; ks < 4; ++ks) acc = sm::mma(sm::frag_n(L + KS, 272, 16 * jt, 32 * ks, lane), sm::frag_n(L + QS, 272, 16 * it, 32 * ks, lane), acc); }
            const int i = 16 * it + (lane & 15), j0 = 16 * jt + 4 * (lane >> 4); const float gi = gcs[i]; f32x4 o;
#pragma unroll
            for (int r = 0; r < 4; ++r) o[r] = (i >= j0 + r) ? acc[r] * __expf(gi - gcs[j0 + r]) : 0.f;
            *(LAS u32x2*)(L + INM + i * 144 + j0 * 2) = sm::pack4(o); }
    }
    lds_barrier();
#if defined(MK_REP) && MK_REP == 23
    for (int rr_ = 0; rr_ < 2; ++rr_)
#endif
#pragma unroll 1
    for (int q = 0; q < 8; ++q) { const int tt = w * 8 + q, which = tt >> 5, xt = (tt & 31) >> 2, it = tt & 3; f32x4 acc = (f32x4){0.f, 0.f, 0.f, 0.f};
        const LAS char* src = L + (which ? VS : KS); const LAS char* tm = L + (which ? T2 : T1);
#pragma unroll
        for (int ks = 0; ks < 2; ++ks) acc = sm::mma(sm::frag_t(src, 272, 16 * xt, 32 * ks, lane), sm::frag_n(tm, 144, 16 * it, 32 * ks, lane), acc);
        *(LAS u32x2*)(L + (which ? UT : WT) + (16 * it + (lane & 15)) * 272 + (16 * xt + 4 * (lane >> 4)) * 2) = sm::pack4(acc); }
    lds_barrier();
#if defined(MK_REP) && MK_REP == 22
    for (int rr_ = 0; rr_ < 2; ++rr_)
#endif
    { bf16* Mg = (bf16*)(C.ws + WS_GM) + (size_t)chunk * 16384; bf16* Bg = (bf16*)(C.ws + WS_GB) + (size_t)chunk * 16384;
      bf16* Cg = (bf16*)(C.ws + WS_GC) + (size_t)chunk * 8192; bf16* Dg = (bf16*)(C.ws + WS_GD) + (size_t)chunk * 8192;
      const int x2 = lane & 15, x1 = 4 * (lane >> 4);
#pragma unroll 1
      for (int q = 0; q < 8; ++q) { const int tt = w * 8 + q, at = tt >> 3, bt = tt & 7;
        f32x4 am = (f32x4){0.f, 0.f, 0.f, 0.f}, ab = (f32x4){0.f, 0.f, 0.f, 0.f};
#pragma unroll
        for (int ks = 0; ks < 2; ++ks) { const bf16x8 fkd_b = sm::frag_t(L + KDS, 272, 16 * bt, 32 * ks, lane), fw = sm::frag_t(L + WT, 272, 16 * at, 32 * ks, lane);
            const bf16x8 fkd_a = sm::frag_t(L + KDS, 272, 16 * at, 32 * ks, lane), fu = sm::frag_t(L + UT, 272, 16 * bt, 32 * ks, lane);
            am = sm::mma(fw, fkd_b, am);
            ab = sm::mma(fkd_a, fu, ab); }
        *(u32x2*)(Mg + (16 * bt + x2) * 128 + 16 * at + x1) = sm::pack4(-am);
        *(u32x2*)(Bg + (16 * bt + x2) * 128 + 16 * at + x1) = sm::pack4(ab); }
#pragma unroll 1
      for (int q = 0; q < 4; ++q) { const int tt = w * 4 + q, at = tt >> 2, it = tt & 3;
        f32x4 ac = (f32x4){0.f, 0.f, 0.f, 0.f}, ad = (f32x4){0.f, 0.f, 0.f, 0.f};
#pragma unroll
        for (int ks = 0; ks < 2; ++ks) { const bf16x8 fin = sm::frag_n(L + INM, 144, 16 * it, 32 * ks, lane);
            ac = sm::mma(sm::frag_t(L + WT, 272, 16 * at, 32 * ks, lane), fin, ac);
            ad = sm::mma(sm::frag_t(L + UT, 272, 16 * at, 32 * ks, lane), fin, ad); }
        const int i = 16 * it + x2, d = 16 * at + x1; const f32x4 qv = sm::unpack4(*(const LAS u32x2*)(L + QS + i * 272 + d * 2));
        *(u32x2*)(Cg + i * 128 + d) = sm::pack4(qv * egs[i] - ac);
        *(u32x2*)(Dg + i * 128 + d) = sm::pack4(ad); } }
#ifdef DBG_DUMP
    { unsigned char* dst = C.ws + WS_HID + (size_t)chunk * 150528; for (int o = tid * 16; o < 150528; o += 512 * 16) *(u32x4*)(dst + o) = *(const LAS u32x4*)(L + o); }
#endif
    lds_barrier();
}

__device__ __forceinline__ void scan_unit(const Ctx& C, int unit) {
    const int cs = unit & 7, bh = unit >> 3;
    const int lane = C.lane, w = C.wave, x2 = lane & 15, g = lane >> 4;
    LAS char* ST = (LAS char*)C.lds;
    const bf16* Mg = (const bf16*)(C.ws + WS_GM) + (size_t)bh * 64 * 16384; const bf16* Bg = (const bf16*)(C.ws + WS_GB) + (size_t)bh * 64 * 16384;
    bf16* Sg = (bf16*)(C.ws + WS_GS) + (size_t)bh * 64 * 16384; const float* GAM = (const float*)(C.ws + WS_GAM) + bh * 64;
    const int c = cs * 16 + x2, d0 = 16 * w + 4 * g;
    { unsigned zz = 0u; asm volatile("" : "+v"(zz));
      if (C.tid < 272) *(LAS u32x4*)(ST + C.tid * 16) = (u32x4){zz, zz, zz, zz}; }
    __syncthreads();
    f32x4 acc = (f32x4){0.f, 0.f, 0.f, 0.f};
    const bf16* mrow = Mg + (16 * w + x2) * 128 + 8 * g; const bf16* brow = Bg + c * 128 + d0; bf16* srow = Sg + c * 128 + d0;
    int zl = 0; asm volatile("" : "+v"(zl));
    const float* gamp = GAM + zl;
    bf16x8 fm0[4], fm1[4], fm2[4], fm3[4]; u32x2 bv0, bv1, bv2, bv3; float gm0, gm1, gm2, gm3;
#define SC_LOAD(FM, BV, GM, n_) do { _Pragma("unroll") for (int ks = 0; ks < 4; ++ks) FM[ks] = *(const bf16x8*)(mrow + (size_t)(n_) * 16384 + 32 * ks); \
        BV = *(const u32x2*)(brow + (size_t)(n_) * 16384); GM = gamp[n_]; } while (0)
#define SC_STEP(FM, BV, GM, n_) do { \
        *(u32x2*)(srow + (size_t)(n_) * 16384) = sm::pack4(acc);            \
        f32x4 a_ = acc * GM + sm::unpack4(BV); const LAS char* sb_ = ST + ((n_) & 1) * 4352; \
        _Pragma("unroll") for (int ks = 0; ks < 4; ++ks) a_ = sm::mma(FM[ks], sm::frag_n(sb_, 272, 0, 32 * ks, lane), a_); \
        acc = a_; *(LAS u32x2*)(ST + (((n_) + 1) & 1) * 4352 + x2 * 272 + d0 * 2) = sm::pack4(acc); \
        if ((n_) + 4 < 64) SC_LOAD(FM, BV, GM, (n_) + 4); \
        lds_barrier(); } while (0)
    SC_LOAD(fm0, bv0, gm0, 0); SC_LOAD(fm1, bv1, gm1, 1); SC_LOAD(fm2, bv2, gm2, 2); SC_LOAD(fm3, bv3, gm3, 3);
#pragma unroll 1
    for (int n = 0; n < 64; n += 4) { SC_STEP(fm0, bv0, gm0, n); SC_STEP(fm1, bv1, gm1, n + 1); SC_STEP(fm2, bv2, gm2, n + 2); SC_STEP(fm3, bv3, gm3, n + 3); }
#undef SC_LOAD
#undef SC_STEP
}

__device__ __forceinline__ void out_unit(const Ctx& C, int ei, int unit) {
    const int pr = unit & 31, h = (unit >> 5) & 3, b = unit >> 7;
    const int lane = C.lane, w = C.wave, x2 = lane & 15, g = lane >> 4;
    const int n = 2 * pr + (w >> 2), it = w & 3, chunk = (b * 4 + h) * 64 + n;
    const bf16* Sg = (const bf16*)(C.ws + WS_GS) + (size_t)chunk * 16384; const bf16* Cg = (const bf16*)(C.ws + WS_GC) + (size_t)chunk * 8192; const bf16* Dg = (const bf16*)(C.ws + WS_GD) + (size_t)chunk * 8192;
    const bf16* H1 = (const bf16*)(C.ws + WS_ARENA); bf16* MIX = (bf16*)(C.ws + WS_MIX);
    const int i = 16 * it + x2; const size_t tok = (size_t)b * SEQ + n * 64 + i;
    bf16x8 fc[4];
#pragma unroll
    for (int ks = 0; ks < 4; ++ks) fc[ks] = *(const bf16x8*)(Cg + i * 128 + 32 * ks + 8 * g);
    f32x4 o[8]; float ss = 0.f;
#pragma unroll
    for (int ct = 0; ct < 8; ++ct) { f32x4 a = sm::unpack4(*(const u32x2*)(Dg + i * 128 + 16 * ct + 4 * g));
#pragma unroll
        for (int ks = 0; ks < 4; ++ks) a = sm::mma(*(const bf16x8*)(Sg + (16 * ct + x2) * 128 + 32 * ks + 8 * g), fc[ks], a);
        o[ct] = a; ss += (a[0] * a[0] + a[1] * a[1]) + (a[2] * a[2] + a[3] * a[3]); }
    ss += __shfl_xor(ss, 16); ss += __shfl_xor(ss, 32);
    const float rstd = 1.0f / sqrtf(ss * (1.f / 128.f) + RMS_EPS);
    const float* nw = C.inp(9) + ei * 128; const bf16* zrow = H1 + tok * H1LD + 2560 + h * 128; bf16* orow = MIX + tok * DM + 512 + h * 128;
#pragma unroll
    for (int ct = 0; ct < 8; ++ct) { const int c = 16 * ct + 4 * g; const f32x4 z = sm::unpack4(*(const u32x2*)(zrow + c)); const f32x4 nv = *(const f32x4*)(nw + c); f32x4 y;
#pragma unroll
        for (int r = 0; r < 4; ++r) y[r] = o[ct][r] * rstd * nv[r] * silu(z[r]);
        *(u32x2*)(orow + c) = sm::pack4(y); }
}
}

__device__ __forceinline__ void phase_even_local(const Ctx& C0, int ei) {
    { const Ctx C = phase_ctx(C0); for (int u = C.bid; u < 1024; u += C.G) { sgu_unit(C, ei, u);
#if defined(MK_REP) && MK_REP == 20
        sgu_unit(C, ei, u);
#endif
      } }
    { const Ctx C = phase_ctx(C0); gdn::Pre P; int u = C.bid; if (u < 2048) gdn::prep_load(C, ei, u, P);
      { const int h = (C.bid >> 6) & 3; const float* cw = C.inp(6) + (size_t)ei * 4 * 1536;
        for (int idx = C.tid; idx < 4 * 384; idx += NWAVES * 64) { const int jj = idx / 384, c = idx % 384; ((LAS float*)(C.lds + gdn::CWL))[idx] = cw[jj * 1536 + (c >> 7) * 512 + h * 128 + (c & 127)]; }
        lds_barrier(); }
      for (; u < 2048; u += C.G) gdn::prep_unit(C, ei, u, P, u + C.G < 2048, u + C.G); }
}
__device__ __forceinline__ void phase_scan(const Ctx& C0) { const Ctx C = phase_ctx(C0);
    for (int v = C.bid; v < 256; v += C.G) { const int x = v & 7, k = v >> 3, u = ((x * 4 + (k >> 3)) << 3) | (k & 7); gdn::scan_unit(C, u); __syncthreads(); } }
__device__ __forceinline__ void phase_gdn_out(const Ctx& C0, int ei) { const Ctx C = phase_ctx(C0); for (int u = C.bid; u < 1024; u += C.G) gdn::out_unit(C, ei, u); }

#ifndef MK_PER_PHASE
#define MK_PER_PHASE 0
#endif
constexpr int N_PHASES = 1 + DEPTH * 9;
#ifndef PH_EN
#define PH_EN 0x7fff
#endif
#define PEN(k) ((PH_EN >> (k)) & 1)
#ifndef MK_REP
#define MK_REP -1
#endif
#define REPF(k) for (int r_ = 0; r_ < ((MK_REP == (k)) ? 2 : 1); ++r_)
struct Args { const float* in[27]; float* out; unsigned char* ws; int ph_lo, ph_hi; };

__global__ void __launch_bounds__(NWAVES * 64, 2) mk_fwd(Args args) {
    extern __shared__ __attribute__((aligned(16))) unsigned char lds_raw[];
    Ctx C;
    C.lds = (LAS unsigned char*)lds_raw;
    C.tid = threadIdx.x; C.lane = C.tid & 63; C.wave = __builtin_amdgcn_readfirstlane(C.tid >> 6); C.G = gridDim.x; C.bid = blockIdx.x;
    C.ka = (const __attribute__((address_space(4))) char*)__builtin_amdgcn_kernarg_segment_ptr();
    C.out = nullptr; C.ws = nullptr; C.ctl = nullptr;
    for (int u = C.tid; u < 128; u += NWAVES * 64) ((LAS unsigned*)(C.lds + LDS_CTL_OFF))[u] = 0u;
    __syncthreads();
#if !MK_PER_PHASE
    { const Ctx P = phase_ctx(C); (void)xcd_barrier_post((unsigned*)P.ws + CW_BAR, (volatile LAS unsigned*)(C.lds + LDS_CTL_OFF) + 8); }
#define GRID_BAR() do { const Ctx P_ = phase_ctx(C); XcdBarrier b_; b_.bar = (unsigned*)P_.ws + CW_BAR; b_.x = xb_xcc_id(); b_.st = (volatile LAS unsigned*)(C.lds + LDS_CTL_OFF) + 8; xcd_barrier(b_); } while (0)
#else
#define GRID_BAR() do {} while (0)
#endif
    const int lo = args.ph_lo, hi = args.ph_hi;
#define IN(k) (lo <= (k) && (k) < hi)
#define SEAM(k) do { if (IN((k) + 1)) GRID_BAR(); } while (0)
    if (PEN(0) && IN(0)) { REPF(0) phase_prologue(C); SEAM(0); }
#define MK_LAYER(L) { \
        const int pb = 1 + L * 9, li = L >> 1; \
        if ((L & 1) == 0) { \
            if (PEN(1) && IN(pb + 0)) { \
                const Ctx P = phase_ctx(C); unsigned char* ws = P.ws; \
                EpiBf16 E{(bf16*)(ws + WS_ARENA), EVEN_N, 1024}; \
                REPF(1) run_plain_gemm(P, (const bf16*)(ws + WS_XB), DM, DM, EVEN_N, (const bf16*)(ws + WS_WEIN) + (size_t)li * EVEN_N * DM, E); \
                SEAM(pb + 0); } \
            if (PEN(2) && IN(pb + 1)) { REPF(2) phase_even_local(C, li); SEAM(pb + 1); } \
            if (PEN(3) && IN(pb + 2)) { REPF(3) phase_scan(C); SEAM(pb + 2); } \
            if (PEN(4) && IN(pb + 3)) { REPF(4) phase_gdn_out(C, li); SEAM(pb + 3); } \
            if (PEN(5) && IN(pb + 4)) { \
                const Ctx P = phase_ctx(C); unsigned char* ws = P.ws; \
                EpiRes E{(const bf16*)(ws + WS_XB), (bf16*)(ws + WS_Y)}; \
                REPF(5) run_plain_gemm(P, (const bf16*)(ws + WS_MIX), DM, DM, DM, (const bf16*)(ws + WS_WEOUT) + (size_t)li * DM * DM, E); \
                SEAM(pb + 4); } \
        } else { \
            if (PEN(6) && IN(pb + 0)) { \
                const Ctx P = phase_ctx(C); unsigned char* ws = P.ws; \
                EpiBf16 E{(bf16*)(ws + WS_ARENA + AR_C1), ODD_N, 0}; \
                REPF(6) run_plain_gemm(P, (const bf16*)(ws + WS_XB), DM, DM, ODD_N, (const bf16*)(ws + WS_WOIN) + (size_t)li * ODD_N * DM, E); \
                SEAM(pb + 0); } \
            if (PEN(7) && IN(pb + 1)) { REPF(7) phase_o1b(C); SEAM(pb + 1); } \
            if (PEN(8) && IN(pb + 2)) { \
                { const Ctx P = phase_ctx(C); unsigned char* ws = P.ws; \
                  EpiQ E{(bf16*)(ws + WS_ARENA + AR_Q), (const float*)(ws + WS_RS), (const f32x4*)(ws + WS_ROPE)}; \
                  REPF(8) run_plain_gemm(P, (const bf16*)(ws + WS_ARENA + AR_C1), ODD_N, QL, 1536, (const bf16*)(ws + WS_WUQ) + (size_t)li * 1536 * QL, E); } \
                { const Ctx P = phase_ctx(C); unsigned char* ws = P.ws; \
                  EpiKV E{(bf16*)(ws + WS_ARENA + AR_KV), (const float*)(ws + WS_RS) + T}; \
                  REPF(8) run_plain_gemm(P, (const bf16*)(ws + WS_ARENA + AR_C1) + QL, ODD_N, KVL, 2048, (const bf16*)(ws + WS_WUKV) + (size_t)li * 2048 * KVL, E); } \
                SEAM(pb + 2); } \
            if (PEN(9) && IN(pb + 3)) { REPF(9) phase_attn(C); SEAM(pb + 3); } \
            if (PEN(10) && IN(pb + 4)) { \
                const Ctx P = phase_ctx(C); unsigned char* ws = P.ws; \
                EpiRes E{(const bf16*)(ws + WS_XB), (bf16*)(ws + WS_Y)}; \
                REPF(10) run_plain_gemm(P, (const bf16*)(ws + WS_MIX), DM, DM, DM, (const bf16*)(ws + WS_WOOUT) + (size_t)li * DM * DM, E); \
                SEAM(pb + 4); } \
        } \
        if (PEN(11) && IN(pb + 5)) { phase_router(C, L); SEAM(pb + 5); } \
        if (PEN(12) && IN(pb + 6)) { \
            const Ctx P = phase_ctx(C); unsigned char* ws = P.ws; \
            EpiSwiglu E{(bf16*)(ws + WS_HID), P.inp(24) + (size_t)L * NEXP * 2048, nullptr}; \
            REPF(12) run_moe_gemm(P, L, (const bf16*)(ws + WS_XB), DM, 2, DM, 2048, (const bf16*)(ws + WS_WGU) + (size_t)L * NEXP * 2048 * DM, (size_t)2048 * DM, E); \
            SEAM(pb + 6); } \
        if (PEN(13) && IN(pb + 7)) { \
            const Ctx P = phase_ctx(C); unsigned char* ws = P.ws; \
            EpiDown E{(bf16*)(ws + WS_YE), P.inp(26) + (size_t)L * NEXP * DM, (const float*)(ws + WS_GATE), nullptr}; \
            REPF(13) run_moe_gemm(P, L, (const bf16*)(ws + WS_HID), DFF, 0, DFF, DM, (const bf16*)(ws + WS_WDN) + (size_t)L * NEXP * DM * DFF, (size_t)DM * DFF, E); \
            SEAM(pb + 7); } \
        if (PEN(14) && IN(pb + 8)) { phase_combine(C, L); SEAM(pb + 8); } \
    }
    MK_LAYER(0) MK_LAYER(1) MK_LAYER(2) MK_LAYER(3)
#undef MK_LAYER
#undef IN
#undef SEAM
}

extern "C" void kernel_launch(void* const* d_in, const int* in_sizes, int n_in, void* d_out, int out_size, void* d_ws, size_t ws_size, hipStream_t stream) {
    static int grid = 0;
    if (grid == 0) {
        if (n_in != 27 || in_sizes[0] != T * DM || out_size != T * DM || ws_size < WS_END) { fprintf(stderr, "kernel_launch: unexpected shapes (n_in %d, in0 %d, out %d, ws %zu)\n", n_in, n_in > 0 ? in_sizes[0] : -1, out_size, ws_size); grid = -1; return; }
        int dev = 0, cus = 0, per_cu = 0;
        if (hipGetDevice(&dev) != hipSuccess || hipDeviceGetAttribute(&cus, hipDeviceAttributeMultiprocessorCount, dev) != hipSuccess) { grid = -1; return; }
        if (hipFuncSetAttribute((const void*)mk_fwd, hipFuncAttributeMaxDynamicSharedMemorySize, LDS_BYTES) != hipSuccess) { fprintf(stderr, "kernel_launch: hipFuncSetAttribute failed\n"); grid = -1; return; }
        if (hipOccupancyMaxActiveBlocksPerMultiprocessor(&per_cu, (const void*)mk_fwd, NWAVES * 64, LDS_BYTES) != hipSuccess || per_cu < 1) fprintf(stderr, "kernel_launch: occupancy query reports %d\n", per_cu);
        (void)hipGetLastError();
        grid = cus;
        if (grid != 256) fprintf(stderr, "kernel_launch: %d CUs (built for 256)\n", grid);
    }
    if (grid < 0) return;
    if (hipMemsetAsync((char*)d_ws + WS_CTL, 0, CTL_ZERO_BYTES, stream) != hipSuccess) return;
    Args a{};
    for (int i = 0; i < 27; ++i) a.in[i] = (const float*)d_in[i];
    a.out = (float*)d_out; a.ws = (unsigned char*)d_ws;
#if MK_PER_PHASE
    for (int p = 0; p < N_PHASES; ++p) { a.ph_lo = p; a.ph_hi = p + 1; hipLaunchKernelGGL(mk_fwd, dim3(grid), dim3(NWAVES * 64), LDS_BYTES, stream, a); }
#else
    a.ph_lo = 0; a.ph_hi = N_PHASES;
    hipLaunchKernelGGL(mk_fwd, dim3(grid), dim3(NWAVES * 64), LDS_BYTES, stream, a);
#endif
    const hipError_t le = hipPeekAtLastError();
    if (le != hipSuccess) fprintf(stderr, "kernel_launch: launch failed: %s\n", hipGetErrorName(le));
}
```

```cpp
#define MK_PER_PHASE 0
#include <hip/hip_runtime.h>
#include <cstdio>
#include <cstdint>

#define GAS __attribute__((address_space(1)))
#define LAS __attribute__((address_space(3)))
typedef unsigned short bf16;
typedef short bf16x8 __attribute__((ext_vector_type(8)));
typedef short s16x4 __attribute__((ext_vector_type(4)));
typedef float f32x2 __attribute__((ext_vector_type(2)));
typedef float f32x4 __attribute__((ext_vector_type(4)));
typedef float f32x16 __attribute__((ext_vector_type(16)));
typedef unsigned u32x2 __attribute__((ext_vector_type(2)));
typedef unsigned u32x4 __attribute__((ext_vector_type(4)));
typedef GAS unsigned gu32;

typedef __bf16 bf16v2_t __attribute__((ext_vector_type(2)));
__device__ __forceinline__ unsigned cvt_pk_bf16(float lo, float hi) { const bf16v2_t v = __builtin_convertvector((f32x2){lo, hi}, bf16v2_t); return __builtin_bit_cast(unsigned, v); }
__device__ __forceinline__ int lane_id_opaque() { int l; asm volatile("v_mbcnt_lo_u32_b32 %0, -1, 0\n\tv_mbcnt_hi_u32_b32 %0, -1, %0" : "=v"(l)); return l; }
__device__ __forceinline__ float bf_lo(unsigned w) { return __uint_as_float(w << 16); }
__device__ __forceinline__ float bf_hi(unsigned w) { return __uint_as_float(w & 0xffff0000u); }
__device__ __forceinline__ float bf2f(bf16 b) { return __uint_as_float(((unsigned)b) << 16); }
__device__ __forceinline__ bf16 f2bf(float f) { return (bf16)(cvt_pk_bf16(f, 0.f) & 0xffffu); }
__device__ __forceinline__ float wave_sum(float v) {
#pragma unroll
    for (int o = 1; o < 64; o <<= 1) v += __shfl_xor(v, o);
    return v;
}

namespace pg8 {
constexpr int BM = 256, BK = 64, HALF = 128, HTB = HALF * BK * 2, STAGE_BYTES = 8 * HTB, NXCD = 8, WGM = 8;
__host__ __device__ __forceinline__ int lds_byte(int r, int c) { const int st = (r >> 4) * 2 + (c >> 5), rr = r & 15, cc = c & 31, ob = rr * 64 + cc * 2; return st * 1024 + (ob ^ (((ob >> 9) & 1) << 5)); }
__host__ __device__ __forceinline__ void stage_rc(int b, int& R, int& C) { const int st = b / 1024, sb = b % 1024, swz = sb ^ (((sb >> 9) & 1) << 5); R = (st >> 1) * 16 + swz / 64; C = (st & 1) * 32 + (swz % 64) / 2; }
__host__ __device__ __forceinline__ int perm32(int rho) { const int n = rho >> 4, i = rho & 15; return 8 * (i >> 2) + 4 * n + (i & 3); }

struct Unit { int pm, pn, e, li; };

struct StaticOrder {
    int nM, nN, nwg, G, c;
    __device__ void init(int M, int N, int G_, int c_) { nM = M / BM; nN = N / BM; nwg = nM * nN; G = G_; c = c_; }
    __device__ bool next(int i, Unit& u) const {
        const long L = (long)i * G + c; if (L >= nwg) return false;
        int wgid = (int)L; { const int q = nwg / NXCD, r = nwg % NXCD, xcd = wgid % NXCD, off = wgid / NXCD; wgid = (xcd < r ? xcd * (q + 1) : r * (q + 1) + (xcd - r) * q) + off; }
        const int nig = WGM * nN, gid = wgid / nig, fm = gid * WGM, gsz = (nM - fm) < WGM ? (nM - fm) : WGM;
        u.pm = fm + ((wgid % nig) % gsz); u.pn = (wgid % nig) / gsz; u.e = 0; u.li = i; return true;
    }
};
struct PlainSched {
    static constexpr bool GATHER = false;
    StaticOrder o; const char* Bt; int K; int lda;
    __device__ __forceinline__ size_t arow0(const Unit& u) const { return (size_t)u.pm * BM * lda * 2; }
    __device__ __forceinline__ bool next(int i, Unit& u) const { return o.next(i, u); }
    __device__ __forceinline__ const char* bbase(const Unit& u) const { return Bt + (size_t)u.pn * BM * K * 2; }
};

__device__ __forceinline__ f32x2 gelu_pk(f32x2 v) {
    const f32x2 av = __builtin_elementwise_abs(v), d = av * 0.2316418882f + 1.0f;
    f32x2 t; t.x = __builtin_amdgcn_rcpf(d.x); t.y = __builtin_amdgcn_rcpf(d.y);
    f32x2 q = t * 0.5307027145f + (-0.7265760135f); q = q * t + 0.7107068705f; q = q * t + (-0.142248368f); q = q * t + 0.127414796f; q = q * t;
    const f32x2 s = (v * v) * (-0.72134752044f);
    f32x2 e; e.x = __builtin_amdgcn_exp2f(s.x); e.y = __builtin_amdgcn_exp2f(s.y);
    const f32x2 m = v * (q * e), r = v - m;
    f32x2 o; o.x = v.x < 0.f ? m.x : r.x; o.y = v.y < 0.f ? m.y : r.y; return o;
}

template <class Epi, class Sched, bool ALIGN_EPI>
__device__ __forceinline__ void gemm_phase(LAS unsigned char* lds, const char* Abase, int K, const Sched& S, const Epi& E, int wave_idx) {
    int tid_ = wave_idx * 64 + lane_id_opaque();
    const int tid = tid_, wid = __builtin_amdgcn_readfirstlane(tid >> 6), lane = tid & 63, wr = wid >> 2, wc = wid & 3, fr = lane & 15, fq = lane >> 4;
    int nt = K / BK; asm volatile("" : "+s"(nt));
    int Rr[2], Cc[2]; unsigned voffB[2], voffA[2];
#pragma unroll
    for (int i = 0; i < 2; ++i) { stage_rc(tid * 16 + i * 8192, Rr[i], Cc[i]); const int Rb = Epi::PERM ? ((Rr[i] & ~31) + perm32(Rr[i] & 31)) : Rr[i]; voffB[i] = (unsigned)(Rb * K + Cc[i]) * 2u;
        voffA[i] = 0u; if constexpr (!Sched::GATHER) voffA[i] = (unsigned)(Rr[i] * S.lda + Cc[i]) * 2u; }
    const size_t hstepA = (size_t)HALF * S.lda * 2;
    const size_t kstep = (size_t)(BK * 2);
    const size_t hstepB = (size_t)HALF * K * 2;
    const unsigned ldsw = (unsigned)wid * 1024u;
    const int aoff = lds_byte(wr * 64 + fr, fq * 8), boff = lds_byte(wc * 32 + fr, fq * 8);
#define PG8_SA(b, h) (((b) * 2 + (h)) * HTB)
#define PG8_SB(b, h) ((4 + (b) * 2 + (h)) * HTB)
#define PG8_STAGEB(bufoff, gbase) do { _Pragma("unroll") for (int _i = 0; _i < 2; ++_i) \
        __builtin_amdgcn_global_load_lds((const unsigned*)((const char*)(gbase) + voffB[_i]), (LAS unsigned*)(lds + (bufoff) + ldsw + _i * 8192), 16, 0, 0); } while (0)
#define PG8_STAGEA(bufoff, h, koff) do { _Pragma("unroll") for (int _i = 0; _i < 2; ++_i) { \
        if constexpr (Sched::GATHER) __builtin_amdgcn_global_load_lds((const unsigned*)(Abase + (size_t)va[h][_i] + (koff)), (LAS unsigned*)(lds + (bufoff) + ldsw + _i * 8192), 16, 0, 0); \
        else __builtin_amdgcn_global_load_lds((const unsigned*)(cA + (h) * hstepA + (koff) + voffA[_i]), (LAS unsigned*)(lds + (bufoff) + ldsw + _i * 8192), 16, 0, 0); } } while (0)
#define PG8_LDA(dst, b, h) do { _Pragma("unroll") for (int m = 0; m < 4; ++m) _Pragma("unroll") for (int k = 0; k < 2; ++k) dst[m][k] = *(const LAS bf16x8*)(lds + PG8_SA(b, h) + aoff + m * 2048 + k * 1024); } while (0)
#define PG8_LDB(dst, b, h) do { _Pragma("unroll") for (int n = 0; n < 2; ++n) _Pragma("unroll") for (int k = 0; k < 2; ++k) dst[n][k] = *(const LAS bf16x8*)(lds + PG8_SB(b, h) + boff + n * 2048 + k * 1024); } while (0)
#define PG8_MMA(ai, bj, At, Bt) do { __builtin_amdgcn_s_setprio(1); _Pragma("unroll") for (int m = 0; m < 4; ++m) _Pragma("unroll") for (int n = 0; n < 2; ++n) _Pragma("unroll") for (int k = 0; k < 2; ++k) \
        acc[ai][bj][m][n] = __builtin_amdgcn_mfma_f32_16x16x32_bf16(Bt[n][k], At[m][k], acc[ai][bj][m][n], 0, 0, 0); __builtin_amdgcn_s_setprio(0); } while (0)
#define PG8_WAIT_V(n) asm volatile("s_waitcnt vmcnt(" #n ")" ::: "memory")
#define PG8_WAIT_L(n) asm volatile("s_waitcnt lgkmcnt(" #n ")" ::: "memory")
#define PG8_BAR __builtin_amdgcn_s_barrier()
#define PG8_SCHED __builtin_amdgcn_sched_barrier(0)
    Unit cur, nxt; int ui = 0;
    if (!S.next(0, cur)) return;
    f32x4 acc[2][2][4][2];
#pragma unroll
    for (int a = 0; a < 2; ++a)
#pragma unroll
        for (int b = 0; b < 2; ++b)
#pragma unroll
            for (int m = 0; m < 4; ++m)
#pragma unroll
                for (int n = 0; n < 2; ++n) acc[a][b][m][n] = (f32x4){0.f, 0.f, 0.f, 0.f};
    bf16x8 At[4][2], B0[2][2], B1[2][2];
    unsigned va[2][2], vn[2][2]; const char* cA = Abase; const char* nA = Abase;
    if constexpr (Sched::GATHER) {
#pragma unroll
        for (int h = 0; h < 2; ++h)
#pragma unroll
            for (int i = 0; i < 2; ++i) va[h][i] = S.aoff(cur, h * HALF + Rr[i]) + (unsigned)Cc[i] * 2u;
    } else { cA = Abase + S.arow0(cur); }
    const char* cB = S.bbase(cur);
    PG8_STAGEB(PG8_SB(0, 0), cB); PG8_STAGEB(PG8_SB(0, 1), cB + hstepB); PG8_STAGEA(PG8_SA(0, 0), 0, 0); PG8_STAGEA(PG8_SA(0, 1), 1, 0);
    if (wr == 1) PG8_BAR;
    PG8_WAIT_V(2); PG8_BAR;
    PG8_STAGEB(PG8_SB(1, 0), cB + kstep); PG8_STAGEA(PG8_SA(1, 0), 0, kstep); PG8_STAGEB(PG8_SB(1, 1), cB + hstepB + kstep);
    PG8_WAIT_V(6); PG8_BAR;
    for (;;) {
        const bool has_next = S.next(ui + 1, nxt);
        const char* nB = has_next ? S.bbase(nxt) : cB;
        if constexpr (Sched::GATHER) {
            if (has_next) {
#pragma unroll
                for (int h = 0; h < 2; ++h)
#pragma unroll
                    for (int i = 0; i < 2; ++i) vn[h][i] = S.aoff(nxt, h * HALF + Rr[i]) + (unsigned)Cc[i] * 2u;
            } else {
#pragma unroll
                for (int h = 0; h < 2; ++h)
#pragma unroll
                    for (int i = 0; i < 2; ++i) vn[h][i] = va[h][i];
            }
        } else { nA = has_next ? Abase + S.arow0(nxt) : cA; }
        for (int t = 0; t < nt; t += 2) {
            const bool last = (t == nt - 2);
            const size_t k1 = (size_t)(t + 1) * kstep;
            PG8_LDB(B0, 0, 0); PG8_LDB(B1, 0, 1); PG8_SCHED; PG8_LDA(At, 0, 0); PG8_STAGEA(PG8_SA(1, 1), 1, k1);
            PG8_WAIT_V(8); PG8_WAIT_L(0); PG8_BAR; PG8_MMA(0, 0, At, B0); PG8_MMA(0, 1, At, B1); PG8_BAR; PG8_SCHED;
            if (last) {
                if constexpr (Sched::GATHER) {
#pragma unroll
                    for (int h = 0; h < 2; ++h)
#pragma unroll
                        for (int i = 0; i < 2; ++i) va[h][i] = vn[h][i];
                } else { cA = nA; }
            }
            const char* bX = last ? nB : cB;
            const size_t k2 = last ? (size_t)0 : (size_t)(t + 2) * kstep, k3 = k2 + kstep;
            PG8_LDA(At, 0, 1); PG8_STAGEB(PG8_SB(0, 0), bX + k2); PG8_STAGEB(PG8_SB(0, 1), bX + hstepB + k2); PG8_STAGEA(PG8_SA(0, 0), 0, k2);
            PG8_WAIT_V(8); PG8_WAIT_L(0); PG8_BAR; PG8_MMA(1, 0, At, B0); PG8_MMA(1, 1, At, B1); PG8_BAR; PG8_SCHED;
            PG8_LDB(B0, 1, 0); PG8_LDB(B1, 1, 1); PG8_SCHED; PG8_LDA(At, 1, 0); PG8_STAGEA(PG8_SA(0, 1), 1, k2);
            PG8_WAIT_V(8); PG8_WAIT_L(0); PG8_BAR; PG8_MMA(0, 0, At, B0); PG8_MMA(0, 1, At, B1); PG8_BAR; PG8_SCHED;
            PG8_LDA(At, 1, 1); PG8_STAGEB(PG8_SB(1, 0), bX + k3); PG8_STAGEB(PG8_SB(1, 1), bX + hstepB + k3); PG8_STAGEA(PG8_SA(1, 0), 0, k3);
            PG8_WAIT_V(8); PG8_WAIT_L(0); PG8_BAR; PG8_MMA(1, 0, At, B0); PG8_MMA(1, 1, At, B1); PG8_BAR; PG8_SCHED;
        }
        if constexpr (ALIGN_EPI) { if (wr == 0) PG8_BAR; }
        E(acc, cur, wr, wc, fr, fq);
        if (!has_next) break;
#pragma unroll
        for (int a = 0; a < 2; ++a)
#pragma unroll
            for (int b = 0; b < 2; ++b)
#pragma unroll
                for (int m = 0; m < 4; ++m)
#pragma unroll
                    for (int n = 0; n < 2; ++n) acc[a][b][m][n] = (f32x4){0.f, 0.f, 0.f, 0.f};
        cur = nxt; cB = nB; ++ui;
        if constexpr (ALIGN_EPI) { if (wr == 1) PG8_BAR; }
    }
    PG8_WAIT_V(0);
    if constexpr (!ALIGN_EPI) { if (wr == 0) PG8_BAR; }
    PG8_BAR;
#undef PG8_SA
#undef PG8_SB
#undef PG8_STAGEA
#undef PG8_STAGEB
#undef PG8_LDA
#undef PG8_LDB
#undef PG8_MMA
#undef PG8_WAIT_V
#undef PG8_WAIT_L
#undef PG8_BAR
#undef PG8_SCHED
}
}

constexpr int NWAVES = 8;
constexpr int BATCH = 8, SEQ = 4096, DM = 1024, DEPTH = 4;
constexpr int T = BATCH * SEQ;
constexpr int EVEN_IN = 3080, EVEN_N = 3072;
constexpr int ODD_IN = 704, ODD_N = 768, QL = 384, KVL = 256;
constexpr int NEXP = 32, TOPK = 4, DFF = 1024;
constexpr int NSLOT = T * TOPK;
constexpr int LCAP = T;
constexpr float LN_EPS = 1e-5f, RMS_EPS = 1e-6f;
constexpr float DN_ALPHA = 1.681792830507429f;
constexpr float ATT_SCALE = 0.07216878364870323f;

constexpr size_t MiB = 1u << 20;
constexpr size_t WS_CTL = 0, CTL_ZERO_BYTES = 1 * MiB;
constexpr size_t WS_WGU = 16 * MiB, WS_WDN = 528 * MiB, WS_WEIN = 784 * MiB, WS_WEOUT = 796 * MiB, WS_WOIN = 800 * MiB, WS_WUQ = 804 * MiB, WS_WUKV = 808 * MiB, WS_WOOUT = 810 * MiB;
constexpr size_t WS_ROPE = 814 * MiB, WS_AB = 815 * MiB, WS_RS = 816 * MiB, WS_GATE = 817 * MiB, WS_LIST = 818 * MiB, WS_GAM = 822 * MiB;
constexpr size_t WS_XF = 832 * MiB, WS_XB = 960 * MiB, WS_Y = 1024 * MiB, WS_ARENA = 1152 * MiB, WS_MIX = 1440 * MiB;
constexpr size_t WS_GM = 1504 * MiB, WS_GB = 1568 * MiB, WS_GC = 1632 * MiB, WS_GD = 1664 * MiB, WS_GS = 1696 * MiB, WS_HID = 1760 * MiB, WS_YE = 2048 * MiB, WS_END = 2304 * MiB;
constexpr size_t AR_C1 = 0, AR_Q = 48 * MiB, AR_KV = 144 * MiB, AR_KPE = 272 * MiB;
constexpr int CW_TMO = 0, CW_CODE = 1, CW_BAR = 4096, CW_CNT = 16384;

constexpr int LDS_BYTES = 163840;
constexpr int LDS_CTL_OFF = 163840 - 512;
constexpr int LDS_SPARE = 131072;

#define RLX_AGENT __ATOMIC_RELAXED, __HIP_MEMORY_SCOPE_AGENT
#define LDS_WAIT() asm volatile("s_waitcnt lgkmcnt(0)" ::: "memory")
#define VM_WAIT() asm volatile("s_waitcnt vmcnt(0)" ::: "memory")
__device__ __forceinline__ void lds_barrier() { asm volatile("s_waitcnt lgkmcnt(0)" ::: "memory"); __builtin_amdgcn_s_barrier(); asm volatile("" ::: "memory"); }

#define XB_TMO      128
#define XB_XCNT(j)  (256  + 64 * (j))
#define XB_XSUB(j)  (1280 + 64 * (j))
#define XB_XGEN(j)  (2304 + 64 * (j))
#define XB_TOP      3328
#define XB_TOPGEN   3392
#define XCD_BAR_WORDS 3456
#define XB_SPIN_CAP (1u << 18)
__device__ __forceinline__ unsigned xb_ld(unsigned* p)              { return __hip_atomic_load(p, __ATOMIC_RELAXED, __HIP_MEMORY_SCOPE_AGENT); }
__device__ __forceinline__ unsigned xb_add(unsigned* p, unsigned v) { return __hip_atomic_fetch_add(p, v, __ATOMIC_RELAXED, __HIP_MEMORY_SCOPE_AGENT); }
__device__ __forceinline__ unsigned xb_xcc_id() { return (unsigned)__builtin_amdgcn_s_getreg((3 << 11) | 20) & 0xFu; }
#define XB_SPIN(cond, bar) do { unsigned _sp = 0; while (cond) { __builtin_amdgcn_s_sleep(1); \
    if ((++_sp & 255u) == 0u) { if (xb_ld(&(bar)[XB_TMO])) break; if (_sp > XB_SPIN_CAP) { atomicAdd(&(bar)[XB_TMO], 1u); break; } } } } while (0)
struct XcdBarrier { unsigned* bar; unsigned x; volatile LAS unsigned* st; };
__device__ __forceinline__ XcdBarrier xcd_barrier_post(unsigned* bar, volatile LAS unsigned* st, bool leader) {
    XcdBarrier b; b.bar = bar; b.x = xb_xcc_id(); b.st = st;
    if (leader) (void)xb_add(&bar[XB_XCNT(b.x)], 1u);
    return b;
}
__device__ __forceinline__ void xcd_barrier_complete(unsigned* bar, unsigned x, unsigned& nloc, unsigned& nx) {
    const unsigned G = gridDim.x * gridDim.y * gridDim.z;
    unsigned sum, cnt, mine, sp = 0u;
    for (;;) {
        sum = 0u; cnt = 0u; mine = 0u;
#pragma unroll
        for (unsigned j = 0; j < 16; ++j) { const unsigned c = xb_ld(&bar[XB_XCNT(j)]); sum += c; cnt += (c > 0u) ? 1u : 0u; mine = (j == x) ? c : mine; }
        if (sum == G) break;
        __builtin_amdgcn_s_sleep(1);
        if ((++sp & 255u) == 0u) { if (xb_ld(&bar[XB_TMO])) break; if (sp > XB_SPIN_CAP) { atomicAdd(&bar[XB_TMO], 1u); break; } }
    }
    nloc = mine > 0u ? mine : 1u; nx = cnt > 0u ? cnt : 1u;
}
__device__ __forceinline__ void xcd_barrier(const XcdBarrier& b, bool leader) {
    asm volatile("s_waitcnt vmcnt(0)" ::: "memory");
    __syncthreads();
    if (leader) {
        unsigned* bar = b.bar;
        __builtin_amdgcn_s_waitcnt(0);
        unsigned nloc = b.st[0], nx = b.st[1];
        if (nloc == 0u) { xcd_barrier_complete(bar, b.x, nloc, nx); b.st[0] = nloc; b.st[1] = nx; }
        const unsigned old = xb_add(&bar[XB_XSUB(b.x)], 1u);
        const unsigned gen = old / nloc;
        if (old + 1u == (gen + 1u) * nloc) {
            __builtin_amdgcn_fence(__ATOMIC_RELEASE, "agent");
            asm volatile("s_waitcnt vmcnt(0)" ::: "memory");
            const unsigned og = xb_add(&bar[XB_TOP], 1u);
            const unsigned tg = og / nx;
            if (og + 1u == (tg + 1u) * nx) xb_add(&bar[XB_TOPGEN], 1u);
            else XB_SPIN(xb_ld(&bar[XB_TOPGEN]) == tg, bar);
            __builtin_amdgcn_fence(__ATOMIC_ACQUIRE, "agent");
            xb_add(&bar[XB_XGEN(b.x)], 1u);
            asm volatile("s_waitcnt vmcnt(0)" ::: "memory");
        } else {
            XB_SPIN(xb_ld(&bar[XB_XGEN(b.x)]) == gen, bar);
            __builtin_amdgcn_fence(__ATOMIC_ACQUIRE, "agent");
            asm volatile("s_waitcnt vmcnt(0)" ::: "memory");
        }
    }
    __syncthreads();
}

struct Ctx {
    LAS unsigned char* lds;
    int tid, lane, wave, G, bid;
    const __attribute__((address_space(4))) char* ka;
    __device__ __forceinline__ const float* inp(int i) const { return ((const float* const __attribute__((address_space(4)))*)ka)[i]; }
    float* out;
    unsigned char* ws;
    unsigned* ctl;
};

__device__ __forceinline__ Ctx phase_ctx(const Ctx& C0) { Ctx C; C.lds = C0.lds; { int g_ = C0.G, b_ = C0.bid; asm volatile("" : "+s"(g_), "+s"(b_)); C.G = g_; C.bid = b_; } int t = C0.wave * 64 + lane_id_opaque(); C.tid = t; C.lane = t & 63; C.wave = C0.wave;
    const __attribute__((address_space(4))) char* ka = C0.ka; asm volatile("" : "+s"(ka)); C.ka = ka;
    C.out = *(float* const __attribute__((address_space(4)))*)(ka + 216); C.ws = *(unsigned char* const __attribute__((address_space(4)))*)(ka + 224); C.ctl = (unsigned*)C.ws; return C; }

__device__ __forceinline__ int uq_rowmap(int n) { const int h = n / 192, o = n - h * 192; if (o < 128) return n; const int j = o - 128; return h * 192 + 128 + (j < 32 ? 2 * j : 2 * (j - 32) + 1); }
__device__ __forceinline__ int kpe_rowmap(int n) { if (n < 640 || n >= 704) return n; const int j = n - 640; return 640 + (j < 32 ? 2 * j : 2 * (j - 32) + 1); }
__device__ __forceinline__ void conv_item(const float* W, int ldn, int c0, int nvalid, int K, bf16* WT, const float* kscale, int mode, LAS float* scr, int kb, int nb, int lane) {
    const int k0 = 64 * kb, n0 = 64 * nb;
    const int lc = (lane & 15) * 4, lr = lane >> 4;
#pragma unroll
    for (int i = 0; i < 16; ++i) {
        const int kk = lr + 4 * i;
        f32x4 v = (f32x4){0.f, 0.f, 0.f, 0.f};
        if (n0 + lc < nvalid) v = __builtin_nontemporal_load((const f32x4*)(W + (size_t)(k0 + kk) * ldn + c0 + n0 + lc));
        if (kscale) { const float s = kscale[k0 + kk]; v = v * s; }
        scr[kk * 65 + lc + 0] = v.x; scr[kk * 65 + lc + 1] = v.y; scr[kk * 65 + lc + 2] = v.z; scr[kk * 65 + lc + 3] = v.w;
    }
    LDS_WAIT(); asm volatile("" ::: "memory");
    const int c = lane & 7;
#pragma unroll
    for (int j = 0; j < 8; ++j) {
        const int n = (lane >> 3) + 8 * j; const LAS float* s = scr + (8 * c) * 65 + n;
        u32x4 o; o.x = cvt_pk_bf16(s[0 * 65], s[1 * 65]); o.y = cvt_pk_bf16(s[2 * 65], s[3 * 65]); o.z = cvt_pk_bf16(s[4 * 65], s[5 * 65]); o.w = cvt_pk_bf16(s[6 * 65], s[7 * 65]);
        const int dn = mode == 1 ? uq_rowmap(n0 + n) : mode == 2 ? kpe_rowmap(n0 + n) : (n0 + n);
        __builtin_nontemporal_store(o, (u32x4*)(WT + (size_t)dn * K + k0 + 8 * c));
    }
    LDS_WAIT(); asm volatile("" ::: "memory");
}

__device__ __forceinline__ void row_load_f32(const float* p, int lane, f32x4 (&v)[4]) {
#pragma unroll
    for (int j = 0; j < 4; ++j) v[j] = *(const f32x4*)(p + 4 * lane + 256 * j);
}
__device__ __forceinline__ void row_load_bf16(const bf16* p, int lane, f32x4 (&v)[4]) {
#pragma unroll
    for (int j = 0; j < 4; ++j) { const u32x2 w = *(const u32x2*)(p + 4 * lane + 256 * j); v[j] = (f32x4){bf_lo(w.x), bf_hi(w.x), bf_lo(w.y), bf_hi(w.y)}; }
}
__device__ __forceinline__ void row_store_f32(float* p, int lane, const f32x4 (&v)[4]) {
#pragma unroll
    for (int j = 0; j < 4; ++j) *(f32x4*)(p + 4 * lane + 256 * j) = v[j];
}
__device__ __forceinline__ void row_store_bf16(bf16* p, int lane, const f32x4 (&v)[4]) {
#pragma unroll
    for (int j = 0; j < 4; ++j) { u32x2 w; w.x = cvt_pk_bf16(v[j].x, v[j].y); w.y = cvt_pk_bf16(v[j].z, v[j].w); *(u32x2*)(p + 4 * lane + 256 * j) = w; }
}
__device__ __forceinline__ void row_store_bf16_nt(bf16* p, int lane, const f32x4 (&v)[4]) {
#pragma unroll
    for (int j = 0; j < 4; ++j) { u32x2 w; w.x = cvt_pk_bf16(v[j].x, v[j].y); w.y = cvt_pk_bf16(v[j].z, v[j].w); __builtin_nontemporal_store(w, (u32x2*)(p + 4 * lane + 256 * j)); }
}
__device__ __forceinline__ void row_layernorm(f32x4 (&v)[4], const f32x4 (&g)[4], const f32x4 (&b)[4]) {
    float s = 0.f, s2 = 0.f;
#pragma unroll
    for (int j = 0; j < 4; ++j) { s += (v[j].x + v[j].y) + (v[j].z + v[j].w); s2 += (v[j].x * v[j].x + v[j].y * v[j].y) + (v[j].z * v[j].z + v[j].w * v[j].w); }
#pragma unroll
    for (int o = 1; o < 64; o <<= 1) { s += __shfl_xor(s, o); s2 += __shfl_xor(s2, o); }
    const float mean = s * (1.f / DM); const float var = fmaxf(s2 * (1.f / DM) - mean * mean, 0.f);
    const float rstd = 1.f / sqrtf(var + LN_EPS);
#pragma unroll
    for (int j = 0; j < 4; ++j) v[j] = (v[j] - mean) * rstd * g[j] + b[j];
}
__device__ __forceinline__ void row_ab(const f32x4 (&v)[4], const LAS float* w8, int lane, float (&ab)[8]) {
#pragma unroll
    for (int e = 0; e < 8; ++e) { float s = 0.f;
#pragma unroll
        for (int j = 0; j < 4; ++j) { const f32x4 w = *(const LAS f32x4*)(w8 + e * 1024 + 4 * lane + 256 * j); s += (v[j].x * w.x + v[j].y * w.y) + (v[j].z * w.z + v[j].w * w.w); }
        ab[e] = wave_sum(s); }
}
__device__ __forceinline__ void load_w8(const Ctx& C, int ei, LAS float* w8) {
    const float* W = C.inp(1) + (size_t)ei * DM * EVEN_IN;
    float wv[16];
#pragma unroll
    for (int q = 0; q < 16; ++q) { const int idx = C.tid + q * NWAVES * 64; wv[q] = W[(size_t)(idx >> 3) * EVEN_IN + EVEN_N + (idx & 7)]; }
#pragma unroll
    for (int q = 0; q < 16; ++q) { const int idx = C.tid + q * NWAVES * 64; w8[(idx & 7) * 1024 + (idx >> 3)] = wv[q]; }
}

__device__ __forceinline__ void phase_prologue(const Ctx& C0) {
    const Ctx C = phase_ctx(C0);
    const int gw = C.bid * NWAVES + C.wave, NGW = C.G * NWAVES, lane = C.lane;
    LAS float* scr = (LAS float*)(C.lds + C.wave * 16640);
    unsigned char* ws = C.ws;
    constexpr int I0 = 128 * 512, I1 = 128 * 256, I2 = 2 * 768, I3 = 2 * 256, I4 = 2 * 192, I5 = 2 * 144, I6 = 2 * 128, I7 = 2 * 256;
    constexpr int NITEMS = I0 + I1 + I2 + I3 + I4 + I5 + I6 + I7;
    { auto src = [&](int r, int i) -> const f32x4* { const bool g0 = r < I0; const int r1 = g0 ? r : r - I0; const int mi = g0 ? (r1 >> 9) : (r1 >> 8), q = g0 ? (r1 & 511) : (r1 & 255);
                                                       const int ldn = g0 ? 2048 : 1024, kb = g0 ? (q >> 5) : (q >> 4), nb = g0 ? (q & 31) : (q & 15);
                                                       const float* W = (g0 ? C.inp(23) : C.inp(25)) + (size_t)mi * 1024 * ldn;
                                                       return (const f32x4*)(W + (size_t)(64 * kb + (lane >> 4) + 4 * i) * ldn + 64 * nb + (lane & 15) * 4); };
      f32x4 pv[16];
      int it = gw;
      if (it < I0 + I1) {
#pragma unroll
          for (int i = 0; i < 16; ++i) pv[i] = __builtin_nontemporal_load(src(it, i)); }
      for (; it < I0 + I1; it += NGW) {
          const int lc = (lane & 15) * 4, lr = lane >> 4;
#pragma unroll
          for (int i = 0; i < 16; ++i) { const int kk = lr + 4 * i; scr[kk * 65 + lc + 0] = pv[i].x; scr[kk * 65 + lc + 1] = pv[i].y; scr[kk * 65 + lc + 2] = pv[i].z; scr[kk * 65 + lc + 3] = pv[i].w; }
          const int nx = it + NGW;
          if (nx < I0 + I1) {
#pragma unroll
              for (int i = 0; i < 16; ++i) pv[i] = __builtin_nontemporal_load(src(nx, i)); }
          LDS_WAIT(); asm volatile("" ::: "memory");
          const bool g0 = it < I0; const int r1 = g0 ? it : it - I0; const int mi = g0 ? (r1 >> 9) : (r1 >> 8), q = g0 ? (r1 & 511) : (r1 & 255);
          const int kb = g0 ? (q >> 5) : (q >> 4), nb = g0 ? (q & 31) : (q & 15);
          bf16* WT = g0 ? (bf16*)(ws + WS_WGU) + (size_t)mi * 2048 * 1024 : (bf16*)(ws + WS_WDN) + (size_t)mi * 1024 * 1024;
          const int c = lane & 7;
#pragma unroll
          for (int j = 0; j < 8; ++j) { const int n = (lane >> 3) + 8 * j; const LAS float* sp = scr + (8 * c) * 65 + n;
              u32x4 o; o.x = cvt_pk_bf16(sp[0 * 65], sp[1 * 65]); o.y = cvt_pk_bf16(sp[2 * 65], sp[3 * 65]); o.z = cvt_pk_bf16(sp[4 * 65], sp[5 * 65]); o.w = cvt_pk_bf16(sp[6 * 65], sp[7 * 65]);
              __builtin_nontemporal_store(o, (u32x4*)(WT + (size_t)(64 * nb + n) * 1024 + 64 * kb + 8 * c)); }
          LDS_WAIT(); asm volatile("" ::: "memory");
      } }
    for (int it = I0 + I1 + gw; it < NITEMS; it += NGW) {
        int r = it;
        if (r < I0) { const int mi = r / 512, q = r % 512; conv_item(C.inp(23) + (size_t)mi * 1024 * 2048, 2048, 0, 2048, 1024, (bf16*)(ws + WS_WGU) + (size_t)mi * 2048 * 1024, nullptr, 0, scr, q / 32, q % 32, lane); continue; } r -= I0;
        if (r < I1) { const int mi = r / 256, q = r % 256; conv_item(C.inp(25) + (size_t)mi * 1024 * 1024, 1024, 0, 1024, 1024, (bf16*)(ws + WS_WDN) + (size_t)mi * 1024 * 1024, nullptr, 0, scr, q / 16, q % 16, lane); continue; } r -= I1;
        if (r < I2) { const int mi = r / 768, q = r % 768; conv_item(C.inp(1) + (size_t)mi * 1024 * EVEN_IN, EVEN_IN, 0, EVEN_N, 1024, (bf16*)(ws + WS_WEIN) + (size_t)mi * EVEN_N * 1024, nullptr, 0, scr, q / 48, q % 48, lane); continue; } r -= I2;
        if (r < I3) { const int mi = r / 256, q = r % 256; conv_item(C.inp(10) + (size_t)mi * 1024 * 1024, 1024, 0, 1024, 1024, (bf16*)(ws + WS_WEOUT) + (size_t)mi * 1024 * 1024, nullptr, 0, scr, q / 16, q % 16, lane); continue; } r -= I3;
        if (r < I4) { const int mi = r / 192, q = r % 192; conv_item(C.inp(11) + (size_t)mi * 1024 * ODD_IN, ODD_IN, 0, ODD_IN, 1024, (bf16*)(ws + WS_WOIN) + (size_t)mi * ODD_N * 1024, nullptr, 2, scr, q / 12, q % 12, lane); continue; } r -= I4;
        if (r < I5) { const int mi = r / 144, q = r % 144; conv_item(C.inp(13) + (size_t)mi * QL * 1536, 1536, 0, 1536, QL, (bf16*)(ws + WS_WUQ) + (size_t)mi * 1536 * QL, C.inp(12) + mi * QL, 1, scr, q / 24, q % 24, lane); continue; } r -= I5;
        if (r < I6) { const int mi = r / 128, q = r % 128; conv_item(C.inp(15) + (size_t)mi * KVL * 2048, 2048, 0, 2048, KVL, (bf16*)(ws + WS_WUKV) + (size_t)mi * 2048 * KVL, C.inp(14) + mi * KVL, 0, scr, q / 32, q % 32, lane); continue; } r -= I6;
        { const int mi = r / 256, q = r % 256; conv_item(C.inp(16) + (size_t)mi * 1024 * 1024, 1024, 0, 1024, 1024, (bf16*)(ws + WS_WOOUT) + (size_t)mi * 1024 * 1024, nullptr, 0, scr, q / 16, q % 16, lane); }
    }
    { f32x2* rope = (f32x2*)(ws + WS_ROPE);
      for (int idx = C.bid * NWAVES * 64 + C.tid; idx < SEQ * 32; idx += C.G * NWAVES * 64) { const int pos = idx >> 5, j = idx & 31;
          const float inv = powf(10000.0f, -(float)(2 * j) / 64.0f); const float ang = (float)pos * inv; rope[idx] = (f32x2){cosf(ang), sinf(ang)}; } }
    __syncthreads();
    LAS float* w8 = (LAS float*)(C.lds);
    load_w8(C, 0, w8);
    __syncthreads();
    const float* x = C.inp(0); bf16* XB = (bf16*)(ws + WS_XB); float* AB = (float*)(ws + WS_AB);
    f32x4 vn[4]; if (gw < T) row_load_f32(x + (size_t)gw * DM, lane, vn);
    for (int m = gw; m < T; m += NGW) { f32x4 v[4];
#pragma unroll
        for (int j = 0; j < 4; ++j) v[j] = vn[j];
        if (m + NGW < T) row_load_f32(x + (size_t)(m + NGW) * DM, lane, vn);
        row_store_bf16_nt(XB + (size_t)m * DM, lane, v);
        float ab[8]; row_ab(v, w8, lane, ab); if (lane < 8) { float s = ab[0];
#pragma unroll
            for (int e = 1; e < 8; ++e) s = (lane == e) ? ab[e] : s;
            AB[(size_t)m * 8 + lane] = s; } }
}

#ifndef MK_ALIGN_MOE
#define MK_ALIGN_MOE true
#endif
#ifndef MK_ALIGN_PLAIN
#define MK_ALIGN_PLAIN true
#endif
using pg8::Unit;
struct EpiBf16 {
    static constexpr bool PERM = true;
    bf16* O; int ldc; int gelu_cols;
    __device__ __forceinline__ void operator()(const f32x4 (&acc)[2][2][4][2], const Unit& u, int wr, int wc, int fr, int fq) const {
        const int row0 = u.pm * 256 + wr * 64 + fr, col0 = u.pn * 256 + wc * 32 + 8 * fq;
        const bool g = (u.pn * 256) < gelu_cols;
#pragma unroll
        for (int ai = 0; ai < 2; ++ai)
#pragma unroll
            for (int m = 0; m < 4; ++m) { bf16* rowp = O + (size_t)(row0 + ai * 128 + m * 16) * ldc + col0;
#pragma unroll
                for (int bj = 0; bj < 2; ++bj) { f32x4 v0 = acc[ai][bj][m][0], v1 = acc[ai][bj][m][1];
                    if (g) { f32x2 a = pg8::gelu_pk((f32x2){v0[0], v0[1]}), b = pg8::gelu_pk((f32x2){v0[2], v0[3]}), c = pg8::gelu_pk((f32x2){v1[0], v1[1]}), d = pg8::gelu_pk((f32x2){v1[2], v1[3]});
                        v0 = (f32x4){a.x, a.y, b.x, b.y}; v1 = (f32x4){c.x, c.y, d.x, d.y}; }
                    u32x4 w; w.x = cvt_pk_bf16(v0[0], v0[1]); w.y = cvt_pk_bf16(v0[2], v0[3]); w.z = cvt_pk_bf16(v1[0], v1[1]); w.w = cvt_pk_bf16(v1[2], v1[3]);
                    *(u32x4*)(rowp + bj * 128) = w; } }
    }
};
struct EpiO1 {
    static constexpr bool PERM = true;
    bf16* O; float* rsp; bf16* KPE; const f32x4* rope;
    __device__ __forceinline__ void operator()(const f32x4 (&acc)[2][2][4][2], const Unit& u, int wr, int wc, int fr_in, int fq_in) const {
        (void)fr_in; (void)fq_in; const int ln_ = lane_id_opaque(), fr = ln_ & 15, fq = ln_ >> 4;
        const int row0 = u.pm * 256 + wr * 64 + fr, col0 = u.pn * 256 + wc * 32 + 8 * fq;
        const bool ropew = (u.pn == 2) && (wc < 2);
#pragma unroll
        for (int ai = 0; ai < 2; ++ai) {
            f32x4 r0[4], r1[4];
            if (ropew) {
#pragma unroll
                for (int m = 0; m < 4; ++m) { const int pos = (row0 + ai * 128 + m * 16) & (SEQ - 1), jp = 16 * wc + 4 * fq; r0[m] = rope[(pos * 32 + jp) >> 1]; r1[m] = rope[(pos * 32 + jp + 2) >> 1]; } }
#pragma unroll
            for (int m = 0; m < 4; ++m) { const int row = row0 + ai * 128 + m * 16; bf16* rowp = O + (size_t)row * ODD_N + col0;
                float ss[2];
#pragma unroll
                for (int bj = 0; bj < 2; ++bj) { const f32x4 v0 = acc[ai][bj][m][0], v1 = acc[ai][bj][m][1];
                    ss[bj] = ((v0[0] * v0[0] + v0[1] * v0[1]) + (v0[2] * v0[2] + v0[3] * v0[3])) + ((v1[0] * v1[0] + v1[1] * v1[1]) + (v1[2] * v1[2] + v1[3] * v1[3]));
                    u32x4 w; w.x = cvt_pk_bf16(v0[0], v0[1]); w.y = cvt_pk_bf16(v0[2], v0[3]); w.z = cvt_pk_bf16(v1[0], v1[1]); w.w = cvt_pk_bf16(v1[2], v1[3]);
                    *(u32x4*)(rowp + bj * 128) = w; }
#pragma unroll
                for (int bj = 0; bj < 2; ++bj) { ss[bj] += __shfl_xor(ss[bj], 16); ss[bj] += __shfl_xor(ss[bj], 32); }
                if (fq == 0) { float* p = rsp + (size_t)row * 16;
                    if (u.pn == 0) p[wc] = ss[0] + ss[1];
                    else if (u.pn == 1) { p[4 + wc] = ss[0]; p[8 + wc] = ss[1]; }
                    else p[12 + wc] = ss[0]; }
                if (ropew) { const f32x4 a = r0[m], b = r1[m];
                    const f32x4 v0 = acc[ai][1][m][0], v1 = acc[ai][1][m][1];
                    u32x4 w; w.x = cvt_pk_bf16(v0[0] * a[0] - v0[1] * a[1], v0[0] * a[1] + v0[1] * a[0]); w.y = cvt_pk_bf16(v0[2] * a[2] - v0[3] * a[3], v0[2] * a[3] + v0[3] * a[2]);
                    w.z = cvt_pk_bf16(v1[0] * b[0] - v1[1] * b[1], v1[0] * b[1] + v1[1] * b[0]); w.w = cvt_pk_bf16(v1[2] * b[2] - v1[3] * b[3], v1[2] * b[3] + v1[3] * b[2]);
                    *(u32x4*)(KPE + (size_t)row * 64 + 32 * wc + 8 * fq) = w; } }
            asm volatile("" ::: "memory"); }
    }
};
struct EpiRes {
    static constexpr bool PERM = true;
    const bf16* X; bf16* Y;
    __device__ __forceinline__ void operator()(const f32x4 (&acc)[2][2][4][2], const Unit& u, int wr, int wc, int fr, int fq) const {
        const int row0 = u.pm * 256 + wr * 64 + fr, col0 = u.pn * 256 + wc * 32 + 8 * fq;
        u32x4 xs[2][4][2];
#pragma unroll
        for (int ai = 0; ai < 2; ++ai)
#pragma unroll
            for (int m = 0; m < 4; ++m)
#pragma unroll
                for (int bj = 0; bj < 2; ++bj) xs[ai][m][bj] = *(const u32x4*)(X + (size_t)(row0 + ai * 128 + m * 16) * DM + col0 + bj * 128);
#pragma unroll
        for (int ai = 0; ai < 2; ++ai)
#pragma unroll
            for (int m = 0; m < 4; ++m) { const size_t off = (size_t)(row0 + ai * 128 + m * 16) * DM + col0;
#pragma unroll
                for (int bj = 0; bj < 2; ++bj) { const f32x4 a0 = acc[ai][bj][m][0], a1 = acc[ai][bj][m][1]; const u32x4 x = xs[ai][m][bj]; u32x4 w;
                    w.x = cvt_pk_bf16(bf_lo(x.x) * DN_ALPHA + a0[0], bf_hi(x.x) * DN_ALPHA + a0[1]); w.y = cvt_pk_bf16(bf_lo(x.y) * DN_ALPHA + a0[2], bf_hi(x.y) * DN_ALPHA + a0[3]);
                    w.z = cvt_pk_bf16(bf_lo(x.z) * DN_ALPHA + a1[0], bf_hi(x.z) * DN_ALPHA + a1[1]); w.w = cvt_pk_bf16(bf_lo(x.w) * DN_ALPHA + a1[2], bf_hi(x.w) * DN_ALPHA + a1[3]);
                    *(u32x4*)(Y + off + bj * 128) = w; } }
    }
};
struct EpiQ {
    static constexpr bool PERM = true;
    bf16* O; const LAS float* scl; const f32x4* rope;
    __device__ __forceinline__ void operator()(const f32x4 (&acc)[2][2][4][2], const Unit& u, int wr, int wc, int fr_in, int fq_in) const {
        (void)fr_in; (void)fq_in; const int ln_ = lane_id_opaque(), fr = ln_ & 15, fq = ln_ >> 4;
        const int row0 = u.pm * 256 + wr * 64 + fr, col0 = u.pn * 256 + wc * 32 + 8 * fq;
        float sc[2][4];
#pragma unroll
        for (int ai = 0; ai < 2; ++ai)
#pragma unroll
            for (int m = 0; m < 4; ++m) sc[ai][m] = scl[u.li * 256 + wr * 64 + fr + ai * 128 + m * 16];
#pragma unroll
        for (int bj = 0; bj < 2; ++bj) { const int c = col0 + bj * 128, o = c % 192; const bool rp = o >= 128; const int jp = (o - 128) >> 1;
#pragma unroll
          for (int ai = 0; ai < 2; ++ai) {
            f32x4 r0[4], r1[4];
            if (rp) {
#pragma unroll
                for (int m = 0; m < 4; ++m) { const int pos = (row0 + ai * 128 + m * 16) & (SEQ - 1); r0[m] = rope[(pos * 32 + jp) >> 1]; r1[m] = rope[(pos * 32 + jp + 2) >> 1]; } }
#pragma unroll
            for (int m = 0; m < 4; ++m) { const int row = row0 + ai * 128 + m * 16; const float s = sc[ai][m];
                f32x4 v0 = acc[ai][bj][m][0] * s, v1 = acc[ai][bj][m][1] * s;
                if (rp) { const f32x4 a = r0[m], b = r1[m];
                    v0 = (f32x4){v0[0] * a[0] - v0[1] * a[1], v0[0] * a[1] + v0[1] * a[0], v0[2] * a[2] - v0[3] * a[3], v0[2] * a[3] + v0[3] * a[2]};
                    v1 = (f32x4){v1[0] * b[0] - v1[1] * b[1], v1[0] * b[1] + v1[1] * b[0], v1[2] * b[2] - v1[3] * b[3], v1[2] * b[3] + v1[3] * b[2]}; }
                u32x4 w; w.x = cvt_pk_bf16(v0[0], v0[1]); w.y = cvt_pk_bf16(v0[2], v0[3]); w.z = cvt_pk_bf16(v1[0], v1[1]); w.w = cvt_pk_bf16(v1[2], v1[3]);
                *(u32x4*)(O + (size_t)row * 1536 + c) = w; }
            asm volatile("" ::: "memory"); } }
    }
};
struct EpiKV {
    static constexpr bool PERM = true;
    bf16* O; const LAS float* scl;
    __device__ __forceinline__ void operator()(const f32x4 (&acc)[2][2][4][2], const Unit& u, int wr, int wc, int fr_in, int fq_in) const {
        (void)fr_in; (void)fq_in; const int ln_ = lane_id_opaque(), fr = ln_ & 15, fq = ln_ >> 4;
        const int row0 = u.pm * 256 + wr * 64 + fr, col0 = u.pn * 256 + wc * 32 + 8 * fq;
        float sc[2][4];
#pragma unroll
        for (int ai = 0; ai < 2; ++ai)
#pragma unroll
            for (int m = 0; m < 4; ++m) sc[ai][m] = scl[u.li * 256 + wr * 64 + fr + ai * 128 + m * 16];
#pragma unroll
        for (int ai = 0; ai < 2; ++ai)
#pragma unroll
            for (int m = 0; m < 4; ++m) { const int row = row0 + ai * 128 + m * 16; const float s = sc[ai][m]; bf16* rowp = O + (size_t)row * 2048 + col0;
#pragma unroll
                for (int bj = 0; bj < 2; ++bj) { const f32x4 v0 = acc[ai][bj][m][0] * s, v1 = acc[ai][bj][m][1] * s;
                    u32x4 w; w.x = cvt_pk_bf16(v0[0], v0[1]); w.y = cvt_pk_bf16(v0[2], v0[3]); w.z = cvt_pk_bf16(v1[0], v1[1]); w.w = cvt_pk_bf16(v1[2], v1[3]);
                    *(u32x4*)(rowp + bj * 128) = w; } }
    }
};
struct EpiSwiglu {
    static constexpr bool PERM = true;
    bf16* HID; const LAS bf16* lbias; const LAS int* rmap; const LAS int* utab;
    __device__ __forceinline__ void operator()(const f32x4 (&acc)[2][2][4][2], const Unit& u, int wr, int wc, int fr, int fq) const {
        const int cl = wc * 32 + 8 * fq, col0 = u.pn * 256 + cl;
        f32x4 bv[2][2];
#pragma unroll
        for (int bj = 0; bj < 2; ++bj) { const u32x4 w = *(const LAS u32x4*)(lbias + u.li * 256 + bj * 128 + cl);
            bv[bj][0] = (f32x4){bf_lo(w.x), bf_hi(w.x), bf_lo(w.y), bf_hi(w.y)}; bv[bj][1] = (f32x4){bf_lo(w.z), bf_hi(w.z), bf_lo(w.w), bf_hi(w.w)}; }
#pragma unroll
        for (int ai = 0; ai < 2; ++ai)
#pragma unroll
            for (int m = 0; m < 4; ++m) { const int tr_ = ai * 128 + wr * 64 + m * 16 + fr; const int slot = rmap[u.li * 256 + tr_];
                if (slot >= 0) { bf16* rowp = HID + ((size_t)utab[u.li * 4 + 3] * 256 + tr_) * DFF + (col0 >> 1);
#pragma unroll
                    for (int bj = 0; bj < 2; ++bj) { const f32x4 h0 = acc[ai][bj][m][0] + bv[bj][0], h1 = acc[ai][bj][m][1] + bv[bj][1];
                        float o[4];
#pragma unroll
                        for (int q = 0; q < 4; ++q) { const float glu = fminf(q < 2 ? h0[2 * q] : h1[2 * q - 4], 7.0f); float lin = q < 2 ? h0[2 * q + 1] : h1[2 * q - 3]; lin = fminf(fmaxf(lin, -7.0f), 7.0f);
                            const float sg = __builtin_amdgcn_rcpf(1.0f + __builtin_amdgcn_exp2f(-1.702f * 1.4426950408889634f * glu)); o[q] = glu * sg * (lin + 1.0f); }
                        u32x2 w; w.x = cvt_pk_bf16(o[0], o[1]); w.y = cvt_pk_bf16(o[2], o[3]);
                        *(u32x2*)(rowp + bj * 64) = w; } } }
    }
};
struct EpiDown {
    static constexpr bool PERM = true;
    bf16* YE; const LAS float* lbias; const LAS float* lgate; const LAS int* rmap;
    __device__ __forceinline__ void operator()(const f32x4 (&acc)[2][2][4][2], const Unit& u, int wr, int wc, int fr, int fq) const {
        const int cl = wc * 32 + 8 * fq, col0 = u.pn * 256 + cl;
        f32x4 bv[2][2];
#pragma unroll
        for (int bj = 0; bj < 2; ++bj)
#pragma unroll
            for (int n = 0; n < 2; ++n) bv[bj][n] = *(const LAS f32x4*)(lbias + u.li * 256 + bj * 128 + cl + 4 * n);
#pragma unroll
        for (int ai = 0; ai < 2; ++ai)
#pragma unroll
            for (int m = 0; m < 4; ++m) { const int r = u.li * 256 + ai * 128 + wr * 64 + m * 16 + fr; const int slot = rmap[r];
                if (slot >= 0) { const float g = lgate[r]; unsigned char* rowp = (unsigned char*)YE + (size_t)slot * DM + col0;
#pragma unroll
                    for (int bj = 0; bj < 2; ++bj) { f32x4 v0 = (acc[ai][bj][m][0] + bv[bj][0]) * g, v1 = (acc[ai][bj][m][1] + bv[bj][1]) * g;
#pragma unroll
                        for (int q = 0; q < 4; ++q) { v0[q] = __builtin_amdgcn_fmed3f(v0[q], -448.0f, 448.0f); v1[q] = __builtin_amdgcn_fmed3f(v1[q], -448.0f, 448.0f); }
                        int w0 = __builtin_amdgcn_cvt_pk_fp8_f32(v0[0], v0[1], 0, false); w0 = __builtin_amdgcn_cvt_pk_fp8_f32(v0[2], v0[3], w0, true);
                        int w1 = __builtin_amdgcn_cvt_pk_fp8_f32(v1[0], v1[1], 0, false); w1 = __builtin_amdgcn_cvt_pk_fp8_f32(v1[2], v1[3], w1, true);
                        *(u32x2*)(rowp + bj * 128) = (u32x2){(unsigned)w0, (unsigned)w1}; } } }
    }
};

template <class Epi>
__device__ __forceinline__ void run_plain_gemm(const Ctx& C, const bf16* A, int lda, int K, int N, const bf16* Bt, const Epi& E) {
    pg8::PlainSched S; S.o.init(T, N, C.G, C.bid); S.Bt = (const char*)Bt; S.K = K; S.lda = lda;
    pg8::gemm_phase<Epi, pg8::PlainSched, MK_ALIGN_PLAIN>(C.lds, (const char*)A, K, S, E, C.wave);
}

template <class Epi>
__device__ __forceinline__ void run_scaled_gemm(const Ctx& C, const bf16* A, int lda, int K, int N, const bf16* Bt, Epi E, const float* rsp, int half, float inv_n) {
    pg8::PlainSched S; S.o.init(T, N, C.G, C.bid); S.Bt = (const char*)Bt; S.K = K; S.lda = lda;
    LAS float* scl = (LAS float*)(C.lds + LDS_SPARE);
    __syncthreads();
    { f32x4 a_[2], b_[2]; bool ok_[2];
#pragma unroll
      for (int q = 0; q < 2; ++q) { const int ent = C.tid + q * NWAVES * 64, i = ent >> 8, r = ent & 255; pg8::Unit u; ok_[q] = S.o.next(i, u);
          const f32x4* p = (const f32x4*)(rsp + (size_t)((ok_[q] ? u.pm : 0) * 256 + r) * 16) + 2 * half; a_[q] = p[0]; b_[q] = p[1]; }
#pragma unroll
      for (int q = 0; q < 2; ++q) { const int ent = C.tid + q * NWAVES * 64; const f32x4 a = a_[q], b = b_[q];
          const float s = ((a.x + a.y) + (a.z + a.w)) + ((b.x + b.y) + (b.z + b.w));
          if (ok_[q]) scl[ent] = 1.0f / sqrtf(s * inv_n + RMS_EPS); } }
    __syncthreads();
    E.scl = scl;
    pg8::gemm_phase<Epi, pg8::PlainSched, MK_ALIGN_PLAIN>(C.lds, (const char*)A, K, S, E, C.wave);
}

constexpr int MOE_RMAP_OFF = LDS_SPARE, MOE_MAX_UNITS = 18, MOE_MAX_UNITS2 = 10;
constexpr int MOE1_BIAS_OFF = LDS_SPARE + 18 * 1024, MOE1_PRE_OFF = MOE1_BIAS_OFF + 18 * 512;
constexpr int MOE2_GATE_OFF = LDS_SPARE + 10 * 1024, MOE2_BIAS_OFF = MOE2_GATE_OFF + 10 * 1024, MOE2_PRE_OFF = MOE2_BIAS_OFF + 10 * 1024;
static_assert(MOE1_PRE_OFF + 512 <= LDS_CTL_OFF && MOE2_PRE_OFF + 512 <= LDS_CTL_OFF, "MoE LDS map");
struct MoeSched {
    static constexpr bool GATHER = true;
    const LAS int* pre; const LAS int* rmap; const LAS int* utab; const char* Bt; size_t bstride; int K, NT, G, c, lda, shift, maxu; bool compact;
    __device__ __forceinline__ bool decode(int i, Unit& u) const {
        const int x = c & 7, k = c >> 3, per = G >> 3;
        const int RT = 32 / NT, tot = pre[32];
        const int slot = i * per + k;
        const int st = (slot >> 5) * 8 + x, within = slot & 31;
        const int rt = st * RT + within / NT;
        if (rt >= tot || i >= maxu) return false;
        int e = 0;
#pragma unroll 1
        for (; e < 31; ++e) if (rt < pre[e + 1]) break;
        u.e = e; u.pn = within % NT; u.pm = rt - pre[e]; u.li = i; return true;
    }
    __device__ __forceinline__ bool next(int i, Unit& u) const {
        if (i >= maxu) return false;
        const int e = utab[i * 4]; if (e < 0) return false;
        u.e = e; u.pm = utab[i * 4 + 1]; u.pn = utab[i * 4 + 2]; u.li = i; return true;
    }
    __device__ __forceinline__ const char* bbase(const Unit& u) const { return Bt + (size_t)u.e * bstride + (size_t)u.pn * 256 * K * 2; }
    __device__ __forceinline__ unsigned aoff(const Unit& u, int r) const {
        if (compact) return (unsigned)((utab[u.li * 4 + 3] * 256 + r) * lda) * 2u;
        const int slot = rmap[u.li * 256 + r]; const int s = slot < 0 ? 0 : (slot >> shift); return (unsigned)(s * lda) * 2u; }
};
template <int WHICH  , class Epi>
__device__ __forceinline__ void run_moe_gemm(const Ctx& C0, int layer, const bf16* A, int lda, int shift, int K, int N, const bf16* Bt, size_t bstride_elems, const float* bias_g, Epi E) {
    const Ctx C = phase_ctx(C0);
    constexpr int PRE_OFF = WHICH == 1 ? MOE1_PRE_OFF : MOE2_PRE_OFF;
    LAS int* pre = (LAS int*)(C.lds + PRE_OFF); LAS int* cnt = pre + 64; LAS int* rmap = (LAS int*)(C.lds + MOE_RMAP_OFF);
    const int* list = (const int*)(C.ws + WS_LIST);
    if (C.tid < 32) cnt[C.tid] = (int)__hip_atomic_load(C.ctl + CW_CNT + (layer * 32 + C.tid) * 64, RLX_AGENT);
    __syncthreads();
    if (C.tid == 0) { int s = 0; for (int e = 0; e < 32; ++e) { pre[e] = s; s += (cnt[e] + 255) >> 8; } pre[32] = s; }
    __syncthreads();
    MoeSched S; S.pre = pre; S.rmap = rmap; S.Bt = (const char*)Bt; S.bstride = bstride_elems * 2; S.K = K; S.NT = N / 256; S.G = C.G; S.c = C.bid; S.lda = lda; S.shift = shift; S.maxu = WHICH == 1 ? MOE_MAX_UNITS : MOE_MAX_UNITS2; S.compact = (WHICH == 2);
    constexpr int MAXU = WHICH == 1 ? MOE_MAX_UNITS : MOE_MAX_UNITS2;
    LAS int* utab = pre + 96;
    S.utab = utab;
    if (C.tid < MAXU) { Unit u; const bool ok = S.decode(C.tid, u); utab[C.tid * 4] = ok ? u.e : -1; utab[C.tid * 4 + 1] = u.pm; utab[C.tid * 4 + 2] = u.pn; utab[C.tid * 4 + 3] = ok ? pre[u.e] + u.pm : 0; }
    __syncthreads();
    { constexpr int NENT = (MAXU * 256 + NWAVES * 64 - 1) / (NWAVES * 64);
      int slot_[NENT]; float bias_[NENT]; float gate_[NENT]; bool ok_[NENT];
#pragma unroll
      for (int q = 0; q < NENT; ++q) { const int ent = C.tid + q * NWAVES * 64, i = ent >> 8, r = ent & 255; const int e = i < MAXU ? utab[i * 4] : -1; ok_[q] = e >= 0;
          const int ec = e < 0 ? 0 : e, pm = ok_[q] ? utab[i * 4 + 1] : 0, pn = ok_[q] ? utab[i * 4 + 2] : 0; const int idx = pm * 256 + r;
          const bool in_ = ok_[q] && idx < cnt[ec]; slot_[q] = in_ ? list[(size_t)ec * LCAP + idx] : -1;
          gate_[q] = 0.f; if constexpr (WHICH == 2) { if (in_) gate_[q] = ((const float*)(C.ws + WS_XF + 8 * MiB))[(size_t)ec * LCAP + idx]; }
          bias_[q] = bias_g[(size_t)ec * N + pn * 256 + r]; }
#pragma unroll
      for (int q = 0; q < NENT; ++q) { const int ent = C.tid + q * NWAVES * 64;
          if (ok_[q]) { rmap[ent] = slot_[q];
              if constexpr (WHICH == 1) ((LAS bf16*)(C.lds + MOE1_BIAS_OFF))[ent] = f2bf(bias_[q]);
              else { ((LAS float*)(C.lds + MOE2_BIAS_OFF))[ent] = bias_[q]; ((LAS float*)(C.lds + MOE2_GATE_OFF))[ent] = gate_[q]; } } } }
    __syncthreads();
    E.rmap = rmap; if constexpr (WHICH == 1) E.utab = utab;
    pg8::gemm_phase<Epi, MoeSched, MK_ALIGN_MOE>(C.lds, (const char*)A, K, S, E, C.wave);
}

__device__ __forceinline__ void phase_router(const Ctx& C0, int layer) {
    const Ctx C = phase_ctx(C0);
    LAS char* WT = (LAS char*)C.lds;
    constexpr int WSB = 2064;
    LAS int* lcnt = (LAS int*)(C.lds + 132608); LAS int* lbase = (LAS int*)(C.lds + 132736);
    LAS int* asg_e = (LAS int*)(C.lds + 132864); LAS int* asg_pos = (LAS int*)(C.lds + 134912); LAS float* asg_gate = (LAS float*)(C.lds + 136960);
    const float* Wr = C.inp(21) + (size_t)layer * DM * NEXP; const float* br = C.inp(22) + layer * NEXP;
    const int lane = C.lane, tid = C.tid, x2 = lane & 15, g = lane >> 4;
    { f32x4 wv[16];
#pragma unroll
      for (int q = 0; q < 16; ++q) wv[q] = *(const f32x4*)(Wr + (tid + 512 * q) * 4);
#pragma unroll
      for (int q = 0; q < 16; ++q) { const int f = (tid + 512 * q) * 4, k = f >> 5, e = f & 31;
#pragma unroll
        for (int j = 0; j < 4; ++j) { const float w = wv[q][j]; const bf16 hi = f2bf(w); const bf16 lo = f2bf(w - bf2f(hi));
            *(LAS bf16*)(WT + (e + j) * WSB + k * 2) = hi; *(LAS bf16*)(WT + (32 + e + j) * WSB + k * 2) = lo; } } }
    f32x4 gg[4], bb[4]; row_load_f32(C.inp(17) + layer * DM, lane, gg); row_load_f32(C.inp(18) + layer * DM, lane, bb);
    const bf16* Y = (const bf16*)(C.ws + WS_Y); bf16* XB = (bf16*)(C.ws + WS_XB);
    int* list = (int*)(C.ws + WS_LIST); float* GATE = (float*)(C.ws + WS_XF + 8 * MiB);
    const f32x4 bias0 = *(const f32x4*)(br + 4 * g), bias1 = *(const f32x4*)(br + 16 + 4 * g);
    for (int rb = C.bid; rb < T / 128; rb += C.G) {
        if (tid < 32) lcnt[tid] = 0;
#pragma unroll 1
        for (int hb = 0; hb < 2; ++hb) { u32x2 raw[8][4];
#pragma unroll
          for (int i = 0; i < 8; ++i) { const bf16* yp = Y + (size_t)(rb * 128 + C.wave * 16 + hb * 8 + i) * DM + 4 * lane;
#pragma unroll
              for (int j = 0; j < 4; ++j) raw[i][j] = *(const u32x2*)(yp + 256 * j); }
#pragma unroll
          for (int i = 0; i < 8; ++i) { const int row = rb * 128 + C.wave * 16 + hb * 8 + i; f32x4 v[4];
#pragma unroll
              for (int j = 0; j < 4; ++j) v[j] = (f32x4){bf_lo(raw[i][j].x), bf_hi(raw[i][j].x), bf_lo(raw[i][j].y), bf_hi(raw[i][j].y)};
              row_layernorm(v, gg, bb); row_store_bf16(XB + (size_t)row * DM, lane, v); } }
        asm volatile("s_waitcnt vmcnt(0)" ::: "memory");
        __syncthreads();
        f32x4 acc[4];
#pragma unroll
        for (int nt = 0; nt < 4; ++nt) acc[nt] = (f32x4){0.f, 0.f, 0.f, 0.f};
        { const bf16* xrow = XB + (size_t)(rb * 128 + C.wave * 16 + x2) * DM + 8 * g; const LAS char* wrow = WT + x2 * WSB + 16 * g;
#pragma unroll 16
          for (int ks = 0; ks < 32; ++ks) { const bf16x8 xa = *(const bf16x8*)(xrow + 32 * ks);
#pragma unroll
            for (int nt = 0; nt < 4; ++nt) acc[nt] = __builtin_amdgcn_mfma_f32_16x16x32_bf16(*(const LAS bf16x8*)(wrow + 16 * nt * WSB + 64 * ks), xa, acc[nt], 0, 0, 0); } }
        float lg[8];
#pragma unroll
        for (int r = 0; r < 4; ++r) { lg[r] = acc[0][r] + acc[2][r] + bias0[r]; lg[4 + r] = acc[1][r] + acc[3][r] + bias1[r]; }
        float tv[4]; int te[4];
#pragma unroll
        for (int k = 0; k < 4; ++k) { tv[k] = -__builtin_inff(); te[k] = 1 << 20; }
#define RT_INS(val_, idx_) { float cv_ = (val_); int ce_ = (idx_); _Pragma("unroll") for (int k = 0; k < 4; ++k) { const bool gt_ = (cv_ > tv[k]) || (cv_ == tv[k] && ce_ < te[k]); \
            const float nv_ = gt_ ? cv_ : tv[k]; const int ne_ = gt_ ? ce_ : te[k]; cv_ = gt_ ? tv[k] : cv_; ce_ = gt_ ? te[k] : ce_; tv[k] = nv_; te[k] = ne_; } }
#pragma unroll
        for (int q = 0; q < 8; ++q) RT_INS(lg[q], 16 * (q >> 2) + 4 * g + (q & 3))
#pragma unroll
        for (int off = 16; off < 64; off <<= 1) { float pv[4]; int pe[4];
#pragma unroll
            for (int k = 0; k < 4; ++k) { pv[k] = __shfl_xor(tv[k], off); pe[k] = __shfl_xor(te[k], off); }
#pragma unroll
            for (int k = 0; k < 4; ++k) RT_INS(pv[k], pe[k]) }
#undef RT_INS
        const float e1 = __expf(tv[1] - tv[0]), e2 = __expf(tv[2] - tv[0]), e3 = __expf(tv[3] - tv[0]); const float inv = 1.0f / (1.0f + e1 + e2 + e3);
        if (lane < 16) { const int rl = C.wave * 16 + x2; const float gk[4] = {inv, e1 * inv, e2 * inv, e3 * inv};
#pragma unroll
            for (int k = 0; k < 4; ++k) { const int lpos = __hip_atomic_fetch_add(lcnt + te[k], 1, __ATOMIC_RELAXED, __HIP_MEMORY_SCOPE_WORKGROUP);
                const int a = rl * 4 + k; asg_e[a] = te[k]; asg_pos[a] = lpos; asg_gate[a] = gk[k]; } }
        __syncthreads();
        if (tid < 32) lbase[tid] = (int)__hip_atomic_fetch_add(C.ctl + CW_CNT + (layer * 32 + tid) * 64, (unsigned)lcnt[tid], RLX_AGENT);
        __syncthreads();
        { const int a = tid, e = asg_e[a], slot = (rb * 128 + (a >> 2)) * 4 + (a & 3); const size_t li_ = (size_t)e * LCAP + lbase[e] + asg_pos[a]; list[li_] = slot; GATE[li_] = asg_gate[a]; }
        __syncthreads();
    }
}

__device__ __forceinline__ void phase_combine(const Ctx& C0, int layer) {
    const Ctx C = phase_ctx(C0);
    const int gw = C.bid * NWAVES + C.wave, NGW = C.G * NWAVES, lane = C.lane;
    LAS float* w8 = (LAS float*)C.lds;
    if (layer == 1) { load_w8(C, 1, w8); __syncthreads(); }
    f32x4 g[4], b[4]; row_load_f32(C.inp(19) + layer * DM, lane, g); row_load_f32(C.inp(20) + layer * DM, lane, b);
    bf16* XB = (bf16*)(C.ws + WS_XB); const bf16* YE = (const bf16*)(C.ws + WS_YE); float* AB = (float*)(C.ws + WS_AB);
    u32x2 nx[4]; unsigned ny[4][4];
#define CB_LOAD(m_) do { const bf16* xr_ = XB + (size_t)(m_) * DM + 4 * lane; const unsigned char* yr_ = (const unsigned char*)YE + (size_t)(m_) * 4 * DM + 4 * lane; \
        _Pragma("unroll") for (int j = 0; j < 4; ++j) nx[j] = *(const u32x2*)(xr_ + 256 * j); \
        _Pragma("unroll") for (int k = 0; k < 4; ++k) _Pragma("unroll") for (int j = 0; j < 4; ++j) ny[k][j] = *(const unsigned*)(yr_ + (size_t)k * DM + 256 * j); } while (0)
    auto row_body = [&](int m, bool pf) {
        f32x4 v[4];
        if (!pf) CB_LOAD(m);
#pragma unroll
        for (int j = 0; j < 4; ++j) { v[j] = (f32x4){bf_lo(nx[j].x), bf_hi(nx[j].x), bf_lo(nx[j].y), bf_hi(nx[j].y)} * DN_ALPHA;
#pragma unroll
            for (int k = 0; k < 4; ++k) { const f32x2 lo_ = __builtin_amdgcn_cvt_pk_f32_fp8((int)ny[k][j], false), hi_ = __builtin_amdgcn_cvt_pk_f32_fp8((int)ny[k][j], true); v[j] = v[j] + (f32x4){lo_.x, lo_.y, hi_.x, hi_.y}; } }
        if (pf) { const int mn = (m + NGW < T) ? m + NGW : m; CB_LOAD(mn); }
        row_layernorm(v, g, b);
        if (layer == DEPTH - 1) row_store_f32(C.out + (size_t)m * DM, lane, v);
        else row_store_bf16(XB + (size_t)m * DM, lane, v);
        if (layer == 1) { asm volatile("" ::: "memory");
            float ab[8]; row_ab(v, w8, lane, ab); if (lane < 8) { float s = ab[0];
#pragma unroll
                for (int e = 1; e < 8; ++e) s = (lane == e) ? ab[e] : s;
                AB[(size_t)m * 8 + lane] = s; }
            asm volatile("" ::: "memory"); } };
    if (gw < T) { CB_LOAD(gw); row_body(gw, true);
#pragma unroll 1
        for (int m = gw + NGW; m < T; m += NGW) row_body(m, true); }
#undef CB_LOAD
}

__device__ __forceinline__ void phase_o1b(const Ctx& C0) {
    const Ctx C = phase_ctx(C0);
    const int gw = C.bid * NWAVES + C.wave, NGW = C.G * NWAVES, lane = C.lane;
    const bf16* C1 = (const bf16*)(C.ws + WS_ARENA + AR_C1); bf16* KPE = (bf16*)(C.ws + WS_ARENA + AR_KPE);
    float* RSQ = (float*)(C.ws + WS_RS); float* RKV = RSQ + T; const f32x2* rope = (const f32x2*)(C.ws + WS_ROPE);
#pragma unroll 2
    for (int m = gw; m < T; m += NGW) {
        const bf16* rp = C1 + (size_t)m * ODD_N;
        const u32x4 a = *(const u32x4*)(rp + 8 * lane);
        float s = 0.f;
#pragma unroll
        for (int q = 0; q < 4; ++q) { const float lo = bf_lo(a[q]), hi = bf_hi(a[q]); s += lo * lo + hi * hi; }
        float sq = lane < 48 ? s : 0.f, skv = lane < 48 ? 0.f : s;
        if (lane < 16) { const u32x4 b = *(const u32x4*)(rp + 8 * (64 + lane)); float s2 = 0.f;
#pragma unroll
            for (int q = 0; q < 4; ++q) { const float lo = bf_lo(b[q]), hi = bf_hi(b[q]); s2 += lo * lo + hi * hi; }
            skv += s2; }
        sq = wave_sum(sq); skv = wave_sum(skv);
        if (lane == 0) { RSQ[m] = 1.0f / sqrtf(sq * (1.0f / QL) + RMS_EPS); RKV[m] = 1.0f / sqrtf(skv * (1.0f / KVL) + RMS_EPS); }
        if (lane < 32) { const float x1 = bf2f(rp[640 + lane]), x2 = bf2f(rp[672 + lane]); const f32x2 cs = rope[(m & (SEQ - 1)) * 32 + lane];
            *(unsigned*)(KPE + (size_t)m * 64 + 2 * lane) = cvt_pk_bf16(x1 * cs.x - x2 * cs.y, x1 * cs.y + x2 * cs.x); }
    }
}

namespace att {
constexpr int SHM_V = 16384, SHM_K = 16384, SHM_KR = 8192;
constexpr int NBUF = 3;
constexpr int OFF_V = 0, OFF_K = NBUF * SHM_V, OFF_KR = OFF_K + NBUF * SHM_K, OFF_WS = OFF_KR + NBUF * SHM_KR, OFF_QR = OFF_WS + 2048;
static_assert(OFF_QR + 8 * 4096 <= LDS_CTL_OFF, "attention LDS map");
constexpr float THR = 8.f, SCALE = ATT_SCALE;
#define KSWZ(row, colB) ((row) * 256 + ((colB) ^ (((row) & 7) << 4)))
#define KRSWZ(row, colB) ((row) * 128 + ((colB) ^ (((row) & 7) << 4)))
#define SBAR() __builtin_amdgcn_sched_barrier(0)
__device__ __forceinline__ int v_st(int k, int c) { const int kk = (k & ~0xC) | ((k & 4) << 1) | ((k & 8) >> 1); return ((kk >> 3) * 4 + (c >> 5)) * 512 + ((kk & 7) * 32 + (c & 31)) * 2; }
__device__ __forceinline__ int v_rd_base(int lane) { return ((lane & 3) << 3) | (((lane >> 2) & 3) << 6) | (((lane >> 4) & 1) << 5) | (((lane >> 5) & 1) << 8); }
constexpr int v_rd_off(int d0, int ks, int half) { return d0 * 512 + ks * 4096 + half * 2048; }
__device__ __forceinline__ int crow(int r, int hi) { return (r & 3) + 8 * (r >> 2) + 4 * hi; }
__device__ __forceinline__ void partialSM(f32x16& p0, f32x16& p1, float& m_reg, float& mn, float& alpha) {
    float pmax = p0[0];
#pragma unroll
    for (int r = 1; r < 16; ++r) pmax = fmaxf(pmax, p0[r]);
#pragma unroll
    for (int r = 0; r < 16; ++r) pmax = fmaxf(pmax, p1[r]);
    { auto rr = __builtin_amdgcn_permlane32_swap(__float_as_uint(pmax), __float_as_uint(pmax), false, false);
      pmax = fmaxf(__uint_as_float(rr[0]), __uint_as_float(rr[1])); }
    constexpr float C2 = 1.4426950408889634f * SCALE;
    if (__builtin_expect(__all((pmax - m_reg) * SCALE <= THR), 1)) { mn = m_reg; alpha = 1.f; }
    else { mn = fmaxf(m_reg, pmax); alpha = __builtin_amdgcn_exp2f((m_reg - mn) * C2); m_reg = mn; }
    const float mnL = -mn * C2;
#pragma unroll
    for (int r = 0; r < 16; ++r) p0[r] = fmaf(p0[r], C2, mnL);
#pragma unroll
    for (int r = 0; r < 16; ++r) p1[r] = fmaf(p1[r], C2, mnL);
#pragma unroll
    for (int r = 0; r < 16; ++r) p0[r] = __builtin_amdgcn_exp2f(p0[r]);
}
__device__ __forceinline__ void finishSM(f32x16& p0, f32x16& p1, float alpha, float& l_reg, bf16x8& pa0, bf16x8& pa1, bf16x8& pa2, bf16x8& pa3) {
#pragma unroll
    for (int r = 0; r < 16; ++r) p1[r] = __builtin_amdgcn_exp2f(p1[r]);
    float ps = 0;
#pragma unroll
    for (int r = 0; r < 16; ++r) ps += p0[r];
#pragma unroll
    for (int r = 0; r < 16; ++r) ps += p1[r];
    { auto rr = __builtin_amdgcn_permlane32_swap(__float_as_uint(ps), __float_as_uint(ps), false, false);
      ps = __uint_as_float(rr[0]) + __uint_as_float(rr[1]); }
    l_reg = l_reg * alpha + ps;
#define PK4(P, B_, OUT) do { unsigned a0 = cvt_pk_bf16(P[B_+0], P[B_+1]), a1 = cvt_pk_bf16(P[B_+2], P[B_+3]);                          \
        unsigned b0 = cvt_pk_bf16(P[B_+4], P[B_+5]), b1 = cvt_pk_bf16(P[B_+6], P[B_+7]);                                             \
        auto r0 = __builtin_amdgcn_permlane32_swap(a0, b0, false, false); auto r1 = __builtin_amdgcn_permlane32_swap(a1, b1, false, false); \
        u32x4 w = {r0[0], r1[0], r0[1], r1[1]}; OUT = *reinterpret_cast<bf16x8*>(&w); } while (0)
    PK4(p0, 0, pa0); PK4(p0, 8, pa1); PK4(p1, 0, pa2); PK4(p1, 8, pa3);
#undef PK4
}
template <int KB>
__device__ __forceinline__ void qkt(f32x16& p0, f32x16& p1, const LAS char* lds, int r32, int hi, const bf16x8* qr, const LAS char* qrl) {
    p0 = f32x16{}; p1 = f32x16{};
    const LAS char* kb[4]; const LAS char* kr[4];
#pragma unroll
    for (int dd = 0; dd < 4; ++dd) { kb[dd] = lds + OFF_K + KB * SHM_K + KSWZ(r32, (dd * 16 + hi * 8) * 2); kr[dd] = lds + OFF_KR + KB * SHM_KR + KRSWZ(r32, (dd * 16 + hi * 8) * 2); }
#pragma unroll
    for (int d0 = 0; d0 < 8; ++d0) { const LAS char* a = kb[d0 & 3] + (d0 >> 2) * 128;
        const bf16x8 b0 = *reinterpret_cast<const LAS bf16x8*>(a);
        const bf16x8 b1 = *reinterpret_cast<const LAS bf16x8*>(a + 32 * 256);
        p0 = __builtin_amdgcn_mfma_f32_32x32x16_bf16(b0, qr[d0], p0, 0, 0, 0);
        p1 = __builtin_amdgcn_mfma_f32_32x32x16_bf16(b1, qr[d0], p1, 0, 0, 0); }
#pragma unroll
    for (int d0 = 0; d0 < 4; ++d0) { const LAS char* a = kr[d0];
        const bf16x8 b0 = *reinterpret_cast<const LAS bf16x8*>(a);
        const bf16x8 b1 = *reinterpret_cast<const LAS bf16x8*>(a + 32 * 128);
        const bf16x8 qf = *reinterpret_cast<const LAS bf16x8*>(qrl + d0 * 1024);
        p0 = __builtin_amdgcn_mfma_f32_32x32x16_bf16(b0, qf, p0, 0, 0, 0);
        p1 = __builtin_amdgcn_mfma_f32_32x32x16_bf16(b1, qf, p1, 0, 0, 0); }
}
template <int VB>
__device__ __forceinline__ void pv_tile(f32x16* o, int vb0, bf16x8 pa0, bf16x8 pa1, bf16x8 pa2, bf16x8 pa3) {
#define TRRD(dst, off) asm volatile("ds_read_b64_tr_b16 %0, %1 offset:%2" : "=&v"(dst) : "v"(vb0), "i"(off) : "memory")
#define PV_RD(L_, H_, ks) do { constexpr int b_ = OFF_V + VB * SHM_V + (ks) * 4096; \
        TRRD(L_[0], b_); TRRD(H_[0], b_ + 2048); TRRD(L_[1], b_ + 512); TRRD(H_[1], b_ + 512 + 2048); TRRD(L_[2], b_ + 1024); TRRD(H_[2], b_ + 1024 + 2048); TRRD(L_[3], b_ + 1536); TRRD(H_[3], b_ + 1536 + 2048); } while (0)
#define PV_MM(L_, H_, pa) do { _Pragma("unroll") for (int d0 = 0; d0 < 4; ++d0) \
        o[d0] = __builtin_amdgcn_mfma_f32_32x32x16_bf16(pa, (bf16x8){L_[d0][0], L_[d0][1], L_[d0][2], L_[d0][3], H_[d0][0], H_[d0][1], H_[d0][2], H_[d0][3]}, o[d0], 0, 0, 0); } while (0)
    s16x4 la[4], ha[4], lb[4], hb[4];
    PV_RD(la, ha, 0); PV_RD(lb, hb, 1);
    asm volatile("s_waitcnt lgkmcnt(8)" ::: "memory"); SBAR(); PV_MM(la, ha, pa0); SBAR();
    PV_RD(la, ha, 2);
    asm volatile("s_waitcnt lgkmcnt(8)" ::: "memory"); SBAR(); PV_MM(lb, hb, pa1); SBAR();
    PV_RD(lb, hb, 3);
    asm volatile("s_waitcnt lgkmcnt(8)" ::: "memory"); SBAR(); PV_MM(la, ha, pa2); SBAR();
    asm volatile("s_waitcnt lgkmcnt(0)" ::: "memory"); SBAR(); PV_MM(lb, hb, pa3);
#undef PV_MM
#undef PV_RD
#undef TRRD
}

__device__ __forceinline__ void attn_block(const Ctx& C, int b, int h, int qb) {
    LAS char* lds = (LAS char*)C.lds;
    const int tid = C.tid, wid = C.wave, lane = C.lane, r32 = lane & 31, hi = lane >> 5;
    const bf16* Qg = (const bf16*)(C.ws + WS_ARENA + AR_Q); const bf16* KVg = (const bf16*)(C.ws + WS_ARENA + AR_KV); const bf16* KPE = (const bf16*)(C.ws + WS_ARENA + AR_KPE);
    bf16* MIX = (bf16*)(C.ws + WS_MIX);
    const size_t tok0 = (size_t)b * SEQ; const int P0 = qb * 256;
    const int NT = 4 * (qb + 1), jmax = (P0 + wid * 32) >> 6;
    const bf16* kvp = KVg + tok0 * 2048 + h * 256; const bf16* kpp = KPE + tok0 * 64;
#define A_LOAD(kb, bf) do { const bf16* p_ = kvp + (size_t)(kb) * 2048; int ln_ = lane; asm volatile("" : "+v"(ln_)); \
        _Pragma("unroll") for (int i_ = 0; i_ < 2; ++i_) { const int B_ = (wid * 2 + i_) * 1024 + ln_ * 16; \
            const int row_ = B_ >> 8, c_ = ((B_ & 255) >> 4) ^ (row_ & 7); \
            const int sub_ = B_ >> 9, kk_ = (sub_ >> 2) * 8 + ((B_ & 511) >> 6), k_ = (kk_ & ~0xC) | ((kk_ & 4) << 1) | ((kk_ & 8) >> 1), cc_ = (sub_ & 3) * 32 + ((B_ & 63) >> 1); \
            __builtin_amdgcn_global_load_lds((const unsigned*)(p_ + (unsigned)(row_ * 2048 + c_ * 8)), (LAS unsigned*)(lds + OFF_K + (bf) * SHM_K + (wid * 2 + i_) * 1024), 16, 0, 0); \
            __builtin_amdgcn_global_load_lds((const unsigned*)(p_ + (unsigned)(k_ * 2048 + 128 + cc_)), (LAS unsigned*)(lds + OFF_V + (bf) * SHM_V + (wid * 2 + i_) * 1024), 16, 0, 0); } \
        { const int B_ = wid * 1024 + ln_ * 16, row_ = B_ >> 7, c_ = ((B_ & 127) >> 4) ^ (row_ & 7); \
          __builtin_amdgcn_global_load_lds((const unsigned*)(kpp + (size_t)(kb) * 64 + (unsigned)(row_ * 64 + c_ * 8)), (LAS unsigned*)(lds + OFF_KR + (bf) * SHM_KR + wid * 1024), 16, 0, 0); } } while (0)
    LAS float* wsl = (LAS float*)(lds + OFF_WS) + wid * 64; LAS float* li_l = wsl; LAS float* al_l = wsl + 32;
    float m_reg = -1e30f, l_reg = 0.f; f32x16 o[4] = {};
    const int vb0 = (int)(uintptr_t)lds + v_rd_base(lane);
    A_LOAD(0, 0); A_LOAD(64, 1);
    bf16x8 qr[8];
    LAS char* qrl = lds + OFF_QR + wid * 4096 + lane * 16;
    { const bf16* qp = Qg + (tok0 + P0 + wid * 32 + r32) * 1536 + h * 192 + hi * 8;
#pragma unroll
      for (int d0 = 0; d0 < 8; ++d0) qr[d0] = *(const bf16x8*)(qp + d0 * 16);
#pragma unroll
      for (int d0 = 0; d0 < 4; ++d0) *(LAS bf16x8*)(qrl + d0 * 1024) = *(const bf16x8*)(qp + (8 + d0) * 16); }
    asm volatile("s_waitcnt vmcnt(5)" ::: "memory");
    asm volatile("s_waitcnt lgkmcnt(0)" ::: "memory"); __builtin_amdgcn_s_barrier(); asm volatile("" ::: "memory");
    f32x16 p0, p1; float mn, al; bf16x8 pa0, pa1, pa2, pa3;
#define A_STEP(KB, tt) do { \
        if ((tt) + 2 < NT) A_LOAD(((tt) + 2) * 64, ((KB) + 2) % 3);            \
        if ((tt) <= jmax) { qkt<KB>(p0, p1, lds, r32, hi, qr, qrl); partialSM(p0, p1, m_reg, mn, al); \
            if (__any(al < 1.f)) { if (hi == 0) al_l[r32] = al; asm volatile("s_waitcnt lgkmcnt(0)" ::: "memory"); \
                _Pragma("unroll") for (int d_ = 0; d_ < 4; ++d_) _Pragma("unroll") for (int r = 0; r < 16; ++r) o[d_][r] *= al_l[crow(r, hi)]; } \
            finishSM(p0, p1, al, l_reg, pa0, pa1, pa2, pa3); SBAR(); pv_tile<KB>(o, vb0, pa0, pa1, pa2, pa3); } \
        if ((tt) + 2 < NT) { asm volatile("s_waitcnt vmcnt(5)" ::: "memory"); } else { asm volatile("s_waitcnt vmcnt(0)" ::: "memory"); }     \
        asm volatile("s_waitcnt lgkmcnt(0)" ::: "memory"); __builtin_amdgcn_s_barrier(); asm volatile("" ::: "memory"); } while (0)
    for (int t = 0; t < NT; t += 3) { A_STEP(0, t); if (t + 1 < NT) A_STEP(1, t + 1); if (t + 2 < NT) A_STEP(2, t + 2); }
#undef A_STEP
#undef A_LOAD
    if (hi == 0) li_l[r32] = l_reg;
    asm volatile("s_waitcnt lgkmcnt(0)" ::: "memory");
    float rli[16];
#pragma unroll
    for (int r = 0; r < 16; ++r) rli[r] = __builtin_amdgcn_rcpf(li_l[crow(r, hi)]);
    bf16* Ow = MIX + (tok0 + P0 + wid * 32) * DM + h * 128;
#pragma unroll
    for (int r = 0; r < 16; ++r) { const int orow = crow(r, hi);
#pragma unroll
        for (int d0 = 0; d0 < 4; ++d0) { const float v = o[d0][r] * rli[r]; const float vn = __shfl_xor(v, 1);
            if ((r32 & 1) == 0) *(unsigned*)(Ow + (size_t)orow * DM + d0 * 32 + r32) = cvt_pk_bf16(v, vn); } }
    __syncthreads();
}
#undef KSWZ
#undef KRSWZ
#undef SBAR
}

__device__ __forceinline__ void phase_attn(const Ctx& C0) {
    const Ctx C = phase_ctx(C0);
    const int x = C.bid & 7, k = C.bid >> 3, per = C.G >> 3;
    for (int u = k; u < 64; u += per) {
        const int bh = x * 8 + (u >> 3), p = u & 7;
        att::attn_block(C, bh >> 3, bh & 7, 15 - p);
        att::attn_block(C, bh >> 3, bh & 7, p);
    }
}

namespace sm {
__device__ __forceinline__ bf16x8 frag_n(const LAS char* base, int S, int x0, int k0, int lane) { return *(const LAS bf16x8*)(base + (x0 + (lane & 15)) * S + (k0 + 8 * (lane >> 4)) * 2); }
__device__ __forceinline__ bf16x8 frag_t(const LAS char* base, int S, int x0, int k0, int lane) {
    const int g = lane >> 4, q = (lane >> 2) & 3, p = lane & 3;
    const LAS char* a = base + (k0 + 8 * g + q) * S + (x0 + 4 * p) * 2;
    const s16x4 lo = __builtin_amdgcn_ds_read_tr16_b64_v4i16((LAS s16x4*)a);
    const s16x4 hi = __builtin_amdgcn_ds_read_tr16_b64_v4i16((LAS s16x4*)(a + 4 * S));
    return (bf16x8){lo[0], lo[1], lo[2], lo[3], hi[0], hi[1], hi[2], hi[3]};
}
__device__ __forceinline__ f32x4 mma(bf16x8 a, bf16x8 b, f32x4 c) { return __builtin_amdgcn_mfma_f32_16x16x32_bf16(a, b, c, 0, 0, 0); }
__device__ __forceinline__ u32x2 pack4(f32x4 v) { u32x2 w; w.x = cvt_pk_bf16(v[0], v[1]); w.y = cvt_pk_bf16(v[2], v[3]); return w; }
__device__ __forceinline__ f32x4 unpack4(u32x2 w) { return (f32x4){bf_lo(w.x), bf_hi(w.x), bf_lo(w.y), bf_hi(w.y)}; }
}

constexpr int H1LD = EVEN_N;

struct SguPre { u32x4 raw[4]; };
__device__ __forceinline__ void sgu_load(const Ctx& C, int unit, SguPre& P) {
    const int g4 = unit & 3, blk = (unit >> 2) & 31, b = unit >> 7; int tid = C.tid; asm volatile("" : "+v"(tid));
    const bf16* H1 = (const bf16*)(C.ws + WS_ARENA); const size_t t0 = (size_t)b * SEQ + blk * 128;
#pragma unroll
    for (int pp = 0; pp < 4; ++pp) P.raw[pp] = *(const u32x4*)(H1 + (t0 + pp * 32 + (tid >> 4)) * H1LD + 512 + g4 * 128 + 8 * (tid & 15));
}
__device__ __forceinline__ void sgu_setup(const Ctx& C, int ei, int g4) {
    LAS char* Wm = (LAS char*)C.lds + 34816; const float* Wg = C.inp(4) + (size_t)(ei * 4 + g4) * 128 * 128;
    f32x4 wv[8];
#pragma unroll
    for (int q = 0; q < 8; ++q) wv[q] = *(const f32x4*)(Wg + (C.tid + 512 * q) * 4);
#pragma unroll
    for (int q = 0; q < 8; ++q) { const int f = (C.tid + 512 * q) * 4, i = f >> 7, j = f & 127; *(LAS u32x2*)(Wm + i * 272 + j * 2) = sm::pack4(wv[q]); }
}
__device__ __forceinline__ void sgu_unit(const Ctx& C, int ei, int unit, SguPre& P, bool has_next, int unit_next) {
    const int g4 = unit & 3, blk = (unit >> 2) & 31, b = unit >> 7;
    int tid_ = C.tid; asm volatile("" : "+v"(tid_));
    const int tid = tid_, lane = tid & 63, w = C.wave;
    const bf16* H1 = (const bf16*)(C.ws + WS_ARENA); bf16* MIX = (bf16*)(C.ws + WS_MIX);
    LAS char* Vn = (LAS char*)C.lds; LAS char* Wm = Vn + 34816;
    const size_t t0 = (size_t)b * SEQ + blk * 128;
    const float* lng = C.inp(2) + ei * 512 + g4 * 128; const float* lnb = C.inp(3) + ei * 512 + g4 * 128;
    const float* bs = C.inp(5) + (ei * 4 + g4) * 128;
    { const int l16 = tid & 15; f32x4 ga = *(const f32x4*)(lng + 8 * l16), gb = *(const f32x4*)(lng + 8 * l16 + 4), ba = *(const f32x4*)(lnb + 8 * l16), bb = *(const f32x4*)(lnb + 8 * l16 + 4);
#pragma unroll
      for (int pp = 0; pp < 4; ++pp) { const int j = pp * 32 + (tid >> 4);
        const u32x4 raw = P.raw[pp];
        float x[8];
#pragma unroll
        for (int q = 0; q < 4; ++q) { x[2 * q] = bf_lo(raw[q]); x[2 * q + 1] = bf_hi(raw[q]); }
        float s = 0.f;
#pragma unroll
        for (int q = 0; q < 8; ++q) s += x[q];
        s += __shfl_xor(s, 1); s += __shfl_xor(s, 2); s += __shfl_xor(s, 4); s += __shfl_xor(s, 8);
        const float mean = s * (1.f / 128.f); float s2 = 0.f;
#pragma unroll
        for (int q = 0; q < 8; ++q) { x[q] -= mean; s2 += x[q] * x[q]; }
        s2 += __shfl_xor(s2, 1); s2 += __shfl_xor(s2, 2); s2 += __shfl_xor(s2, 4); s2 += __shfl_xor(s2, 8);
        const float rstd = 1.f / sqrtf(s2 * (1.f / 128.f) + LN_EPS);
        u32x4 o; o.x = cvt_pk_bf16(x[0] * rstd * ga[0] + ba[0], x[1] * rstd * ga[1] + ba[1]); o.y = cvt_pk_bf16(x[2] * rstd * ga[2] + ba[2], x[3] * rstd * ga[3] + ba[3]);
        o.z = cvt_pk_bf16(x[4] * rstd * gb[0] + bb[0], x[5] * rstd * gb[1] + bb[1]); o.w = cvt_pk_bf16(x[6] * rstd * gb[2] + bb[2], x[7] * rstd * gb[3] + bb[3]);
        *(LAS u32x4*)(Vn + j * 272 + l16 * 16) = o; } }
    lds_barrier();
    if (has_next) sgu_load(C, unit_next, P);
    const int i0 = 16 * w, nks = (w < 4) ? 2 : 4;
    bf16x8 f2[4];
#pragma unroll
    for (int ks = 0; ks < 4; ++ks) f2[ks] = sm::frag_n(Wm, 272, i0, 32 * ks, lane);
    const int i = i0 + (lane & 15), gq = lane >> 4; const float bsi = bs[i];
    const bf16* urow = H1 + (t0 + i) * H1LD + g4 * 128; bf16* orow = MIX + (t0 + i) * DM + g4 * 128;
    u32x2 uu[8];
#pragma unroll
    for (int ct = 0; ct < 8; ++ct) uu[ct] = *(const u32x2*)(urow + 16 * ct + 4 * gq);
#pragma unroll
    for (int ct = 0; ct < 8; ++ct) { f32x4 acc = (f32x4){0.f, 0.f, 0.f, 0.f};
#pragma unroll
        for (int ks = 0; ks < 4; ++ks) if (ks < nks) acc = sm::mma(sm::frag_t(Vn, 272, 16 * ct, 32 * ks, lane), f2[ks], acc);
        const int c = 16 * ct + 4 * gq; const f32x4 u = sm::unpack4(uu[ct]);
        *(u32x2*)(orow + c) = sm::pack4(u * (acc + bsi)); }
    lds_barrier();
}

namespace gdn {
#ifdef MK_TIME
#define GT_BEG(k) unsigned long long gt0_ = 0ull; if (MK_TIME == (k)) gt0_ = __builtin_amdgcn_s_memrealtime();
#define GT_END(k) if (MK_TIME == (k)) { const unsigned long long n_ = __builtin_amdgcn_s_memrealtime(); const unsigned long long e_ = n_ + 7ull * (n_ - gt0_); while (__builtin_amdgcn_s_memrealtime() < e_) __builtin_amdgcn_s_sleep(8); }
#else
#define GT_BEG(k)
#define GT_END(k)
#endif
constexpr int LF = 0, T1 = 17408, T2 = 26624, INM = 35840, VEC = 45056, QS = 46080, KS = 63488, VS = 80896, KDS = 98304, WT = 115712, UT = 133120;
__device__ __forceinline__ float silu(float x) { return x * __builtin_amdgcn_rcpf(1.0f + __expf(-x)); }
struct Pre { u32x4 r[11]; float a, b; };
constexpr int CWL = 150528, L21B = 156672, PB = 159232;
__device__ __forceinline__ void prep_load(const Ctx& C, int ei, int unit, Pre& P) {
    const int n = unit & 63, h = (unit >> 6) & 3, b = unit >> 8; int tid = C.tid; asm volatile("" : "+v"(tid)); const int w = C.wave;
    const long tok0 = (long)b * SEQ + n * 64;
    if (w < 6) { const int X = tid >> 7, t = tid & 127, ck = t & 15, strip = t >> 4;
        const bf16* hp = (const bf16*)(C.ws + WS_ARENA) + 1024 + X * 512 + h * 128 + ck * 8;
#pragma unroll
        for (int idx = 0; idx < 11; ++idx) { const int r = strip * 8 - 3 + idx;
            P.r[idx] = (u32x4){0u, 0u, 0u, 0u}; if (n * 64 + r >= 0) P.r[idx] = *(const u32x4*)(hp + (tok0 + r) * H1LD); }
    } else if (w == 6) { const float* AB = (const float*)(C.ws + WS_AB) + (tok0 + (tid & 63)) * 8; P.a = AB[h]; P.b = AB[4 + h]; }
}
__device__ __forceinline__ void prep_unit(const Ctx& C, int ei, int unit, Pre& P, bool has_next, int unit_next) {
    const int n = unit & 63, h = (unit >> 6) & 3, b = unit >> 8;
    int tid_ = C.tid; asm volatile("" : "+v"(tid_));
    const int tid = tid_, lane = tid & 63, w = C.wave;
    LAS char* L = (LAS char*)C.lds;
    LAS float* gcs = (LAS float*)(L + VEC); LAS float* bet = gcs + 64; LAS float* egs = gcs + 128; LAS float* eks = gcs + 192;
    const int chunk = (b * 4 + h) * 64 + n;
    { GT_BEG(30)
    if (w < 6) { const int X = tid >> 7, t = tid & 127, ck = t & 15, strip = t >> 4;
        LAS char* dstb = L + (X == 0 ? QS : X == 1 ? KS : VS) + (strip * 8) * 272 + ck * 16;
#pragma unroll
        for (int tt = 0; tt < 8; ++tt) { float acc[8];
#pragma unroll
            for (int q = 0; q < 8; ++q) acc[q] = 0.f;
#pragma unroll
            for (int jj = 0; jj < 4; ++jj) { const u32x4 r = P.r[tt + jj]; const LAS float* wl = (const LAS float*)(L + CWL) + jj * 384 + X * 128 + ck * 8; const f32x4 w0 = *(const LAS f32x4*)wl, w1 = *(const LAS f32x4*)(wl + 4);
                acc[0] += w0[0] * bf_lo(r[0]); acc[1] += w0[1] * bf_hi(r[0]); acc[2] += w0[2] * bf_lo(r[1]); acc[3] += w0[3] * bf_hi(r[1]);
                acc[4] += w1[0] * bf_lo(r[2]); acc[5] += w1[1] * bf_hi(r[2]); acc[6] += w1[2] * bf_lo(r[3]); acc[7] += w1[3] * bf_hi(r[3]); }
            float ss = 0.f;
#pragma unroll
            for (int q = 0; q < 8; ++q) { acc[q] = silu(acc[q]); ss += acc[q] * acc[q]; }
            float sc = 1.f;
            if (X < 2) { ss += __shfl_xor(ss, 1); ss += __shfl_xor(ss, 2); ss += __shfl_xor(ss, 4); ss += __shfl_xor(ss, 8); sc = 1.0f / sqrtf(ss + RMS_EPS); if (X == 0) sc *= 0.08838834764831845f; }
            u32x4 o; o.x = cvt_pk_bf16(acc[0] * sc, acc[1] * sc); o.y = cvt_pk_bf16(acc[2] * sc, acc[3] * sc); o.z = cvt_pk_bf16(acc[4] * sc, acc[5] * sc); o.w = cvt_pk_bf16(acc[6] * sc, acc[7] * sc);
            *(LAS u32x4*)(dstb + tt * 272) = o; }
    } else if (w == 6) {
        const float a = P.a, bb = P.b; const float alog = C.inp(7)[ei * 4 + h], dtb = C.inp(8)[ei * 4 + h];
        const float xs = a + dtb; const float sp = xs > 20.f ? xs : log1pf(__expf(xs));
        float gv = -__expf(alog) * sp;
#pragma unroll
        for (int o = 1; o < 64; o <<= 1) { const float t_ = __shfl_up(gv, o); if (lane >= o) gv += t_; }
        const float gl = __shfl(gv, 63);
        gcs[lane] = gv; bet[lane] = 1.0f / (1.0f + __expf(-bb)); egs[lane] = __expf(gv); eks[lane] = __expf(gl - gv);
        if (lane == 0) ((float*)(C.ws + WS_GAM))[chunk] = __expf(gl); }
    GT_END(30) }
    lds_barrier();
    { GT_BEG(31)
    { const int i = tid >> 3, dc = (tid & 7) * 16; const float e = eks[i];
#pragma unroll
      for (int hh = 0; hh < 2; ++hh) { const u32x4 r = *(const LAS u32x4*)(L + KS + i * 272 + dc * 2 + 16 * hh); u32x4 o;
#pragma unroll
        for (int q = 0; q < 4; ++q) o[q] = cvt_pk_bf16(bf_lo(r[q]) * e, bf_hi(r[q]) * e);
        *(LAS u32x4*)(L + KDS + i * 272 + dc * 2 + 16 * hh) = o; } }
#pragma unroll
    for (int q = 0; q < 2; ++q) { const int tt = 2 * w + q, it = tt >> 2, jt = tt & 3;
        if (jt <= it) { f32x4 acc = (f32x4){0.f, 0.f, 0.f, 0.f};
#pragma unroll
            for (int ks = 0; ks < 4; ++ks) acc = sm::mma(sm::frag_n(L + KS, 272, 16 * jt, 32 * ks, lane), sm::frag_n(L + KS, 272, 16 * it, 32 * ks, lane), acc);
            const int i = 16 * it + (lane & 15), j0 = 16 * jt + 4 * (lane >> 4); const float gi = gcs[i], bi = bet[i]; f32x4 o;
#pragma unroll
            for (int r = 0; r < 4; ++r) o[r] = (i > j0 + r) ? bi * acc[r] * __expf(gi - gcs[j0 + r]) : 0.f;
            *(LAS f32x4*)(L + LF + (i * 68 + j0) * 4) = o; } }
    GT_END(31) }
    lds_barrier();
    if (has_next) prep_load(C, ei, unit_next, P);
    { GT_BEG(32)
    if (w >= 6) {
        const int o = (w == 7) ? 32 : 0, jl = lane & 31;
        float t[32];
#pragma unroll
        for (int i = 0; i < 32; ++i) t[i] = 0.f;
#pragma unroll
        for (int i = 0; i < 32; ++i) { float s0 = 0.f, s1 = 0.f, s2 = 0.f, s3 = 0.f;
#pragma unroll
            for (int m = 0; m < i; m += 4) { const f32x4 l = *(const LAS f32x4*)(L + LF + ((o + i) * 68 + o + m) * 4); s0 += l[0] * t[m]; s1 += l[1] * t[m + 1]; s2 += l[2] * t[m + 2]; s3 += l[3] * t[m + 3]; }
            t[i] = ((jl == i) ? 1.f : 0.f) - ((s0 + s1) + (s2 + s3)); }
        if (lane < 32) {
#pragma unroll
            for (int i = 0; i < 32; ++i) *(LAS bf16*)(L + T2 + (o + i) * 144 + (o + jl) * 2) = f2bf(t[i]); }
    } else {
        for (int tt = w; tt < 16; tt += 6) { const int it = tt >> 2, jt = tt & 3; f32x4 acc = (f32x4){0.f, 0.f, 0.f, 0.f};
            if (jt <= it) {
#pragma unroll
                for (int ks = 0; ks < 4; ++ks) acc = sm::mma(sm::frag_n(L + KS, 272, 16 * jt, 32 * ks, lane), sm::frag_n(L + QS, 272, 16 * it, 32 * ks, lane), acc); }
            const int i = 16 * it + (lane & 15), j0 = 16 * jt + 4 * (lane >> 4); const float gi = gcs[i]; f32x4 o;
#pragma unroll
            for (int r = 0; r < 4; ++r) o[r] = (i >= j0 + r) ? acc[r] * __expf(gi - gcs[j0 + r]) : 0.f;
            *(LAS u32x2*)(L + INM + i * 144 + j0 * 2) = sm::pack4(o); }
        for (int idx = tid; idx < 1024; idx += 384) { const int i = idx >> 5, k = idx & 31; *(LAS bf16*)(L + L21B + i * 80 + k * 2) = f2bf(*(const LAS float*)(L + LF + ((32 + i) * 68 + k) * 4)); }
    }
    lds_barrier();
    if (w < 4) { const int it = w >> 1, jt = w & 1;
        const f32x4 acc = sm::mma(sm::frag_t(L + T2, 144, 16 * jt, 0, lane), sm::frag_n(L + L21B, 80, 16 * it, 0, lane), (f32x4){0.f, 0.f, 0.f, 0.f});
        *(LAS u32x2*)(L + PB + (16 * it + (lane & 15)) * 80 + (16 * jt + 4 * (lane >> 4)) * 2) = sm::pack4(acc); }
    lds_barrier();
    if (w < 4) { const int it = w >> 1, jt = w & 1;
        const f32x4 acc = sm::mma(sm::frag_t(L + PB, 80, 16 * jt, 0, lane), sm::frag_n(L + T2 + 32 * 144 + 64, 144, 16 * it, 0, lane), (f32x4){0.f, 0.f, 0.f, 0.f});
        *(LAS u32x2*)(L + T2 + (32 + 16 * it + (lane & 15)) * 144 + (16 * jt + 4 * (lane >> 4)) * 2) = sm::pack4(-acc); }
    lds_barrier();
    for (int idx = tid; idx < 64 * 16; idx += NWAVES * 64) { const int i = idx >> 4, j4 = (idx & 15) * 4;
        const f32x4 tv = sm::unpack4(*(const LAS u32x2*)(L + T2 + i * 144 + j4 * 2)); f32x4 a, bq;
#pragma unroll
        for (int r = 0; r < 4; ++r) { const int j = j4 + r; const float t = (i < 32 && j >= 32) ? 0.f : tv[r]; const float bj = bet[j]; bq[r] = t * bj; a[r] = bq[r] * egs[j]; }
        *(LAS u32x2*)(L + T1 + i * 144 + j4 * 2) = sm::pack4(a); *(LAS u32x2*)(L + T2 + i * 144 + j4 * 2) = sm::pack4(bq); }
    GT_END(32) }
    lds_barrier();
    int tl272 = (8 * (lane >> 4) + ((lane >> 2) & 3)) * 272 + 8 * (lane & 3), nl144 = (lane & 15) * 144 + 16 * (lane >> 4);
    asm volatile("" : "+v"(tl272), "+v"(nl144));
    auto ft_ = [&](const LAS char* bp, int x0, int k0) -> bf16x8 {
        const LAS char* a = bp + k0 * 272 + x0 * 2;
        const s16x4 lo = __builtin_amdgcn_ds_read_tr16_b64_v4i16((LAS s16x4*)a); const s16x4 hi = __builtin_amdgcn_ds_read_tr16_b64_v4i16((LAS s16x4*)(a + 4 * 272));
        return (bf16x8){lo[0], lo[1], lo[2], lo[3], hi[0], hi[1], hi[2], hi[3]}; };
    auto fn_ = [&](const LAS char* bp, int x0, int k0) -> bf16x8 { return *(const LAS bf16x8*)(bp + x0 * 144 + k0 * 2); };
    const f32x4 z4 = (f32x4){0.f, 0.f, 0.f, 0.f};
    { GT_BEG(33)
    { const int which = w >> 2, xb = (w & 3) * 2;
      int so = (which ? VS : KS) + tl272, to = (which ? T2 : T1) + nl144, oo = (which ? UT : WT) + (lane & 15) * 272 + 8 * (lane >> 4);
      asm volatile("" : "+v"(so), "+v"(to), "+v"(oo));
      const LAS char* sp = L + so; const LAS char* tp = L + to; LAS char* op = L + oo;
      bf16x8 fs[2][2], ftm[4][2];
#pragma unroll
      for (int xi = 0; xi < 2; ++xi)
#pragma unroll
          for (int ks = 0; ks < 2; ++ks) fs[xi][ks] = ft_(sp, 16 * (xb + xi), 32 * ks);
#pragma unroll
      for (int it = 0; it < 4; ++it)
#pragma unroll
          for (int ks = 0; ks < 2; ++ks) ftm[it][ks] = fn_(tp, 16 * it, 32 * ks);
      f32x4 acc[2][4];
#pragma unroll
      for (int xi = 0; xi < 2; ++xi)
#pragma unroll
          for (int it = 0; it < 4; ++it) { acc[xi][it] = sm::mma(fs[xi][0], ftm[it][0], z4); acc[xi][it] = sm::mma(fs[xi][1], ftm[it][1], acc[xi][it]); }
#pragma unroll
      for (int xi = 0; xi < 2; ++xi)
#pragma unroll
          for (int it = 0; it < 4; ++it) *(LAS u32x2*)(op + (16 * it) * 272 + (16 * (xb + xi)) * 2) = sm::pack4(acc[xi][it]); }
    GT_END(33) }
    lds_barrier();
    { GT_BEG(34)
    { bf16* Mg = (bf16*)(C.ws + WS_GM) + (size_t)chunk * 16384; bf16* Bg = (bf16*)(C.ws + WS_GB) + (size_t)chunk * 16384;
      bf16* Cg = (bf16*)(C.ws + WS_GC) + (size_t)chunk * 8192; bf16* Dg = (bf16*)(C.ws + WS_GD) + (size_t)chunk * 8192;
      const int x2 = lane & 15, x1 = 4 * (lane >> 4);
      int wo = WT + tl272, ko = KDS + tl272, uo = UT + tl272, io = INM + nl144;
      asm volatile("" : "+v"(wo), "+v"(ko), "+v"(uo), "+v"(io));
      const LAS char* wp = L + wo; const LAS char* kp = L + ko; const LAS char* up = L + uo; const LAS char* ip = L + io;
      const bf16x8 fw0 = ft_(wp, 16 * w, 0), fw1 = ft_(wp, 16 * w, 32), fa0 = ft_(kp, 16 * w, 0), fa1 = ft_(kp, 16 * w, 32);
#pragma unroll
      for (int hb = 0; hb < 2; ++hb) {
          bf16x8 kb[4][2], fu[4][2];
#pragma unroll
          for (int j = 0; j < 4; ++j)
#pragma unroll
              for (int ks = 0; ks < 2; ++ks) { kb[j][ks] = ft_(kp, 16 * (hb * 4 + j), 32 * ks); fu[j][ks] = ft_(up, 16 * (hb * 4 + j), 32 * ks); }
          f32x4 am[4], ab[4];
#pragma unroll
          for (int j = 0; j < 4; ++j) { am[j] = sm::mma(fw0, kb[j][0], z4); am[j] = sm::mma(fw1, kb[j][1], am[j]);
                                        ab[j] = sm::mma(fa0, fu[j][0], z4); ab[j] = sm::mma(fa1, fu[j][1], ab[j]); }
#pragma unroll
          for (int j = 0; j < 4; ++j) { const int bt = hb * 4 + j;
              *(u32x2*)(Mg + (16 * bt + x2) * 128 + 16 * w + x1) = sm::pack4(-am[j]);
              *(u32x2*)(Bg + (16 * bt + x2) * 128 + 16 * w + x1) = sm::pack4(ab[j]); } }
      { const bf16x8 fu0 = ft_(up, 16 * w, 0), fu1 = ft_(up, 16 * w, 32);
        bf16x8 fin[4][2]; u32x2 qr[4]; float eg[4];
#pragma unroll
        for (int it = 0; it < 4; ++it) { fin[it][0] = fn_(ip, 16 * it, 0); fin[it][1] = fn_(ip, 16 * it, 32);
            qr[it] = *(const LAS u32x2*)(L + QS + (16 * it + x2) * 272 + (16 * w + x1) * 2); eg[it] = egs[16 * it + x2]; }
        f32x4 ac[4], ad[4];
#pragma unroll
        for (int it = 0; it < 4; ++it) { ac[it] = sm::mma(fw0, fin[it][0], z4); ac[it] = sm::mma(fw1, fin[it][1], ac[it]);
                                         ad[it] = sm::mma(fu0, fin[it][0], z4); ad[it] = sm::mma(fu1, fin[it][1], ad[it]); }
#pragma unroll
        for (int it = 0; it < 4; ++it) { const int i = 16 * it + x2, d = 16 * w + x1;
            *(u32x2*)(Cg + i * 128 + d) = sm::pack4(sm::unpack4(qr[it]) * eg[it] - ac[it]);
            *(u32x2*)(Dg + i * 128 + d) = sm::pack4(ad[it]); } } }
    GT_END(34) }
#ifdef DBG_DUMP
    { unsigned char* dst = C.ws + WS_HID + (size_t)chunk * 150528; for (int o = tid * 16; o < 150528; o += 512 * 16) *(u32x4*)(dst + o) = *(const LAS u32x4*)(L + o); }
#endif
    lds_barrier();
}

__device__ __forceinline__ void scan_unit(const Ctx& C, int unit) {
    const int cs = unit & 7, bh = unit >> 3;
    const int lane = C.lane, w = C.wave, x2 = lane & 15, g = lane >> 4;
    LAS char* ST = (LAS char*)C.lds;
    LAS char* MR = ST + 9216;
    LAS char* BR = MR + 4 * 32768;
    LAS float* GL = (LAS float*)(BR + 4 * 4096);
    static_assert(9216 + 4 * 32768 + 4 * 4096 + 256 <= LDS_CTL_OFF, "scan LDS map");
    const bf16* Mg = (const bf16*)(C.ws + WS_GM) + (size_t)bh * 64 * 16384; const bf16* Bg = (const bf16*)(C.ws + WS_GB) + (size_t)bh * 64 * 16384 + (size_t)cs * 16 * 128;
    bf16* Sg = (bf16*)(C.ws + WS_GS) + (size_t)bh * 64 * 16384; const float* GAM = (const float*)(C.ws + WS_GAM) + bh * 64;
    const int c = cs * 16 + x2, d0 = 16 * w + 4 * g;
    { unsigned zz = 0u; asm volatile("" : "+v"(zz));
      if (C.tid < 272) *(LAS u32x4*)(ST + C.tid * 16) = (u32x4){zz, zz, zz, zz};
      if (C.tid < 64) GL[C.tid] = GAM[C.tid]; }
    unsigned moff[4];
#pragma unroll
    for (int q = 0; q < 4; ++q) { const int r = 4 * q + (lane >> 4), cp = lane & 15; moff[q] = (unsigned)((16 * w + r) * 128 + ((cp ^ r) & 15) * 8); }
    const unsigned boff = (unsigned)((4 * (w & 3) + (lane >> 4)) * 128 + (lane & 15) * 8);
#define SC_ISSUE(n_) do { const bf16* mp_ = Mg + (size_t)(n_) * 16384; const int sl_ = (n_) & 3; \
        _Pragma("unroll") for (int q = 0; q < 4; ++q) __builtin_amdgcn_global_load_lds((const unsigned*)(mp_ + moff[q]), (LAS unsigned*)(MR + sl_ * 32768 + w * 4096 + q * 1024), 16, 0, 0); \
        __builtin_amdgcn_global_load_lds((const unsigned*)(Bg + (size_t)(n_) * 16384 + boff), (LAS unsigned*)(BR + sl_ * 4096 + (w & 3) * 1024), 16, 0, 0); } while (0)
    __syncthreads();
    SC_ISSUE(0); SC_ISSUE(1); SC_ISSUE(2);
    asm volatile("s_waitcnt vmcnt(10)" ::: "memory"); lds_barrier();
    f32x4 acc = (f32x4){0.f, 0.f, 0.f, 0.f};
    bf16* srow = Sg + c * 128 + d0;
    const LAS char* mrd = MR + w * 4096 + x2 * 256; const LAS char* brd = BR + x2 * 256 + d0 * 2;
#define SC_STEP(n_, SP) do { const int sl_ = (n_) & 3; \
        SP = sm::pack4(acc);                                   \
        f32x4 a_ = acc * GL[n_] + sm::unpack4(*(const LAS u32x2*)(brd + sl_ * 4096)); const LAS char* sb_ = ST + ((n_) & 1) * 4352; \
        _Pragma("unroll") for (int ks = 0; ks < 4; ++ks) a_ = sm::mma(*(const LAS bf16x8*)(mrd + sl_ * 32768 + (((4 * ks + g) ^ x2) & 15) * 16), sm::frag_n(sb_, 272, 0, 32 * ks, lane), a_); \
        acc = a_; *(LAS u32x2*)(ST + (((n_) + 1) & 1) * 4352 + x2 * 272 + d0 * 2) = sm::pack4(acc); \
        if ((n_) + 3 < 64) { SC_ISSUE((n_) + 3); asm volatile("s_waitcnt vmcnt(10)" ::: "memory"); }        \
        else if ((n_) + 2 < 64) { asm volatile("s_waitcnt vmcnt(5)" ::: "memory"); } else { asm volatile("s_waitcnt vmcnt(0)" ::: "memory"); } \
        lds_barrier(); } while (0)
#pragma unroll 1
    for (int n = 0; n < 64; n += 8) { u32x2 sp[8];
        SC_STEP(n, sp[0]); SC_STEP(n + 1, sp[1]); SC_STEP(n + 2, sp[2]); SC_STEP(n + 3, sp[3]); SC_STEP(n + 4, sp[4]); SC_STEP(n + 5, sp[5]); SC_STEP(n + 6, sp[6]); SC_STEP(n + 7, sp[7]);
#pragma unroll
        for (int k = 0; k < 8; ++k) *(u32x2*)(srow + (size_t)(n + k) * 16384) = sp[k]; }
#undef SC_ISSUE
#undef SC_STEP
}

__device__ __forceinline__ void out_unit(const Ctx& C, int ei, int unit) {
    const int pr = unit & 31, h = (unit >> 5) & 3, b = unit >> 7;
    const int lane = C.lane, w = C.wave, x2 = lane & 15, g = lane >> 4;
    const int n = 2 * pr + (w >> 2), it = w & 3, chunk = (b * 4 + h) * 64 + n;
    const bf16* Sg = (const bf16*)(C.ws + WS_GS) + (size_t)chunk * 16384; const bf16* Cg = (const bf16*)(C.ws + WS_GC) + (size_t)chunk * 8192; const bf16* Dg = (const bf16*)(C.ws + WS_GD) + (size_t)chunk * 8192;
    const bf16* H1 = (const bf16*)(C.ws + WS_ARENA); bf16* MIX = (bf16*)(C.ws + WS_MIX);
    const int i = 16 * it + x2; const size_t tok = (size_t)b * SEQ + n * 64 + i;
    bf16x8 fc[4];
#pragma unroll
    for (int ks = 0; ks < 4; ++ks) fc[ks] = *(const bf16x8*)(Cg + i * 128 + 32 * ks + 8 * g);
    f32x4 o[8]; float ss = 0.f;
#pragma unroll
    for (int ct = 0; ct < 8; ++ct) { f32x4 a = sm::unpack4(*(const u32x2*)(Dg + i * 128 + 16 * ct + 4 * g));
#pragma unroll
        for (int ks = 0; ks < 4; ++ks) a = sm::mma(*(const bf16x8*)(Sg + (16 * ct + x2) * 128 + 32 * ks + 8 * g), fc[ks], a);
        o[ct] = a; ss += (a[0] * a[0] + a[1] * a[1]) + (a[2] * a[2] + a[3] * a[3]); }
    ss += __shfl_xor(ss, 16); ss += __shfl_xor(ss, 32);
    const float rstd = 1.0f / sqrtf(ss * (1.f / 128.f) + RMS_EPS);
    const float* nw = C.inp(9) + ei * 128; const bf16* zrow = H1 + tok * H1LD + 2560 + h * 128; bf16* orow = MIX + tok * DM + 512 + h * 128;
#pragma unroll
    for (int ct = 0; ct < 8; ++ct) { const int c = 16 * ct + 4 * g; const f32x4 z = sm::unpack4(*(const u32x2*)(zrow + c)); const f32x4 nv = *(const f32x4*)(nw + c); f32x4 y;
#pragma unroll
        for (int r = 0; r < 4; ++r) y[r] = o[ct][r] * rstd * nv[r] * silu(z[r]);
        *(u32x2*)(orow + c) = sm::pack4(y); }
}
}

__device__ __forceinline__ void phase_even_local(const Ctx& C0, int ei) {
    { const Ctx C = phase_ctx(C0);
#ifdef MK_TIME
      unsigned long long st0_ = 0ull; if (MK_TIME == 35) st0_ = __builtin_amdgcn_s_memrealtime();
#endif
      SguPre SP; int u = C.bid; if (u < 1024) { sgu_load(C, u, SP); sgu_setup(C, ei, u & 3); }
      for (; u < 1024; u += C.G) sgu_unit(C, ei, u, SP, u + C.G < 1024, u + C.G);
#ifdef MK_TIME
      if (MK_TIME == 35) { const unsigned long long n_ = __builtin_amdgcn_s_memrealtime(); const unsigned long long e_ = n_ + 7ull * (n_ - st0_); while (__builtin_amdgcn_s_memrealtime() < e_) __builtin_amdgcn_s_sleep(8); }
#endif
    }
    { const Ctx C = phase_ctx(C0); gdn::Pre P; int u = C.bid; if (u < 2048) gdn::prep_load(C, ei, u, P);
      { const int h = (C.bid >> 6) & 3; const float* cw = C.inp(6) + (size_t)ei * 4 * 1536;
#pragma unroll
        for (int idx = C.tid; idx < 4 * 384; idx += NWAVES * 64) { const int jj = idx / 384, c = idx % 384; ((LAS float*)(C.lds + gdn::CWL))[idx] = cw[jj * 1536 + (c >> 7) * 512 + h * 128 + (c & 127)]; }
        lds_barrier(); }
      for (; u < 2048; u += C.G) gdn::prep_unit(C, ei, u, P, u + C.G < 2048, u + C.G); }
}
__device__ __forceinline__ void phase_scan(const Ctx& C0) { const Ctx C = phase_ctx(C0);
    for (int v = C.bid; v < 256; v += C.G) { const int x = v & 7, k = v >> 3, u = ((x * 4 + (k >> 3)) << 3) | (k & 7); gdn::scan_unit(C, u); __syncthreads(); } }
__device__ __forceinline__ void phase_gdn_out(const Ctx& C0, int ei) {
    const Ctx C = phase_ctx(C0);
    const int lane = C.lane, w = C.wave, x2 = lane & 15, g = lane >> 4, cc = w >> 2, it = w & 3;
    LAS char* L = (LAS char*)C.lds; LAS float* NW = (LAS float*)(L + 131072);
    if (C.tid < 32) *(LAS f32x4*)(NW + 4 * C.tid) = *(const f32x4*)(C.inp(9) + ei * 128 + 4 * C.tid);
    unsigned soff[4];
#pragma unroll
    for (int j = 0; j < 4; ++j) { const int r = 32 * it + 4 * j + (lane >> 4), cp = lane & 15; soff[j] = (unsigned)(r * 256 + ((cp ^ r) & 15) * 16); }
    const bf16* H1 = (const bf16*)(C.ws + WS_ARENA); bf16* MIX = (bf16*)(C.ws + WS_MIX);
#define GO_ISSUE(unit_, buf_) do { const int pr_ = (unit_) & 31, h_ = ((unit_) >> 5) & 3, b_ = (unit_) >> 7; \
        const char* sg_ = (const char*)(C.ws + WS_GS) + (size_t)((b_ * 4 + h_) * 64 + 2 * pr_ + cc) * 32768; \
        _Pragma("unroll") for (int j = 0; j < 8; ++j) __builtin_amdgcn_global_load_lds((const unsigned*)(sg_ + soff[j & 3] + (j >> 2) * 4096), (LAS unsigned*)(L + (buf_) * 65536 + cc * 32768 + (32 * it + 4 * j) * 256), 16, 0, 0); } while (0)
#define GO_REGS(unit_, FC, DD, ZZ) do { const int pr_ = (unit_) & 31, h_ = ((unit_) >> 5) & 3, b_ = (unit_) >> 7; const int n_ = 2 * pr_ + cc, chunk_ = (b_ * 4 + h_) * 64 + n_, i_ = 16 * it + x2; \
        const bf16* cg_ = (const bf16*)(C.ws + WS_GC) + (size_t)chunk_ * 8192 + i_ * 128; const bf16* dg_ = (const bf16*)(C.ws + WS_GD) + (size_t)chunk_ * 8192 + i_ * 128; \
        const bf16* zr_ = H1 + ((size_t)b_ * SEQ + n_ * 64 + i_) * H1LD + 2560 + h_ * 128; \
        _Pragma("unroll") for (int ks = 0; ks < 4; ++ks) FC[ks] = *(const bf16x8*)(cg_ + 32 * ks + 8 * g); \
        _Pragma("unroll") for (int ct = 0; ct < 8; ++ct) { DD[ct] = *(const u32x2*)(dg_ + 16 * ct + 4 * g); ZZ[ct] = *(const u32x2*)(zr_ + 16 * ct + 4 * g); } } while (0)
#define GO_COMPUTE(unit_, buf_, FC, DD, ZZ) do { \
        const int pr = (unit_) & 31, h = ((unit_) >> 5) & 3, b = (unit_) >> 7; const int n = 2 * pr + cc, i = 16 * it + x2; const size_t tok = (size_t)b * SEQ + n * 64 + i; \
        const LAS char* sb = L + (buf_) * 65536 + cc * 32768 + x2 * 256; \
        f32x4 o[8]; float ss = 0.f; \
        _Pragma("unroll") for (int ct = 0; ct < 8; ++ct) { f32x4 a = sm::unpack4(DD[ct]); \
            _Pragma("unroll") for (int ks = 0; ks < 4; ++ks) a = sm::mma(*(const LAS bf16x8*)(sb + ct * 4096 + (((4 * ks + g) ^ x2) & 15) * 16), FC[ks], a); \
            o[ct] = a; ss += (a[0] * a[0] + a[1] * a[1]) + (a[2] * a[2] + a[3] * a[3]); } \
        ss += __shfl_xor(ss, 16); ss += __shfl_xor(ss, 32); \
        const float rstd = 1.0f / sqrtf(ss * (1.f / 128.f) + RMS_EPS); \
        bf16* orow = MIX + tok * DM + 512 + h * 128; \
        _Pragma("unroll") for (int ct = 0; ct < 8; ++ct) { const int c = 16 * ct + 4 * g; const f32x4 z = sm::unpack4(ZZ[ct]); const f32x4 nv = *(const LAS f32x4*)(NW + c); f32x4 y; \
            _Pragma("unroll") for (int r = 0; r < 4; ++r) y[r] = o[ct][r] * rstd * nv[r] * gdn::silu(z[r]); \
            *(u32x2*)(orow + c) = sm::pack4(y); } } while (0)
    int u = C.bid;
    bf16x8 fcA[4], fcB[4]; u32x2 dA[8], zA[8], dB[8], zB[8];
    if (u < 1024) { GO_ISSUE(u, 0); GO_REGS(u, fcA, dA, zA);
#pragma unroll 1
      for (;;) {
        int un = u + C.G;
        if (un < 1024) { GO_ISSUE(un, 1); GO_REGS(un, fcB, dB, zB); asm volatile("s_waitcnt vmcnt(28)" ::: "memory"); lds_barrier(); GO_COMPUTE(u, 0, fcA, dA, zA); lds_barrier(); }
        else { asm volatile("s_waitcnt vmcnt(0)" ::: "memory"); lds_barrier(); GO_COMPUTE(u, 0, fcA, dA, zA); break; }
        u = un; un = u + C.G;
        if (un < 1024) { GO_ISSUE(un, 0); GO_REGS(un, fcA, dA, zA); asm volatile("s_waitcnt vmcnt(28)" ::: "memory"); lds_barrier(); GO_COMPUTE(u, 1, fcB, dB, zB); lds_barrier(); }
        else { asm volatile("s_waitcnt vmcnt(0)" ::: "memory"); lds_barrier(); GO_COMPUTE(u, 1, fcB, dB, zB); break; }
        u = un; } }
#undef GO_COMPUTE
#undef GO_ISSUE
#undef GO_REGS
}

#ifndef MK_PER_PHASE
#define MK_PER_PHASE 0
#endif
constexpr int N_PHASES = 1 + DEPTH * 9;
#ifndef PH_EN
#define PH_EN 0x7fff
#endif
#define PEN(k) ((PH_EN >> (k)) & 1)
#ifndef MK_REP
#define MK_REP -1
#endif
#ifdef MK_TIME
#define TBEG(k) unsigned long long t0_ = 0ull; if (MK_TIME == (k)) t0_ = __builtin_amdgcn_s_memrealtime();
#define TEND(k) if (MK_TIME == (k)) { const unsigned long long n_ = __builtin_amdgcn_s_memrealtime(); const unsigned long long e_ = n_ + 7ull * (n_ - t0_); while (__builtin_amdgcn_s_memrealtime() < e_) __builtin_amdgcn_s_sleep(8); }
#else
#define TBEG(k)
#define TEND(k)
#endif
#define REPF(k) for (int r_ = 0; r_ < ((MK_REP == (k)) ? 2 : 1); ++r_)
struct Args { const float* in[27]; float* out; unsigned char* ws; int ph_lo, ph_hi; };

__global__ void __launch_bounds__(NWAVES * 64, 2) mk_fwd(Args args) {
    extern __shared__ __attribute__((aligned(16))) unsigned char lds_raw[];
    Ctx C;
    C.lds = (LAS unsigned char*)lds_raw;
    C.tid = threadIdx.x; C.lane = C.tid & 63; C.wave = __builtin_amdgcn_readfirstlane(C.tid >> 6); C.G = gridDim.x; C.bid = blockIdx.x;
    C.ka = (const __attribute__((address_space(4))) char*)__builtin_amdgcn_kernarg_segment_ptr();
    C.out = nullptr; C.ws = nullptr; C.ctl = nullptr;
    for (int u = C.tid; u < 128; u += NWAVES * 64) ((LAS unsigned*)(C.lds + LDS_CTL_OFF))[u] = 0u;
    __syncthreads();
#if !MK_PER_PHASE
    { const Ctx P = phase_ctx(C); (void)xcd_barrier_post((unsigned*)P.ws + CW_BAR, (volatile LAS unsigned*)(C.lds + LDS_CTL_OFF) + 8, P.tid == 0); }
#define GRID_BAR() do { const Ctx P_ = phase_ctx(C); XcdBarrier b_; b_.bar = (unsigned*)P_.ws + CW_BAR; b_.x = xb_xcc_id(); b_.st = (volatile LAS unsigned*)(C.lds + LDS_CTL_OFF) + 8; xcd_barrier(b_, P_.tid == 0); } while (0)
#else
#define GRID_BAR() do {} while (0)
#endif
    const int lo = args.ph_lo, hi = args.ph_hi;
#define IN(k) (lo <= (k) && (k) < hi)
#if defined(MK_REP) && MK_REP == 60
#define SEAM(k) do { if (IN((k) + 1)) { GRID_BAR(); GRID_BAR(); GRID_BAR(); } } while (0)
#else
#define SEAM(k) do { if (IN((k) + 1)) GRID_BAR(); } while (0)
#endif
    if (PEN(0) && IN(0)) { TBEG(0) REPF(0) phase_prologue(C); TEND(0) SEAM(0); }
#define MK_LAYER(L) { \
        const int pb = 1 + L * 9, li = L >> 1; \
        if ((L & 1) == 0) { \
            if (PEN(1) && IN(pb + 0)) { TBEG(1) \
                const Ctx P = phase_ctx(C); unsigned char* ws = P.ws; \
                EpiBf16 E{(bf16*)(ws + WS_ARENA), EVEN_N, 1024}; \
                REPF(1) run_plain_gemm(P, (const bf16*)(ws + WS_XB), DM, DM, EVEN_N, (const bf16*)(ws + WS_WEIN) + (size_t)li * EVEN_N * DM, E); \
                TEND(1) SEAM(pb + 0); } \
            if (PEN(2) && IN(pb + 1)) { TBEG(2) REPF(2) phase_even_local(C, li); TEND(2) SEAM(pb + 1); } \
            if (PEN(3) && IN(pb + 2)) { TBEG(3) REPF(3) phase_scan(C); TEND(3) SEAM(pb + 2); } \
            if (PEN(4) && IN(pb + 3)) { TBEG(4) REPF(4) phase_gdn_out(C, li); TEND(4) SEAM(pb + 3); } \
            if (PEN(5) && IN(pb + 4)) { TBEG(5) \
                const Ctx P = phase_ctx(C); unsigned char* ws = P.ws; \
                EpiRes E{(const bf16*)(ws + WS_XB), (bf16*)(ws + WS_Y)}; \
                REPF(5) run_plain_gemm(P, (const bf16*)(ws + WS_MIX), DM, DM, DM, (const bf16*)(ws + WS_WEOUT) + (size_t)li * DM * DM, E); \
                TEND(5) SEAM(pb + 4); } \
        } else { \
            if (PEN(6) && IN(pb + 0)) { TBEG(6) \
                const Ctx P = phase_ctx(C); unsigned char* ws = P.ws; \
                EpiO1 E{(bf16*)(ws + WS_ARENA + AR_C1), (float*)(ws + WS_XF), (bf16*)(ws + WS_ARENA + AR_KPE), (const f32x4*)(ws + WS_ROPE)}; \
                REPF(6) run_plain_gemm(P, (const bf16*)(ws + WS_XB), DM, DM, ODD_N, (const bf16*)(ws + WS_WOIN) + (size_t)li * ODD_N * DM, E); \
                TEND(6) SEAM(pb + 0); } \
            if (PEN(8) && IN(pb + 2)) { TBEG(8) \
                { const Ctx P = phase_ctx(C); unsigned char* ws = P.ws; \
                  EpiQ E{(bf16*)(ws + WS_ARENA + AR_Q), nullptr, (const f32x4*)(ws + WS_ROPE)}; \
                  REPF(8) run_scaled_gemm(P, (const bf16*)(ws + WS_ARENA + AR_C1), ODD_N, QL, 1536, (const bf16*)(ws + WS_WUQ) + (size_t)li * 1536 * QL, E, (const float*)(ws + WS_XF), 0, 1.0f / QL); } \
                { const Ctx P = phase_ctx(C); unsigned char* ws = P.ws; \
                  EpiKV E{(bf16*)(ws + WS_ARENA + AR_KV), nullptr}; \
                  REPF(8) run_scaled_gemm(P, (const bf16*)(ws + WS_ARENA + AR_C1) + QL, ODD_N, KVL, 2048, (const bf16*)(ws + WS_WUKV) + (size_t)li * 2048 * KVL, E, (const float*)(ws + WS_XF), 1, 1.0f / KVL); } \
                TEND(8) SEAM(pb + 2); } \
            if (PEN(9) && IN(pb + 3)) { TBEG(9) REPF(9) phase_attn(C); TEND(9) SEAM(pb + 3); } \
            if (PEN(10) && IN(pb + 4)) { TBEG(10) \
                const Ctx P = phase_ctx(C); unsigned char* ws = P.ws; \
                EpiRes E{(const bf16*)(ws + WS_XB), (bf16*)(ws + WS_Y)}; \
                REPF(10) run_plain_gemm(P, (const bf16*)(ws + WS_MIX), DM, DM, DM, (const bf16*)(ws + WS_WOOUT) + (size_t)li * DM * DM, E); \
                TEND(10) SEAM(pb + 4); } \
        } \
        if (PEN(11) && IN(pb + 5)) { TBEG(11) phase_router(C, L); TEND(11) SEAM(pb + 5); } \
        if (PEN(12) && IN(pb + 6)) { TBEG(12) \
            const Ctx P = phase_ctx(C); unsigned char* ws = P.ws; \
            EpiSwiglu E{(bf16*)(ws + WS_HID), (const LAS bf16*)(P.lds + MOE1_BIAS_OFF), nullptr, nullptr}; \
            REPF(12) run_moe_gemm<1>(P, L, (const bf16*)(ws + WS_XB), DM, 2, DM, 2048, (const bf16*)(ws + WS_WGU) + (size_t)L * NEXP * 2048 * DM, (size_t)2048 * DM, P.inp(24) + (size_t)L * NEXP * 2048, E); \
            TEND(12) SEAM(pb + 6); } \
        if (PEN(13) && IN(pb + 7)) { TBEG(13) \
            const Ctx P = phase_ctx(C); unsigned char* ws = P.ws; \
            EpiDown E{(bf16*)(ws + WS_YE), (const LAS float*)(P.lds + MOE2_BIAS_OFF), (const LAS float*)(P.lds + MOE2_GATE_OFF), nullptr}; \
            REPF(13) run_moe_gemm<2>(P, L, (const bf16*)(ws + WS_HID), DFF, 0, DFF, DM, (const bf16*)(ws + WS_WDN) + (size_t)L * NEXP * DM * DFF, (size_t)DM * DFF, P.inp(26) + (size_t)L * NEXP * DM, E); \
            TEND(13) SEAM(pb + 7); } \
        if (PEN(14) && IN(pb + 8)) { TBEG(14) phase_combine(C, L); TEND(14) SEAM(pb + 8); } \
    }
    MK_LAYER(0) MK_LAYER(1) MK_LAYER(2) MK_LAYER(3)
#undef MK_LAYER
#undef IN
#undef SEAM
}

extern "C" void kernel_launch(void* const* d_in, const int* in_sizes, int n_in, void* d_out, int out_size, void* d_ws, size_t ws_size, hipStream_t stream) {
    static int grid = 0;
    if (grid == 0) {
        if (n_in != 27 || in_sizes[0] != T * DM || out_size != T * DM || ws_size < WS_END) { fprintf(stderr, "kernel_launch: unexpected shapes (n_in %d, in0 %d, out %d, ws %zu)\n", n_in, n_in > 0 ? in_sizes[0] : -1, out_size, ws_size); grid = -1; return; }
        int dev = 0, cus = 0, per_cu = 0;
        if (hipGetDevice(&dev) != hipSuccess || hipDeviceGetAttribute(&cus, hipDeviceAttributeMultiprocessorCount, dev) != hipSuccess) { grid = -1; return; }
        if (hipFuncSetAttribute((const void*)mk_fwd, hipFuncAttributeMaxDynamicSharedMemorySize, LDS_BYTES) != hipSuccess) { fprintf(stderr, "kernel_launch: hipFuncSetAttribute failed\n"); grid = -1; return; }
        if (hipOccupancyMaxActiveBlocksPerMultiprocessor(&per_cu, (const void*)mk_fwd, NWAVES * 64, LDS_BYTES) != hipSuccess || per_cu < 1) fprintf(stderr, "kernel_launch: occupancy query reports %d\n", per_cu);
        (void)hipGetLastError();
        grid = cus;
        if (grid != 256) fprintf(stderr, "kernel_launch: %d CUs (built for 256)\n", grid);
    }
    if (grid < 0) return;
    if (hipMemsetAsync((char*)d_ws + WS_CTL, 0, CTL_ZERO_BYTES, stream) != hipSuccess) return;
    Args a{};
    for (int i = 0; i < 27; ++i) a.in[i] = (const float*)d_in[i];
    a.out = (float*)d_out; a.ws = (unsigned char*)d_ws;
#if MK_PER_PHASE
    for (int p = 0; p < N_PHASES; ++p) { a.ph_lo = p; a.ph_hi = p + 1; hipLaunchKernelGGL(mk_fwd, dim3(grid), dim3(NWAVES * 64), LDS_BYTES, stream, a); }
#else
    a.ph_lo = 0; a.ph_hi = N_PHASES;
    hipLaunchKernelGGL(mk_fwd, dim3(grid), dim3(NWAVES * 64), LDS_BYTES, stream, a);
#endif
    const hipError_t le = hipPeekAtLastError();
    if (le != hipSuccess) fprintf(stderr, "kernel_launch: launch failed: %s\n", hipGetErrorName(le));
}
```

```cpp
#define MK_PER_PHASE 0
#include <hip/hip_runtime.h>
#include <cstdio>
#include <cstdint>

#define GAS __attribute__((address_space(1)))
#define LAS __attribute__((address_space(3)))
typedef unsigned short bf16;
typedef short bf16x8 __attribute__((ext_vector_type(8)));
typedef short s16x4 __attribute__((ext_vector_type(4)));
typedef float f32x2 __attribute__((ext_vector_type(2)));
typedef float f32x4 __attribute__((ext_vector_type(4)));
typedef float f32x16 __attribute__((ext_vector_type(16)));
typedef unsigned u32x2 __attribute__((ext_vector_type(2)));
typedef unsigned u32x4 __attribute__((ext_vector_type(4)));
typedef GAS unsigned gu32;

typedef __bf16 bf16v2_t __attribute__((ext_vector_type(2)));
__device__ __forceinline__ unsigned cvt_pk_bf16(float lo, float hi) { const bf16v2_t v = __builtin_convertvector((f32x2){lo, hi}, bf16v2_t); return __builtin_bit_cast(unsigned, v); }
__device__ __forceinline__ int lane_id_opaque() { int l; asm volatile("v_mbcnt_lo_u32_b32 %0, -1, 0\n\tv_mbcnt_hi_u32_b32 %0, -1, %0" : "=v"(l)); return l; }
__device__ __forceinline__ float bf_lo(unsigned w) { return __uint_as_float(w << 16); }
__device__ __forceinline__ float bf_hi(unsigned w) { return __uint_as_float(w & 0xffff0000u); }
__device__ __forceinline__ float bf2f(bf16 b) { return __uint_as_float(((unsigned)b) << 16); }
__device__ __forceinline__ bf16 f2bf(float f) { return (bf16)(cvt_pk_bf16(f, 0.f) & 0xffffu); }
__device__ __forceinline__ float wave_sum(float v) {
#pragma unroll
    for (int o = 1; o < 64; o <<= 1) v += __shfl_xor(v, o);
    return v;
}

namespace pg8 {
constexpr int BM = 256, BK = 64, HALF = 128, HTB = HALF * BK * 2, STAGE_BYTES = 8 * HTB, NXCD = 8, WGM = 8;
__host__ __device__ __forceinline__ int lds_byte(int r, int c) { const int st = (r >> 4) * 2 + (c >> 5), rr = r & 15, cc = c & 31, ob = rr * 64 + cc * 2; return st * 1024 + (ob ^ (((ob >> 9) & 1) << 5)); }
__host__ __device__ __forceinline__ void stage_rc(int b, int& R, int& C) { const int st = b / 1024, sb = b % 1024, swz = sb ^ (((sb >> 9) & 1) << 5); R = (st >> 1) * 16 + swz / 64; C = (st & 1) * 32 + (swz % 64) / 2; }
__host__ __device__ __forceinline__ int perm32(int rho) { const int n = rho >> 4, i = rho & 15; return 8 * (i >> 2) + 4 * n + (i & 3); }

struct Unit { int pm, pn, e, li; };

struct StaticOrder {
    int nM, nN, nwg, G, c;
    __device__ void init(int M, int N, int G_, int c_) { nM = M / BM; nN = N / BM; nwg = nM * nN; G = G_; c = c_; }
    __device__ bool next(int i, Unit& u) const {
        const long L = (long)i * G + c; if (L >= nwg) return false;
        int wgid = (int)L; { const int q = nwg / NXCD, r = nwg % NXCD, xcd = wgid % NXCD, off = wgid / NXCD; wgid = (xcd < r ? xcd * (q + 1) : r * (q + 1) + (xcd - r) * q) + off; }
        const int nig = WGM * nN, gid = wgid / nig, fm = gid * WGM, gsz = (nM - fm) < WGM ? (nM - fm) : WGM;
        u.pm = fm + ((wgid % nig) % gsz); u.pn = (wgid % nig) / gsz; u.e = 0; u.li = i; return true;
    }
};
struct PlainSched {
    static constexpr bool GATHER = false;
    StaticOrder o; const char* Bt; int K; int lda;
    __device__ __forceinline__ size_t arow0(const Unit& u) const { return (size_t)u.pm * BM * lda * 2; }
    __device__ __forceinline__ bool next(int i, Unit& u) const { return o.next(i, u); }
    __device__ __forceinline__ const char* bbase(const Unit& u) const { return Bt + (size_t)u.pn * BM * K * 2; }
};

__device__ __forceinline__ f32x2 gelu_pk(f32x2 v) {
    const f32x2 av = __builtin_elementwise_abs(v), d = av * 0.2316418882f + 1.0f;
    f32x2 t; t.x = __builtin_amdgcn_rcpf(d.x); t.y = __builtin_amdgcn_rcpf(d.y);
    f32x2 q = t * 0.5307027145f + (-0.7265760135f); q = q * t + 0.7107068705f; q = q * t + (-0.142248368f); q = q * t + 0.127414796f; q = q * t;
    const f32x2 s = (v * v) * (-0.72134752044f);
    f32x2 e; e.x = __builtin_amdgcn_exp2f(s.x); e.y = __builtin_amdgcn_exp2f(s.y);
    const f32x2 m = v * (q * e), r = v - m;
    f32x2 o; o.x = v.x < 0.f ? m.x : r.x; o.y = v.y < 0.f ? m.y : r.y; return o;
}

template <class Epi, class Sched, bool ALIGN_EPI>
__device__ __forceinline__ void gemm_phase(LAS unsigned char* lds, const char* Abase, int K, const Sched& S, const Epi& E, int wave_idx) {
    int tid_ = wave_idx * 64 + lane_id_opaque();
    const int tid = tid_, wid = __builtin_amdgcn_readfirstlane(tid >> 6), lane = tid & 63, wr = wid >> 2, wc = wid & 3, fr = lane & 15, fq = lane >> 4;
    int nt = K / BK; asm volatile("" : "+s"(nt));
    int Rr[2], Cc[2]; unsigned voffB[2], voffA[2];
#pragma unroll
    for (int i = 0; i < 2; ++i) { stage_rc(tid * 16 + i * 8192, Rr[i], Cc[i]); const int Rb = Epi::PERM ? ((Rr[i] & ~31) + perm32(Rr[i] & 31)) : Rr[i]; voffB[i] = (unsigned)(Rb * K + Cc[i]) * 2u;
        voffA[i] = 0u; if constexpr (!Sched::GATHER) voffA[i] = (unsigned)(Rr[i] * S.lda + Cc[i]) * 2u; }
    const size_t hstepA = (size_t)HALF * S.lda * 2;
    const size_t kstep = (size_t)(BK * 2);
    const size_t hstepB = (size_t)HALF * K * 2;
    const unsigned ldsw = (unsigned)wid * 1024u;
    const int aoff = lds_byte(wr * 64 + fr, fq * 8), boff = lds_byte(wc * 32 + fr, fq * 8);
#define PG8_SA(b, h) (((b) * 2 + (h)) * HTB)
#define PG8_SB(b, h) ((4 + (b) * 2 + (h)) * HTB)
#define PG8_STAGEB(bufoff, gbase) do { _Pragma("unroll") for (int _i = 0; _i < 2; ++_i) \
        __builtin_amdgcn_global_load_lds((const unsigned*)((const char*)(gbase) + voffB[_i]), (LAS unsigned*)(lds + (bufoff) + ldsw + _i * 8192), 16, 0, 0); } while (0)
#define PG8_STAGEA(bufoff, h, koff) do { _Pragma("unroll") for (int _i = 0; _i < 2; ++_i) { \
        if constexpr (Sched::GATHER) __builtin_amdgcn_global_load_lds((const unsigned*)(Abase + (size_t)va[h][_i] + (koff)), (LAS unsigned*)(lds + (bufoff) + ldsw + _i * 8192), 16, 0, 0); \
        else __builtin_amdgcn_global_load_lds((const unsigned*)(cA + (h) * hstepA + (koff) + voffA[_i]), (LAS unsigned*)(lds + (bufoff) + ldsw + _i * 8192), 16, 0, 0); } } while (0)
#define PG8_LDA(dst, b, h) do { _Pragma("unroll") for (int m = 0; m < 4; ++m) _Pragma("unroll") for (int k = 0; k < 2; ++k) dst[m][k] = *(const LAS bf16x8*)(lds + PG8_SA(b, h) + aoff + m * 2048 + k * 1024); } while (0)
#define PG8_LDB(dst, b, h) do { _Pragma("unroll") for (int n = 0; n < 2; ++n) _Pragma("unroll") for (int k = 0; k < 2; ++k) dst[n][k] = *(const LAS bf16x8*)(lds + PG8_SB(b, h) + boff + n * 2048 + k * 1024); } while (0)
#define PG8_MMA(ai, bj, At, Bt) do { __builtin_amdgcn_s_setprio(1); _Pragma("unroll") for (int m = 0; m < 4; ++m) _Pragma("unroll") for (int n = 0; n < 2; ++n) _Pragma("unroll") for (int k = 0; k < 2; ++k) \
        acc[ai][bj][m][n] = __builtin_amdgcn_mfma_f32_16x16x32_bf16(Bt[n][k], At[m][k], acc[ai][bj][m][n], 0, 0, 0); __builtin_amdgcn_s_setprio(0); } while (0)
#define PG8_WAIT_V(n) asm volatile("s_waitcnt vmcnt(" #n ")" ::: "memory")
#define PG8_WAIT_L(n) asm volatile("s_waitcnt lgkmcnt(" #n ")" ::: "memory")
#define PG8_BAR __builtin_amdgcn_s_barrier()
#define PG8_SCHED __builtin_amdgcn_sched_barrier(0)
    Unit cur, nxt; int ui = 0;
    if (!S.next(0, cur)) return;
    f32x4 acc[2][2][4][2];
#pragma unroll
    for (int a = 0; a < 2; ++a)
#pragma unroll
        for (int b = 0; b < 2; ++b)
#pragma unroll
            for (int m = 0; m < 4; ++m)
#pragma unroll
                for (int n = 0; n < 2; ++n) acc[a][b][m][n] = (f32x4){0.f, 0.f, 0.f, 0.f};
    bf16x8 At[4][2], B0[2][2], B1[2][2];
    unsigned va[2][2], vn[2][2]; const char* cA = Abase; const char* nA = Abase;
    if constexpr (Sched::GATHER) {
#pragma unroll
        for (int h = 0; h < 2; ++h)
#pragma unroll
            for (int i = 0; i < 2; ++i) va[h][i] = S.aoff(cur, h * HALF + Rr[i]) + (unsigned)Cc[i] * 2u;
    } else { cA = Abase + S.arow0(cur); }
    const char* cB = S.bbase(cur);
    PG8_STAGEB(PG8_SB(0, 0), cB); PG8_STAGEB(PG8_SB(0, 1), cB + hstepB); PG8_STAGEA(PG8_SA(0, 0), 0, 0); PG8_STAGEA(PG8_SA(0, 1), 1, 0);
    if (wr == 1) PG8_BAR;
    PG8_WAIT_V(2); PG8_BAR;
    PG8_STAGEB(PG8_SB(1, 0), cB + kstep); PG8_STAGEA(PG8_SA(1, 0), 0, kstep); PG8_STAGEB(PG8_SB(1, 1), cB + hstepB + kstep);
    PG8_WAIT_V(6); PG8_BAR;
    for (;;) {
        const bool has_next = S.next(ui + 1, nxt);
        const char* nB = has_next ? S.bbase(nxt) : cB;
        if constexpr (Sched::GATHER) {
            if (has_next) {
#pragma unroll
                for (int h = 0; h < 2; ++h)
#pragma unroll
                    for (int i = 0; i < 2; ++i) vn[h][i] = S.aoff(nxt, h * HALF + Rr[i]) + (unsigned)Cc[i] * 2u;
            } else {
#pragma unroll
                for (int h = 0; h < 2; ++h)
#pragma unroll
                    for (int i = 0; i < 2; ++i) vn[h][i] = va[h][i];
            }
        } else { nA = has_next ? Abase + S.arow0(nxt) : cA; }
        for (int t = 0; t < nt; t += 2) {
            const bool last = (t == nt - 2);
            const size_t k1 = (size_t)(t + 1) * kstep;
            PG8_LDB(B0, 0, 0); PG8_LDB(B1, 0, 1); PG8_SCHED; PG8_LDA(At, 0, 0); PG8_STAGEA(PG8_SA(1, 1), 1, k1);
            PG8_WAIT_V(8); PG8_WAIT_L(0); PG8_BAR; PG8_MMA(0, 0, At, B0); PG8_MMA(0, 1, At, B1); PG8_BAR; PG8_SCHED;
            if (last) {
                if constexpr (Sched::GATHER) {
#pragma unroll
                    for (int h = 0; h < 2; ++h)
#pragma unroll
                        for (int i = 0; i < 2; ++i) va[h][i] = vn[h][i];
                } else { cA = nA; }
            }
            const char* bX = last ? nB : cB;
            const size_t k2 = last ? (size_t)0 : (size_t)(t + 2) * kstep, k3 = k2 + kstep;
            PG8_LDA(At, 0, 1); PG8_STAGEB(PG8_SB(0, 0), bX + k2); PG8_STAGEB(PG8_SB(0, 1), bX + hstepB + k2); PG8_STAGEA(PG8_SA(0, 0), 0, k2);
            PG8_WAIT_V(8); PG8_WAIT_L(0); PG8_BAR; PG8_MMA(1, 0, At, B0); PG8_MMA(1, 1, At, B1); PG8_BAR; PG8_SCHED;
            PG8_LDB(B0, 1, 0); PG8_LDB(B1, 1, 1); PG8_SCHED; PG8_LDA(At, 1, 0); PG8_STAGEA(PG8_SA(0, 1), 1, k2);
            PG8_WAIT_V(8); PG8_WAIT_L(0); PG8_BAR; PG8_MMA(0, 0, At, B0); PG8_MMA(0, 1, At, B1); PG8_BAR; PG8_SCHED;
            PG8_LDA(At, 1, 1); PG8_STAGEB(PG8_SB(1, 0), bX + k3); PG8_STAGEB(PG8_SB(1, 1), bX + hstepB + k3); PG8_STAGEA(PG8_SA(1, 0), 0, k3);
            PG8_WAIT_V(8); PG8_WAIT_L(0); PG8_BAR; PG8_MMA(1, 0, At, B0); PG8_MMA(1, 1, At, B1); PG8_BAR; PG8_SCHED;
        }
        if constexpr (ALIGN_EPI) { if (wr == 0) PG8_BAR; }
        E(acc, cur, wr, wc, fr, fq);
        if (!has_next) break;
#pragma unroll
        for (int a = 0; a < 2; ++a)
#pragma unroll
            for (int b = 0; b < 2; ++b)
#pragma unroll
                for (int m = 0; m < 4; ++m)
#pragma unroll
                    for (int n = 0; n < 2; ++n) acc[a][b][m][n] = (f32x4){0.f, 0.f, 0.f, 0.f};
        cur = nxt; cB = nB; ++ui;
        if constexpr (ALIGN_EPI) { if (wr == 1) PG8_BAR; }
    }
    PG8_WAIT_V(0);
    if constexpr (!ALIGN_EPI) { if (wr == 0) PG8_BAR; }
    PG8_BAR;
#undef PG8_SA
#undef PG8_SB
#undef PG8_STAGEA
#undef PG8_STAGEB
#undef PG8_LDA
#undef PG8_LDB
#undef PG8_MMA
#undef PG8_WAIT_V
#undef PG8_WAIT_L
#undef PG8_BAR
#undef PG8_SCHED
}
}

constexpr int NWAVES = 8;
constexpr int BATCH = 8, SEQ = 4096, DM = 1024, DEPTH = 4;
constexpr int T = BATCH * SEQ;
constexpr int EVEN_IN = 3080, EVEN_N = 3072;
constexpr int ODD_IN = 704, ODD_N = 768, QL = 384, KVL = 256;
constexpr int NEXP = 32, TOPK = 4, DFF = 1024;
constexpr int NSLOT = T * TOPK;
constexpr int LCAP = T;
constexpr float LN_EPS = 1e-5f, RMS_EPS = 1e-6f;
constexpr float DN_ALPHA = 1.681792830507429f;
constexpr float ATT_SCALE = 0.07216878364870323f;

constexpr size_t MiB = 1u << 20;
constexpr size_t WS_CTL = 0, CTL_ZERO_BYTES = 1 * MiB;
constexpr size_t WS_WGU = 16 * MiB, WS_WDN = 528 * MiB, WS_WEIN = 784 * MiB, WS_WEOUT = 796 * MiB, WS_WOIN = 800 * MiB, WS_WUQ = 804 * MiB, WS_WUKV = 808 * MiB, WS_WOOUT = 810 * MiB;
constexpr size_t WS_ROPE = 814 * MiB, WS_AB = 815 * MiB, WS_RS = 816 * MiB, WS_GATE = 817 * MiB, WS_LIST = 818 * MiB, WS_GAM = 822 * MiB;
constexpr size_t WS_XF = 832 * MiB, WS_XB = 960 * MiB, WS_Y = 1024 * MiB, WS_ARENA = 1152 * MiB, WS_MIX = 1440 * MiB;
constexpr size_t WS_GM = 1504 * MiB, WS_GB = 1568 * MiB, WS_GC = 1632 * MiB, WS_GD = 1664 * MiB, WS_GS = 1696 * MiB, WS_HID = 1760 * MiB, WS_YE = 2048 * MiB, WS_END = 2304 * MiB;
constexpr size_t AR_C1 = 0, AR_Q = 48 * MiB, AR_KV = 144 * MiB, AR_KPE = 272 * MiB;
constexpr int CW_TMO = 0, CW_CODE = 1, CW_BAR = 4096, CW_CNT = 16384;

constexpr int LDS_BYTES = 163840;
constexpr int LDS_CTL_OFF = 163840 - 512;
constexpr int LDS_SPARE = 131072;

#define RLX_AGENT __ATOMIC_RELAXED, __HIP_MEMORY_SCOPE_AGENT
#define LDS_WAIT() asm volatile("s_waitcnt lgkmcnt(0)" ::: "memory")
#define VM_WAIT() asm volatile("s_waitcnt vmcnt(0)" ::: "memory")
__device__ __forceinline__ void lds_barrier() { asm volatile("s_waitcnt lgkmcnt(0)" ::: "memory"); __builtin_amdgcn_s_barrier(); asm volatile("" ::: "memory"); }

#define XB_TMO      128
#define XB_XCNT(j)  (256  + 64 * (j))
#define XB_XSUB(j)  (1280 + 64 * (j))
#define XB_XGEN(j)  (2304 + 64 * (j))
#define XB_TOP      3328
#define XB_TOPGEN   3392
#define XCD_BAR_WORDS 3456
#define XB_SPIN_CAP (1u << 18)
__device__ __forceinline__ unsigned xb_ld(unsigned* p)              { return __hip_atomic_load(p, __ATOMIC_RELAXED, __HIP_MEMORY_SCOPE_AGENT); }
__device__ __forceinline__ unsigned xb_add(unsigned* p, unsigned v) { return __hip_atomic_fetch_add(p, v, __ATOMIC_RELAXED, __HIP_MEMORY_SCOPE_AGENT); }
__device__ __forceinline__ unsigned xb_xcc_id() { return (unsigned)__builtin_amdgcn_s_getreg((3 << 11) | 20) & 0xFu; }
#define XB_SPIN(cond, bar) do { unsigned _sp = 0; while (cond) { __builtin_amdgcn_s_sleep(1); \
    if ((++_sp & 255u) == 0u) { if (xb_ld(&(bar)[XB_TMO])) break; if (_sp > XB_SPIN_CAP) { atomicAdd(&(bar)[XB_TMO], 1u); break; } } } } while (0)
struct XcdBarrier { unsigned* bar; unsigned x; volatile LAS unsigned* st; };
__device__ __forceinline__ XcdBarrier xcd_barrier_post(unsigned* bar, volatile LAS unsigned* st, bool leader) {
    XcdBarrier b; b.bar = bar; b.x = xb_xcc_id(); b.st = st;
    if (leader) (void)xb_add(&bar[XB_XCNT(b.x)], 1u);
    return b;
}
__device__ __forceinline__ void xcd_barrier_complete(unsigned* bar, unsigned x, unsigned& nloc, unsigned& nx) {
    const unsigned G = gridDim.x * gridDim.y * gridDim.z;
    unsigned sum, cnt, mine, sp = 0u;
    for (;;) {
        sum = 0u; cnt = 0u; mine = 0u;
#pragma unroll
        for (unsigned j = 0; j < 16; ++j) { const unsigned c = xb_ld(&bar[XB_XCNT(j)]); sum += c; cnt += (c > 0u) ? 1u : 0u; mine = (j == x) ? c : mine; }
        if (sum == G) break;
        __builtin_amdgcn_s_sleep(1);
        if ((++sp & 255u) == 0u) { if (xb_ld(&bar[XB_TMO])) break; if (sp > XB_SPIN_CAP) { atomicAdd(&bar[XB_TMO], 1u); break; } }
    }
    nloc = mine > 0u ? mine : 1u; nx = cnt > 0u ? cnt : 1u;
}
__device__ __forceinline__ void xcd_barrier(const XcdBarrier& b, bool leader) {
    asm volatile("s_waitcnt vmcnt(0)" ::: "memory");
    __syncthreads();
    if (leader) {
        unsigned* bar = b.bar;
        __builtin_amdgcn_s_waitcnt(0);
        unsigned nloc = b.st[0], nx = b.st[1];
        if (nloc == 0u) { xcd_barrier_complete(bar, b.x, nloc, nx); b.st[0] = nloc; b.st[1] = nx; }
        const unsigned old = xb_add(&bar[XB_XSUB(b.x)], 1u);
        const unsigned gen = old / nloc;
        if (old + 1u == (gen + 1u) * nloc) {
            __builtin_amdgcn_fence(__ATOMIC_RELEASE, "agent");
            asm volatile("s_waitcnt vmcnt(0)" ::: "memory");
            const unsigned og = xb_add(&bar[XB_TOP], 1u);
            const unsigned tg = og / nx;
            if (og + 1u == (tg + 1u) * nx) xb_add(&bar[XB_TOPGEN], 1u);
            else XB_SPIN(xb_ld(&bar[XB_TOPGEN]) == tg, bar);
            __builtin_amdgcn_fence(__ATOMIC_ACQUIRE, "agent");
            xb_add(&bar[XB_XGEN(b.x)], 1u);
            asm volatile("s_waitcnt vmcnt(0)" ::: "memory");
        } else {
            XB_SPIN(xb_ld(&bar[XB_XGEN(b.x)]) == gen, bar);
            __builtin_amdgcn_fence(__ATOMIC_ACQUIRE, "agent");
            asm volatile("s_waitcnt vmcnt(0)" ::: "memory");
        }
    }
    __syncthreads();
}

struct Ctx {
    LAS unsigned char* lds;
    int tid, lane, wave, G, bid;
    const __attribute__((address_space(4))) char* ka;
    __device__ __forceinline__ const float* inp(int i) const { return ((const float* const __attribute__((address_space(4)))*)ka)[i]; }
    float* out;
    unsigned char* ws;
    unsigned* ctl;
};

__device__ __forceinline__ Ctx phase_ctx(const Ctx& C0) { Ctx C; C.lds = C0.lds; { int g_ = C0.G, b_ = C0.bid; asm volatile("" : "+s"(g_), "+s"(b_)); C.G = g_; C.bid = b_; } int t = C0.wave * 64 + lane_id_opaque(); C.tid = t; C.lane = t & 63; C.wave = C0.wave;
    const __attribute__((address_space(4))) char* ka = C0.ka; asm volatile("" : "+s"(ka)); C.ka = ka;
    C.out = *(float* const __attribute__((address_space(4)))*)(ka + 216); C.ws = *(unsigned char* const __attribute__((address_space(4)))*)(ka + 224); C.ctl = (unsigned*)C.ws; return C; }

__device__ __forceinline__ int uq_rowmap(int n) { const int h = n / 192, o = n - h * 192; if (o < 128) return n; const int j = o - 128; return h * 192 + 128 + (j < 32 ? 2 * j : 2 * (j - 32) + 1); }
__device__ __forceinline__ int kpe_rowmap(int n) { if (n < 640 || n >= 704) return n; const int j = n - 640; return 640 + (j < 32 ? 2 * j : 2 * (j - 32) + 1); }
__device__ __forceinline__ void conv_item(const float* W, int ldn, int c0, int nvalid, int K, bf16* WT, const float* kscale, int mode, LAS float* scr, int kb, int nb, int lane) {
    const int k0 = 64 * kb, n0 = 64 * nb;
    const int lc = (lane & 15) * 4, lr = lane >> 4;
#pragma unroll
    for (int i = 0; i < 16; ++i) {
        const int kk = lr + 4 * i;
        f32x4 v = (f32x4){0.f, 0.f, 0.f, 0.f};
        if (n0 + lc < nvalid) v = __builtin_nontemporal_load((const f32x4*)(W + (size_t)(k0 + kk) * ldn + c0 + n0 + lc));
        if (kscale) { const float s = kscale[k0 + kk]; v = v * s; }
        scr[kk * 65 + lc + 0] = v.x; scr[kk * 65 + lc + 1] = v.y; scr[kk * 65 + lc + 2] = v.z; scr[kk * 65 + lc + 3] = v.w;
    }
    LDS_WAIT(); asm volatile("" ::: "memory");
    const int c = lane & 7;
#pragma unroll
    for (int j = 0; j < 8; ++j) {
        const int n = (lane >> 3) + 8 * j; const LAS float* s = scr + (8 * c) * 65 + n;
        u32x4 o; o.x = cvt_pk_bf16(s[0 * 65], s[1 * 65]); o.y = cvt_pk_bf16(s[2 * 65], s[3 * 65]); o.z = cvt_pk_bf16(s[4 * 65], s[5 * 65]); o.w = cvt_pk_bf16(s[6 * 65], s[7 * 65]);
        const int dn = mode == 1 ? uq_rowmap(n0 + n) : mode == 2 ? kpe_rowmap(n0 + n) : (n0 + n);
        __builtin_nontemporal_store(o, (u32x4*)(WT + (size_t)dn * K + k0 + 8 * c));
    }
    LDS_WAIT(); asm volatile("" ::: "memory");
}

__device__ __forceinline__ void row_load_f32(const float* p, int lane, f32x4 (&v)[4]) {
#pragma unroll
    for (int j = 0; j < 4; ++j) v[j] = *(const f32x4*)(p + 4 * lane + 256 * j);
}
__device__ __forceinline__ void row_load_bf16(const bf16* p, int lane, f32x4 (&v)[4]) {
#pragma unroll
    for (int j = 0; j < 4; ++j) { const u32x2 w = *(const u32x2*)(p + 4 * lane + 256 * j); v[j] = (f32x4){bf_lo(w.x), bf_hi(w.x), bf_lo(w.y), bf_hi(w.y)}; }
}
__device__ __forceinline__ void row_store_f32(float* p, int lane, const f32x4 (&v)[4]) {
#pragma unroll
    for (int j = 0; j < 4; ++j) *(f32x4*)(p + 4 * lane + 256 * j) = v[j];
}
__device__ __forceinline__ void row_store_bf16(bf16* p, int lane, const f32x4 (&v)[4]) {
#pragma unroll
    for (int j = 0; j < 4; ++j) { u32x2 w; w.x = cvt_pk_bf16(v[j].x, v[j].y); w.y = cvt_pk_bf16(v[j].z, v[j].w); *(u32x2*)(p + 4 * lane + 256 * j) = w; }
}
__device__ __forceinline__ void row_store_bf16_nt(bf16* p, int lane, const f32x4 (&v)[4]) {
#pragma unroll
    for (int j = 0; j < 4; ++j) { u32x2 w; w.x = cvt_pk_bf16(v[j].x, v[j].y); w.y = cvt_pk_bf16(v[j].z, v[j].w); __builtin_nontemporal_store(w, (u32x2*)(p + 4 * lane + 256 * j)); }
}
__device__ __forceinline__ void row_layernorm(f32x4 (&v)[4], const f32x4 (&g)[4], const f32x4 (&b)[4]) {
    float s = 0.f, s2 = 0.f;
#pragma unroll
    for (int j = 0; j < 4; ++j) { s += (v[j].x + v[j].y) + (v[j].z + v[j].w); s2 += (v[j].x * v[j].x + v[j].y * v[j].y) + (v[j].z * v[j].z + v[j].w * v[j].w); }
#pragma unroll
    for (int o = 1; o < 64; o <<= 1) { s += __shfl_xor(s, o); s2 += __shfl_xor(s2, o); }
    const float mean = s * (1.f / DM); const float var = fmaxf(s2 * (1.f / DM) - mean * mean, 0.f);
    const float rstd = 1.f / sqrtf(var + LN_EPS);
#pragma unroll
    for (int j = 0; j < 4; ++j) v[j] = (v[j] - mean) * rstd * g[j] + b[j];
}
__device__ __forceinline__ void row_ab(const f32x4 (&v)[4], const LAS float* w8, int lane, float (&ab)[8]) {
#pragma unroll
    for (int e = 0; e < 8; ++e) { float s = 0.f;
#pragma unroll
        for (int j = 0; j < 4; ++j) { const f32x4 w = *(const LAS f32x4*)(w8 + e * 1024 + 4 * lane + 256 * j); s += (v[j].x * w.x + v[j].y * w.y) + (v[j].z * w.z + v[j].w * w.w); }
        ab[e] = wave_sum(s); }
}
__device__ __forceinline__ void load_w8(const Ctx& C, int ei, LAS float* w8) {
    const float* W = C.inp(1) + (size_t)ei * DM * EVEN_IN;
    float wv[16];
#pragma unroll
    for (int q = 0; q < 16; ++q) { const int idx = C.tid + q * NWAVES * 64; wv[q] = W[(size_t)(idx >> 3) * EVEN_IN + EVEN_N + (idx & 7)]; }
#pragma unroll
    for (int q = 0; q < 16; ++q) { const int idx = C.tid + q * NWAVES * 64; w8[(idx & 7) * 1024 + (idx >> 3)] = wv[q]; }
}

__device__ __forceinline__ void phase_prologue(const Ctx& C0) {
    const Ctx C = phase_ctx(C0);
    const int gw = C.bid * NWAVES + C.wave, NGW = C.G * NWAVES, lane = C.lane;
    LAS float* scr = (LAS float*)(C.lds + C.wave * 16640);
    unsigned char* ws = C.ws;
    constexpr int I0 = 128 * 512, I1 = 128 * 256, I2 = 2 * 768, I3 = 2 * 256, I4 = 2 * 192, I5 = 2 * 144, I6 = 2 * 128, I7 = 2 * 256;
    constexpr int NITEMS = I0 + I1 + I2 + I3 + I4 + I5 + I6 + I7;
    { auto src = [&](int r, int i) -> const f32x4* { const bool g0 = r < I0; const int r1 = g0 ? r : r - I0; const int mi = g0 ? (r1 >> 9) : (r1 >> 8), q = g0 ? (r1 & 511) : (r1 & 255);
                                                       const int ldn = g0 ? 2048 : 1024, kb = g0 ? (q >> 5) : (q >> 4), nb = g0 ? (q & 31) : (q & 15);
                                                       const float* W = (g0 ? C.inp(23) : C.inp(25)) + (size_t)mi * 1024 * ldn;
                                                       return (const f32x4*)(W + (size_t)(64 * kb + (lane >> 4) + 4 * i) * ldn + 64 * nb + (lane & 15) * 4); };
      f32x4 pv[16];
      int it = gw;
      if (it < I0 + I1) {
#pragma unroll
          for (int i = 0; i < 16; ++i) pv[i] = __builtin_nontemporal_load(src(it, i)); }
      for (; it < I0 + I1; it += NGW) {
          const int lc = (lane & 15) * 4, lr = lane >> 4;
#pragma unroll
          for (int i = 0; i < 16; ++i) { const int kk = lr + 4 * i; scr[kk * 65 + lc + 0] = pv[i].x; scr[kk * 65 + lc + 1] = pv[i].y; scr[kk * 65 + lc + 2] = pv[i].z; scr[kk * 65 + lc + 3] = pv[i].w; }
          const int nx = it + NGW;
          if (nx < I0 + I1) {
#pragma unroll
              for (int i = 0; i < 16; ++i) pv[i] = __builtin_nontemporal_load(src(nx, i)); }
          LDS_WAIT(); asm volatile("" ::: "memory");
          const bool g0 = it < I0; const int r1 = g0 ? it : it - I0; const int mi = g0 ? (r1 >> 9) : (r1 >> 8), q = g0 ? (r1 & 511) : (r1 & 255);
          const int kb = g0 ? (q >> 5) : (q >> 4), nb = g0 ? (q & 31) : (q & 15);
          bf16* WT = g0 ? (bf16*)(ws + WS_WGU) + (size_t)mi * 2048 * 1024 : (bf16*)(ws + WS_WDN) + (size_t)mi * 1024 * 1024;
          const int c = lane & 7;
#pragma unroll
          for (int j = 0; j < 8; ++j) { const int n = (lane >> 3) + 8 * j; const LAS float* sp = scr + (8 * c) * 65 + n;
              u32x4 o; o.x = cvt_pk_bf16(sp[0 * 65], sp[1 * 65]); o.y = cvt_pk_bf16(sp[2 * 65], sp[3 * 65]); o.z = cvt_pk_bf16(sp[4 * 65], sp[5 * 65]); o.w = cvt_pk_bf16(sp[6 * 65], sp[7 * 65]);
              __builtin_nontemporal_store(o, (u32x4*)(WT + (size_t)(64 * nb + n) * 1024 + 64 * kb + 8 * c)); }
          LDS_WAIT(); asm volatile("" ::: "memory");
      } }
    for (int it = I0 + I1 + gw; it < NITEMS; it += NGW) {
        int r = it;
        if (r < I0) { const int mi = r / 512, q = r % 512; conv_item(C.inp(23) + (size_t)mi * 1024 * 2048, 2048, 0, 2048, 1024, (bf16*)(ws + WS_WGU) + (size_t)mi * 2048 * 1024, nullptr, 0, scr, q / 32, q % 32, lane); continue; } r -= I0;
        if (r < I1) { const int mi = r / 256, q = r % 256; conv_item(C.inp(25) + (size_t)mi * 1024 * 1024, 1024, 0, 1024, 1024, (bf16*)(ws + WS_WDN) + (size_t)mi * 1024 * 1024, nullptr, 0, scr, q / 16, q % 16, lane); continue; } r -= I1;
        if (r < I2) { const int mi = r / 768, q = r % 768; conv_item(C.inp(1) + (size_t)mi * 1024 * EVEN_IN, EVEN_IN, 0, EVEN_N, 1024, (bf16*)(ws + WS_WEIN) + (size_t)mi * EVEN_N * 1024, nullptr, 0, scr, q / 48, q % 48, lane); continue; } r -= I2;
        if (r < I3) { const int mi = r / 256, q = r % 256; conv_item(C.inp(10) + (size_t)mi * 1024 * 1024, 1024, 0, 1024, 1024, (bf16*)(ws + WS_WEOUT) + (size_t)mi * 1024 * 1024, nullptr, 0, scr, q / 16, q % 16, lane); continue; } r -= I3;
        if (r < I4) { const int mi = r / 192, q = r % 192; conv_item(C.inp(11) + (size_t)mi * 1024 * ODD_IN, ODD_IN, 0, ODD_IN, 1024, (bf16*)(ws + WS_WOIN) + (size_t)mi * ODD_N * 1024, nullptr, 2, scr, q / 12, q % 12, lane); continue; } r -= I4;
        if (r < I5) { const int mi = r / 144, q = r % 144; conv_item(C.inp(13) + (size_t)mi * QL * 1536, 1536, 0, 1536, QL, (bf16*)(ws + WS_WUQ) + (size_t)mi * 1536 * QL, C.inp(12) + mi * QL, 1, scr, q / 24, q % 24, lane); continue; } r -= I5;
        if (r < I6) { const int mi = r / 128, q = r % 128; conv_item(C.inp(15) + (size_t)mi * KVL * 2048, 2048, 0, 2048, KVL, (bf16*)(ws + WS_WUKV) + (size_t)mi * 2048 * KVL, C.inp(14) + mi * KVL, 0, scr, q / 32, q % 32, lane); continue; } r -= I6;
        { const int mi = r / 256, q = r % 256; conv_item(C.inp(16) + (size_t)mi * 1024 * 1024, 1024, 0, 1024, 1024, (bf16*)(ws + WS_WOOUT) + (size_t)mi * 1024 * 1024, nullptr, 0, scr, q / 16, q % 16, lane); }
    }
    { f32x2* rope = (f32x2*)(ws + WS_ROPE);
      for (int idx = C.bid * NWAVES * 64 + C.tid; idx < SEQ * 32; idx += C.G * NWAVES * 64) { const int pos = idx >> 5, j = idx & 31;
          const float inv = powf(10000.0f, -(float)(2 * j) / 64.0f); const float ang = (float)pos * inv; rope[idx] = (f32x2){cosf(ang), sinf(ang)}; } }
    __syncthreads();
    LAS float* w8 = (LAS float*)(C.lds);
    load_w8(C, 0, w8);
    __syncthreads();
    const float* x = C.inp(0); bf16* XB = (bf16*)(ws + WS_XB); float* AB = (float*)(ws + WS_AB);
    f32x4 vn[4]; if (gw < T) row_load_f32(x + (size_t)gw * DM, lane, vn);
    for (int m = gw; m < T; m += NGW) { f32x4 v[4];
#pragma unroll
        for (int j = 0; j < 4; ++j) v[j] = vn[j];
        if (m + NGW < T) row_load_f32(x + (size_t)(m + NGW) * DM, lane, vn);
        row_store_bf16_nt(XB + (size_t)m * DM, lane, v);
        float ab[8]; row_ab(v, w8, lane, ab); if (lane < 8) { float s = ab[0];
#pragma unroll
            for (int e = 1; e < 8; ++e) s = (lane == e) ? ab[e] : s;
            AB[(size_t)m * 8 + lane] = s; } }
}

#ifndef MK_ALIGN_MOE
#define MK_ALIGN_MOE true
#endif
#ifndef MK_ALIGN_PLAIN
#define MK_ALIGN_PLAIN true
#endif
using pg8::Unit;
struct EpiBf16 {
    static constexpr bool PERM = true;
    bf16* O; int ldc; int gelu_cols;
    __device__ __forceinline__ void operator()(const f32x4 (&acc)[2][2][4][2], const Unit& u, int wr, int wc, int fr, int fq) const {
        const int row0 = u.pm * 256 + wr * 64 + fr, col0 = u.pn * 256 + wc * 32 + 8 * fq;
        const bool g = (u.pn * 256) < gelu_cols;
#pragma unroll
        for (int ai = 0; ai < 2; ++ai)
#pragma unroll
            for (int m = 0; m < 4; ++m) { bf16* rowp = O + (size_t)(row0 + ai * 128 + m * 16) * ldc + col0;
#pragma unroll
                for (int bj = 0; bj < 2; ++bj) { f32x4 v0 = acc[ai][bj][m][0], v1 = acc[ai][bj][m][1];
                    if (g) { f32x2 a = pg8::gelu_pk((f32x2){v0[0], v0[1]}), b = pg8::gelu_pk((f32x2){v0[2], v0[3]}), c = pg8::gelu_pk((f32x2){v1[0], v1[1]}), d = pg8::gelu_pk((f32x2){v1[2], v1[3]});
                        v0 = (f32x4){a.x, a.y, b.x, b.y}; v1 = (f32x4){c.x, c.y, d.x, d.y}; }
                    u32x4 w; w.x = cvt_pk_bf16(v0[0], v0[1]); w.y = cvt_pk_bf16(v0[2], v0[3]); w.z = cvt_pk_bf16(v1[0], v1[1]); w.w = cvt_pk_bf16(v1[2], v1[3]);
                    *(u32x4*)(rowp + bj * 128) = w; } }
    }
};
struct EpiO1 {
    static constexpr bool PERM = true;
    bf16* O; float* rsp; bf16* KPE; const f32x4* rope;
    __device__ __forceinline__ void operator()(const f32x4 (&acc)[2][2][4][2], const Unit& u, int wr, int wc, int fr_in, int fq_in) const {
        (void)fr_in; (void)fq_in; const int ln_ = lane_id_opaque(), fr = ln_ & 15, fq = ln_ >> 4;
        const int row0 = u.pm * 256 + wr * 64 + fr, col0 = u.pn * 256 + wc * 32 + 8 * fq;
        const bool ropew = (u.pn == 2) && (wc < 2);
#pragma unroll
        for (int ai = 0; ai < 2; ++ai) {
            f32x4 r0[4], r1[4];
            if (ropew) {
#pragma unroll
                for (int m = 0; m < 4; ++m) { const int pos = (row0 + ai * 128 + m * 16) & (SEQ - 1), jp = 16 * wc + 4 * fq; r0[m] = rope[(pos * 32 + jp) >> 1]; r1[m] = rope[(pos * 32 + jp + 2) >> 1]; } }
#pragma unroll
            for (int m = 0; m < 4; ++m) { const int row = row0 + ai * 128 + m * 16; bf16* rowp = O + (size_t)row * ODD_N + col0;
                float ss[2];
#pragma unroll
                for (int bj = 0; bj < 2; ++bj) { const f32x4 v0 = acc[ai][bj][m][0], v1 = acc[ai][bj][m][1];
                    ss[bj] = ((v0[0] * v0[0] + v0[1] * v0[1]) + (v0[2] * v0[2] + v0[3] * v0[3])) + ((v1[0] * v1[0] + v1[1] * v1[1]) + (v1[2] * v1[2] + v1[3] * v1[3]));
                    u32x4 w; w.x = cvt_pk_bf16(v0[0], v0[1]); w.y = cvt_pk_bf16(v0[2], v0[3]); w.z = cvt_pk_bf16(v1[0], v1[1]); w.w = cvt_pk_bf16(v1[2], v1[3]);
                    *(u32x4*)(rowp + bj * 128) = w; }
#pragma unroll
                for (int bj = 0; bj < 2; ++bj) { ss[bj] += __shfl_xor(ss[bj], 16); ss[bj] += __shfl_xor(ss[bj], 32); }
                if (fq == 0) { float* p = rsp + (size_t)row * 16;
                    if (u.pn == 0) p[wc] = ss[0] + ss[1];
                    else if (u.pn == 1) { p[4 + wc] = ss[0]; p[8 + wc] = ss[1]; }
                    else p[12 + wc] = ss[0]; }
                if (ropew) { const f32x4 a = r0[m], b = r1[m];
                    const f32x4 v0 = acc[ai][1][m][0], v1 = acc[ai][1][m][1];
                    u32x4 w; w.x = cvt_pk_bf16(v0[0] * a[0] - v0[1] * a[1], v0[0] * a[1] + v0[1] * a[0]); w.y = cvt_pk_bf16(v0[2] * a[2] - v0[3] * a[3], v0[2] * a[3] + v0[3] * a[2]);
                    w.z = cvt_pk_bf16(v1[0] * b[0] - v1[1] * b[1], v1[0] * b[1] + v1[1] * b[0]); w.w = cvt_pk_bf16(v1[2] * b[2] - v1[3] * b[3], v1[2] * b[3] + v1[3] * b[2]);
                    *(u32x4*)(KPE + (size_t)row * 64 + 32 * wc + 8 * fq) = w; } }
            asm volatile("" ::: "memory"); }
    }
};
struct EpiRes {
    static constexpr bool PERM = true;
    const bf16* X; bf16* Y;
    __device__ __forceinline__ void operator()(const f32x4 (&acc)[2][2][4][2], const Unit& u, int wr, int wc, int fr, int fq) const {
        const int row0 = u.pm * 256 + wr * 64 + fr, col0 = u.pn * 256 + wc * 32 + 8 * fq;
        u32x4 xs[2][4][2];
#pragma unroll
        for (int ai = 0; ai < 2; ++ai)
#pragma unroll
            for (int m = 0; m < 4; ++m)
#pragma unroll
                for (int bj = 0; bj < 2; ++bj) xs[ai][m][bj] = *(const u32x4*)(X + (size_t)(row0 + ai * 128 + m * 16) * DM + col0 + bj * 128);
#pragma unroll
        for (int ai = 0; ai < 2; ++ai)
#pragma unroll
            for (int m = 0; m < 4; ++m) { const size_t off = (size_t)(row0 + ai * 128 + m * 16) * DM + col0;
#pragma unroll
                for (int bj = 0; bj < 2; ++bj) { const f32x4 a0 = acc[ai][bj][m][0], a1 = acc[ai][bj][m][1]; const u32x4 x = xs[ai][m][bj]; u32x4 w;
                    w.x = cvt_pk_bf16(bf_lo(x.x) * DN_ALPHA + a0[0], bf_hi(x.x) * DN_ALPHA + a0[1]); w.y = cvt_pk_bf16(bf_lo(x.y) * DN_ALPHA + a0[2], bf_hi(x.y) * DN_ALPHA + a0[3]);
                    w.z = cvt_pk_bf16(bf_lo(x.z) * DN_ALPHA + a1[0], bf_hi(x.z) * DN_ALPHA + a1[1]); w.w = cvt_pk_bf16(bf_lo(x.w) * DN_ALPHA + a1[2], bf_hi(x.w) * DN_ALPHA + a1[3]);
                    *(u32x4*)(Y + off + bj * 128) = w; } }
    }
};
struct EpiQ {
    static constexpr bool PERM = true;
    bf16* O; const LAS float* scl; const f32x4* rope;
    __device__ __forceinline__ void operator()(const f32x4 (&acc)[2][2][4][2], const Unit& u, int wr, int wc, int fr_in, int fq_in) const {
        (void)fr_in; (void)fq_in; const int ln_ = lane_id_opaque(), fr = ln_ & 15, fq = ln_ >> 4;
        const int row0 = u.pm * 256 + wr * 64 + fr, col0 = u.pn * 256 + wc * 32 + 8 * fq;
        float sc[2][4];
#pragma unroll
        for (int ai = 0; ai < 2; ++ai)
#pragma unroll
            for (int m = 0; m < 4; ++m) sc[ai][m] = scl[u.li * 256 + wr * 64 + fr + ai * 128 + m * 16];
#pragma unroll
        for (int bj = 0; bj < 2; ++bj) { const int c = col0 + bj * 128, o = c % 192; const bool rp = o >= 128; const int jp = (o - 128) >> 1;
#pragma unroll
          for (int ai = 0; ai < 2; ++ai) {
            f32x4 r0[4], r1[4];
            if (rp) {
#pragma unroll
                for (int m = 0; m < 4; ++m) { const int pos = (row0 + ai * 128 + m * 16) & (SEQ - 1); r0[m] = rope[(pos * 32 + jp) >> 1]; r1[m] = rope[(pos * 32 + jp + 2) >> 1]; } }
#pragma unroll
            for (int m = 0; m < 4; ++m) { const int row = row0 + ai * 128 + m * 16; const float s = sc[ai][m];
                f32x4 v0 = acc[ai][bj][m][0] * s, v1 = acc[ai][bj][m][1] * s;
                if (rp) { const f32x4 a = r0[m], b = r1[m];
                    v0 = (f32x4){v0[0] * a[0] - v0[1] * a[1], v0[0] * a[1] + v0[1] * a[0], v0[2] * a[2] - v0[3] * a[3], v0[2] * a[3] + v0[3] * a[2]};
                    v1 = (f32x4){v1[0] * b[0] - v1[1] * b[1], v1[0] * b[1] + v1[1] * b[0], v1[2] * b[2] - v1[3] * b[3], v1[2] * b[3] + v1[3] * b[2]}; }
                u32x4 w; w.x = cvt_pk_bf16(v0[0], v0[1]); w.y = cvt_pk_bf16(v0[2], v0[3]); w.z = cvt_pk_bf16(v1[0], v1[1]); w.w = cvt_pk_bf16(v1[2], v1[3]);
                *(u32x4*)(O + (size_t)row * 1536 + c) = w; }
            asm volatile("" ::: "memory"); } }
    }
};
struct EpiKV {
    static constexpr bool PERM = true;
    bf16* O; const LAS float* scl;
    __device__ __forceinline__ void operator()(const f32x4 (&acc)[2][2][4][2], const Unit& u, int wr, int wc, int fr_in, int fq_in) const {
        (void)fr_in; (void)fq_in; const int ln_ = lane_id_opaque(), fr = ln_ & 15, fq = ln_ >> 4;
        const int row0 = u.pm * 256 + wr * 64 + fr, col0 = u.pn * 256 + wc * 32 + 8 * fq;
        float sc[2][4];
#pragma unroll
        for (int ai = 0; ai < 2; ++ai)
#pragma unroll
            for (int m = 0; m < 4; ++m) sc[ai][m] = scl[u.li * 256 + wr * 64 + fr + ai * 128 + m * 16];
#pragma unroll
        for (int ai = 0; ai < 2; ++ai)
#pragma unroll
            for (int m = 0; m < 4; ++m) { const int row = row0 + ai * 128 + m * 16; const float s = sc[ai][m]; bf16* rowp = O + (size_t)row * 2048 + col0;
#pragma unroll
                for (int bj = 0; bj < 2; ++bj) { const f32x4 v0 = acc[ai][bj][m][0] * s, v1 = acc[ai][bj][m][1] * s;
                    u32x4 w; w.x = cvt_pk_bf16(v0[0], v0[1]); w.y = cvt_pk_bf16(v0[2], v0[3]); w.z = cvt_pk_bf16(v1[0], v1[1]); w.w = cvt_pk_bf16(v1[2], v1[3]);
                    *(u32x4*)(rowp + bj * 128) = w; } }
    }
};
struct EpiSwiglu {
    static constexpr bool PERM = true;
    bf16* HID; const LAS bf16* lbias; const LAS int* rmap; const LAS int* utab;
    __device__ __forceinline__ void operator()(const f32x4 (&acc)[2][2][4][2], const Unit& u, int wr, int wc, int fr, int fq) const {
        const int cl = wc * 32 + 8 * fq, col0 = u.pn * 256 + cl;
        f32x4 bv[2][2];
#pragma unroll
        for (int bj = 0; bj < 2; ++bj) { const u32x4 w = *(const LAS u32x4*)(lbias + u.li * 256 + bj * 128 + cl);
            bv[bj][0] = (f32x4){bf_lo(w.x), bf_hi(w.x), bf_lo(w.y), bf_hi(w.y)}; bv[bj][1] = (f32x4){bf_lo(w.z), bf_hi(w.z), bf_lo(w.w), bf_hi(w.w)}; }
#pragma unroll
        for (int ai = 0; ai < 2; ++ai)
#pragma unroll
            for (int m = 0; m < 4; ++m) { const int tr_ = ai * 128 + wr * 64 + m * 16 + fr; const int slot = rmap[u.li * 256 + tr_];
                if (slot >= 0) { bf16* rowp = HID + ((size_t)utab[u.li * 4 + 3] * 256 + tr_) * DFF + (col0 >> 1);
#pragma unroll
                    for (int bj = 0; bj < 2; ++bj) { const f32x4 h0 = acc[ai][bj][m][0] + bv[bj][0], h1 = acc[ai][bj][m][1] + bv[bj][1];
                        float o[4];
#pragma unroll
                        for (int q = 0; q < 4; ++q) { const float glu = fminf(q < 2 ? h0[2 * q] : h1[2 * q - 4], 7.0f); float lin = q < 2 ? h0[2 * q + 1] : h1[2 * q - 3]; lin = fminf(fmaxf(lin, -7.0f), 7.0f);
                            const float sg = __builtin_amdgcn_rcpf(1.0f + __builtin_amdgcn_exp2f(-1.702f * 1.4426950408889634f * glu)); o[q] = glu * sg * (lin + 1.0f); }
                        u32x2 w; w.x = cvt_pk_bf16(o[0], o[1]); w.y = cvt_pk_bf16(o[2], o[3]);
                        *(u32x2*)(rowp + bj * 64) = w; } } }
    }
};
struct EpiDown {
    static constexpr bool PERM = true;
    bf16* YE; const LAS float* lbias; const LAS float* lgate; const LAS int* rmap;
    __device__ __forceinline__ void operator()(const f32x4 (&acc)[2][2][4][2], const Unit& u, int wr, int wc, int fr, int fq) const {
        const int cl = wc * 32 + 8 * fq, col0 = u.pn * 256 + cl;
        f32x4 bv[2][2];
#pragma unroll
        for (int bj = 0; bj < 2; ++bj)
#pragma unroll
            for (int n = 0; n < 2; ++n) bv[bj][n] = *(const LAS f32x4*)(lbias + u.li * 256 + bj * 128 + cl + 4 * n);
#pragma unroll
        for (int ai = 0; ai < 2; ++ai)
#pragma unroll
            for (int m = 0; m < 4; ++m) { const int r = u.li * 256 + ai * 128 + wr * 64 + m * 16 + fr; const int slot = rmap[r];
                if (slot >= 0) { const float g = lgate[r]; unsigned char* rowp = (unsigned char*)YE + (size_t)slot * DM + col0;
#pragma unroll
                    for (int bj = 0; bj < 2; ++bj) { f32x4 v0 = (acc[ai][bj][m][0] + bv[bj][0]) * g, v1 = (acc[ai][bj][m][1] + bv[bj][1]) * g;
#pragma unroll
                        for (int q = 0; q < 4; ++q) { v0[q] = __builtin_amdgcn_fmed3f(v0[q], -448.0f, 448.0f); v1[q] = __builtin_amdgcn_fmed3f(v1[q], -448.0f, 448.0f); }
                        int w0 = __builtin_amdgcn_cvt_pk_fp8_f32(v0[0], v0[1], 0, false); w0 = __builtin_amdgcn_cvt_pk_fp8_f32(v0[2], v0[3], w0, true);
                        int w1 = __builtin_amdgcn_cvt_pk_fp8_f32(v1[0], v1[1], 0, false); w1 = __builtin_amdgcn_cvt_pk_fp8_f32(v1[2], v1[3], w1, true);
                        *(u32x2*)(rowp + bj * 128) = (u32x2){(unsigned)w0, (unsigned)w1}; } } }
    }
};

template <class Epi>
__device__ __forceinline__ void run_plain_gemm(const Ctx& C, const bf16* A, int lda, int K, int N, const bf16* Bt, const Epi& E) {
    pg8::PlainSched S; S.o.init(T, N, C.G, C.bid); S.Bt = (const char*)Bt; S.K = K; S.lda = lda;
    pg8::gemm_phase<Epi, pg8::PlainSched, MK_ALIGN_PLAIN>(C.lds, (const char*)A, K, S, E, C.wave);
}

template <class Epi>
__device__ __forceinline__ void run_scaled_gemm(const Ctx& C, const bf16* A, int lda, int K, int N, const bf16* Bt, Epi E, const float* rsp, int half, float inv_n) {
    pg8::PlainSched S; S.o.init(T, N, C.G, C.bid); S.Bt = (const char*)Bt; S.K = K; S.lda = lda;
    LAS float* scl = (LAS float*)(C.lds + LDS_SPARE);
    __syncthreads();
    { f32x4 a_[2], b_[2]; bool ok_[2];
#pragma unroll
      for (int q = 0; q < 2; ++q) { const int ent = C.tid + q * NWAVES * 64, i = ent >> 8, r = ent & 255; pg8::Unit u; ok_[q] = S.o.next(i, u);
          const f32x4* p = (const f32x4*)(rsp + (size_t)((ok_[q] ? u.pm : 0) * 256 + r) * 16) + 2 * half; a_[q] = p[0]; b_[q] = p[1]; }
#pragma unroll
      for (int q = 0; q < 2; ++q) { const int ent = C.tid + q * NWAVES * 64; const f32x4 a = a_[q], b = b_[q];
          const float s = ((a.x + a.y) + (a.z + a.w)) + ((b.x + b.y) + (b.z + b.w));
          if (ok_[q]) scl[ent] = 1.0f / sqrtf(s * inv_n + RMS_EPS); } }
    __syncthreads();
    E.scl = scl;
    pg8::gemm_phase<Epi, pg8::PlainSched, MK_ALIGN_PLAIN>(C.lds, (const char*)A, K, S, E, C.wave);
}

constexpr int MOE_RMAP_OFF = LDS_SPARE, MOE_MAX_UNITS = 18, MOE_MAX_UNITS2 = 10;
constexpr int MOE1_BIAS_OFF = LDS_SPARE + 18 * 1024, MOE1_PRE_OFF = MOE1_BIAS_OFF + 18 * 512;
constexpr int MOE2_GATE_OFF = LDS_SPARE + 10 * 1024, MOE2_BIAS_OFF = MOE2_GATE_OFF + 10 * 1024, MOE2_PRE_OFF = MOE2_BIAS_OFF + 10 * 1024;
static_assert(MOE1_PRE_OFF + 512 <= LDS_CTL_OFF && MOE2_PRE_OFF + 512 <= LDS_CTL_OFF, "MoE LDS map");
struct MoeSched {
    static constexpr bool GATHER = true;
    const LAS int* pre; const LAS int* rmap; const LAS int* utab; const char* Bt; size_t bstride; int K, NT, G, c, lda, shift, maxu; bool compact;
    __device__ __forceinline__ bool decode(int i, Unit& u) const {
        const int x = c & 7, k = c >> 3, per = G >> 3;
        const int RT = 32 / NT, tot = pre[32];
        const int slot = i * per + k;
        const int st = (slot >> 5) * 8 + x, within = slot & 31;
        const int rt = st * RT + within / NT;
        if (rt >= tot || i >= maxu) return false;
        int e = 0;
#pragma unroll 1
        for (; e < 31; ++e) if (rt < pre[e + 1]) break;
        u.e = e; u.pn = within % NT; u.pm = rt - pre[e]; u.li = i; return true;
    }
    __device__ __forceinline__ bool next(int i, Unit& u) const {
        if (i >= maxu) return false;
        const int e = utab[i * 4]; if (e < 0) return false;
        u.e = e; u.pm = utab[i * 4 + 1]; u.pn = utab[i * 4 + 2]; u.li = i; return true;
    }
    __device__ __forceinline__ const char* bbase(const Unit& u) const { return Bt + (size_t)u.e * bstride + (size_t)u.pn * 256 * K * 2; }
    __device__ __forceinline__ unsigned aoff(const Unit& u, int r) const {
        if (compact) return (unsigned)((utab[u.li * 4 + 3] * 256 + r) * lda) * 2u;
        const int slot = rmap[u.li * 256 + r]; const int s = slot < 0 ? 0 : (slot >> shift); return (unsigned)(s * lda) * 2u; }
};
template <int WHICH  , class Epi>
__device__ __forceinline__ void run_moe_gemm(const Ctx& C0, int layer, const bf16* A, int lda, int shift, int K, int N, const bf16* Bt, size_t bstride_elems, const float* bias_g, Epi E) {
    const Ctx C = phase_ctx(C0);
    constexpr int PRE_OFF = WHICH == 1 ? MOE1_PRE_OFF : MOE2_PRE_OFF;
    LAS int* pre = (LAS int*)(C.lds + PRE_OFF); LAS int* cnt = pre + 64; LAS int* rmap = (LAS int*)(C.lds + MOE_RMAP_OFF);
    const int* list = (const int*)(C.ws + WS_LIST);
    if (C.tid < 32) cnt[C.tid] = (int)__hip_atomic_load(C.ctl + CW_CNT + (layer * 32 + C.tid) * 64, RLX_AGENT);
    __syncthreads();
    if (C.tid == 0) { int s = 0; for (int e = 0; e < 32; ++e) { pre[e] = s; s += (cnt[e] + 255) >> 8; } pre[32] = s; }
    __syncthreads();
    MoeSched S; S.pre = pre; S.rmap = rmap; S.Bt = (const char*)Bt; S.bstride = bstride_elems * 2; S.K = K; S.NT = N / 256; S.G = C.G; S.c = C.bid; S.lda = lda; S.shift = shift; S.maxu = WHICH == 1 ? MOE_MAX_UNITS : MOE_MAX_UNITS2; S.compact = (WHICH == 2);
    constexpr int MAXU = WHICH == 1 ? MOE_MAX_UNITS : MOE_MAX_UNITS2;
    LAS int* utab = pre + 96;
    S.utab = utab;
    if (C.tid < MAXU) { Unit u; const bool ok = S.decode(C.tid, u); utab[C.tid * 4] = ok ? u.e : -1; utab[C.tid * 4 + 1] = u.pm; utab[C.tid * 4 + 2] = u.pn; utab[C.tid * 4 + 3] = ok ? pre[u.e] + u.pm : 0; }
    __syncthreads();
    { constexpr int NENT = (MAXU * 256 + NWAVES * 64 - 1) / (NWAVES * 64);
      int slot_[NENT]; float bias_[NENT]; float gate_[NENT]; bool ok_[NENT];
#pragma unroll
      for (int q = 0; q < NENT; ++q) { const int ent = C.tid + q * NWAVES * 64, i = ent >> 8, r = ent & 255; const int e = i < MAXU ? utab[i * 4] : -1; ok_[q] = e >= 0;
          const int ec = e < 0 ? 0 : e, pm = ok_[q] ? utab[i * 4 + 1] : 0, pn = ok_[q] ? utab[i * 4 + 2] : 0; const int idx = pm * 256 + r;
          const bool in_ = ok_[q] && idx < cnt[ec]; slot_[q] = in_ ? list[(size_t)ec * LCAP + idx] : -1;
          gate_[q] = 0.f; if constexpr (WHICH == 2) { if (in_) gate_[q] = ((const float*)(C.ws + WS_XF + 8 * MiB))[(size_t)ec * LCAP + idx]; }
          bias_[q] = bias_g[(size_t)ec * N + pn * 256 + r]; }
#pragma unroll
      for (int q = 0; q < NENT; ++q) { const int ent = C.tid + q * NWAVES * 64;
          if (ok_[q]) { rmap[ent] = slot_[q];
              if constexpr (WHICH == 1) ((LAS bf16*)(C.lds + MOE1_BIAS_OFF))[ent] = f2bf(bias_[q]);
              else { ((LAS float*)(C.lds + MOE2_BIAS_OFF))[ent] = bias_[q]; ((LAS float*)(C.lds + MOE2_GATE_OFF))[ent] = gate_[q]; } } } }
    __syncthreads();
    E.rmap = rmap; if constexpr (WHICH == 1) E.utab = utab;
    pg8::gemm_phase<Epi, MoeSched, MK_ALIGN_MOE>(C.lds, (const char*)A, K, S, E, C.wave);
}

__device__ __forceinline__ void phase_router(const Ctx& C0, int layer) {
    const Ctx C = phase_ctx(C0);
    LAS char* WT = (LAS char*)C.lds;
    constexpr int WSB = 2064;
    LAS int* lcnt = (LAS int*)(C.lds + 132608); LAS int* lbase = (LAS int*)(C.lds + 132736);
    LAS int* asg_e = (LAS int*)(C.lds + 132864); LAS int* asg_pos = (LAS int*)(C.lds + 134912); LAS float* asg_gate = (LAS float*)(C.lds + 136960);
    const float* Wr = C.inp(21) + (size_t)layer * DM * NEXP; const float* br = C.inp(22) + layer * NEXP;
    const int lane = C.lane, tid = C.tid, x2 = lane & 15, g = lane >> 4;
    { f32x4 wv[16];
#pragma unroll
      for (int q = 0; q < 16; ++q) wv[q] = *(const f32x4*)(Wr + (tid + 512 * q) * 4);
#pragma unroll
      for (int q = 0; q < 16; ++q) { const int f = (tid + 512 * q) * 4, k = f >> 5, e = f & 31;
#pragma unroll
        for (int j = 0; j < 4; ++j) { const float w = wv[q][j]; const bf16 hi = f2bf(w); const bf16 lo = f2bf(w - bf2f(hi));
            *(LAS bf16*)(WT + (e + j) * WSB + k * 2) = hi; *(LAS bf16*)(WT + (32 + e + j) * WSB + k * 2) = lo; } } }
    f32x4 gg[4], bb[4]; row_load_f32(C.inp(17) + layer * DM, lane, gg); row_load_f32(C.inp(18) + layer * DM, lane, bb);
    const bf16* Y = (const bf16*)(C.ws + WS_Y); bf16* XB = (bf16*)(C.ws + WS_XB);
    int* list = (int*)(C.ws + WS_LIST); float* GATE = (float*)(C.ws + WS_XF + 8 * MiB);
    const f32x4 bias0 = *(const f32x4*)(br + 4 * g), bias1 = *(const f32x4*)(br + 16 + 4 * g);
    for (int rb = C.bid; rb < T / 128; rb += C.G) {
        if (tid < 32) lcnt[tid] = 0;
#pragma unroll 1
        for (int hb = 0; hb < 2; ++hb) { u32x2 raw[8][4];
#pragma unroll
          for (int i = 0; i < 8; ++i) { const bf16* yp = Y + (size_t)(rb * 128 + C.wave * 16 + hb * 8 + i) * DM + 4 * lane;
#pragma unroll
              for (int j = 0; j < 4; ++j) raw[i][j] = *(const u32x2*)(yp + 256 * j); }
#pragma unroll
          for (int i = 0; i < 8; ++i) { const int row = rb * 128 + C.wave * 16 + hb * 8 + i; f32x4 v[4];
#pragma unroll
              for (int j = 0; j < 4; ++j) v[j] = (f32x4){bf_lo(raw[i][j].x), bf_hi(raw[i][j].x), bf_lo(raw[i][j].y), bf_hi(raw[i][j].y)};
              row_layernorm(v, gg, bb); row_store_bf16(XB + (size_t)row * DM, lane, v); } }
        asm volatile("s_waitcnt vmcnt(0)" ::: "memory");
        __syncthreads();
        f32x4 acc[4];
#pragma unroll
        for (int nt = 0; nt < 4; ++nt) acc[nt] = (f32x4){0.f, 0.f, 0.f, 0.f};
        { const bf16* xrow = XB + (size_t)(rb * 128 + C.wave * 16 + x2) * DM + 8 * g; const LAS char* wrow = WT + x2 * WSB + 16 * g;
#pragma unroll 16
          for (int ks = 0; ks < 32; ++ks) { const bf16x8 xa = *(const bf16x8*)(xrow + 32 * ks);
#pragma unroll
            for (int nt = 0; nt < 4; ++nt) acc[nt] = __builtin_amdgcn_mfma_f32_16x16x32_bf16(*(const LAS bf16x8*)(wrow + 16 * nt * WSB + 64 * ks), xa, acc[nt], 0, 0, 0); } }
        float lg[8];
#pragma unroll
        for (int r = 0; r < 4; ++r) { lg[r] = acc[0][r] + acc[2][r] + bias0[r]; lg[4 + r] = acc[1][r] + acc[3][r] + bias1[r]; }
        float tv[4]; int te[4];
#pragma unroll
        for (int k = 0; k < 4; ++k) { tv[k] = -__builtin_inff(); te[k] = 1 << 20; }
#define RT_INS(val_, idx_) { float cv_ = (val_); int ce_ = (idx_); _Pragma("unroll") for (int k = 0; k < 4; ++k) { const bool gt_ = (cv_ > tv[k]) || (cv_ == tv[k] && ce_ < te[k]); \
            const float nv_ = gt_ ? cv_ : tv[k]; const int ne_ = gt_ ? ce_ : te[k]; cv_ = gt_ ? tv[k] : cv_; ce_ = gt_ ? te[k] : ce_; tv[k] = nv_; te[k] = ne_; } }
#pragma unroll
        for (int q = 0; q < 8; ++q) RT_INS(lg[q], 16 * (q >> 2) + 4 * g + (q & 3))
#pragma unroll
        for (int off = 16; off < 64; off <<= 1) { float pv[4]; int pe[4];
#pragma unroll
            for (int k = 0; k < 4; ++k) { pv[k] = __shfl_xor(tv[k], off); pe[k] = __shfl_xor(te[k], off); }
#pragma unroll
            for (int k = 0; k < 4; ++k) RT_INS(pv[k], pe[k]) }
#undef RT_INS
        const float e1 = __expf(tv[1] - tv[0]), e2 = __expf(tv[2] - tv[0]), e3 = __expf(tv[3] - tv[0]); const float inv = 1.0f / (1.0f + e1 + e2 + e3);
        if (lane < 16) { const int rl = C.wave * 16 + x2; const float gk[4] = {inv, e1 * inv, e2 * inv, e3 * inv};
#pragma unroll
            for (int k = 0; k < 4; ++k) { const int lpos = __hip_atomic_fetch_add(lcnt + te[k], 1, __ATOMIC_RELAXED, __HIP_MEMORY_SCOPE_WORKGROUP);
                const int a = rl * 4 + k; asg_e[a] = te[k]; asg_pos[a] = lpos; asg_gate[a] = gk[k]; } }
        __syncthreads();
        if (tid < 32) lbase[tid] = (int)__hip_atomic_fetch_add(C.ctl + CW_CNT + (layer * 32 + tid) * 64, (unsigned)lcnt[tid], RLX_AGENT);
        __syncthreads();
        { const int a = tid, e = asg_e[a], slot = (rb * 128 + (a >> 2)) * 4 + (a & 3); const size_t li_ = (size_t)e * LCAP + lbase[e] + asg_pos[a]; list[li_] = slot; GATE[li_] = asg_gate[a]; }
        __syncthreads();
    }
}

__device__ __forceinline__ void phase_combine(const Ctx& C0, int layer) {
    const Ctx C = phase_ctx(C0);
    const int gw = C.bid * NWAVES + C.wave, NGW = C.G * NWAVES, lane = C.lane;
    LAS float* w8 = (LAS float*)C.lds;
    if (layer == 1) { load_w8(C, 1, w8); __syncthreads(); }
    f32x4 g[4], b[4]; row_load_f32(C.inp(19) + layer * DM, lane, g); row_load_f32(C.inp(20) + layer * DM, lane, b);
    bf16* XB = (bf16*)(C.ws + WS_XB); const bf16* YE = (const bf16*)(C.ws + WS_YE); float* AB = (float*)(C.ws + WS_AB);
    u32x2 nx[4]; unsigned ny[4][4];
#define CB_LOAD(m_) do { const bf16* xr_ = XB + (size_t)(m_) * DM + 4 * lane; const unsigned char* yr_ = (const unsigned char*)YE + (size_t)(m_) * 4 * DM + 4 * lane; \
        _Pragma("unroll") for (int j = 0; j < 4; ++j) nx[j] = *(const u32x2*)(xr_ + 256 * j); \
        _Pragma("unroll") for (int k = 0; k < 4; ++k) _Pragma("unroll") for (int j = 0; j < 4; ++j) ny[k][j] = *(const unsigned*)(yr_ + (size_t)k * DM + 256 * j); } while (0)
    auto row_body = [&](int m, bool pf) {
        f32x4 v[4];
        if (!pf) CB_LOAD(m);
#pragma unroll
        for (int j = 0; j < 4; ++j) { v[j] = (f32x4){bf_lo(nx[j].x), bf_hi(nx[j].x), bf_lo(nx[j].y), bf_hi(nx[j].y)} * DN_ALPHA;
#pragma unroll
            for (int k = 0; k < 4; ++k) { const f32x2 lo_ = __builtin_amdgcn_cvt_pk_f32_fp8((int)ny[k][j], false), hi_ = __builtin_amdgcn_cvt_pk_f32_fp8((int)ny[k][j], true); v[j] = v[j] + (f32x4){lo_.x, lo_.y, hi_.x, hi_.y}; } }
        if (pf) { const int mn = (m + NGW < T) ? m + NGW : m; CB_LOAD(mn); }
        row_layernorm(v, g, b);
        if (layer == DEPTH - 1) row_store_f32(C.out + (size_t)m * DM, lane, v);
        else row_store_bf16(XB + (size_t)m * DM, lane, v);
        if (layer == 1) { asm volatile("" ::: "memory");
            float ab[8]; row_ab(v, w8, lane, ab); if (lane < 8) { float s = ab[0];
#pragma unroll
                for (int e = 1; e < 8; ++e) s = (lane == e) ? ab[e] : s;
                AB[(size_t)m * 8 + lane] = s; }
            asm volatile("" ::: "memory"); } };
    if (gw < T) { CB_LOAD(gw); row_body(gw, true);
#pragma unroll 1
        for (int m = gw + NGW; m < T; m += NGW) row_body(m, true); }
#undef CB_LOAD
}

__device__ __forceinline__ void phase_o1b(const Ctx& C0) {
    const Ctx C = phase_ctx(C0);
    const int gw = C.bid * NWAVES + C.wave, NGW = C.G * NWAVES, lane = C.lane;
    const bf16* C1 = (const bf16*)(C.ws + WS_ARENA + AR_C1); bf16* KPE = (bf16*)(C.ws + WS_ARENA + AR_KPE);
    float* RSQ = (float*)(C.ws + WS_RS); float* RKV = RSQ + T; const f32x2* rope = (const f32x2*)(C.ws + WS_ROPE);
#pragma unroll 2
    for (int m = gw; m < T; m += NGW) {
        const bf16* rp = C1 + (size_t)m * ODD_N;
        const u32x4 a = *(const u32x4*)(rp + 8 * lane);
        float s = 0.f;
#pragma unroll
        for (int q = 0; q < 4; ++q) { const float lo = bf_lo(a[q]), hi = bf_hi(a[q]); s += lo * lo + hi * hi; }
        float sq = lane < 48 ? s : 0.f, skv = lane < 48 ? 0.f : s;
        if (lane < 16) { const u32x4 b = *(const u32x4*)(rp + 8 * (64 + lane)); float s2 = 0.f;
#pragma unroll
            for (int q = 0; q < 4; ++q) { const float lo = bf_lo(b[q]), hi = bf_hi(b[q]); s2 += lo * lo + hi * hi; }
            skv += s2; }
        sq = wave_sum(sq); skv = wave_sum(skv);
        if (lane == 0) { RSQ[m] = 1.0f / sqrtf(sq * (1.0f / QL) + RMS_EPS); RKV[m] = 1.0f / sqrtf(skv * (1.0f / KVL) + RMS_EPS); }
        if (lane < 32) { const float x1 = bf2f(rp[640 + lane]), x2 = bf2f(rp[672 + lane]); const f32x2 cs = rope[(m & (SEQ - 1)) * 32 + lane];
            *(unsigned*)(KPE + (size_t)m * 64 + 2 * lane) = cvt_pk_bf16(x1 * cs.x - x2 * cs.y, x1 * cs.y + x2 * cs.x); }
    }
}

namespace att {
constexpr int SHM_V = 16384, SHM_K = 16384, SHM_KR = 8192;
constexpr int NBUF = 3;
constexpr int OFF_V = 0, OFF_K = NBUF * SHM_V, OFF_KR = OFF_K + NBUF * SHM_K, OFF_WS = OFF_KR + NBUF * SHM_KR, OFF_QR = OFF_WS + 2048;
static_assert(OFF_QR + 8 * 4096 <= LDS_CTL_OFF, "attention LDS map");
constexpr float THR = 8.f, SCALE = ATT_SCALE;
#define KSWZ(row, colB) ((row) * 256 + ((colB) ^ (((row) & 7) << 4)))
#define KRSWZ(row, colB) ((row) * 128 + ((colB) ^ (((row) & 7) << 4)))
#define SBAR() __builtin_amdgcn_sched_barrier(0)
__device__ __forceinline__ int v_st(int k, int c) { const int kk = (k & ~0xC) | ((k & 4) << 1) | ((k & 8) >> 1); return ((kk >> 3) * 4 + (c >> 5)) * 512 + ((kk & 7) * 32 + (c & 31)) * 2; }
__device__ __forceinline__ int v_rd_base(int lane) { return ((lane & 3) << 3) | (((lane >> 2) & 3) << 6) | (((lane >> 4) & 1) << 5) | (((lane >> 5) & 1) << 8); }
constexpr int v_rd_off(int d0, int ks, int half) { return d0 * 512 + ks * 4096 + half * 2048; }
__device__ __forceinline__ int crow(int r, int hi) { return (r & 3) + 8 * (r >> 2) + 4 * hi; }
__device__ __forceinline__ void partialSM(f32x16& p0, f32x16& p1, float& m_reg, float& mn, float& alpha) {
    float pmax = p0[0];
#pragma unroll
    for (int r = 1; r < 16; ++r) pmax = fmaxf(pmax, p0[r]);
#pragma unroll
    for (int r = 0; r < 16; ++r) pmax = fmaxf(pmax, p1[r]);
    { auto rr = __builtin_amdgcn_permlane32_swap(__float_as_uint(pmax), __float_as_uint(pmax), false, false);
      pmax = fmaxf(__uint_as_float(rr[0]), __uint_as_float(rr[1])); }
    constexpr float C2 = 1.4426950408889634f * SCALE;
    if (__builtin_expect(__all((pmax - m_reg) * SCALE <= THR), 1)) { mn = m_reg; alpha = 1.f; }
    else { mn = fmaxf(m_reg, pmax); alpha = __builtin_amdgcn_exp2f((m_reg - mn) * C2); m_reg = mn; }
    const float mnL = -mn * C2;
#pragma unroll
    for (int r = 0; r < 16; ++r) p0[r] = fmaf(p0[r], C2, mnL);
#pragma unroll
    for (int r = 0; r < 16; ++r) p1[r] = fmaf(p1[r], C2, mnL);
#pragma unroll
    for (int r = 0; r < 16; ++r) p0[r] = __builtin_amdgcn_exp2f(p0[r]);
}
__device__ __forceinline__ void finishSM(f32x16& p0, f32x16& p1, float alpha, float& l_reg, bf16x8& pa0, bf16x8& pa1, bf16x8& pa2, bf16x8& pa3) {
#pragma unroll
    for (int r = 0; r < 16; ++r) p1[r] = __builtin_amdgcn_exp2f(p1[r]);
    float ps = 0;
#pragma unroll
    for (int r = 0; r < 16; ++r) ps += p0[r];
#pragma unroll
    for (int r = 0; r < 16; ++r) ps += p1[r];
    { auto rr = __builtin_amdgcn_permlane32_swap(__float_as_uint(ps), __float_as_uint(ps), false, false);
      ps = __uint_as_float(rr[0]) + __uint_as_float(rr[1]); }
    l_reg = l_reg * alpha + ps;
#define PK4(P, B_, OUT) do { unsigned a0 = cvt_pk_bf16(P[B_+0], P[B_+1]), a1 = cvt_pk_bf16(P[B_+2], P[B_+3]);                          \
        unsigned b0 = cvt_pk_bf16(P[B_+4], P[B_+5]), b1 = cvt_pk_bf16(P[B_+6], P[B_+7]);                                             \
        auto r0 = __builtin_amdgcn_permlane32_swap(a0, b0, false, false); auto r1 = __builtin_amdgcn_permlane32_swap(a1, b1, false, false); \
        u32x4 w = {r0[0], r1[0], r0[1], r1[1]}; OUT = *reinterpret_cast<bf16x8*>(&w); } while (0)
    PK4(p0, 0, pa0); PK4(p0, 8, pa1); PK4(p1, 0, pa2); PK4(p1, 8, pa3);
#undef PK4
}
template <int KB>
__device__ __forceinline__ void qkt(f32x16& p0, f32x16& p1, const LAS char* lds, int r32, int hi, const bf16x8* qr, const LAS char* qrl) {
    p0 = f32x16{}; p1 = f32x16{};
    const LAS char* kb[4]; const LAS char* kr[4];
#pragma unroll
    for (int dd = 0; dd < 4; ++dd) { kb[dd] = lds + OFF_K + KB * SHM_K + KSWZ(r32, (dd * 16 + hi * 8) * 2); kr[dd] = lds + OFF_KR + KB * SHM_KR + KRSWZ(r32, (dd * 16 + hi * 8) * 2); }
#pragma unroll
    for (int d0 = 0; d0 < 8; ++d0) { const LAS char* a = kb[d0 & 3] + (d0 >> 2) * 128;
        const bf16x8 b0 = *reinterpret_cast<const LAS bf16x8*>(a);
        const bf16x8 b1 = *reinterpret_cast<const LAS bf16x8*>(a + 32 * 256);
        p0 = __builtin_amdgcn_mfma_f32_32x32x16_bf16(b0, qr[d0], p0, 0, 0, 0);
        p1 = __builtin_amdgcn_mfma_f32_32x32x16_bf16(b1, qr[d0], p1, 0, 0, 0); }
#pragma unroll
    for (int d0 = 0; d0 < 4; ++d0) { const LAS char* a = kr[d0];
        const bf16x8 b0 = *reinterpret_cast<const LAS bf16x8*>(a);
        const bf16x8 b1 = *reinterpret_cast<const LAS bf16x8*>(a + 32 * 128);
        const bf16x8 qf = *reinterpret_cast<const LAS bf16x8*>(qrl + d0 * 1024);
        p0 = __builtin_amdgcn_mfma_f32_32x32x16_bf16(b0, qf, p0, 0, 0, 0);
        p1 = __builtin_amdgcn_mfma_f32_32x32x16_bf16(b1, qf, p1, 0, 0, 0); }
}
template <int VB>
__device__ __forceinline__ void pv_tile(f32x16* o, int vb0, bf16x8 pa0, bf16x8 pa1, bf16x8 pa2, bf16x8 pa3) {
#define TRRD(dst, off) asm volatile("ds_read_b64_tr_b16 %0, %1 offset:%2" : "=&v"(dst) : "v"(vb0), "i"(off) : "memory")
#define PV_RD(L_, H_, ks) do { constexpr int b_ = OFF_V + VB * SHM_V + (ks) * 4096; \
        TRRD(L_[0], b_); TRRD(H_[0], b_ + 2048); TRRD(L_[1], b_ + 512); TRRD(H_[1], b_ + 512 + 2048); TRRD(L_[2], b_ + 1024); TRRD(H_[2], b_ + 1024 + 2048); TRRD(L_[3], b_ + 1536); TRRD(H_[3], b_ + 1536 + 2048); } while (0)
#define PV_MM(L_, H_, pa) do { _Pragma("unroll") for (int d0 = 0; d0 < 4; ++d0) \
        o[d0] = __builtin_amdgcn_mfma_f32_32x32x16_bf16(pa, (bf16x8){L_[d0][0], L_[d0][1], L_[d0][2], L_[d0][3], H_[d0][0], H_[d0][1], H_[d0][2], H_[d0][3]}, o[d0], 0, 0, 0); } while (0)
    s16x4 la[4], ha[4], lb[4], hb[4];
    PV_RD(la, ha, 0); PV_RD(lb, hb, 1);
    asm volatile("s_waitcnt lgkmcnt(8)" ::: "memory"); SBAR(); PV_MM(la, ha, pa0); SBAR();
    PV_RD(la, ha, 2);
    asm volatile("s_waitcnt lgkmcnt(8)" ::: "memory"); SBAR(); PV_MM(lb, hb, pa1); SBAR();
    PV_RD(lb, hb, 3);
    asm volatile("s_waitcnt lgkmcnt(8)" ::: "memory"); SBAR(); PV_MM(la, ha, pa2); SBAR();
    asm volatile("s_waitcnt lgkmcnt(0)" ::: "memory"); SBAR(); PV_MM(lb, hb, pa3);
#undef PV_MM
#undef PV_RD
#undef TRRD
}

__device__ __forceinline__ void attn_block(const Ctx& C, int b, int h, int qb) {
    LAS char* lds = (LAS char*)C.lds;
    const int tid = C.tid, wid = C.wave, lane = C.lane, r32 = lane & 31, hi = lane >> 5;
    const bf16* Qg = (const bf16*)(C.ws + WS_ARENA + AR_Q); const bf16* KVg = (const bf16*)(C.ws + WS_ARENA + AR_KV); const bf16* KPE = (const bf16*)(C.ws + WS_ARENA + AR_KPE);
    bf16* MIX = (bf16*)(C.ws + WS_MIX);
    const size_t tok0 = (size_t)b * SEQ; const int P0 = qb * 256;
    const int NT = 4 * (qb + 1), jmax = (P0 + wid * 32) >> 6;
    const bf16* kvp = KVg + tok0 * 2048 + h * 256; const bf16* kpp = KPE + tok0 * 64;
#define A_LOAD(kb, bf) do { const bf16* p_ = kvp + (size_t)(kb) * 2048; int ln_ = lane; asm volatile("" : "+v"(ln_)); \
        _Pragma("unroll") for (int i_ = 0; i_ < 2; ++i_) { const int B_ = (wid * 2 + i_) * 1024 + ln_ * 16; \
            const int row_ = B_ >> 8, c_ = ((B_ & 255) >> 4) ^ (row_ & 7); \
            const int sub_ = B_ >> 9, kk_ = (sub_ >> 2) * 8 + ((B_ & 511) >> 6), k_ = (kk_ & ~0xC) | ((kk_ & 4) << 1) | ((kk_ & 8) >> 1), cc_ = (sub_ & 3) * 32 + ((B_ & 63) >> 1); \
            __builtin_amdgcn_global_load_lds((const unsigned*)(p_ + (unsigned)(row_ * 2048 + c_ * 8)), (LAS unsigned*)(lds + OFF_K + (bf) * SHM_K + (wid * 2 + i_) * 1024), 16, 0, 0); \
            __builtin_amdgcn_global_load_lds((const unsigned*)(p_ + (unsigned)(k_ * 2048 + 128 + cc_)), (LAS unsigned*)(lds + OFF_V + (bf) * SHM_V + (wid * 2 + i_) * 1024), 16, 0, 0); } \
        { const int B_ = wid * 1024 + ln_ * 16, row_ = B_ >> 7, c_ = ((B_ & 127) >> 4) ^ (row_ & 7); \
          __builtin_amdgcn_global_load_lds((const unsigned*)(kpp + (size_t)(kb) * 64 + (unsigned)(row_ * 64 + c_ * 8)), (LAS unsigned*)(lds + OFF_KR + (bf) * SHM_KR + wid * 1024), 16, 0, 0); } } while (0)
    LAS float* wsl = (LAS float*)(lds + OFF_WS) + wid * 64; LAS float* li_l = wsl; LAS float* al_l = wsl + 32;
    float m_reg = -1e30f, l_reg = 0.f; f32x16 o[4] = {};
    const int vb0 = (int)(uintptr_t)lds + v_rd_base(lane);
    A_LOAD(0, 0); A_LOAD(64, 1);
    bf16x8 qr[8];
    LAS char* qrl = lds + OFF_QR + wid * 4096 + lane * 16;
    { const bf16* qp = Qg + (tok0 + P0 + wid * 32 + r32) * 1536 + h * 192 + hi * 8;
#pragma unroll
      for (int d0 = 0; d0 < 8; ++d0) qr[d0] = *(const bf16x8*)(qp + d0 * 16);
#pragma unroll
      for (int d0 = 0; d0 < 4; ++d0) *(LAS bf16x8*)(qrl + d0 * 1024) = *(const bf16x8*)(qp + (8 + d0) * 16); }
    asm volatile("s_waitcnt vmcnt(5)" ::: "memory");
    asm volatile("s_waitcnt lgkmcnt(0)" ::: "memory"); __builtin_amdgcn_s_barrier(); asm volatile("" ::: "memory");
    f32x16 p0, p1; float mn, al; bf16x8 pa0, pa1, pa2, pa3;
#define A_STEP(KB, tt) do { \
        if ((tt) + 2 < NT) A_LOAD(((tt) + 2) * 64, ((KB) + 2) % 3);            \
        if ((tt) <= jmax) { qkt<KB>(p0, p1, lds, r32, hi, qr, qrl); partialSM(p0, p1, m_reg, mn, al); \
            if (__any(al < 1.f)) { if (hi == 0) al_l[r32] = al; asm volatile("s_waitcnt lgkmcnt(0)" ::: "memory"); \
                _Pragma("unroll") for (int d_ = 0; d_ < 4; ++d_) _Pragma("unroll") for (int r = 0; r < 16; ++r) o[d_][r] *= al_l[crow(r, hi)]; } \
            finishSM(p0, p1, al, l_reg, pa0, pa1, pa2, pa3); SBAR(); pv_tile<KB>(o, vb0, pa0, pa1, pa2, pa3); } \
        if ((tt) + 2 < NT) { asm volatile("s_waitcnt vmcnt(5)" ::: "memory"); } else { asm volatile("s_waitcnt vmcnt(0)" ::: "memory"); }     \
        asm volatile("s_waitcnt lgkmcnt(0)" ::: "memory"); __builtin_amdgcn_s_barrier(); asm volatile("" ::: "memory"); } while (0)
    for (int t = 0; t < NT; t += 3) { A_STEP(0, t); if (t + 1 < NT) A_STEP(1, t + 1); if (t + 2 < NT) A_STEP(2, t + 2); }
#undef A_STEP
#undef A_LOAD
    if (hi == 0) li_l[r32] = l_reg;
    asm volatile("s_waitcnt lgkmcnt(0)" ::: "memory");
    float rli[16];
#pragma unroll
    for (int r = 0; r < 16; ++r) rli[r] = __builtin_amdgcn_rcpf(li_l[crow(r, hi)]);
    bf16* Ow = MIX + (tok0 + P0 + wid * 32) * DM + h * 128;
#pragma unroll
    for (int r = 0; r < 16; ++r) { const int orow = crow(r, hi);
#pragma unroll
        for (int d0 = 0; d0 < 4; ++d0) { const float v = o[d0][r] * rli[r]; const float vn = __shfl_xor(v, 1);
            if ((r32 & 1) == 0) *(unsigned*)(Ow + (size_t)orow * DM + d0 * 32 + r32) = cvt_pk_bf16(v, vn); } }
    __syncthreads();
}
#undef KSWZ
#undef KRSWZ
#undef SBAR
}

__device__ __forceinline__ void phase_attn(const Ctx& C0) {
    const Ctx C = phase_ctx(C0);
    const int x = C.bid & 7, k = C.bid >> 3, per = C.G >> 3;
    for (int u = k; u < 64; u += per) {
        const int bh = x * 8 + (u >> 3), p = u & 7;
        att::attn_block(C, bh >> 3, bh & 7, 15 - p);
        att::attn_block(C, bh >> 3, bh & 7, p);
    }
}

namespace sm {
__device__ __forceinline__ bf16x8 frag_n(const LAS char* base, int S, int x0, int k0, int lane) { return *(const LAS bf16x8*)(base + (x0 + (lane & 15)) * S + (k0 + 8 * (lane >> 4)) * 2); }
__device__ __forceinline__ bf16x8 frag_t(const LAS char* base, int S, int x0, int k0, int lane) {
    const int g = lane >> 4, q = (lane >> 2) & 3, p = lane & 3;
    const LAS char* a = base + (k0 + 8 * g + q) * S + (x0 + 4 * p) * 2;
    const s16x4 lo = __builtin_amdgcn_ds_read_tr16_b64_v4i16((LAS s16x4*)a);
    const s16x4 hi = __builtin_amdgcn_ds_read_tr16_b64_v4i16((LAS s16x4*)(a + 4 * S));
    return (bf16x8){lo[0], lo[1], lo[2], lo[3], hi[0], hi[1], hi[2], hi[3]};
}
__device__ __forceinline__ f32x4 mma(bf16x8 a, bf16x8 b, f32x4 c) { return __builtin_amdgcn_mfma_f32_16x16x32_bf16(a, b, c, 0, 0, 0); }
__device__ __forceinline__ u32x2 pack4(f32x4 v) { u32x2 w; w.x = cvt_pk_bf16(v[0], v[1]); w.y = cvt_pk_bf16(v[2], v[3]); return w; }
__device__ __forceinline__ f32x4 unpack4(u32x2 w) { return (f32x4){bf_lo(w.x), bf_hi(w.x), bf_lo(w.y), bf_hi(w.y)}; }
}

constexpr int H1LD = EVEN_N;

struct SguPre { u32x4 raw[4]; };
__device__ __forceinline__ void sgu_load(const Ctx& C, int unit, SguPre& P) {
    const int g4 = unit & 3, blk = (unit >> 2) & 31, b = unit >> 7; int tid = C.tid; asm volatile("" : "+v"(tid));
    const bf16* H1 = (const bf16*)(C.ws + WS_ARENA); const size_t t0 = (size_t)b * SEQ + blk * 128;
#pragma unroll
    for (int pp = 0; pp < 4; ++pp) P.raw[pp] = *(const u32x4*)(H1 + (t0 + pp * 32 + (tid >> 4)) * H1LD + 512 + g4 * 128 + 8 * (tid & 15));
}
__device__ __forceinline__ void sgu_setup(const Ctx& C, int ei, int g4) {
    LAS char* Wm = (LAS char*)C.lds + 34816; const float* Wg = C.inp(4) + (size_t)(ei * 4 + g4) * 128 * 128;
    f32x4 wv[8];
#pragma unroll
    for (int q = 0; q < 8; ++q) wv[q] = *(const f32x4*)(Wg + (C.tid + 512 * q) * 4);
#pragma unroll
    for (int q = 0; q < 8; ++q) { const int f = (C.tid + 512 * q) * 4, i = f >> 7, j = f & 127; *(LAS u32x2*)(Wm + i * 272 + j * 2) = sm::pack4(wv[q]); }
}
__device__ __forceinline__ void sgu_unit(const Ctx& C, int ei, int unit, SguPre& P, bool has_next, int unit_next) {
    const int g4 = unit & 3, blk = (unit >> 2) & 31, b = unit >> 7;
    int tid_ = C.tid; asm volatile("" : "+v"(tid_));
    const int tid = tid_, lane = tid & 63, w = C.wave;
    const bf16* H1 = (const bf16*)(C.ws + WS_ARENA); bf16* MIX = (bf16*)(C.ws + WS_MIX);
    LAS char* Vn = (LAS char*)C.lds; LAS char* Wm = Vn + 34816;
    const size_t t0 = (size_t)b * SEQ + blk * 128;
    const float* lng = C.inp(2) + ei * 512 + g4 * 128; const float* lnb = C.inp(3) + ei * 512 + g4 * 128;
    const float* bs = C.inp(5) + (ei * 4 + g4) * 128;
    { const int l16 = tid & 15; f32x4 ga = *(const f32x4*)(lng + 8 * l16), gb = *(const f32x4*)(lng + 8 * l16 + 4), ba = *(const f32x4*)(lnb + 8 * l16), bb = *(const f32x4*)(lnb + 8 * l16 + 4);
#pragma unroll
      for (int pp = 0; pp < 4; ++pp) { const int j = pp * 32 + (tid >> 4);
        const u32x4 raw = P.raw[pp];
        float x[8];
#pragma unroll
        for (int q = 0; q < 4; ++q) { x[2 * q] = bf_lo(raw[q]); x[2 * q + 1] = bf_hi(raw[q]); }
        float s = 0.f;
#pragma unroll
        for (int q = 0; q < 8; ++q) s += x[q];
        s += __shfl_xor(s, 1); s += __shfl_xor(s, 2); s += __shfl_xor(s, 4); s += __shfl_xor(s, 8);
        const float mean = s * (1.f / 128.f); float s2 = 0.f;
#pragma unroll
        for (int q = 0; q < 8; ++q) { x[q] -= mean; s2 += x[q] * x[q]; }
        s2 += __shfl_xor(s2, 1); s2 += __shfl_xor(s2, 2); s2 += __shfl_xor(s2, 4); s2 += __shfl_xor(s2, 8);
        const float rstd = 1.f / sqrtf(s2 * (1.f / 128.f) + LN_EPS);
        u32x4 o; o.x = cvt_pk_bf16(x[0] * rstd * ga[0] + ba[0], x[1] * rstd * ga[1] + ba[1]); o.y = cvt_pk_bf16(x[2] * rstd * ga[2] + ba[2], x[3] * rstd * ga[3] + ba[3]);
        o.z = cvt_pk_bf16(x[4] * rstd * gb[0] + bb[0], x[5] * rstd * gb[1] + bb[1]); o.w = cvt_pk_bf16(x[6] * rstd * gb[2] + bb[2], x[7] * rstd * gb[3] + bb[3]);
        *(LAS u32x4*)(Vn + j * 272 + l16 * 16) = o; } }
    lds_barrier();
    if (has_next) sgu_load(C, unit_next, P);
    const int i0 = 16 * w, nks = (w < 4) ? 2 : 4;
    bf16x8 f2[4];
#pragma unroll
    for (int ks = 0; ks < 4; ++ks) f2[ks] = sm::frag_n(Wm, 272, i0, 32 * ks, lane);
    const int i = i0 + (lane & 15), gq = lane >> 4; const float bsi = bs[i];
    const bf16* urow = H1 + (t0 + i) * H1LD + g4 * 128; bf16* orow = MIX + (t0 + i) * DM + g4 * 128;
    u32x2 uu[8];
#pragma unroll
    for (int ct = 0; ct < 8; ++ct) uu[ct] = *(const u32x2*)(urow + 16 * ct + 4 * gq);
#pragma unroll
    for (int ct = 0; ct < 8; ++ct) { f32x4 acc = (f32x4){0.f, 0.f, 0.f, 0.f};
#pragma unroll
        for (int ks = 0; ks < 4; ++ks) if (ks < nks) acc = sm::mma(sm::frag_t(Vn, 272, 16 * ct, 32 * ks, lane), f2[ks], acc);
        const int c = 16 * ct + 4 * gq; const f32x4 u = sm::unpack4(uu[ct]);
        *(u32x2*)(orow + c) = sm::pack4(u * (acc + bsi)); }
    lds_barrier();
}

namespace gdn {
#ifdef MK_TIME
#define GT_BEG(k) unsigned long long gt0_ = 0ull; if (MK_TIME == (k)) gt0_ = __builtin_amdgcn_s_memrealtime();
#define GT_END(k) if (MK_TIME == (k)) { const unsigned long long n_ = __builtin_amdgcn_s_memrealtime(); const unsigned long long e_ = n_ + 7ull * (n_ - gt0_); while (__builtin_amdgcn_s_memrealtime() < e_) __builtin_amdgcn_s_sleep(8); }
#else
#define GT_BEG(k)
#define GT_END(k)
#endif
constexpr int LF = 0, T1 = 17408, T2 = 26624, INM = 35840, VEC = 45056, QS = 46080, KS = 63488, VS = 80896, KDS = 98304, WT = 115712, UT = 133120;
__device__ __forceinline__ float silu(float x) { return x * __builtin_amdgcn_rcpf(1.0f + __expf(-x)); }
struct Pre { u32x4 r[11]; float a, b; };
constexpr int CWL = 150528, L21B = 156672, PB = 159232;
__device__ __forceinline__ void prep_load(const Ctx& C, int ei, int unit, Pre& P) {
    const int n = unit & 63, h = (unit >> 6) & 3, b = unit >> 8; int tid = C.tid; asm volatile("" : "+v"(tid)); const int w = C.wave;
    const long tok0 = (long)b * SEQ + n * 64;
    if (w < 6) { const int X = tid >> 7, t = tid & 127, ck = t & 15, strip = t >> 4;
        const bf16* hp = (const bf16*)(C.ws + WS_ARENA) + 1024 + X * 512 + h * 128 + ck * 8;
#pragma unroll
        for (int idx = 0; idx < 11; ++idx) { const int r = strip * 8 - 3 + idx;
            P.r[idx] = (u32x4){0u, 0u, 0u, 0u}; if (n * 64 + r >= 0) P.r[idx] = *(const u32x4*)(hp + (tok0 + r) * H1LD); }
    } else if (w == 6) { const float* AB = (const float*)(C.ws + WS_AB) + (tok0 + (tid & 63)) * 8; P.a = AB[h]; P.b = AB[4 + h]; }
}
__device__ __forceinline__ void prep_unit(const Ctx& C, int ei, int unit, Pre& P, bool has_next, int unit_next) {
    const int n = unit & 63, h = (unit >> 6) & 3, b = unit >> 8;
    int tid_ = C.tid; asm volatile("" : "+v"(tid_));
    const int tid = tid_, lane = tid & 63, w = C.wave;
    LAS char* L = (LAS char*)C.lds;
    LAS float* gcs = (LAS float*)(L + VEC); LAS float* bet = gcs + 64; LAS float* egs = gcs + 128; LAS float* eks = gcs + 192;
    const int chunk = (b * 4 + h) * 64 + n;
    { GT_BEG(30)
    if (w < 6) { const int X = tid >> 7, t = tid & 127, ck = t & 15, strip = t >> 4;
        LAS char* dstb = L + (X == 0 ? QS : X == 1 ? KS : VS) + (strip * 8) * 272 + ck * 16;
#pragma unroll
        for (int tt = 0; tt < 8; ++tt) { float acc[8];
#pragma unroll
            for (int q = 0; q < 8; ++q) acc[q] = 0.f;
#pragma unroll
            for (int jj = 0; jj < 4; ++jj) { const u32x4 r = P.r[tt + jj]; const LAS float* wl = (const LAS float*)(L + CWL) + jj * 384 + X * 128 + ck * 8; const f32x4 w0 = *(const LAS f32x4*)wl, w1 = *(const LAS f32x4*)(wl + 4);
                acc[0] += w0[0] * bf_lo(r[0]); acc[1] += w0[1] * bf_hi(r[0]); acc[2] += w0[2] * bf_lo(r[1]); acc[3] += w0[3] * bf_hi(r[1]);
                acc[4] += w1[0] * bf_lo(r[2]); acc[5] += w1[1] * bf_hi(r[2]); acc[6] += w1[2] * bf_lo(r[3]); acc[7] += w1[3] * bf_hi(r[3]); }
            float ss = 0.f;
#pragma unroll
            for (int q = 0; q < 8; ++q) { acc[q] = silu(acc[q]); ss += acc[q] * acc[q]; }
            float sc = 1.f;
            if (X < 2) { ss += __shfl_xor(ss, 1); ss += __shfl_xor(ss, 2); ss += __shfl_xor(ss, 4); ss += __shfl_xor(ss, 8); sc = 1.0f / sqrtf(ss + RMS_EPS); if (X == 0) sc *= 0.08838834764831845f; }
            u32x4 o; o.x = cvt_pk_bf16(acc[0] * sc, acc[1] * sc); o.y = cvt_pk_bf16(acc[2] * sc, acc[3] * sc); o.z = cvt_pk_bf16(acc[4] * sc, acc[5] * sc); o.w = cvt_pk_bf16(acc[6] * sc, acc[7] * sc);
            *(LAS u32x4*)(dstb + tt * 272) = o; }
    } else if (w == 6) {
        const float a = P.a, bb = P.b; const float alog = C.inp(7)[ei * 4 + h], dtb = C.inp(8)[ei * 4 + h];
        const float xs = a + dtb; const float sp = xs > 20.f ? xs : log1pf(__expf(xs));
        float gv = -__expf(alog) * sp;
#pragma unroll
        for (int o = 1; o < 64; o <<= 1) { const float t_ = __shfl_up(gv, o); if (lane >= o) gv += t_; }
        const float gl = __shfl(gv, 63);
        gcs[lane] = gv; bet[lane] = 1.0f / (1.0f + __expf(-bb)); egs[lane] = __expf(gv); eks[lane] = __expf(gl - gv);
        if (lane == 0) ((float*)(C.ws + WS_GAM))[chunk] = __expf(gl); }
    GT_END(30) }
    lds_barrier();
    { GT_BEG(31)
    { const int i = tid >> 3, dc = (tid & 7) * 16; const float e = eks[i];
#pragma unroll
      for (int hh = 0; hh < 2; ++hh) { const u32x4 r = *(const LAS u32x4*)(L + KS + i * 272 + dc * 2 + 16 * hh); u32x4 o;
#pragma unroll
        for (int q = 0; q < 4; ++q) o[q] = cvt_pk_bf16(bf_lo(r[q]) * e, bf_hi(r[q]) * e);
        *(LAS u32x4*)(L + KDS + i * 272 + dc * 2 + 16 * hh) = o; } }
#pragma unroll
    for (int q = 0; q < 2; ++q) { const int tt = 2 * w + q, it = tt >> 2, jt = tt & 3;
        if (jt <= it) { f32x4 acc = (f32x4){0.f, 0.f, 0.f, 0.f};
#pragma unroll
            for (int ks = 0; ks < 4; ++ks) acc = sm::mma(sm::frag_n(L + KS, 272, 16 * jt, 32 * ks, lane), sm::frag_n(L + KS, 272, 16 * it, 32 * ks, lane), acc);
            const int i = 16 * it + (lane & 15), j0 = 16 * jt + 4 * (lane >> 4); const float gi = gcs[i], bi = bet[i]; f32x4 o;
#pragma unroll
            for (int r = 0; r < 4; ++r) o[r] = (i > j0 + r) ? bi * acc[r] * __expf(gi - gcs[j0 + r]) : 0.f;
            *(LAS f32x4*)(L + LF + (i * 68 + j0) * 4) = o; } }
    GT_END(31) }
    lds_barrier();
    if (has_next) prep_load(C, ei, unit_next, P);
    { GT_BEG(32)
    if (w >= 6) {
        const int o = (w == 7) ? 32 : 0, jl = lane & 31;
        float t[32];
#pragma unroll
        for (int i = 0; i < 32; ++i) t[i] = 0.f;
#pragma unroll
        for (int i = 0; i < 32; ++i) { float s0 = 0.f, s1 = 0.f, s2 = 0.f, s3 = 0.f;
#pragma unroll
            for (int m = 0; m < i; m += 4) { const f32x4 l = *(const LAS f32x4*)(L + LF + ((o + i) * 68 + o + m) * 4); s0 += l[0] * t[m]; s1 += l[1] * t[m + 1]; s2 += l[2] * t[m + 2]; s3 += l[3] * t[m + 3]; }
            t[i] = ((jl == i) ? 1.f : 0.f) - ((s0 + s1) + (s2 + s3)); }
        if (lane < 32) {
#pragma unroll
            for (int i = 0; i < 32; ++i) *(LAS bf16*)(L + T2 + (o + i) * 144 + (o + jl) * 2) = f2bf(t[i]); }
    } else {
#pragma unroll
        for (int q3 = 0; q3 < 3; ++q3) { const int tt = w + 6 * q3; if (tt >= 16) break; const int it = tt >> 2, jt = tt & 3; f32x4 acc = (f32x4){0.f, 0.f, 0.f, 0.f};
            if (jt <= it) {
#pragma unroll
                for (int ks = 0; ks < 4; ++ks) acc = sm::mma(sm::frag_n(L + KS, 272, 16 * jt, 32 * ks, lane), sm::frag_n(L + QS, 272, 16 * it, 32 * ks, lane), acc); }
            const int i = 16 * it + (lane & 15), j0 = 16 * jt + 4 * (lane >> 4); const float gi = gcs[i]; f32x4 o;
#pragma unroll
            for (int r = 0; r < 4; ++r) o[r] = (i >= j0 + r) ? acc[r] * __expf(gi - gcs[j0 + r]) : 0.f;
            *(LAS u32x2*)(L + INM + i * 144 + j0 * 2) = sm::pack4(o); }
        for (int idx = tid; idx < 1024; idx += 384) { const int i = idx >> 5, k = idx & 31; *(LAS bf16*)(L + L21B + i * 80 + k * 2) = f2bf(*(const LAS float*)(L + LF + ((32 + i) * 68 + k) * 4)); }
    }
    lds_barrier();
    if (w < 4) { const int it = w >> 1, jt = w & 1;
        const f32x4 acc = sm::mma(sm::frag_t(L + T2, 144, 16 * jt, 0, lane), sm::frag_n(L + L21B, 80, 16 * it, 0, lane), (f32x4){0.f, 0.f, 0.f, 0.f});
        *(LAS u32x2*)(L + PB + (16 * it + (lane & 15)) * 80 + (16 * jt + 4 * (lane >> 4)) * 2) = sm::pack4(acc); }
    lds_barrier();
    if (w < 4) { const int it = w >> 1, jt = w & 1;
        const f32x4 acc = sm::mma(sm::frag_t(L + PB, 80, 16 * jt, 0, lane), sm::frag_n(L + T2 + 32 * 144 + 64, 144, 16 * it, 0, lane), (f32x4){0.f, 0.f, 0.f, 0.f});
        *(LAS u32x2*)(L + T2 + (32 + 16 * it + (lane & 15)) * 144 + (16 * jt + 4 * (lane >> 4)) * 2) = sm::pack4(-acc); }
    lds_barrier();
    for (int idx = tid; idx < 64 * 16; idx += NWAVES * 64) { const int i = idx >> 4, j4 = (idx & 15) * 4;
        const f32x4 tv = sm::unpack4(*(const LAS u32x2*)(L + T2 + i * 144 + j4 * 2)); f32x4 a, bq;
#pragma unroll
        for (int r = 0; r < 4; ++r) { const int j = j4 + r; const float t = (i < 32 && j >= 32) ? 0.f : tv[r]; const float bj = bet[j]; bq[r] = t * bj; a[r] = bq[r] * egs[j]; }
        *(LAS u32x2*)(L + T1 + i * 144 + j4 * 2) = sm::pack4(a); *(LAS u32x2*)(L + T2 + i * 144 + j4 * 2) = sm::pack4(bq); }
    GT_END(32) }
    lds_barrier();
    int tl272 = (8 * (lane >> 4) + ((lane >> 2) & 3)) * 272 + 8 * (lane & 3), nl144 = (lane & 15) * 144 + 16 * (lane >> 4);
    asm volatile("" : "+v"(tl272), "+v"(nl144));
    auto ft_ = [&](const LAS char* bp, int x0, int k0) -> bf16x8 {
        const LAS char* a = bp + k0 * 272 + x0 * 2;
        const s16x4 lo = __builtin_amdgcn_ds_read_tr16_b64_v4i16((LAS s16x4*)a); const s16x4 hi = __builtin_amdgcn_ds_read_tr16_b64_v4i16((LAS s16x4*)(a + 4 * 272));
        return (bf16x8){lo[0], lo[1], lo[2], lo[3], hi[0], hi[1], hi[2], hi[3]}; };
    auto fn_ = [&](const LAS char* bp, int x0, int k0) -> bf16x8 { return *(const LAS bf16x8*)(bp + x0 * 144 + k0 * 2); };
    const f32x4 z4 = (f32x4){0.f, 0.f, 0.f, 0.f};
    { GT_BEG(33)
    { const int which = w >> 2, xb = (w & 3) * 2;
      int so = (which ? VS : KS) + tl272, to = (which ? T2 : T1) + nl144, oo = (which ? UT : WT) + (lane & 15) * 272 + 8 * (lane >> 4);
      asm volatile("" : "+v"(so), "+v"(to), "+v"(oo));
      const LAS char* sp = L + so; const LAS char* tp = L + to; LAS char* op = L + oo;
      bf16x8 fs[2][2], ftm[4][2];
#pragma unroll
      for (int xi = 0; xi < 2; ++xi)
#pragma unroll
          for (int ks = 0; ks < 2; ++ks) fs[xi][ks] = ft_(sp, 16 * (xb + xi), 32 * ks);
#pragma unroll
      for (int it = 0; it < 4; ++it)
#pragma unroll
          for (int ks = 0; ks < 2; ++ks) ftm[it][ks] = fn_(tp, 16 * it, 32 * ks);
      f32x4 acc[2][4];
#pragma unroll
      for (int xi = 0; xi < 2; ++xi)
#pragma unroll
          for (int it = 0; it < 4; ++it) { acc[xi][it] = sm::mma(fs[xi][0], ftm[it][0], z4); acc[xi][it] = sm::mma(fs[xi][1], ftm[it][1], acc[xi][it]); }
#pragma unroll
      for (int xi = 0; xi < 2; ++xi)
#pragma unroll
          for (int it = 0; it < 4; ++it) *(LAS u32x2*)(op + (16 * it) * 272 + (16 * (xb + xi)) * 2) = sm::pack4(acc[xi][it]); }
    GT_END(33) }
    lds_barrier();
    { GT_BEG(34)
    { bf16* Mg = (bf16*)(C.ws + WS_GM) + (size_t)chunk * 16384; bf16* Bg = (bf16*)(C.ws + WS_GB) + (size_t)chunk * 16384;
      bf16* Cg = (bf16*)(C.ws + WS_GC) + (size_t)chunk * 8192; bf16* Dg = (bf16*)(C.ws + WS_GD) + (size_t)chunk * 8192;
      const int x2 = lane & 15, x1 = 4 * (lane >> 4);
      int wo = WT + tl272, ko = KDS + tl272, uo = UT + tl272, io = INM + nl144;
      asm volatile("" : "+v"(wo), "+v"(ko), "+v"(uo), "+v"(io));
      const LAS char* wp = L + wo; const LAS char* kp = L + ko; const LAS char* up = L + uo; const LAS char* ip = L + io;
      const bf16x8 fw0 = ft_(wp, 16 * w, 0), fw1 = ft_(wp, 16 * w, 32), fa0 = ft_(kp, 16 * w, 0), fa1 = ft_(kp, 16 * w, 32);
#pragma unroll
      for (int hb = 0; hb < 2; ++hb) {
          bf16x8 kb[4][2], fu[4][2];
#pragma unroll
          for (int j = 0; j < 4; ++j)
#pragma unroll
              for (int ks = 0; ks < 2; ++ks) { kb[j][ks] = ft_(kp, 16 * (hb * 4 + j), 32 * ks); fu[j][ks] = ft_(up, 16 * (hb * 4 + j), 32 * ks); }
          f32x4 am[4], ab[4];
#pragma unroll
          for (int j = 0; j < 4; ++j) { am[j] = sm::mma(fw0, kb[j][0], z4); am[j] = sm::mma(fw1, kb[j][1], am[j]);
                                        ab[j] = sm::mma(fa0, fu[j][0], z4); ab[j] = sm::mma(fa1, fu[j][1], ab[j]); }
#pragma unroll
          for (int j = 0; j < 4; ++j) { const int bt = hb * 4 + j;
              *(u32x2*)(Mg + (16 * bt + x2) * 128 + 16 * w + x1) = sm::pack4(-am[j]);
              *(u32x2*)(Bg + (16 * bt + x2) * 128 + 16 * w + x1) = sm::pack4(ab[j]); } }
      { const bf16x8 fu0 = ft_(up, 16 * w, 0), fu1 = ft_(up, 16 * w, 32);
        bf16x8 fin[4][2]; u32x2 qr[4]; float eg[4];
#pragma unroll
        for (int it = 0; it < 4; ++it) { fin[it][0] = fn_(ip, 16 * it, 0); fin[it][1] = fn_(ip, 16 * it, 32);
            qr[it] = *(const LAS u32x2*)(L + QS + (16 * it + x2) * 272 + (16 * w + x1) * 2); eg[it] = egs[16 * it + x2]; }
        f32x4 ac[4], ad[4];
#pragma unroll
        for (int it = 0; it < 4; ++it) { ac[it] = sm::mma(fw0, fin[it][0], z4); ac[it] = sm::mma(fw1, fin[it][1], ac[it]);
                                         ad[it] = sm::mma(fu0, fin[it][0], z4); ad[it] = sm::mma(fu1, fin[it][1], ad[it]); }
#pragma unroll
        for (int it = 0; it < 4; ++it) { const int i = 16 * it + x2, d = 16 * w + x1;
            *(u32x2*)(Cg + i * 128 + d) = sm::pack4(sm::unpack4(qr[it]) * eg[it] - ac[it]);
            *(u32x2*)(Dg + i * 128 + d) = sm::pack4(ad[it]); } } }
    GT_END(34) }
#ifdef DBG_DUMP
    { unsigned char* dst = C.ws + WS_HID + (size_t)chunk * 150528; for (int o = tid * 16; o < 150528; o += 512 * 16) *(u32x4*)(dst + o) = *(const LAS u32x4*)(L + o); }
#endif
    lds_barrier();
}

__device__ __forceinline__ void scan_unit(const Ctx& C, int unit) {
    const int cs = unit & 7, bh = unit >> 3;
    const int lane = C.lane, w = C.wave, x2 = lane & 15, g = lane >> 4;
    LAS char* ST = (LAS char*)C.lds;
    LAS char* MR = ST + 9216;
    LAS char* BR = MR + 4 * 32768;
    LAS float* GL = (LAS float*)(BR + 4 * 4096);
    static_assert(9216 + 4 * 32768 + 4 * 4096 + 256 <= LDS_CTL_OFF, "scan LDS map");
    const bf16* Mg = (const bf16*)(C.ws + WS_GM) + (size_t)bh * 64 * 16384; const bf16* Bg = (const bf16*)(C.ws + WS_GB) + (size_t)bh * 64 * 16384 + (size_t)cs * 16 * 128;
    bf16* Sg = (bf16*)(C.ws + WS_GS) + (size_t)bh * 64 * 16384; const float* GAM = (const float*)(C.ws + WS_GAM) + bh * 64;
    const int c = cs * 16 + x2, d0 = 16 * w + 4 * g;
    { unsigned zz = 0u; asm volatile("" : "+v"(zz));
      if (C.tid < 272) *(LAS u32x4*)(ST + C.tid * 16) = (u32x4){zz, zz, zz, zz};
      if (C.tid < 64) GL[C.tid] = GAM[C.tid]; }
    unsigned moff[4];
#pragma unroll
    for (int q = 0; q < 4; ++q) { const int r = 4 * q + (lane >> 4), cp = lane & 15; moff[q] = (unsigned)((16 * w + r) * 128 + ((cp ^ r) & 15) * 8); }
    const unsigned boff = (unsigned)((4 * (w & 3) + (lane >> 4)) * 128 + (lane & 15) * 8);
#define SC_ISSUE(n_) do { const bf16* mp_ = Mg + (size_t)(n_) * 16384; const int sl_ = (n_) & 3; \
        _Pragma("unroll") for (int q = 0; q < 4; ++q) __builtin_amdgcn_global_load_lds((const unsigned*)(mp_ + moff[q]), (LAS unsigned*)(MR + sl_ * 32768 + w * 4096 + q * 1024), 16, 0, 0); \
        __builtin_amdgcn_global_load_lds((const unsigned*)(Bg + (size_t)(n_) * 16384 + boff), (LAS unsigned*)(BR + sl_ * 4096 + (w & 3) * 1024), 16, 0, 0); } while (0)
    __syncthreads();
    SC_ISSUE(0); SC_ISSUE(1); SC_ISSUE(2);
    asm volatile("s_waitcnt vmcnt(10)" ::: "memory"); lds_barrier();
    f32x4 acc = (f32x4){0.f, 0.f, 0.f, 0.f};
    bf16* srow = Sg + c * 128 + d0;
    const LAS char* mrd = MR + w * 4096 + x2 * 256; const LAS char* brd = BR + x2 * 256 + d0 * 2;
#define SC_STEP(n_, SP) do { const int sl_ = (n_) & 3; \
        SP = sm::pack4(acc);                                   \
        f32x4 a_ = acc * GL[n_] + sm::unpack4(*(const LAS u32x2*)(brd + sl_ * 4096)); const LAS char* sb_ = ST + ((n_) & 1) * 4352; \
        _Pragma("unroll") for (int ks = 0; ks < 4; ++ks) a_ = sm::mma(*(const LAS bf16x8*)(mrd + sl_ * 32768 + (((4 * ks + g) ^ x2) & 15) * 16), sm::frag_n(sb_, 272, 0, 32 * ks, lane), a_); \
        acc = a_; *(LAS u32x2*)(ST + (((n_) + 1) & 1) * 4352 + x2 * 272 + d0 * 2) = sm::pack4(acc); \
        if ((n_) + 3 < 64) { SC_ISSUE((n_) + 3); asm volatile("s_waitcnt vmcnt(10)" ::: "memory"); }        \
        else if ((n_) + 2 < 64) { asm volatile("s_waitcnt vmcnt(5)" ::: "memory"); } else { asm volatile("s_waitcnt vmcnt(0)" ::: "memory"); } \
        lds_barrier(); } while (0)
#pragma unroll 1
    for (int n = 0; n < 64; n += 8) { u32x2 sp[8];
        SC_STEP(n, sp[0]); SC_STEP(n + 1, sp[1]); SC_STEP(n + 2, sp[2]); SC_STEP(n + 3, sp[3]); SC_STEP(n + 4, sp[4]); SC_STEP(n + 5, sp[5]); SC_STEP(n + 6, sp[6]); SC_STEP(n + 7, sp[7]);
#pragma unroll
        for (int k = 0; k < 8; ++k) *(u32x2*)(srow + (size_t)(n + k) * 16384) = sp[k]; }
#undef SC_ISSUE
#undef SC_STEP
}

__device__ __forceinline__ void out_unit(const Ctx& C, int ei, int unit) {
    const int pr = unit & 31, h = (unit >> 5) & 3, b = unit >> 7;
    const int lane = C.lane, w = C.wave, x2 = lane & 15, g = lane >> 4;
    const int n = 2 * pr + (w >> 2), it = w & 3, chunk = (b * 4 + h) * 64 + n;
    const bf16* Sg = (const bf16*)(C.ws + WS_GS) + (size_t)chunk * 16384; const bf16* Cg = (const bf16*)(C.ws + WS_GC) + (size_t)chunk * 8192; const bf16* Dg = (const bf16*)(C.ws + WS_GD) + (size_t)chunk * 8192;
    const bf16* H1 = (const bf16*)(C.ws + WS_ARENA); bf16* MIX = (bf16*)(C.ws + WS_MIX);
    const int i = 16 * it + x2; const size_t tok = (size_t)b * SEQ + n * 64 + i;
    bf16x8 fc[4];
#pragma unroll
    for (int ks = 0; ks < 4; ++ks) fc[ks] = *(const bf16x8*)(Cg + i * 128 + 32 * ks + 8 * g);
    f32x4 o[8]; float ss = 0.f;
#pragma unroll
    for (int ct = 0; ct < 8; ++ct) { f32x4 a = sm::unpack4(*(const u32x2*)(Dg + i * 128 + 16 * ct + 4 * g));
#pragma unroll
        for (int ks = 0; ks < 4; ++ks) a = sm::mma(*(const bf16x8*)(Sg + (16 * ct + x2) * 128 + 32 * ks + 8 * g), fc[ks], a);
        o[ct] = a; ss += (a[0] * a[0] + a[1] * a[1]) + (a[2] * a[2] + a[3] * a[3]); }
    ss += __shfl_xor(ss, 16); ss += __shfl_xor(ss, 32);
    const float rstd = 1.0f / sqrtf(ss * (1.f / 128.f) + RMS_EPS);
    const float* nw = C.inp(9) + ei * 128; const bf16* zrow = H1 + tok * H1LD + 2560 + h * 128; bf16* orow = MIX + tok * DM + 512 + h * 128;
#pragma unroll
    for (int ct = 0; ct < 8; ++ct) { const int c = 16 * ct + 4 * g; const f32x4 z = sm::unpack4(*(const u32x2*)(zrow + c)); const f32x4 nv = *(const f32x4*)(nw + c); f32x4 y;
#pragma unroll
        for (int r = 0; r < 4; ++r) y[r] = o[ct][r] * rstd * nv[r] * silu(z[r]);
        *(u32x2*)(orow + c) = sm::pack4(y); }
}
}

__device__ __forceinline__ void phase_even_local(const Ctx& C0, int ei) {
    { const Ctx C = phase_ctx(C0);
#ifdef MK_TIME
      unsigned long long st0_ = 0ull; if (MK_TIME == 35) st0_ = __builtin_amdgcn_s_memrealtime();
#endif
      SguPre SP; int u = C.bid; if (u < 1024) { sgu_load(C, u, SP); sgu_setup(C, ei, u & 3); }
      for (; u < 1024; u += C.G) sgu_unit(C, ei, u, SP, u + C.G < 1024, u + C.G);
#ifdef MK_TIME
      if (MK_TIME == 35) { const unsigned long long n_ = __builtin_amdgcn_s_memrealtime(); const unsigned long long e_ = n_ + 7ull * (n_ - st0_); while (__builtin_amdgcn_s_memrealtime() < e_) __builtin_amdgcn_s_sleep(8); }
#endif
    }
    { const Ctx C = phase_ctx(C0); gdn::Pre P; int u = C.bid; if (u < 2048) gdn::prep_load(C, ei, u, P);
      { const int h = (C.bid >> 6) & 3; const float* cw = C.inp(6) + (size_t)ei * 4 * 1536;
#pragma unroll
        for (int idx = C.tid; idx < 4 * 384; idx += NWAVES * 64) { const int jj = idx / 384, c = idx % 384; ((LAS float*)(C.lds + gdn::CWL))[idx] = cw[jj * 1536 + (c >> 7) * 512 + h * 128 + (c & 127)]; }
        lds_barrier(); }
      for (; u < 2048; u += C.G) gdn::prep_unit(C, ei, u, P, u + C.G < 2048, u + C.G); }
}
__device__ __forceinline__ void phase_scan(const Ctx& C0) { const Ctx C = phase_ctx(C0);
    for (int v = C.bid; v < 256; v += C.G) { const int x = v & 7, k = v >> 3, u = ((x * 4 + (k >> 3)) << 3) | (k & 7); gdn::scan_unit(C, u); __syncthreads(); } }
__device__ __forceinline__ void phase_gdn_out(const Ctx& C0, int ei) {
    const Ctx C = phase_ctx(C0);
    const int lane = C.lane, w = C.wave, x2 = lane & 15, g = lane >> 4, cc = w >> 2, it = w & 3;
    LAS char* L = (LAS char*)C.lds; LAS float* NW = (LAS float*)(L + 131072);
    if (C.tid < 32) *(LAS f32x4*)(NW + 4 * C.tid) = *(const f32x4*)(C.inp(9) + ei * 128 + 4 * C.tid);
    unsigned soff[4];
#pragma unroll
    for (int j = 0; j < 4; ++j) { const int r = 32 * it + 4 * j + (lane >> 4), cp = lane & 15; soff[j] = (unsigned)(r * 256 + ((cp ^ r) & 15) * 16); }
    const bf16* H1 = (const bf16*)(C.ws + WS_ARENA); bf16* MIX = (bf16*)(C.ws + WS_MIX);
#define GO_ISSUE(unit_, buf_) do { const int pr_ = (unit_) & 31, h_ = ((unit_) >> 5) & 3, b_ = (unit_) >> 7; \
        const char* sg_ = (const char*)(C.ws + WS_GS) + (size_t)((b_ * 4 + h_) * 64 + 2 * pr_ + cc) * 32768; \
        _Pragma("unroll") for (int j = 0; j < 8; ++j) __builtin_amdgcn_global_load_lds((const unsigned*)(sg_ + soff[j & 3] + (j >> 2) * 4096), (LAS unsigned*)(L + (buf_) * 65536 + cc * 32768 + (32 * it + 4 * j) * 256), 16, 0, 0); } while (0)
#define GO_REGS(unit_, FC, DD, ZZ) do { const int pr_ = (unit_) & 31, h_ = ((unit_) >> 5) & 3, b_ = (unit_) >> 7; const int n_ = 2 * pr_ + cc, chunk_ = (b_ * 4 + h_) * 64 + n_, i_ = 16 * it + x2; \
        const bf16* cg_ = (const bf16*)(C.ws + WS_GC) + (size_t)chunk_ * 8192 + i_ * 128; const bf16* dg_ = (const bf16*)(C.ws + WS_GD) + (size_t)chunk_ * 8192 + i_ * 128; \
        const bf16* zr_ = H1 + ((size_t)b_ * SEQ + n_ * 64 + i_) * H1LD + 2560 + h_ * 128; \
        _Pragma("unroll") for (int ks = 0; ks < 4; ++ks) FC[ks] = *(const bf16x8*)(cg_ + 32 * ks + 8 * g); \
        _Pragma("unroll") for (int ct = 0; ct < 8; ++ct) { DD[ct] = *(const u32x2*)(dg_ + 16 * ct + 4 * g); ZZ[ct] = *(const u32x2*)(zr_ + 16 * ct + 4 * g); } } while (0)
#define GO_COMPUTE(unit_, buf_, FC, DD, ZZ) do { \
        const int pr = (unit_) & 31, h = ((unit_) >> 5) & 3, b = (unit_) >> 7; const int n = 2 * pr + cc, i = 16 * it + x2; const size_t tok = (size_t)b * SEQ + n * 64 + i; \
        const LAS char* sb = L + (buf_) * 65536 + cc * 32768 + x2 * 256; \
        f32x4 o[8]; float ss = 0.f; \
        _Pragma("unroll") for (int ct = 0; ct < 8; ++ct) { f32x4 a = sm::unpack4(DD[ct]); \
            _Pragma("unroll") for (int ks = 0; ks < 4; ++ks) a = sm::mma(*(const LAS bf16x8*)(sb + ct * 4096 + (((4 * ks + g) ^ x2) & 15) * 16), FC[ks], a); \
            o[ct] = a; ss += (a[0] * a[0] + a[1] * a[1]) + (a[2] * a[2] + a[3] * a[3]); } \
        ss += __shfl_xor(ss, 16); ss += __shfl_xor(ss, 32); \
        const float rstd = 1.0f / sqrtf(ss * (1.f / 128.f) + RMS_EPS); \
        bf16* orow = MIX + tok * DM + 512 + h * 128; \
        _Pragma("unroll") for (int ct = 0; ct < 8; ++ct) { const int c = 16 * ct + 4 * g; const f32x4 z = sm::unpack4(ZZ[ct]); const f32x4 nv = *(const LAS f32x4*)(NW + c); f32x4 y; \
            _Pragma("unroll") for (int r = 0; r < 4; ++r) y[r] = o[ct][r] * rstd * nv[r] * gdn::silu(z[r]); \
            *(u32x2*)(orow + c) = sm::pack4(y); } } while (0)
    int u = C.bid;
    bf16x8 fcA[4], fcB[4]; u32x2 dA[8], zA[8], dB[8], zB[8];
    if (u < 1024) { GO_ISSUE(u, 0); GO_REGS(u, fcA, dA, zA);
#pragma unroll 1
      for (;;) {
        int un = u + C.G;
        if (un < 1024) { GO_ISSUE(un, 1); GO_REGS(un, fcB, dB, zB); asm volatile("s_waitcnt vmcnt(28)" ::: "memory"); lds_barrier(); GO_COMPUTE(u, 0, fcA, dA, zA); lds_barrier(); }
        else { asm volatile("s_waitcnt vmcnt(0)" ::: "memory"); lds_barrier(); GO_COMPUTE(u, 0, fcA, dA, zA); break; }
        u = un; un = u + C.G;
        if (un < 1024) { GO_ISSUE(un, 0); GO_REGS(un, fcA, dA, zA); asm volatile("s_waitcnt vmcnt(28)" ::: "memory"); lds_barrier(); GO_COMPUTE(u, 1, fcB, dB, zB); lds_barrier(); }
        else { asm volatile("s_waitcnt vmcnt(0)" ::: "memory"); lds_barrier(); GO_COMPUTE(u, 1, fcB, dB, zB); break; }
        u = un; } }
#undef GO_COMPUTE
#undef GO_ISSUE
#undef GO_REGS
}

#ifndef MK_PER_PHASE
#define MK_PER_PHASE 0
#endif
constexpr int N_PHASES = 1 + DEPTH * 9;
#ifndef PH_EN
#define PH_EN 0x7fff
#endif
#define PEN(k) ((PH_EN >> (k)) & 1)
#ifndef MK_REP
#define MK_REP -1
#endif
#ifdef MK_TIME
#define TBEG(k) unsigned long long t0_ = 0ull; if (MK_TIME == (k)) t0_ = __builtin_amdgcn_s_memrealtime();
#define TEND(k) if (MK_TIME == (k)) { const unsigned long long n_ = __builtin_amdgcn_s_memrealtime(); const unsigned long long e_ = n_ + 7ull * (n_ - t0_); while (__builtin_amdgcn_s_memrealtime() < e_) __builtin_amdgcn_s_sleep(8); }
#else
#define TBEG(k)
#define TEND(k)
#endif
#define REPF(k) for (int r_ = 0; r_ < ((MK_REP == (k)) ? 2 : 1); ++r_)
struct Args { const float* in[27]; float* out; unsigned char* ws; int ph_lo, ph_hi; };

__global__ void __launch_bounds__(NWAVES * 64, 2) mk_fwd(Args args) {
    extern __shared__ __attribute__((aligned(16))) unsigned char lds_raw[];
    Ctx C;
    C.lds = (LAS unsigned char*)lds_raw;
    C.tid = threadIdx.x; C.lane = C.tid & 63; C.wave = __builtin_amdgcn_readfirstlane(C.tid >> 6); C.G = gridDim.x; C.bid = blockIdx.x;
    C.ka = (const __attribute__((address_space(4))) char*)__builtin_amdgcn_kernarg_segment_ptr();
    C.out = nullptr; C.ws = nullptr; C.ctl = nullptr;
    for (int u = C.tid; u < 128; u += NWAVES * 64) ((LAS unsigned*)(C.lds + LDS_CTL_OFF))[u] = 0u;
    __syncthreads();
#if !MK_PER_PHASE
    { const Ctx P = phase_ctx(C); (void)xcd_barrier_post((unsigned*)P.ws + CW_BAR, (volatile LAS unsigned*)(C.lds + LDS_CTL_OFF) + 8, P.tid == 0); }
#define GRID_BAR() do { const Ctx P_ = phase_ctx(C); XcdBarrier b_; b_.bar = (unsigned*)P_.ws + CW_BAR; b_.x = xb_xcc_id(); b_.st = (volatile LAS unsigned*)(C.lds + LDS_CTL_OFF) + 8; xcd_barrier(b_, P_.tid == 0); } while (0)
#else
#define GRID_BAR() do {} while (0)
#endif
    const int lo = args.ph_lo, hi = args.ph_hi;
#define IN(k) (lo <= (k) && (k) < hi)
#if defined(MK_REP) && MK_REP == 60
#define SEAM(k) do { if (IN((k) + 1)) { GRID_BAR(); GRID_BAR(); GRID_BAR(); } } while (0)
#else
#define SEAM(k) do { if (IN((k) + 1)) GRID_BAR(); } while (0)
#endif
    if (PEN(0) && IN(0)) { TBEG(0) REPF(0) phase_prologue(C); TEND(0) SEAM(0); }
#define MK_LAYER(L) { \
        const int pb = 1 + L * 9, li = L >> 1; \
        if ((L & 1) == 0) { \
            if (PEN(1) && IN(pb + 0)) { TBEG(1) \
                const Ctx P = phase_ctx(C); unsigned char* ws = P.ws; \
                EpiBf16 E{(bf16*)(ws + WS_ARENA), EVEN_N, 1024}; \
                REPF(1) run_plain_gemm(P, (const bf16*)(ws + WS_XB), DM, DM, EVEN_N, (const bf16*)(ws + WS_WEIN) + (size_t)li * EVEN_N * DM, E); \
                TEND(1) SEAM(pb + 0); } \
            if (PEN(2) && IN(pb + 1)) { TBEG(2) REPF(2) phase_even_local(C, li); TEND(2) SEAM(pb + 1); } \
            if (PEN(3) && IN(pb + 2)) { TBEG(3) REPF(3) phase_scan(C); TEND(3) SEAM(pb + 2); } \
            if (PEN(4) && IN(pb + 3)) { TBEG(4) REPF(4) phase_gdn_out(C, li); TEND(4) SEAM(pb + 3); } \
            if (PEN(5) && IN(pb + 4)) { TBEG(5) \
                const Ctx P = phase_ctx(C); unsigned char* ws = P.ws; \
                EpiRes E{(const bf16*)(ws + WS_XB), (bf16*)(ws + WS_Y)}; \
                REPF(5) run_plain_gemm(P, (const bf16*)(ws + WS_MIX), DM, DM, DM, (const bf16*)(ws + WS_WEOUT) + (size_t)li * DM * DM, E); \
                TEND(5) SEAM(pb + 4); } \
        } else { \
            if (PEN(6) && IN(pb + 0)) { TBEG(6) \
                const Ctx P = phase_ctx(C); unsigned char* ws = P.ws; \
                EpiO1 E{(bf16*)(ws + WS_ARENA + AR_C1), (float*)(ws + WS_XF), (bf16*)(ws + WS_ARENA + AR_KPE), (const f32x4*)(ws + WS_ROPE)}; \
                REPF(6) run_plain_gemm(P, (const bf16*)(ws + WS_XB), DM, DM, ODD_N, (const bf16*)(ws + WS_WOIN) + (size_t)li * ODD_N * DM, E); \
                TEND(6) SEAM(pb + 0); } \
            if (PEN(8) && IN(pb + 2)) { TBEG(8) \
                { const Ctx P = phase_ctx(C); unsigned char* ws = P.ws; \
                  EpiQ E{(bf16*)(ws + WS_ARENA + AR_Q), nullptr, (const f32x4*)(ws + WS_ROPE)}; \
                  REPF(8) run_scaled_gemm(P, (const bf16*)(ws + WS_ARENA + AR_C1), ODD_N, QL, 1536, (const bf16*)(ws + WS_WUQ) + (size_t)li * 1536 * QL, E, (const float*)(ws + WS_XF), 0, 1.0f / QL); } \
                { const Ctx P = phase_ctx(C); unsigned char* ws = P.ws; \
                  EpiKV E{(bf16*)(ws + WS_ARENA + AR_KV), nullptr}; \
                  REPF(8) run_scaled_gemm(P, (const bf16*)(ws + WS_ARENA + AR_C1) + QL, ODD_N, KVL, 2048, (const bf16*)(ws + WS_WUKV) + (size_t)li * 2048 * KVL, E, (const float*)(ws + WS_XF), 1, 1.0f / KVL); } \
                TEND(8) SEAM(pb + 2); } \
            if (PEN(9) && IN(pb + 3)) { TBEG(9) REPF(9) phase_attn(C); TEND(9) SEAM(pb + 3); } \
            if (PEN(10) && IN(pb + 4)) { TBEG(10) \
                const Ctx P = phase_ctx(C); unsigned char* ws = P.ws; \
                EpiRes E{(const bf16*)(ws + WS_XB), (bf16*)(ws + WS_Y)}; \
                REPF(10) run_plain_gemm(P, (const bf16*)(ws + WS_MIX), DM, DM, DM, (const bf16*)(ws + WS_WOOUT) + (size_t)li * DM * DM, E); \
                TEND(10) SEAM(pb + 4); } \
        } \
        if (PEN(11) && IN(pb + 5)) { TBEG(11) phase_router(C, L); TEND(11) SEAM(pb + 5); } \
        if (PEN(12) && IN(pb + 6)) { TBEG(12) \
            const Ctx P = phase_ctx(C); unsigned char* ws = P.ws; \
            EpiSwiglu E{(bf16*)(ws + WS_HID), (const LAS bf16*)(P.lds + MOE1_BIAS_OFF), nullptr, nullptr}; \
            REPF(12) run_moe_gemm<1>(P, L, (const bf16*)(ws + WS_XB), DM, 2, DM, 2048, (const bf16*)(ws + WS_WGU) + (size_t)L * NEXP * 2048 * DM, (size_t)2048 * DM, P.inp(24) + (size_t)L * NEXP * 2048, E); \
            TEND(12) SEAM(pb + 6); } \
        if (PEN(13) && IN(pb + 7)) { TBEG(13) \
            const Ctx P = phase_ctx(C); unsigned char* ws = P.ws; \
            EpiDown E{(bf16*)(ws + WS_YE), (const LAS float*)(P.lds + MOE2_BIAS_OFF), (const LAS float*)(P.lds + MOE2_GATE_OFF), nullptr}; \
            REPF(13) run_moe_gemm<2>(P, L, (const bf16*)(ws + WS_HID), DFF, 0, DFF, DM, (const bf16*)(ws + WS_WDN) + (size_t)L * NEXP * DM * DFF, (size_t)DM * DFF, P.inp(26) + (size_t)L * NEXP * DM, E); \
            TEND(13) SEAM(pb + 7); } \
        if (PEN(14) && IN(pb + 8)) { TBEG(14) phase_combine(C, L); TEND(14) SEAM(pb + 8); } \
    }
    MK_LAYER(0) MK_LAYER(1) MK_LAYER(2) MK_LAYER(3)
#undef MK_LAYER
#undef IN
#undef SEAM
}

extern "C" void kernel_launch(void* const* d_in, const int* in_sizes, int n_in, void* d_out, int out_size, void* d_ws, size_t ws_size, hipStream_t stream) {
    static int grid = 0;
    if (grid == 0) {
        if (n_in != 27 || in_sizes[0] != T * DM || out_size != T * DM || ws_size < WS_END) { fprintf(stderr, "kernel_launch: unexpected shapes (n_in %d, in0 %d, out %d, ws %zu)\n", n_in, n_in > 0 ? in_sizes[0] : -1, out_size, ws_size); grid = -1; return; }
        int dev = 0, cus = 0, per_cu = 0;
        if (hipGetDevice(&dev) != hipSuccess || hipDeviceGetAttribute(&cus, hipDeviceAttributeMultiprocessorCount, dev) != hipSuccess) { grid = -1; return; }
        if (hipFuncSetAttribute((const void*)mk_fwd, hipFuncAttributeMaxDynamicSharedMemorySize, LDS_BYTES) != hipSuccess) { fprintf(stderr, "kernel_launch: hipFuncSetAttribute failed\n"); grid = -1; return; }
        if (hipOccupancyMaxActiveBlocksPerMultiprocessor(&per_cu, (const void*)mk_fwd, NWAVES * 64, LDS_BYTES) != hipSuccess || per_cu < 1) fprintf(stderr, "kernel_launch: occupancy query reports %d\n", per_cu);
        (void)hipGetLastError();
        grid = cus;
        if (grid != 256) fprintf(stderr, "kernel_launch: %d CUs (built for 256)\n", grid);
    }
    if (grid < 0) return;
    if (hipMemsetAsync((char*)d_ws + WS_CTL, 0, CTL_ZERO_BYTES, stream) != hipSuccess) return;
    Args a{};
    for (int i = 0; i < 27; ++i) a.in[i] = (const float*)d_in[i];
    a.out = (float*)d_out; a.ws = (unsigned char*)d_ws;
#if MK_PER_PHASE
    for (int p = 0; p < N_PHASES; ++p) { a.ph_lo = p; a.ph_hi = p + 1; hipLaunchKernelGGL(mk_fwd, dim3(grid), dim3(NWAVES * 64), LDS_BYTES, stream, a); }
#else
    a.ph_lo = 0; a.ph_hi = N_PHASES;
    hipLaunchKernelGGL(mk_fwd, dim3(grid), dim3(NWAVES * 64), LDS_BYTES, stream, a);
#endif
    const hipError_t le = hipPeekAtLastError();
    if (le != hipSuccess) fprintf(stderr, "kernel_launch: launch failed: %s\n", hipGetErrorName(le));
}
```
